# Optimizing an MI355X kernel written in HIP

```python
import math
import numpy as np
import jax
import jax.numpy as jnp
from jax import lax

D_MODEL = 1024
BATCH = 2
SEQ = 16384
DEPTH = 2

GRID_W = 64
CTX_LEN = 256
BLK = 128
ROPE_BASE = 10000.0
NORM_EPS = 1e-6

A_HEADS = 8
A_KV_HEADS = 2
A_HD = 64
A_WINDOW = 128
B_HEADS = 4
B_HD = 128
B_CHUNK = 128
B_FORGET_BIAS = 3.0
C_HEADS = 4
C_Q_LORA = 512
C_KV_LORA = 256
C_NOPE = 128
C_ROPE = 64
C_VD = 128
D_HEADS = 4
D_HD = 64
D_VD = 2 * D_HD

N_BRANCH = 4
BRANCH_W = 512
FFN_HIDDEN = ((8 * D_MODEL + 3 * 256 - 1) // (3 * 256)) * 256

IN_SPLITS = (A_HEADS * A_HD, A_KV_HEADS * A_HD, A_KV_HEADS * A_HD,
             B_HEADS * B_HD, B_HEADS * B_HD, B_HEADS * B_HD, 4 * B_HEADS, B_HEADS * B_HD,
             C_Q_LORA, C_KV_LORA, C_ROPE,
             D_HEADS * 2 * D_HD, D_HEADS * 2 * D_HD, D_HEADS * D_VD,
             N_BRANCH * D_MODEL)
IN_OFFSETS = tuple(int(o) for o in np.cumsum(IN_SPLITS)[:-1])
D_IN = sum(IN_SPLITS)

kernel_name = 'hybrid_gated_parallel_mixer_dit'


def rmsnorm(x, g):
    xf = x.astype(jnp.float32)
    y = xf * lax.rsqrt(jnp.mean(xf * xf, axis=-1, keepdims=True) + NORM_EPS)
    return (y * g.astype(jnp.float32)).astype(x.dtype)


def modulate(x, shift, scale):
    return x * (1 + scale) + shift


def swiglu(u, w_gate_up, w_down):
    gate, up = jnp.split(u @ w_gate_up, 2, axis=-1)
    return (jax.nn.silu(gate) * up) @ w_down


def axial_rope_tables(n_rows, dim, dtype):
    row = jnp.repeat(jnp.arange(n_rows, dtype=jnp.float32), GRID_W)
    col = jnp.tile(jnp.arange(GRID_W, dtype=jnp.float32), n_rows)
    quarter = dim // 4
    inv_freq = ROPE_BASE ** (-jnp.arange(quarter, dtype=jnp.float32) / quarter)
    ang_r = row[:, None] * inv_freq
    ang_c = col[:, None] * inv_freq
    ang = jnp.concatenate([ang_r, ang_r, ang_c, ang_c], axis=-1)
    return jnp.cos(ang).astype(dtype), jnp.sin(ang).astype(dtype)


def rotate_axial(x):
    xs = x.reshape(x.shape[:-1] + (2, 2, x.shape[-1] // 4))
    return jnp.concatenate([-xs[..., 1:, :], xs[..., :1, :]], axis=-2).reshape(x.shape)


def apply_rope(x, cos, sin):
    shape = (cos.shape[0],) + (1,) * (x.ndim - 3) + (cos.shape[1],)
    return x * cos.reshape(shape) + rotate_axial(x) * sin.reshape(shape)


def joint_softmax(scores, sink=None):
    m = scores[0].max(axis=-1, keepdims=True)
    for s in scores[1:]:
        m = jnp.maximum(m, s.max(axis=-1, keepdims=True))
    if sink is not None:
        m = jnp.maximum(m, sink)
    e = [jnp.exp(s - m) for s in scores]
    den = sum(ei.sum(axis=-1, keepdims=True) for ei in e)
    if sink is not None:
        den = den + jnp.exp(sink - m)
    return [ei / den for ei in e]


def sweep_blocks(fn, *qs):
    b, n_tok = qs[0].shape[:2]
    nb = n_tok // BLK
    blocks = tuple(a.reshape((b, nb, BLK) + a.shape[2:]).swapaxes(0, 1) for a in qs)
    out = lax.map(lambda xs: fn(xs[0], *xs[1:]), (jnp.arange(nb),) + blocks)
    return out.swapaxes(0, 1).reshape((b, n_tok) + out.shape[3:])


def window_gqa(q, k, v, q_c, k_c, v_c, sink, with_ctx):
    n_tok = q.shape[1]
    group = A_HEADS // A_KV_HEADS
    scale = A_HD ** -0.5
    sink_f = sink.astype(jnp.float32).reshape(A_KV_HEADS, group)[None, :, :, None, None]
    span = BLK + 2 * A_WINDOW
    pad = ((0, 0), (A_WINDOW, A_WINDOW), (0, 0), (0, 0))
    k_pad, v_pad = jnp.pad(k, pad), jnp.pad(v, pad)

    def score(qg, kk):
        return jnp.einsum('bqhgd,bkhd->bhgqk', qg, kk, preferred_element_type=jnp.float32) * scale

    def values(p, vv):
        return jnp.einsum('bhgqk,bkhd->bqhgd', p.astype(vv.dtype), vv)

    def block(n, qg):
        start = n * BLK
        k_win = lax.dynamic_slice_in_dim(k_pad, start, span, axis=1)
        v_win = lax.dynamic_slice_in_dim(v_pad, start, span, axis=1)
        pos_q = start + jnp.arange(BLK)
        pos_k = start - A_WINDOW + jnp.arange(span)
        valid = ((jnp.abs(pos_k[None, :] - pos_q[:, None]) <= A_WINDOW)
                 & (pos_k[None, :] >= 0) & (pos_k[None, :] < n_tok))
        p_win, p_ctx = joint_softmax([jnp.where(valid, score(qg, k_win), -jnp.inf), score(qg, k_c)], sink_f)
        return values(p_win, v_win) + values(p_ctx, v_c)

    def grouped(a):
        return a.reshape(a.shape[:2] + (A_KV_HEADS, group, A_HD))

    flat = lambda o: o.reshape(o.shape[:2] + (-1,))
    y = flat(sweep_blocks(block, grouped(q)))
    y_c = None
    if with_ctx:
        qg_c = grouped(q_c)
        p_c = joint_softmax([score(qg_c, k_c)], sink_f)[0]
        y_c = flat(values(p_c, v_c))
    return y, y_c


def mlstm_chunkwise(q, k, v, ig, lf, state):
    b, n_tok = q.shape[:2]
    nc = n_tok // B_CHUNK
    tril = jnp.tril(jnp.ones((B_CHUNK, B_CHUNK), dtype=bool))

    def chunks(a):
        return a.reshape((b, nc, B_CHUNK) + a.shape[2:]).swapaxes(0, 1)

    def step(carry, xs):
        c_prev, n_prev, m_prev = carry
        qc, kc, vc, ic, fc = xs
        bcum = jnp.cumsum(fc, axis=1).transpose(0, 2, 1)
        it = ic.transpose(0, 2, 1)
        dmat = jnp.where(tril, bcum[..., :, None] - bcum[..., None, :] + it[..., None, :], -jnp.inf)
        m_t = jnp.maximum(bcum + m_prev[..., None], dmat.max(axis=-1))
        w = jnp.exp(dmat - m_t[..., None])
        wqk = w * jnp.einsum('bthd,bshd->bhts', qc, kc)
        a = jnp.exp(bcum + m_prev[..., None] - m_t)
        num = (jnp.einsum('bhts,bshv->bhtv', wqk, vc)
               + a[..., None] * jnp.einsum('bhvd,bthd->bhtv', c_prev, qc))
        den = wqk.sum(axis=-1) + a * jnp.einsum('bhd,bthd->bht', n_prev, qc)
        h = num / jnp.maximum(jnp.abs(den), jnp.exp(-m_t))[..., None]
        b_last = bcum[..., -1]
        g = b_last[..., None] - bcum + it
        m_new = jnp.maximum(b_last + m_prev, g.max(axis=-1))
        decay = jnp.exp(b_last + m_prev - m_new)
        ws = jnp.exp(g - m_new[..., None])
        c_new = decay[..., None, None] * c_prev + jnp.einsum('bhs,bshv,bshd->bhvd', ws, vc, kc)
        n_new = decay[..., None] * n_prev + jnp.einsum('bhs,bshd->bhd', ws, kc)
        return (c_new, n_new, m_new), h.transpose(0, 2, 1, 3)

    state, hs = lax.scan(step, state, tuple(chunks(a) for a in (q, k, v, ig, lf)))
    return hs.swapaxes(0, 1).reshape((b, n_tok) + hs.shape[3:]), state


def mlstm_bidir(q, k, v, gate_pre, o_pre, q_c, k_c, v_c, gate_pre_c, o_pre_c, gate_bias, with_ctx):
    f32 = jnp.float32

    def prep(qq, kk, vv, gp):
        g = (gp.astype(f32) + gate_bias.astype(f32)).reshape(gp.shape[:2] + (4, B_HEADS))
        qkv = (qq.astype(f32), kk.astype(f32) * B_HD ** -0.5, vv.astype(f32))
        fwd = (g[:, :, 0], jax.nn.log_sigmoid(g[:, :, 1]))
        bwd = (g[:, :, 2], jax.nn.log_sigmoid(g[:, :, 3]))
        return qkv, fwd, bwd

    def run(qkv, gates, state, reverse):
        arrs = qkv + gates
        if reverse:
            arrs = tuple(jnp.flip(a, axis=1) for a in arrs)
        h, st = mlstm_chunkwise(*arrs, state)
        return (jnp.flip(h, axis=1) if reverse else h), st

    b = q.shape[0]
    zero = (jnp.zeros((b, B_HEADS, B_HD, B_HD), f32), jnp.zeros((b, B_HEADS, B_HD), f32),
            jnp.zeros((b, B_HEADS), f32))
    qkv_c, fwd_c, bwd_c = prep(q_c, k_c, v_c, gate_pre_c)
    h_cf, st_f = run(qkv_c, fwd_c, zero, False)
    h_cb, st_b = run(qkv_c, bwd_c, zero, True)
    qkv, fwd, bwd = prep(q, k, v, gate_pre)
    h_f, _ = run(qkv, fwd, st_f, False)
    h_b, _ = run(qkv, bwd, st_b, True)

    def out(h, o):
        return jax.nn.sigmoid(o) * h.reshape(h.shape[:2] + (-1,)).astype(o.dtype)

    y = out(h_f + h_b, o_pre)
    y_c = out(h_cf + h_cb, o_pre_c) if with_ctx else None
    return y, y_c


def mla_attn(q_nope, q_rope, k_nope, k_rope, v, q_nope_c, q_rope_c, k_nope_c, k_rope_c, v_c, with_ctx):
    scale = (C_NOPE + C_ROPE) ** -0.5

    def score(qn, qr, kn, kr):
        return (jnp.einsum('bqhd,bkhd->bhqk', qn, kn, preferred_element_type=jnp.float32)
                + jnp.einsum('bqhr,bkr->bhqk', qr, kr, preferred_element_type=jnp.float32)) * scale

    def attend(qn, qr, key_sets):
        p = joint_softmax([score(qn, qr, kn, kr) for kn, kr, _ in key_sets])
        return sum(jnp.einsum('bhqk,bkhv->bqhv', pi.astype(vv.dtype), vv) for pi, (_, _, vv) in zip(p, key_sets))

    ctx_set = (k_nope_c, k_rope_c, v_c)
    lat_sets = [(k_nope, k_rope, v), ctx_set]
    flat = lambda o: o.reshape(o.shape[:2] + (-1,))
    y = flat(sweep_blocks(lambda n, qn, qr: attend(qn, qr, lat_sets), q_nope, q_rope))
    y_c = flat(attend(q_nope_c, q_rope_c, [ctx_set])) if with_ctx else None
    return y, y_c


def diff_attn(q, k, v, q_c, k_c, v_c, lam, lam_init, g_sub, with_ctx):
    scale = D_HD ** -0.5

    def score(qm, km):
        return jnp.einsum('bqhd,bkhd->bhqk', qm, km, preferred_element_type=jnp.float32) * scale

    def attend(q1, q2, key_sets):
        p1 = joint_softmax([score(q1, k1) for k1, _, _ in key_sets])
        p2 = joint_softmax([score(q2, k2) for _, k2, _ in key_sets])
        return sum(jnp.einsum('bhqk,bkhv->bqhv', (a1 - lam * a2).astype(vv.dtype), vv)
                   for a1, a2, (_, _, vv) in zip(p1, p2, key_sets))

    def post(o):
        return (rmsnorm(o, g_sub) * (1 - lam_init)).reshape(o.shape[:2] + (-1,))

    ctx_set = (k_c[:, :, :, 0], k_c[:, :, :, 1], v_c)
    lat_sets = [(k[:, :, :, 0], k[:, :, :, 1], v), ctx_set]
    y = post(sweep_blocks(lambda n, q1, q2: attend(q1, q2, lat_sets), q[:, :, :, 0], q[:, :, :, 1]))
    y_c = post(attend(q_c[:, :, :, 0], q_c[:, :, :, 1], [ctx_set])) if with_ctx else None
    return y, y_c


def mixer_inputs(parts, ropes, c_g_q, c_g_kv, c_w_uq, c_w_uk, c_w_uv):
    (pa_q, pa_k, pa_v, pb_q, pb_k, pb_v, pb_g, pb_o, pc_q, pc_kv, pc_kr, pd_q, pd_k, pd_v, p_gate) = parts

    def heads(a, *shape):
        return a.reshape(a.shape[:2] + shape)

    def rope(a, dim):
        return a if ropes is None else apply_rope(a, *ropes[dim])

    cq = heads(rmsnorm(pc_q, c_g_q) @ c_w_uq, C_HEADS, C_NOPE + C_ROPE)
    ckv = rmsnorm(pc_kv, c_g_kv)
    return {
        'a_q': rope(heads(pa_q, A_HEADS, A_HD), A_HD),
        'a_k': rope(heads(pa_k, A_KV_HEADS, A_HD), A_HD),
        'a_v': heads(pa_v, A_KV_HEADS, A_HD),
        'b_q': heads(pb_q, B_HEADS, B_HD),
        'b_k': heads(pb_k, B_HEADS, B_HD),
        'b_v': heads(pb_v, B_HEADS, B_HD),
        'b_gates': pb_g,
        'b_o': pb_o,
        'c_qn': cq[..., :C_NOPE],
        'c_qr': rope(cq[..., C_NOPE:], C_ROPE),
        'c_kn': heads(ckv @ c_w_uk, C_HEADS, C_NOPE),
        'c_kr': rope(pc_kr, C_ROPE),
        'c_v': heads(ckv @ c_w_uv, C_HEADS, C_VD),
        'd_q': rope(heads(pd_q, D_HEADS, 2, D_HD), D_HD),
        'd_k': rope(heads(pd_k, D_HEADS, 2, D_HD), D_HD),
        'd_v': heads(pd_v, D_HEADS, D_VD),
        'gates': p_gate,
    }


def merge_branches(ys, gate_logits, w_branch, w_out):
    g = jax.nn.sigmoid(gate_logits.reshape(gate_logits.shape[:2] + (N_BRANCH, D_MODEL)))
    merged = sum(g[:, :, i] * (y @ w_branch[i]) for i, y in enumerate(ys))
    return merged @ w_out


def token_mixers(u, uc, w_in, a_sink, b_gate_bias, c_g_q, c_g_kv, c_w_uq, c_w_uk, c_w_uv, d_g_sub,
                 w_branch, w_out, lam, lam_init, ropes, with_ctx):
    mla_w = (c_g_q, c_g_kv, c_w_uq, c_w_uk, c_w_uv)
    t = mixer_inputs(jnp.split(u @ w_in, IN_OFFSETS, axis=-1), ropes, *mla_w)
    s = mixer_inputs(jnp.split(uc @ w_in, IN_OFFSETS, axis=-1), None, *mla_w)
    y_a, y_a_c = window_gqa(t['a_q'], t['a_k'], t['a_v'], s['a_q'], s['a_k'], s['a_v'], a_sink, with_ctx)
    y_b, y_b_c = mlstm_bidir(t['b_q'], t['b_k'], t['b_v'], t['b_gates'], t['b_o'],
                             s['b_q'], s['b_k'], s['b_v'], s['b_gates'], s['b_o'], b_gate_bias, with_ctx)
    y_c, y_c_c = mla_attn(t['c_qn'], t['c_qr'], t['c_kn'], t['c_kr'], t['c_v'],
                          s['c_qn'], s['c_qr'], s['c_kn'], s['c_kr'], s['c_v'], with_ctx)
    y_d, y_d_c = diff_attn(t['d_q'], t['d_k'], t['d_v'], s['d_q'], s['d_k'], s['d_v'],
                           lam, lam_init, d_g_sub, with_ctx)
    y = merge_branches((y_a, y_b, y_c, y_d), t['gates'], w_branch, w_out)
    y_ctx = merge_branches((y_a_c, y_b_c, y_c_c, y_d_c), s['gates'], w_branch, w_out) if with_ctx else None
    return y, y_ctx


def setup_inputs(seed: int = 0) -> dict:
    key = jax.random.key(seed)
    ks = iter(jax.random.split(key, 32))
    f32 = jnp.float32

    def nrm(shape, scale):
        return jax.random.normal(next(ks), shape, f32) * scale

    def gain(shape):
        return 1.0 + nrm(shape, 0.05)

    L = DEPTH
    forget_offset = jnp.repeat(jnp.array([0.0, B_FORGET_BIAS, 0.0, B_FORGET_BIAS], f32), B_HEADS)
    return {
        'x': nrm((BATCH, SEQ, D_MODEL), 1.0),
        'c': nrm((BATCH, D_MODEL), 1.0),
        'ctx': nrm((BATCH, CTX_LEN, D_MODEL), 1.0),
        'c_ctx': nrm((D_MODEL,), 1.0),
        'w_mod': nrm((L, D_MODEL, 6 * D_MODEL), 0.5 * D_MODEL ** -0.5),
        'b_mod': nrm((L, 6 * D_MODEL), 0.01),
        'g_mix_pre': gain((L, D_MODEL)),
        'g_mix_post': gain((L, D_MODEL)),
        'g_ffn_pre': gain((L, D_MODEL)),
        'g_ffn_post': gain((L, D_MODEL)),
        'w_in': nrm((L, D_MODEL, D_IN), D_MODEL ** -0.5),
        'a_sink': nrm((L, A_HEADS), 1.0),
        'b_gate_bias': nrm((L, 4 * B_HEADS), 0.1) + forget_offset,
        'c_g_q': gain((L, C_Q_LORA)),
        'c_g_kv': gain((L, C_KV_LORA)),
        'c_w_uq': nrm((L, C_Q_LORA, C_HEADS * (C_NOPE + C_ROPE)), C_Q_LORA ** -0.5),
        'c_w_uk': nrm((L, C_KV_LORA, C_HEADS * C_NOPE), C_KV_LORA ** -0.5),
        'c_w_uv': nrm((L, C_KV_LORA, C_HEADS * C_VD), C_KV_LORA ** -0.5),
        'd_lam_q1': nrm((L, D_HD), 0.1),
        'd_lam_k1': nrm((L, D_HD), 0.1),
        'd_lam_q2': nrm((L, D_HD), 0.1),
        'd_lam_k2': nrm((L, D_HD), 0.1),
        'd_g_sub': gain((L, D_VD)),
        'w_branch': nrm((L, N_BRANCH, BRANCH_W, D_MODEL), BRANCH_W ** -0.5),
        'w_out': nrm((L, D_MODEL, D_MODEL), D_MODEL ** -0.5),
        'w_gate_up': nrm((L, D_MODEL, 2 * FFN_HIDDEN), D_MODEL ** -0.5),
        'w_down': nrm((L, FFN_HIDDEN, D_MODEL), FFN_HIDDEN ** -0.5),
    }


def reference(x, c, ctx, c_ctx, w_mod, b_mod, g_mix_pre, g_mix_post, g_ffn_pre, g_ffn_post, w_in, a_sink,
              b_gate_bias, c_g_q, c_g_kv, c_w_uq, c_w_uk, c_w_uv, d_lam_q1, d_lam_k1, d_lam_q2, d_lam_k2,
              d_g_sub, w_branch, w_out, w_gate_up, w_down):
    f32 = jnp.float32
    n_rows = x.shape[1] // GRID_W
    ropes = {dim: axial_rope_tables(n_rows, dim, x.dtype) for dim in sorted({A_HD, C_ROPE, D_HD})}
    silu_c = jax.nn.silu(c)
    silu_cc = jax.nn.silu(c_ctx)
    h, hc = x, ctx
    for l in range(DEPTH):
        with_ctx = l < DEPTH - 1
        mod = jnp.split((silu_c @ w_mod[l] + b_mod[l])[:, None, :], 6, axis=-1)
        modc = jnp.split(silu_cc @ w_mod[l] + b_mod[l], 6, axis=-1)
        lam_init = 0.8 - 0.6 * math.exp(-0.3 * l)
        lam = (jnp.exp(jnp.sum(d_lam_q1[l].astype(f32) * d_lam_k1[l].astype(f32)))
               - jnp.exp(jnp.sum(d_lam_q2[l].astype(f32) * d_lam_k2[l].astype(f32))) + lam_init)
        u = modulate(rmsnorm(h, g_mix_pre[l]), mod[0], mod[1])
        uc = modulate(rmsnorm(hc, g_mix_pre[l]), modc[0], modc[1])
        y, y_ctx = token_mixers(u, uc, w_in[l], a_sink[l], b_gate_bias[l], c_g_q[l], c_g_kv[l], c_w_uq[l],
                                c_w_uk[l], c_w_uv[l], d_g_sub[l], w_branch[l], w_out[l], lam, lam_init,
                                ropes, with_ctx)
        h = h + mod[2] * rmsnorm(y, g_mix_post[l])
        u = modulate(rmsnorm(h, g_ffn_pre[l]), mod[3], mod[4])
        h = h + mod[5] * rmsnorm(swiglu(u, w_gate_up[l], w_down[l]), g_ffn_post[l])
        if with_ctx:
            hc = hc + modc[2] * rmsnorm(y_ctx, g_mix_post[l])
            uc = modulate(rmsnorm(hc, g_ffn_pre[l]), modc[3], modc[4])
            hc = hc + modc[5] * rmsnorm(swiglu(uc, w_gate_up[l], w_down[l]), g_ffn_post[l])
    return h
```

```cpp
#include <hip/hip_runtime.h>
#include <hip/hip_bf16.h>
#include <cstdio>
#include <cstdint>
#include <cmath>

#define LAS __attribute__((address_space(3)))
#define GAS __attribute__((address_space(1)))
typedef unsigned short bf16_t;
typedef short bf16x8 __attribute__((ext_vector_type(8)));
typedef short s16x4 __attribute__((ext_vector_type(4)));
typedef float f32x4 __attribute__((ext_vector_type(4)));
typedef float f32x2 __attribute__((ext_vector_type(2)));
typedef float f32x16 __attribute__((ext_vector_type(16)));
typedef unsigned u32x4 __attribute__((ext_vector_type(4)));
typedef unsigned u32x2 __attribute__((ext_vector_type(2)));

__device__ __forceinline__ unsigned cvt_pk_bf16(float lo, float hi) { unsigned r; asm volatile("v_cvt_pk_bf16_f32 %0, %1, %2" : "=v"(r) : "v"(lo), "v"(hi)); return r; }
__device__ __forceinline__ bf16_t f2bf(float f) { return (bf16_t)(cvt_pk_bf16(f, 0.f) & 0xffffu); }
__device__ __forceinline__ float bf2f(bf16_t v) { return __uint_as_float(((unsigned)v) << 16); }
__device__ __forceinline__ float bflo(unsigned w) { return __uint_as_float(w << 16); }
__device__ __forceinline__ float bfhi(unsigned w) { return __uint_as_float(w & 0xffff0000u); }
__device__ __forceinline__ float sigmoidf_(float x) { return 1.f / (1.f + __expf(-x)); }

namespace pg8 {
constexpr int BM = 256, BK = 64, HALF = 128, HTB = HALF * BK * 2, STAGE_BYTES = 8 * HTB, NXCD = 8, WGM = 8;
__host__ __device__ __forceinline__ int lds_byte(int r, int c) { const int st = (r >> 4) * 2 + (c >> 5), rr = r & 15, cc = c & 31, ob = rr * 64 + cc * 2; return st * 1024 + (ob ^ (((ob >> 9) & 1) << 5)); }
__host__ __device__ __forceinline__ void stage_rc(int b, int& R, int& C) { const int st = b / 1024, sb = b % 1024, swz = sb ^ (((sb >> 9) & 1) << 5); R = (st >> 1) * 16 + swz / 64; C = (st & 1) * 32 + (swz % 64) / 2; }
__host__ __device__ __forceinline__ int perm32(int rho) { const int n = rho >> 4, i = rho & 15; return 8 * (i >> 2) + 4 * n + (i & 3); }

struct Unit { int pm, pn; };
struct Gemm { const bf16_t* A; const bf16_t* Bt; int M, N, K, lda, ldb; };

struct StaticOrder {
    int nM, nN, nwg, G, c;
    __host__ __device__ void init(int M, int N, int G_, int c_) { nM = M / BM; nN = N / BM; nwg = nM * nN; G = G_; c = c_; }
    __host__ __device__ bool next(int i, Unit& u) const {
        const long L = (long)i * G + c; if (L >= nwg) return false;
        int wgid = (int)L; { const int q = nwg / NXCD, r = nwg % NXCD, xcd = wgid % NXCD, off = wgid / NXCD; wgid = (xcd < r ? xcd * (q + 1) : r * (q + 1) + (xcd - r) * q) + off; }
        const int nig = WGM * nN, gid = wgid / nig, fm = gid * WGM, gsz = (nM - fm) < WGM ? (nM - fm) : WGM;
        u.pm = fm + ((wgid % nig) % gsz); u.pn = (wgid % nig) / gsz; return true;
    }
};

enum { EM_BF16 = 0, EM_SIG = 1, EM_SWIGLU = 2, EM_GATEACC = 3 };
template <int MODE> struct EpiB {
    static constexpr bool PERM = true;
    bf16_t* O; int ldc;
    const bf16_t* G; int ldg; int gcol0; int first;
    __device__ __forceinline__ void operator()(const f32x4 (&acc)[2][2][4][2], const Unit& u, int wr, int wc, int fr, int fq) const {
        const int row0 = u.pm * BM + wr * 64 + fr;
        if constexpr (MODE == EM_SWIGLU) {
            const int col0 = u.pn * HALF + wc * 32 + 8 * fq;
#pragma unroll
            for (int ai = 0; ai < 2; ++ai)
#pragma unroll
                for (int m = 0; m < 4; ++m) { bf16_t* rowp = O + (size_t)(row0 + ai * HALF + m * 16) * ldc + col0;
                    float v[8];
#pragma unroll
                    for (int n = 0; n < 2; ++n)
#pragma unroll
                        for (int j = 0; j < 4; ++j) { const float g = acc[ai][0][m][n][j], up = acc[ai][1][m][n][j]; v[n * 4 + j] = g * sigmoidf_(g) * up; }
                    u32x4 w; w.x = cvt_pk_bf16(v[0], v[1]); w.y = cvt_pk_bf16(v[2], v[3]); w.z = cvt_pk_bf16(v[4], v[5]); w.w = cvt_pk_bf16(v[6], v[7]);
                    *(u32x4*)rowp = w; }
        } else {
            const int col0 = u.pn * BM + wc * 32 + 8 * fq;
#pragma unroll
            for (int ai = 0; ai < 2; ++ai)
#pragma unroll
                for (int m = 0; m < 4; ++m) { const size_t r = (size_t)(row0 + ai * HALF + m * 16); bf16_t* rowp = O + r * ldc + col0;
#pragma unroll
                    for (int bj = 0; bj < 2; ++bj) { f32x4 v0 = acc[ai][bj][m][0], v1 = acc[ai][bj][m][1];
                        if constexpr (MODE == EM_SIG) {
#pragma unroll
                            for (int j = 0; j < 4; ++j) { v0[j] = sigmoidf_(v0[j]); v1[j] = sigmoidf_(v1[j]); } }
                        if constexpr (MODE == EM_GATEACC) {
                            const u32x4 gw = *(const u32x4*)(G + r * ldg + gcol0 + col0 + bj * HALF);
                            v0[0] *= bflo(gw.x); v0[1] *= bfhi(gw.x); v0[2] *= bflo(gw.y); v0[3] *= bfhi(gw.y);
                            v1[0] *= bflo(gw.z); v1[1] *= bfhi(gw.z); v1[2] *= bflo(gw.w); v1[3] *= bfhi(gw.w);
                            if (!first) { const u32x4 ow = *(const u32x4*)(rowp + bj * HALF);
                                v0[0] += bflo(ow.x); v0[1] += bfhi(ow.x); v0[2] += bflo(ow.y); v0[3] += bfhi(ow.y);
                                v1[0] += bflo(ow.z); v1[1] += bfhi(ow.z); v1[2] += bflo(ow.w); v1[3] += bfhi(ow.w); } }
                        u32x4 w; w.x = cvt_pk_bf16(v0[0], v0[1]); w.y = cvt_pk_bf16(v0[2], v0[3]); w.z = cvt_pk_bf16(v1[0], v1[1]); w.w = cvt_pk_bf16(v1[2], v1[3]);
                        *(u32x4*)(rowp + bj * HALF) = w; } }
        }
    }
};
struct EpiF32 {
    static constexpr bool PERM = false;
    float* O; int ldc;
    __device__ __forceinline__ void operator()(const f32x4 (&acc)[2][2][4][2], const Unit& u, int wr, int wc, int fr, int fq) const {
        const int row0 = u.pm * BM + wr * 64 + fr, col0 = u.pn * BM + wc * 32 + 4 * fq;
#pragma unroll
        for (int ai = 0; ai < 2; ++ai)
#pragma unroll
            for (int m = 0; m < 4; ++m) { float* rowp = O + (size_t)(row0 + ai * HALF + m * 16) * ldc + col0;
#pragma unroll
                for (int bj = 0; bj < 2; ++bj)
#pragma unroll
                    for (int n = 0; n < 2; ++n) *(f32x4*)(rowp + bj * HALF + n * 16) = acc[ai][bj][m][n]; }
    }
};

template <class Epi, bool ALIGN_EPI = true>
__device__ __forceinline__ void gemm_phase(LAS unsigned char* lds, const Gemm g, const StaticOrder& S, const Epi& E) {
    const int tid = threadIdx.x, wid = __builtin_amdgcn_readfirstlane(tid >> 6), lane = tid & 63, wr = wid >> 2, wc = wid & 3, fr = lane & 15, fq = lane >> 4;
    const int K = g.K, nt = K / BK;
    unsigned voffA[2], voffB[2];
#pragma unroll
    for (int i = 0; i < 2; ++i) { int R, C; stage_rc(tid * 16 + i * 8192, R, C); const int Rb = Epi::PERM ? ((R & ~31) + perm32(R & 31)) : R;
        voffA[i] = (unsigned)(R * g.lda + C) * 2u; voffB[i] = (unsigned)(Rb * g.ldb + C) * 2u; }
    const size_t kstep = (size_t)(BK * 2);
    const size_t hstepA = (size_t)HALF * g.lda * 2, hstepB = (size_t)HALF * g.ldb * 2;
    const size_t tstepA = 2 * hstepA, tstepB = 2 * hstepB;
    const unsigned ldsw = (unsigned)wid * 1024u;
    const int aoff = lds_byte(wr * 64 + fr, fq * 8), boff = lds_byte(wc * 32 + fr, fq * 8);
#define PG8_SA(b, h) (((b) * 2 + (h)) * HTB)
#define PG8_SB(b, h) ((4 + (b) * 2 + (h)) * HTB)
#define PG8_STAGE(bufoff, gbase, voff) do { _Pragma("unroll") for (int _i = 0; _i < 2; ++_i) \
        __builtin_amdgcn_global_load_lds((const unsigned*)((const char*)(gbase) + (voff)[_i]), (LAS unsigned*)(lds + (bufoff) + ldsw + _i * 8192), 16, 0, 0); } while (0)
#define PG8_LDA(dst, b, h) do { _Pragma("unroll") for (int m = 0; m < 4; ++m) _Pragma("unroll") for (int k = 0; k < 2; ++k) dst[m][k] = *(const LAS bf16x8*)(lds + PG8_SA(b, h) + aoff + m * 2048 + k * 1024); } while (0)
#define PG8_LDB(dst, b, h) do { _Pragma("unroll") for (int n = 0; n < 2; ++n) _Pragma("unroll") for (int k = 0; k < 2; ++k) dst[n][k] = *(const LAS bf16x8*)(lds + PG8_SB(b, h) + boff + n * 2048 + k * 1024); } while (0)
#define PG8_MMA(ai, bj, At, Bt) do { __builtin_amdgcn_s_setprio(1); _Pragma("unroll") for (int m = 0; m < 4; ++m) _Pragma("unroll") for (int n = 0; n < 2; ++n) _Pragma("unroll") for (int k = 0; k < 2; ++k) \
        acc[ai][bj][m][n] = __builtin_amdgcn_mfma_f32_16x16x32_bf16(Bt[n][k], At[m][k], acc[ai][bj][m][n], 0, 0, 0); __builtin_amdgcn_s_setprio(0); } while (0)
#define PG8_WAIT_V(n) asm volatile("s_waitcnt vmcnt(" #n ")" ::: "memory")
#define PG8_WAIT_L(n) asm volatile("s_waitcnt lgkmcnt(" #n ")" ::: "memory")
#define PG8_BAR __builtin_amdgcn_s_barrier()
#define PG8_SCHED __builtin_amdgcn_sched_barrier(0)
    Unit cur, nxt; int ui = 0;
    if (!S.next(0, cur)) return;
    f32x4 acc[2][2][4][2];
#pragma unroll
    for (int a = 0; a < 2; ++a)
#pragma unroll
        for (int b = 0; b < 2; ++b)
#pragma unroll
            for (int m = 0; m < 4; ++m)
#pragma unroll
                for (int n = 0; n < 2; ++n) acc[a][b][m][n] = (f32x4){0.f, 0.f, 0.f, 0.f};
    bf16x8 At[4][2], B0[2][2], B1[2][2];
    const char* cA = (const char*)g.A + (size_t)cur.pm * tstepA; const char* cB = (const char*)g.Bt + (size_t)cur.pn * tstepB;
    PG8_STAGE(PG8_SB(0, 0), cB, voffB); PG8_STAGE(PG8_SB(0, 1), cB + hstepB, voffB); PG8_STAGE(PG8_SA(0, 0), cA, voffA); PG8_STAGE(PG8_SA(0, 1), cA + hstepA, voffA);
    if (wr == 1) PG8_BAR;
    PG8_WAIT_V(2); PG8_BAR;
    PG8_STAGE(PG8_SB(1, 0), cB + kstep, voffB); PG8_STAGE(PG8_SA(1, 0), cA + kstep, voffA); PG8_STAGE(PG8_SB(1, 1), cB + hstepB + kstep, voffB);
    PG8_WAIT_V(6); PG8_BAR;
    for (;;) {
        const bool has_next = S.next(ui + 1, nxt);
        const char* nA = has_next ? (const char*)g.A + (size_t)nxt.pm * tstepA : cA; const char* nB = has_next ? (const char*)g.Bt + (size_t)nxt.pn * tstepB : cB;
        for (int t = 0; t < nt; t += 2) {
            const bool last = (t == nt - 2);
            const char* a1 = cA + (size_t)(t + 1) * kstep;
            const char* a2 = last ? nA : cA + (size_t)(t + 2) * kstep; const char* b2 = last ? nB : cB + (size_t)(t + 2) * kstep;
            const char* a3 = a2 + kstep; const char* b3 = b2 + kstep;
            PG8_LDB(B0, 0, 0); PG8_LDB(B1, 0, 1); PG8_SCHED; PG8_LDA(At, 0, 0); PG8_STAGE(PG8_SA(1, 1), a1 + hstepA, voffA);
            PG8_WAIT_V(8); PG8_WAIT_L(0); PG8_BAR; PG8_MMA(0, 0, At, B0); PG8_MMA(0, 1, At, B1); PG8_BAR; PG8_SCHED;
            PG8_LDA(At, 0, 1); PG8_STAGE(PG8_SB(0, 0), b2, voffB); PG8_STAGE(PG8_SB(0, 1), b2 + hstepB, voffB); PG8_STAGE(PG8_SA(0, 0), a2, voffA);
            PG8_WAIT_V(8); PG8_WAIT_L(0); PG8_BAR; PG8_MMA(1, 0, At, B0); PG8_MMA(1, 1, At, B1); PG8_BAR; PG8_SCHED;
            PG8_LDB(B0, 1, 0); PG8_LDB(B1, 1, 1); PG8_SCHED; PG8_LDA(At, 1, 0); PG8_STAGE(PG8_SA(0, 1), a2 + hstepA, voffA);
            PG8_WAIT_V(8); PG8_WAIT_L(0); PG8_BAR; PG8_MMA(0, 0, At, B0); PG8_MMA(0, 1, At, B1); PG8_BAR; PG8_SCHED;
            PG8_LDA(At, 1, 1); PG8_STAGE(PG8_SB(1, 0), b3, voffB); PG8_STAGE(PG8_SB(1, 1), b3 + hstepB, voffB); PG8_STAGE(PG8_SA(1, 0), a3, voffA);
            PG8_WAIT_V(8); PG8_WAIT_L(0); PG8_BAR; PG8_MMA(1, 0, At, B0); PG8_MMA(1, 1, At, B1); PG8_BAR; PG8_SCHED;
        }
        if constexpr (ALIGN_EPI) { if (wr == 0) PG8_BAR; }
        E(acc, cur, wr, wc, fr, fq);
        if (!has_next) break;
#pragma unroll
        for (int a = 0; a < 2; ++a)
#pragma unroll
            for (int b = 0; b < 2; ++b)
#pragma unroll
                for (int m = 0; m < 4; ++m)
#pragma unroll
                    for (int n = 0; n < 2; ++n) acc[a][b][m][n] = (f32x4){0.f, 0.f, 0.f, 0.f};
        cur = nxt; cA = nA; cB = nB; ++ui;
        if constexpr (ALIGN_EPI) { if (wr == 1) PG8_BAR; }
    }
    PG8_WAIT_V(0);
    if constexpr (!ALIGN_EPI) { if (wr == 0) PG8_BAR; }
    PG8_BAR;
#undef PG8_SA
#undef PG8_SB
#undef PG8_STAGE
#undef PG8_LDA
#undef PG8_LDB
#undef PG8_MMA
#undef PG8_WAIT_V
#undef PG8_WAIT_L
#undef PG8_BAR
#undef PG8_SCHED
}
}

namespace att {
#define SBAR() __builtin_amdgcn_sched_barrier(0)
constexpr int KVBLK = 64;
constexpr int SHM_V = KVBLK * 128 * 2;
__device__ __forceinline__ int crow(int r, int hi) { return (r & 3) + 8 * (r >> 2) + 4 * hi; }
__device__ __forceinline__ int v_st(int k, int c) { const int kk = (k & ~0xC) | ((k & 4) << 1) | ((k & 8) >> 1); return ((kk >> 3) * 4 + (c >> 5)) * 512 + ((kk & 7) * 32 + (c & 31)) * 2; }
__device__ __forceinline__ int v_rd_base(int lane) { return ((lane & 3) << 3) | (((lane >> 2) & 3) << 6) | (((lane >> 4) & 1) << 5) | (((lane >> 5) & 1) << 8); }
constexpr int v_rd_off(int d0, int ks, int half) { return d0 * 512 + ks * 4096 + half * 2048; }
template <int OFF> __device__ __forceinline__ s16x4 tr_read(int vb) {
  s16x4 r; asm volatile("ds_read_b64_tr_b16 %0, %1 offset:%2" : "=&v"(r) : "v"(vb), "i"(OFF) : "memory"); return r;
}
template <int D0> __device__ __forceinline__ void pv_one(f32x16& od, int vb, bf16x8 pa0, bf16x8 pa1, bf16x8 pa2, bf16x8 pa3) {
  const s16x4 l0 = tr_read<v_rd_off(D0, 0, 0)>(vb), h0 = tr_read<v_rd_off(D0, 0, 1)>(vb), l1 = tr_read<v_rd_off(D0, 1, 0)>(vb), h1 = tr_read<v_rd_off(D0, 1, 1)>(vb);
  const s16x4 l2 = tr_read<v_rd_off(D0, 2, 0)>(vb), h2 = tr_read<v_rd_off(D0, 2, 1)>(vb), l3 = tr_read<v_rd_off(D0, 3, 0)>(vb), h3 = tr_read<v_rd_off(D0, 3, 1)>(vb);
  asm volatile("s_waitcnt lgkmcnt(0)" ::: "memory"); SBAR();
#define PK(L, H) (bf16x8){L[0], L[1], L[2], L[3], H[0], H[1], H[2], H[3]}
  od = __builtin_amdgcn_mfma_f32_32x32x16_bf16(pa0, PK(l0, h0), od, 0, 0, 0);
  od = __builtin_amdgcn_mfma_f32_32x32x16_bf16(pa1, PK(l1, h1), od, 0, 0, 0);
  od = __builtin_amdgcn_mfma_f32_32x32x16_bf16(pa2, PK(l2, h2), od, 0, 0, 0);
  od = __builtin_amdgcn_mfma_f32_32x32x16_bf16(pa3, PK(l3, h3), od, 0, 0, 0);
#undef PK
}
__device__ __forceinline__ void pv_d0(f32x16* o, int vb, bf16x8 pa0, bf16x8 pa1, bf16x8 pa2, bf16x8 pa3) {
  pv_one<0>(o[0], vb, pa0, pa1, pa2, pa3); pv_one<1>(o[1], vb, pa0, pa1, pa2, pa3); pv_one<2>(o[2], vb, pa0, pa1, pa2, pa3); pv_one<3>(o[3], vb, pa0, pa1, pa2, pa3);
}
__device__ __forceinline__ void partialSM(f32x16& p0, f32x16& p1, float& m_reg, float& mn, float& alpha, const float C, const float thr_raw) {
  float pmax = p0[0];
#pragma unroll
  for (int r = 1; r < 16; ++r) pmax = fmaxf(pmax, p0[r]);
#pragma unroll
  for (int r = 0; r < 16; ++r) pmax = fmaxf(pmax, p1[r]);
  { auto rr = __builtin_amdgcn_permlane32_swap(__float_as_uint(pmax), __float_as_uint(pmax), false, false);
    pmax = fmaxf(__uint_as_float(rr[0]), __uint_as_float(rr[1])); }
  if (__builtin_expect(__all(pmax - m_reg <= thr_raw), 1)) { mn = m_reg; alpha = 1.f; }
  else { mn = fmaxf(m_reg, pmax); alpha = __builtin_amdgcn_exp2f((m_reg - mn) * C); m_reg = mn; }
  const float mnC = -mn * C;
#pragma unroll
  for (int r = 0; r < 16; ++r) p0[r] = fmaf(p0[r], C, mnC);
#pragma unroll
  for (int r = 0; r < 16; ++r) p1[r] = fmaf(p1[r], C, mnC);
#pragma unroll
  for (int r = 0; r < 16; ++r) p0[r] = __builtin_amdgcn_exp2f(p0[r]);
}
__device__ __forceinline__ void finishSM(f32x16& p0, f32x16& p1, float alpha, float& l_reg, bf16x8& pa0, bf16x8& pa1, bf16x8& pa2, bf16x8& pa3) {
#pragma unroll
  for (int r = 0; r < 16; ++r) p1[r] = __builtin_amdgcn_exp2f(p1[r]);
  float ps = 0;
#pragma unroll
  for (int r = 0; r < 16; ++r) ps += p0[r];
#pragma unroll
  for (int r = 0; r < 16; ++r) ps += p1[r];
  { auto rr = __builtin_amdgcn_permlane32_swap(__float_as_uint(ps), __float_as_uint(ps), false, false);
    ps = __uint_as_float(rr[0]) + __uint_as_float(rr[1]); }
  l_reg = l_reg * alpha + ps;
#define PK4(P, BASE, OUT) do { unsigned a0 = cvt_pk_bf16(P[BASE + 0], P[BASE + 1]), a1 = cvt_pk_bf16(P[BASE + 2], P[BASE + 3]);   \
    unsigned b0 = cvt_pk_bf16(P[BASE + 4], P[BASE + 5]), b1 = cvt_pk_bf16(P[BASE + 6], P[BASE + 7]);                              \
    auto r0 = __builtin_amdgcn_permlane32_swap(a0, b0, false, false); auto r1 = __builtin_amdgcn_permlane32_swap(a1, b1, false, false); \
    u32x4 w = {r0[0], r1[0], r0[1], r1[1]}; OUT = *reinterpret_cast<bf16x8*>(&w); } while (0)
  PK4(p0, 0, pa0); PK4(p0, 8, pa1); PK4(p1, 0, pa2); PK4(p1, 8, pa3);
#undef PK4
}
template <int NQ, int KSTR>
__device__ __forceinline__ void qkt(f32x16& p0, f32x16& p1, const char* Ks, const bf16x8* qr, int r32, int hi) {
  p0 = f32x16{}; p1 = f32x16{};
#pragma unroll
  for (int d0 = 0; d0 < NQ; ++d0) { const int cb = (d0 * 16 + hi * 8) * 2;
    const bf16x8 b0 = *reinterpret_cast<const bf16x8*>(Ks + r32 * KSTR + cb);
    const bf16x8 b1 = *reinterpret_cast<const bf16x8*>(Ks + (32 + r32) * KSTR + cb);
    p0 = __builtin_amdgcn_mfma_f32_32x32x16_bf16(b0, qr[d0], p0, 0, 0, 0);
    p1 = __builtin_amdgcn_mfma_f32_32x32x16_bf16(b1, qr[d0], p1, 0, 0, 0); }
}

struct KeySrc {
  int lat_row0, n_lat_tiles, ctx_row0;
  __device__ __forceinline__ long row0(int j) const { return j < n_lat_tiles ? (long)lat_row0 + 64 * j : (long)ctx_row0 + 64 * (j - n_lat_tiles); }
};

template <int MODE>
__device__ __forceinline__ void attn_unit(const bf16_t* __restrict__ Qp, int ldq, const bf16_t* __restrict__ Kn, int ldk, const bf16_t* __restrict__ Kr,
                                          const bf16_t* __restrict__ Vp, int ldv, bf16_t* O1, bf16_t* O2, int ldo, int ldo2, const KeySrc ks, int NT, float scale, char* lds) {
  constexpr int NQ = MODE == 0 ? 12 : 4;
  constexpr int KCOLS = MODE == 0 ? 192 : 128;
  constexpr int KSTR = KCOLS * 2 + 16;
  constexpr int SHM_K = KVBLK * KSTR;
  const int tid = threadIdx.x, wid = tid >> 6, lane = tid & 63, r32 = lane & 31, hi = lane >> 5;
  char* V_lds = lds; char* K_lds = lds + 2 * SHM_V;
  float* wsf = (float*)(lds + 2 * SHM_V + 2 * SHM_K) + wid * 64; float* li_l = wsf; float* al_l = wsf + 32;
  const float C = scale * 1.4426950408889634f, thr_raw = 8.f / scale;
  float m_reg = -1e30f, l_reg = 0; f32x16 o[4] = {}; bf16x8 qr[NQ];
  const int qrow = (MODE == 0 ? wid * 32 : (wid & 3) * 32) + r32;
  const int qcol = (MODE == 0 ? 0 : (wid >> 2) * 64) + hi * 8;
  const int kwoff = (MODE == 0 ? 0 : (wid >> 2) * 128);
  { const bf16_t* Qw = Qp + (long)qrow * ldq + qcol;
#pragma unroll
    for (int d0 = 0; d0 < NQ; ++d0) qr[d0] = *reinterpret_cast<const bf16x8*>(Qw + d0 * 16); }
  const int sr = tid >> 4, sc = (tid & 15) * 8, vst0 = v_st(sr, sc), vst1 = v_st(32 + sr, sc);
  const int rr = tid >> 3, rc = (tid & 7) * 8;
  const int vb0 = (int)(uintptr_t)V_lds + v_rd_base(lane);
  bf16x8 vs0, vs1, ks0, ks1, kr0;
#define SLOAD(j) do { const long r0_ = ks.row0(j); \
    vs0 = *reinterpret_cast<const bf16x8*>(Vp + (r0_ + sr) * ldv + sc); vs1 = *reinterpret_cast<const bf16x8*>(Vp + (r0_ + 32 + sr) * ldv + sc); \
    ks0 = *reinterpret_cast<const bf16x8*>(Kn + (r0_ + sr) * ldk + sc); ks1 = *reinterpret_cast<const bf16x8*>(Kn + (r0_ + 32 + sr) * ldk + sc); \
    if (MODE == 0) kr0 = *reinterpret_cast<const bf16x8*>(Kr + (r0_ + rr) * 64 + rc); } while (0)
#define SWRITE(b) do { *(bf16x8*)(V_lds + (b) * SHM_V + vst0) = vs0; *(bf16x8*)(V_lds + (b) * SHM_V + vst1) = vs1; \
    *(bf16x8*)(K_lds + (b) * SHM_K + sr * KSTR + sc * 2) = ks0; *(bf16x8*)(K_lds + (b) * SHM_K + (32 + sr) * KSTR + sc * 2) = ks1; \
    if (MODE == 0) *(bf16x8*)(K_lds + (b) * SHM_K + rr * KSTR + 256 + rc * 2) = kr0; } while (0)
  f32x16 p0, p1; float mn, al; bf16x8 pa0, pa1, pa2, pa3;
  __syncthreads();
  SLOAD(0); asm volatile("s_waitcnt vmcnt(0)" ::: "memory"); SWRITE(0);
  for (int j = 0; j < NT; ++j) {
    __syncthreads();
    const int b = j & 1;
    if (j + 1 < NT) SLOAD(j + 1);
    SBAR();
    qkt<NQ, KSTR>(p0, p1, K_lds + b * SHM_K + kwoff, qr, r32, hi);
    partialSM(p0, p1, m_reg, mn, al, C, thr_raw);
    if (__any(al < 1.f)) { if (hi == 0) al_l[r32] = al; asm volatile("s_waitcnt lgkmcnt(0)" ::: "memory");
#pragma unroll
      for (int d = 0; d < 4; ++d)
#pragma unroll
        for (int r = 0; r < 16; ++r) o[d][r] *= al_l[crow(r, hi)]; }
    finishSM(p0, p1, al, l_reg, pa0, pa1, pa2, pa3); SBAR();
    pv_d0(o, vb0 + b * SHM_V, pa0, pa1, pa2, pa3);
    if (j + 1 < NT) { asm volatile("s_waitcnt vmcnt(0)" ::: "memory"); SWRITE(b ^ 1); }
  }
  if (hi == 0) li_l[r32] = l_reg; asm volatile("s_waitcnt lgkmcnt(0)" ::: "memory");
  float rli[16];
#pragma unroll
  for (int r = 0; r < 16; ++r) rli[r] = __builtin_amdgcn_rcpf(li_l[crow(r, hi)]);
  const bool second = (MODE == 1 && wid >= 4); const int ldw = second ? ldo2 : ldo;
  bf16_t* Ow = (second ? O2 : O1) + (long)(MODE == 0 ? wid * 32 : (wid & 3) * 32) * ldw;
#pragma unroll
  for (int r = 0; r < 16; ++r) { const int orow = crow(r, hi);
#pragma unroll
    for (int d0 = 0; d0 < 4; ++d0) Ow[(long)orow * ldw + d0 * 32 + r32] = f2bf(o[d0][r] * rli[r]); }
#undef SLOAD
#undef SWRITE
}
#undef SBAR
}

constexpr int DM = 1024, NBATCH = 2, SEQ = 16384, NLAT = NBATCH * SEQ, CTXL = 256, NCTX = NBATCH * CTXL, MTOT = NLAT + NCTX, DIN = 9296, FFH = 2816;
constexpr float EPS = 1e-6f;
constexpr int NCHAIN = 16, NCHUNK = 130;
constexpr float KSCALE_B = 0.08838834764831845f;
enum { I_X = 0, I_C, I_CTX, I_CCTX, I_WMOD, I_BMOD, I_GMIXPRE, I_GMIXPOST, I_GFFNPRE, I_GFFNPOST, I_WIN, I_ASINK, I_BGBIAS, I_CGQ, I_CGKV, I_CWUQ, I_CWUK, I_CWUV,
       I_LQ1, I_LK1, I_LQ2, I_LK2, I_DGSUB, I_WBRANCH, I_WOUT, I_WGU, I_WDOWN, N_IN };
constexpr size_t MiB = 1u << 20, KiB = 1u << 10;
constexpr size_t WS_CTL = 0, CTL_ZERO_BYTES = 1 * MiB;
constexpr size_t WS_SM = 1 * MiB;
constexpr size_t SM_MOD = WS_SM;
constexpr size_t SM_ROPE = WS_SM + 80 * KiB;
constexpr size_t SM_BG = WS_SM + 128 * KiB;
constexpr size_t SM_NST = WS_SM + 2560 * KiB;
constexpr size_t SM_SCAL = WS_SM + 3840 * KiB;
constexpr size_t SM_HC = WS_SM + 4 * MiB;
constexpr size_t WS_W = 8 * MiB;
constexpr size_t W_AB = WS_W, W_C = WS_W + 5632 * KiB, W_D = WS_W + 7680 * KiB, W_G = WS_W + 10752 * KiB, W_UQ = WS_W + 18944 * KiB, W_UKV = WS_W + 19712 * KiB,
                 W_BR = WS_W + 20224 * KiB, W_OUT = WS_W + 24320 * KiB, W_GU = WS_W + 26368 * KiB, W_DN = WS_W + 37632 * KiB;
constexpr size_t WS_U = 52 * MiB;
constexpr size_t WS_Y = 117 * MiB;
constexpr size_t WS_R = 247 * MiB;
constexpr size_t R_PAB = WS_R, R_ST = WS_R + 179 * MiB;
constexpr size_t R_PD = WS_R, R_CQ = WS_R + 98 * MiB, R_CKNV = WS_R + 147 * MiB, R_CKR = WS_R + 212 * MiB, R_O2 = WS_R + 217 * MiB;
constexpr size_t R_G = WS_R, R_YOUT = WS_R, R_HID = WS_R;
constexpr size_t WS_END = 512 * MiB;
static_assert(W_DN + (size_t)1024 * 2816 * 2 <= WS_U, "weights");
static_assert(WS_U + (size_t)MTOT * 1024 * 2 <= WS_Y && WS_Y + (size_t)MTOT * 2048 * 2 <= WS_R, "U/Y");
static_assert(R_PAB + (size_t)MTOT * 2816 * 2 <= R_ST && R_ST + (size_t)16 * 130 * 16384 * 2 <= WS_END, "AB");
static_assert(R_PD + (size_t)MTOT * 1536 * 2 <= R_CQ && R_CQ + (size_t)MTOT * 768 * 2 <= R_CKNV && R_CKNV + (size_t)MTOT * 1024 * 2 <= R_CKR && R_CKR + (size_t)MTOT * 64 * 2 <= R_O2 && R_O2 + (size_t)MTOT * 512 * 2 <= WS_END, "CD");
static_assert(R_G + (size_t)MTOT * 4096 * 2 <= WS_END, "G");
static_assert(SM_BG + (size_t)MTOT * 16 * 4 <= SM_NST && SM_NST + (size_t)16 * 130 * 128 * 4 <= SM_SCAL && SM_SCAL + 3 * 16 * 130 * 4 <= SM_HC && SM_HC + 512 * 1024 * 4 <= WS_W, "SM");
constexpr int LDS_BYTES = 147456;

struct Args { const float* in[N_IN]; float* out; unsigned char* ws; int layer; int pad; };

struct Ctx {
    const float* const* in; float* out; unsigned char* ws; int layer;
    LAS unsigned char* lds; char* ldsg;
    int tid, lane, wave, G, bid;
};

__device__ __forceinline__ float wave_sum(float v) {
#pragma unroll
    for (int o = 1; o < 64; o <<= 1) v += __shfl_xor(v, o);
    return v;
}
__device__ __forceinline__ float wave_max(float v) {
#pragma unroll
    for (int o = 1; o < 64; o <<= 1) v = fmaxf(v, __shfl_xor(v, o));
    return v;
}
__device__ __forceinline__ float siluf_(float x) { return x / (1.f + __expf(-x)); }
__device__ __forceinline__ float logsigf_(float x) { return fminf(x, 0.f) - log1pf(__expf(-fabsf(x))); }
__device__ __forceinline__ float dot8(const u32x4 a, const u32x4 b) {
    return bflo(a.x) * bflo(b.x) + bfhi(a.x) * bfhi(b.x) + bflo(a.y) * bflo(b.y) + bfhi(a.y) * bfhi(b.y)
         + bflo(a.z) * bflo(b.z) + bfhi(a.z) * bfhi(b.z) + bflo(a.w) * bflo(b.w) + bfhi(a.w) * bfhi(b.w);
}
__device__ __forceinline__ const float* hin_row(const Ctx& c, int r) {
    if (c.layer == 0) return r < NLAT ? c.in[I_X] + (size_t)r * DM : c.in[I_CTX] + (size_t)(r - NLAT) * DM;
    return r < NLAT ? c.out + (size_t)r * DM : (const float*)(c.ws + SM_HC) + (size_t)(r - NLAT) * DM;
}
__device__ __forceinline__ float* hout_row(const Ctx& c, int r) { return r < NLAT ? c.out + (size_t)r * DM : (float*)(c.ws + SM_HC) + (size_t)(r - NLAT) * DM; }
__device__ __forceinline__ int mod_idx(int r) { return r < NLAT ? (r >= SEQ ? 1 : 0) : 2; }
__device__ __forceinline__ int tok_row(int dir, int b, int idx, int tp) {
    if (idx < 2) { int j = idx * 128 + tp; if (dir) j = 255 - j; return NLAT + b * CTXL + j; }
    int s = (idx - 2) * 128 + tp; if (dir) s = SEQ - 1 - s; return b * SEQ + s;
}

__device__ __forceinline__ void tr_block(const float* W, int ldw, int k0, int n0, bf16_t* WT, int ldo, int drow, int dcol, float* scr, int lane) {
#pragma unroll 8
    for (int i = 0; i < 32; ++i) { const int kk = 2 * i + (lane >> 5); scr[kk * 33 + (lane & 31)] = W[(size_t)(k0 + kk) * ldw + n0 + (lane & 31)]; }
    asm volatile("s_waitcnt lgkmcnt(0)" ::: "memory");
    const int c8 = lane & 7;
#pragma unroll
    for (int j = 0; j < 4; ++j) { const int n = (lane >> 3) + 8 * j; const float* s = scr + (8 * c8) * 33 + n;
        u32x4 o; o.x = cvt_pk_bf16(s[0 * 33], s[1 * 33]); o.y = cvt_pk_bf16(s[2 * 33], s[3 * 33]); o.z = cvt_pk_bf16(s[4 * 33], s[5 * 33]); o.w = cvt_pk_bf16(s[6 * 33], s[7 * 33]);
        *(u32x4*)(WT + (size_t)(drow + n) * ldo + dcol + 8 * c8) = o; }
    asm volatile("s_waitcnt lgkmcnt(0)" ::: "memory");
}
__device__ __forceinline__ void ph_conv(const Ctx& c) {
    const int l = c.layer;
    unsigned char* ws = c.ws;
    float* scr = (float*)(c.ldsg + c.wave * 16384);
    const int gw = c.bid * 8 + c.wave, NGW = c.G * 8;
    const float* w_in = c.in[I_WIN] + (size_t)l * DM * DIN;
    int base = 0;
#define CONV_SEG(W_, ldw_, K_, nblk_, n0_, WT_, ldo_, drow0_, dcol0_, kind_) do { \
        const float* W__ = (W_); bf16_t* WT__ = (bf16_t*)(WT_); const int nit = ((K_) / 64) * (nblk_); \
        int it = gw - (base % NGW); if (it < 0) it += NGW; \
        for (; it < nit; it += NGW) { const int kb = it / (nblk_), nb = it % (nblk_); int drow = (drow0_) + 32 * nb; \
            if ((kind_) == 1) { const int n0 = 32 * nb; drow = n0 < FFH ? 256 * (n0 / 128) + (n0 % 128) : 256 * ((n0 - FFH) / 128) + 128 + ((n0 - FFH) % 128); } \
            tr_block(W__, (ldw_), 64 * kb, (n0_) + 32 * nb, WT__, (ldo_), drow, (dcol0_) + 64 * kb, scr, c.lane); } \
        base += nit; } while (0)
    CONV_SEG(w_in, DIN, 1024, 72, 0,    ws + W_AB, 1024, 0, 0, 0);
    CONV_SEG(w_in, DIN, 1024, 16, 2320, ws + W_AB, 1024, 2304, 0, 0);
    CONV_SEG(w_in, DIN, 1024, 26, 2832, ws + W_C, 1024, 0, 0, 0);
    CONV_SEG(w_in, DIN, 1024, 48, 3664, ws + W_D, 1024, 0, 0, 0);
    CONV_SEG(w_in, DIN, 1024, 128, 5200, ws + W_G, 1024, 0, 0, 0);
    CONV_SEG(c.in[I_CWUQ] + (size_t)l * 512 * 768, 768, 512, 24, 0, ws + W_UQ, 512, 0, 0, 0);
    CONV_SEG(c.in[I_CWUK] + (size_t)l * 256 * 512, 512, 256, 16, 0, ws + W_UKV, 256, 0, 0, 0);
    CONV_SEG(c.in[I_CWUV] + (size_t)l * 256 * 512, 512, 256, 16, 0, ws + W_UKV, 256, 512, 0, 0);
    CONV_SEG(c.in[I_WBRANCH] + ((size_t)l * 4 + 0) * 512 * 1024, 1024, 512, 32, 0, ws + W_BR, 2048, 0, 0, 0);
    CONV_SEG(c.in[I_WBRANCH] + ((size_t)l * 4 + 1) * 512 * 1024, 1024, 512, 32, 0, ws + W_BR, 2048, 0, 512, 0);
    CONV_SEG(c.in[I_WBRANCH] + ((size_t)l * 4 + 2) * 512 * 1024, 1024, 512, 32, 0, ws + W_BR, 2048, 0, 1024, 0);
    CONV_SEG(c.in[I_WBRANCH] + ((size_t)l * 4 + 3) * 512 * 1024, 1024, 512, 32, 0, ws + W_BR, 2048, 0, 1536, 0);
    CONV_SEG(c.in[I_WOUT] + (size_t)l * 1024 * 1024, 1024, 1024, 32, 0, ws + W_OUT, 1024, 0, 0, 0);
    CONV_SEG(c.in[I_WGU] + (size_t)l * 1024 * 5632, 5632, 1024, 176, 0, ws + W_GU, 1024, 0, 0, 1);
    CONV_SEG(c.in[I_WDOWN] + (size_t)l * 2816 * 1024, 1024, 2816, 32, 0, ws + W_DN, 2816, 0, 0, 0);
#undef CONV_SEG
    { bf16_t* wc = (bf16_t*)(ws + W_C) + (size_t)832 * 1024; const int n16 = 192 * 1024 / 8;
      for (int i = c.bid * 512 + c.tid; i < n16; i += c.G * 512) ((u32x4*)wc)[i] = (u32x4){0u, 0u, 0u, 0u}; }
    { float* T = (float*)(ws + SM_ROPE);
      for (int i = c.bid * 512 + c.tid; i < 256 * 16; i += c.G * 512) { const int p = i >> 4, k = i & 15;
          const float inv = powf(10000.f, -(float)k / 16.f); const float ang = (float)p * inv; T[2 * i] = cosf(ang); T[2 * i + 1] = sinf(ang); } }
    __syncthreads();
    { float* red = (float*)c.ldsg;
      const float* wm = c.in[I_WMOD] + (size_t)l * DM * 6144; const float* bm = c.in[I_BMOD] + (size_t)l * 6144; float* mod = (float*)(ws + SM_MOD);
      for (int it = c.bid; it < 96; it += c.G) {
          const int n = it * 64 + c.lane; float a0 = 0.f, a1 = 0.f, a2 = 0.f;
          for (int kk = 0; kk < 128; ++kk) { const int k = c.wave * 128 + kk; const float w = wm[(size_t)k * 6144 + n];
              a0 += siluf_(c.in[I_C][k]) * w; a1 += siluf_(c.in[I_C][1024 + k]) * w; a2 += siluf_(c.in[I_CCTX][k]) * w; }
          red[(c.wave * 3 + 0) * 64 + c.lane] = a0; red[(c.wave * 3 + 1) * 64 + c.lane] = a1; red[(c.wave * 3 + 2) * 64 + c.lane] = a2;
          __syncthreads();
          if (c.wave < 3) { float s = 0.f;
#pragma unroll
              for (int w = 0; w < 8; ++w) s += red[(w * 3 + c.wave) * 64 + c.lane];
              mod[c.wave * 6144 + n] = s + bm[n]; }
          __syncthreads();
      } }
}

__device__ __forceinline__ void ph_norm1(const Ctx& c) {
    const int l = c.layer; const int gw = c.bid * 8 + c.wave, NGW = c.G * 8;
    const float* gpre = c.in[I_GMIXPRE] + (size_t)l * DM; const float* mod = (const float*)(c.ws + SM_MOD);
    const float* wg = c.in[I_WIN] + (size_t)l * DM * DIN + 2304; const float* bias = c.in[I_BGBIAS] + l * 16;
    bf16_t* U = (bf16_t*)(c.ws + WS_U); float* bg = (float*)(c.ws + SM_BG);
    for (int r = gw; r < MTOT; r += NGW) {
        const f32x4* xr = (const f32x4*)hin_row(c, r) + c.lane; const float* md = mod + mod_idx(r) * 6144;
        f32x4 v[4]; float ss = 0.f;
#pragma unroll
        for (int j = 0; j < 4; ++j) { v[j] = xr[64 * j]; ss += (v[j].x * v[j].x + v[j].y * v[j].y) + (v[j].z * v[j].z + v[j].w * v[j].w); }
        const float rs = rsqrtf(wave_sum(ss) * (1.f / DM) + EPS);
        float ga[16];
#pragma unroll
        for (int q = 0; q < 16; ++q) ga[q] = 0.f;
#pragma unroll
        for (int j = 0; j < 4; ++j) { const int e = 4 * (c.lane + 64 * j);
            const f32x4 g = *(const f32x4*)(gpre + e), sh = *(const f32x4*)(md + e), scl = *(const f32x4*)(md + 1024 + e);
            f32x4 u; u.x = v[j].x * rs * g.x * (1.f + scl.x) + sh.x; u.y = v[j].y * rs * g.y * (1.f + scl.y) + sh.y; u.z = v[j].z * rs * g.z * (1.f + scl.z) + sh.z; u.w = v[j].w * rs * g.w * (1.f + scl.w) + sh.w;
            u32x2 w; w.x = cvt_pk_bf16(u.x, u.y); w.y = cvt_pk_bf16(u.z, u.w); *(u32x2*)(U + (size_t)r * DM + e) = w;
#pragma unroll
            for (int t = 0; t < 4; ++t) { const float uv = u[t]; const float* wrow = wg + (size_t)(e + t) * DIN;
#pragma unroll
                for (int q4 = 0; q4 < 4; ++q4) { const f32x4 w4 = *(const f32x4*)(wrow + 4 * q4); ga[4 * q4 + 0] += uv * w4.x; ga[4 * q4 + 1] += uv * w4.y; ga[4 * q4 + 2] += uv * w4.z; ga[4 * q4 + 3] += uv * w4.w; } } }
        float mine = 0.f;
#pragma unroll
        for (int q = 0; q < 16; ++q) { const float s = wave_sum(ga[q]); if (c.lane == q) mine = s; }
        if (c.lane < 16) { float g = mine + bias[c.lane]; if ((c.lane >> 2) & 1) g = logsigf_(g); bg[(size_t)r * 16 + c.lane] = g; }
    }
}

__device__ __forceinline__ void rope_row(bf16_t* rowp, const bf16_t* srcp, int npairs, int hstride, int pr, int pc, const float* T, int lane) {
    for (int p = lane; p < npairs; p += 64) { const int hh = p >> 5, w = p & 31, half = w >> 4, i = w & 15;
        const int c1 = hh * hstride + 32 * half + i, c2 = c1 + 16; const int pos = half ? pc : pr;
        const float cs = T[(pos * 16 + i) * 2], sn = T[(pos * 16 + i) * 2 + 1];
        const float x1 = bf2f(srcp[c1]), x2 = bf2f(srcp[c2]);
        rowp[c1] = f2bf(x1 * cs - x2 * sn); rowp[c2] = f2bf(x2 * cs + x1 * sn); }
}
__device__ __forceinline__ void ph_rope_a(const Ctx& c) {
    const int gw = c.bid * 8 + c.wave, NGW = c.G * 8; const float* T = (const float*)(c.ws + SM_ROPE);
    bf16_t* P = (bf16_t*)(c.ws + R_PAB);
    for (int r = gw; r < NLAT; r += NGW) { const int t = r & (SEQ - 1); bf16_t* rp = P + (size_t)r * 2816; rope_row(rp, rp, 320, 64, t >> 6, t & 63, T, c.lane); }
}

__device__ __forceinline__ void ph_mix_ab1(const Ctx& c) {
    const int l = c.layer; const bool with_ctx = (l == 0);
    const bf16_t* P = (const bf16_t*)(c.ws + R_PAB); const float* bg = (const float*)(c.ws + SM_BG);
    bf16_t* ST = (bf16_t*)(c.ws + R_ST); float* NST = (float*)(c.ws + SM_NST); float* SCAL = (float*)(c.ws + SM_SCAL);
    {
        float* Kf = (float*)c.ldsg; float* Vw = (float*)(c.ldsg + 65536); float* lf = (float*)(c.ldsg + 131072); float* ig = lf + 128; float* wsr = lf + 256;
        for (int it = c.bid; it < NCHAIN * NCHUNK; it += c.G) {
            const int chain = it / NCHUNK, idx = it % NCHUNK, dir = chain >> 3, b = (chain >> 2) & 1, head = chain & 3;
            if (c.tid < 128) { const int r = tok_row(dir, b, idx, c.tid); lf[c.tid] = bg[(size_t)r * 16 + dir * 8 + 4 + head]; ig[c.tid] = bg[(size_t)r * 16 + dir * 8 + head]; }
            __syncthreads();
            if (c.wave == 0) {
                const float a0 = lf[2 * c.lane], a1 = lf[2 * c.lane + 1]; float s = a0 + a1;
#pragma unroll
                for (int off = 1; off < 64; off <<= 1) { const float t = __shfl_up(s, off); if (c.lane >= off) s += t; }
                const float blast = __shfl(s, 63);
                const float g1 = blast - s + ig[2 * c.lane + 1], g0 = blast - (s - a1) + ig[2 * c.lane];
                const float gmax = wave_max(fmaxf(g0, g1));
                wsr[2 * c.lane] = __expf(g0 - gmax); wsr[2 * c.lane + 1] = __expf(g1 - gmax);
                if (c.lane == 0) { SCAL[0 * NCHAIN * NCHUNK + it] = gmax; SCAL[1 * NCHAIN * NCHUNK + it] = blast; }
            }
            __syncthreads();
            for (int e = c.tid; e < 2048; e += 512) { const int s = e >> 4, c8 = (e & 15) * 8; const int r = tok_row(dir, b, idx, s);
                const u32x4 kk = *(const u32x4*)(P + (size_t)r * 2816 + 1280 + 128 * head + c8), vv = *(const u32x4*)(P + (size_t)r * 2816 + 1792 + 128 * head + c8);
                const float w = wsr[s]; float* kd = Kf + s * 128 + c8; float* vd = Vw + s * 128 + c8;
                kd[0] = bflo(kk.x) * KSCALE_B; kd[1] = bfhi(kk.x) * KSCALE_B; kd[2] = bflo(kk.y) * KSCALE_B; kd[3] = bfhi(kk.y) * KSCALE_B;
                kd[4] = bflo(kk.z) * KSCALE_B; kd[5] = bfhi(kk.z) * KSCALE_B; kd[6] = bflo(kk.w) * KSCALE_B; kd[7] = bfhi(kk.w) * KSCALE_B;
                vd[0] = bflo(vv.x) * w; vd[1] = bfhi(vv.x) * w; vd[2] = bflo(vv.y) * w; vd[3] = bfhi(vv.y) * w;
                vd[4] = bflo(vv.z) * w; vd[5] = bfhi(vv.z) * w; vd[6] = bflo(vv.w) * w; vd[7] = bfhi(vv.w) * w; }
            __syncthreads();
            { const int v = c.tid >> 2, d0 = (c.tid & 3) * 32; float acc[32];
#pragma unroll
              for (int dd = 0; dd < 32; ++dd) acc[dd] = 0.f;
              for (int s = 0; s < 128; ++s) { const float a = Vw[s * 128 + v]; const f32x4* kr = (const f32x4*)(Kf + s * 128 + d0);
#pragma unroll
                  for (int q = 0; q < 8; ++q) { const f32x4 k4 = kr[q]; acc[4 * q] += a * k4.x; acc[4 * q + 1] += a * k4.y; acc[4 * q + 2] += a * k4.z; acc[4 * q + 3] += a * k4.w; } }
              bf16_t* dst = ST + ((size_t)it * 128 + v) * 128 + d0;
#pragma unroll
              for (int q = 0; q < 4; ++q) { u32x4 w; w.x = cvt_pk_bf16(acc[8 * q], acc[8 * q + 1]); w.y = cvt_pk_bf16(acc[8 * q + 2], acc[8 * q + 3]); w.z = cvt_pk_bf16(acc[8 * q + 4], acc[8 * q + 5]); w.w = cvt_pk_bf16(acc[8 * q + 6], acc[8 * q + 7]);
                  *(u32x4*)(dst + 8 * q) = w; } }
            if (c.tid < 128) { float a = 0.f; for (int s = 0; s < 128; ++s) a += wsr[s] * Kf[s * 128 + c.tid]; NST[(size_t)it * 128 + c.tid] = a; }
            __syncthreads();
        }
    }
    __syncthreads();
    {
        float* pbuf = (float*)c.ldsg + c.wave * 576;
        const int gw = c.bid * 8 + c.wave, NGW = c.G * 8; const float* sink = c.in[I_ASINK] + l * 8;
        bf16_t* Y = (bf16_t*)(c.ws + WS_Y);
        const int nitems = (with_ctx ? MTOT : NLAT) * 8;
        for (int it = gw; it < nitems; it += NGW) {
            const int r = it >> 3, h = it & 7, g = h >> 2; const bool lat = r < NLAT;
            const int b = lat ? (r >> 14) : ((r - NLAT) >> 8), t = r & (SEQ - 1);
            const int ctx0 = NLAT + b * CTXL, lat0 = b * SEQ;
            float q[64];
            { const u32x4* qp = (const u32x4*)(P + (size_t)r * 2816 + 64 * h);
#pragma unroll
              for (int j = 0; j < 8; ++j) { const u32x4 w = qp[j]; q[8 * j] = bflo(w.x); q[8 * j + 1] = bfhi(w.x); q[8 * j + 2] = bflo(w.y); q[8 * j + 3] = bfhi(w.y); q[8 * j + 4] = bflo(w.z); q[8 * j + 5] = bfhi(w.z); q[8 * j + 6] = bflo(w.w); q[8 * j + 7] = bfhi(w.w); } }
            const int nk = lat ? 513 : 256;
            float sc[9]; float mx = sink[h];
#pragma unroll
            for (int i = 0; i < 9; ++i) { const int kidx = c.lane + 64 * i; float s = -INFINITY;
                if (kidx < nk) { int kr = -1;
                    if (kidx < 256) kr = ctx0 + kidx; else { const int sp = t - 128 + (kidx - 256); if (sp >= 0 && sp < SEQ) kr = lat0 + sp; }
                    if (kr >= 0) { const u32x4* kp = (const u32x4*)(P + (size_t)kr * 2816 + 512 + 64 * g); float a = 0.f;
#pragma unroll
                        for (int j = 0; j < 8; ++j) { const u32x4 w = kp[j]; a += q[8 * j] * bflo(w.x) + q[8 * j + 1] * bfhi(w.x) + q[8 * j + 2] * bflo(w.y) + q[8 * j + 3] * bfhi(w.y) + q[8 * j + 4] * bflo(w.z) + q[8 * j + 5] * bfhi(w.z) + q[8 * j + 6] * bflo(w.w) + q[8 * j + 7] * bfhi(w.w); }
                        s = a * 0.125f; } }
                sc[i] = s; mx = fmaxf(mx, s); }
            mx = wave_max(mx);
            float den = 0.f;
#pragma unroll
            for (int i = 0; i < 9; ++i) { sc[i] = __expf(sc[i] - mx); den += sc[i]; }
            den = wave_sum(den) + __expf(sink[h] - mx);
            const float rden = 1.f / den;
#pragma unroll
            for (int i = 0; i < 9; ++i) pbuf[c.lane + 64 * i] = sc[i] * rden;
            asm volatile("s_waitcnt lgkmcnt(0)" ::: "memory");
            float o = 0.f;
            for (int kidx = 0; kidx < nk; ++kidx) { int kr;
                if (kidx < 256) kr = ctx0 + kidx; else { int sp = t - 128 + (kidx - 256); sp = sp < 0 ? 0 : (sp >= SEQ ? SEQ - 1 : sp); kr = lat0 + sp; }
                o += pbuf[kidx] * bf2f(P[(size_t)kr * 2816 + 640 + 64 * g + c.lane]); }
            Y[(size_t)r * 2048 + 64 * h + c.lane] = f2bf(o);
            asm volatile("s_waitcnt lgkmcnt(0)" ::: "memory");
        }
    }
}

__device__ __forceinline__ void ph_scan(const Ctx& c) {
    bf16_t* ST = (bf16_t*)(c.ws + R_ST); float* NST = (float*)(c.ws + SM_NST); float* SCAL = (float*)(c.ws + SM_SCAL);
    float* dec = (float*)c.ldsg; float* scl = dec + 160;
    for (int it = c.bid; it < NCHAIN * 32; it += c.G) {
        const int chain = it >> 5, e = (it & 31) * 512 + c.tid;
        __syncthreads();
        if (c.tid == 0) { float m = 0.f;
            for (int idx = 0; idx < NCHUNK; ++idx) { const float gmax = SCAL[chain * NCHUNK + idx], blast = SCAL[NCHAIN * NCHUNK + chain * NCHUNK + idx];
                if ((it & 31) == 0) SCAL[2 * NCHAIN * NCHUNK + chain * NCHUNK + idx] = m;
                const float mn = fmaxf(blast + m, gmax); dec[idx] = __expf(blast + m - mn); scl[idx] = __expf(gmax - mn); m = mn; } }
        __syncthreads();
        { float cs = 0.f; bf16_t* p = ST + (size_t)chain * NCHUNK * 16384 + e;
#pragma unroll 10
          for (int idx = 0; idx < NCHUNK; ++idx) { const float u = bf2f(p[(size_t)idx * 16384]); p[(size_t)idx * 16384] = f2bf(cs); cs = dec[idx] * cs + scl[idx] * u; } }
        if ((it & 31) == 0 && c.tid < 128) { float ns = 0.f; float* p = NST + (size_t)chain * NCHUNK * 128 + c.tid;
            for (int idx = 0; idx < NCHUNK; ++idx) { const float u = p[idx * 128]; p[idx * 128] = ns; ns = dec[idx] * ns + scl[idx] * u; } }
    }
}

__device__ __forceinline__ void ph_mlstm_c(const Ctx& c) {
    const bool with_ctx = (c.layer == 0);
    const bf16_t* P = (const bf16_t*)(c.ws + R_PAB); const float* bg = (const float*)(c.ws + SM_BG);
    const bf16_t* ST = (const bf16_t*)(c.ws + R_ST); const float* NST = (const float*)(c.ws + SM_NST); const float* SCAL = (const float*)(c.ws + SM_SCAL);
    bf16_t* Y = (bf16_t*)(c.ws + WS_Y);
    bf16_t* Kb = (bf16_t*)c.ldsg; bf16_t* Vb = (bf16_t*)(c.ldsg + 32768); bf16_t* Cb = (bf16_t*)(c.ldsg + 65536); bf16_t* Qb = (bf16_t*)(c.ldsg + 98304);
    float* Sw = (float*)(c.ldsg + 106496); float* bcum = (float*)(c.ldsg + 122880); float* ig = bcum + 128; float* mt = bcum + 256; float* np = bcum + 384; float* av = bcum + 512;
    for (int it = c.bid; it < NCHAIN * NCHUNK; it += c.G) {
        const int chain = it / NCHUNK, idx = it % NCHUNK, dir = chain >> 3, b = (chain >> 2) & 1, head = chain & 3;
        if (idx < 2 && !with_ctx) continue;
        __syncthreads();
        if (c.tid < 128) { const int r = tok_row(dir, b, idx, c.tid); bcum[c.tid] = bg[(size_t)r * 16 + dir * 8 + 4 + head]; ig[c.tid] = bg[(size_t)r * 16 + dir * 8 + head]; np[c.tid] = NST[(size_t)it * 128 + c.tid]; }
        for (int e = c.tid; e < 2048; e += 512) { const int s = e >> 4, c8 = (e & 15) * 8; const int r = tok_row(dir, b, idx, s);
            *(u32x4*)(Kb + s * 128 + c8) = *(const u32x4*)(P + (size_t)r * 2816 + 1280 + 128 * head + c8);
            *(u32x4*)(Vb + s * 128 + c8) = *(const u32x4*)(P + (size_t)r * 2816 + 1792 + 128 * head + c8);
            *(u32x4*)(Cb + s * 128 + c8) = *(const u32x4*)(ST + (size_t)it * 16384 + s * 128 + c8); }
        __syncthreads();
        if (c.tid == 0) { const float mprev = SCAL[2 * NCHAIN * NCHUNK + it]; float cum = 0.f, pm = -INFINITY;
            for (int t = 0; t < 128; ++t) { cum += bcum[t]; bcum[t] = cum; pm = fmaxf(pm, ig[t] - cum); const float m = cum + fmaxf(mprev, pm); mt[t] = m; av[t] = __expf(cum + mprev - m); } }
        __syncthreads();
        for (int rb = 0; rb < 4; ++rb) {
            for (int e = c.tid; e < 512; e += 512) { const int i = e >> 4, c8 = (e & 15) * 8; const int r = tok_row(dir, b, idx, rb * 32 + i);
                *(u32x4*)(Qb + i * 128 + c8) = *(const u32x4*)(P + (size_t)r * 2816 + 768 + 128 * head + c8); }
            __syncthreads();
            const int i = c.tid >> 4, sgp = c.tid & 15, tp = rb * 32 + i;
            u32x4 qv[16];
#pragma unroll
            for (int k = 0; k < 16; ++k) qv[k] = *(const u32x4*)(Qb + i * 128 + 8 * k);
            const float bt = bcum[tp], mtt = mt[tp];
            float dpart = 0.f;
#pragma unroll 1
            for (int j = 0; j < 8; ++j) { const int s = sgp + 16 * j; float a = 0.f;
#pragma unroll
                for (int k = 0; k < 16; ++k) a += dot8(qv[k], *(const u32x4*)(Kb + s * 128 + 8 * k));
                const float w = (s <= tp) ? __expf(bt - bcum[s] + ig[s] - mtt) : 0.f; const float sw = w * a * KSCALE_B;
                Sw[i * 128 + s] = sw; dpart += sw; }
            float nq = 0.f;
#pragma unroll
            for (int k = 0; k < 16; ++k) if (k == sgp) { const u32x4 w = qv[k]; const float* n8 = np + 8 * k;
                nq = bflo(w.x) * n8[0] + bfhi(w.x) * n8[1] + bflo(w.y) * n8[2] + bfhi(w.y) * n8[3] + bflo(w.z) * n8[4] + bfhi(w.z) * n8[5] + bflo(w.w) * n8[6] + bfhi(w.w) * n8[7]; }
#pragma unroll
            for (int o = 1; o < 16; o <<= 1) { dpart += __shfl_xor(dpart, o); nq += __shfl_xor(nq, o); }
            const float a_t = av[tp]; const float den = dpart + a_t * nq; const float dn = fmaxf(fabsf(den), __expf(-mtt)); const float rdn = 1.f / dn;
            __syncthreads();
            const int orow = tok_row(dir, b, idx, tp);
#pragma unroll 1
            for (int j = 0; j < 8; ++j) { const int v = sgp + 16 * j; float acc = 0.f;
#pragma unroll 8
                for (int s = 0; s < 128; ++s) acc += Sw[i * 128 + s] * bf2f(Vb[s * 128 + v]);
                float cq = 0.f;
#pragma unroll
                for (int k = 0; k < 16; ++k) cq += dot8(qv[k], *(const u32x4*)(Cb + v * 128 + 8 * k));
                const float hv = (acc + a_t * cq) * rdn;
                Y[(size_t)orow * 2048 + (dir ? 1024 : 512) + 128 * head + v] = f2bf(hv); }
            __syncthreads();
        }
    }
}
__device__ __forceinline__ void ph_yb(const Ctx& c) {
    const int M = (c.layer == 0) ? MTOT : NLAT; const bf16_t* P = (const bf16_t*)(c.ws + R_PAB); bf16_t* Y = (bf16_t*)(c.ws + WS_Y);
    for (size_t i = (size_t)c.bid * 512 + c.tid; i < (size_t)M * 64; i += (size_t)c.G * 512) { const size_t r = i >> 6; const int c8 = (int)(i & 63) * 8;
        const u32x4 o = *(const u32x4*)(P + r * 2816 + 2304 + c8), f = *(const u32x4*)(Y + r * 2048 + 512 + c8), bb = *(const u32x4*)(Y + r * 2048 + 1024 + c8);
        u32x4 w;
        w.x = cvt_pk_bf16(sigmoidf_(bflo(o.x)) * (bflo(f.x) + bflo(bb.x)), sigmoidf_(bfhi(o.x)) * (bfhi(f.x) + bfhi(bb.x)));
        w.y = cvt_pk_bf16(sigmoidf_(bflo(o.y)) * (bflo(f.y) + bflo(bb.y)), sigmoidf_(bfhi(o.y)) * (bfhi(f.y) + bfhi(bb.y)));
        w.z = cvt_pk_bf16(sigmoidf_(bflo(o.z)) * (bflo(f.z) + bflo(bb.z)), sigmoidf_(bfhi(o.z)) * (bfhi(f.z) + bfhi(bb.z)));
        w.w = cvt_pk_bf16(sigmoidf_(bflo(o.w)) * (bflo(f.w) + bflo(bb.w)), sigmoidf_(bfhi(o.w)) * (bfhi(f.w) + bfhi(bb.w)));
        *(u32x4*)(Y + r * 2048 + 512 + c8) = w; }
}

__device__ __forceinline__ void ph_mla_pre(const Ctx& c) {
    const int l = c.layer; const int gw = c.bid * 8 + c.wave, NGW = c.G * 8; const float* T = (const float*)(c.ws + SM_ROPE);
    bf16_t* Y = (bf16_t*)(c.ws + WS_Y); bf16_t* PD = (bf16_t*)(c.ws + R_PD); bf16_t* CKR = (bf16_t*)(c.ws + R_CKR);
    const float* gq = c.in[I_CGQ] + l * 512; const float* gkv = c.in[I_CGKV] + l * 256;
    for (int r = gw; r < MTOT; r += NGW) {
        bf16_t* pc = Y + (size_t)r * 2048 + 1024;
        { const u32x4 w = *(const u32x4*)(pc + 8 * c.lane); float x[8] = {bflo(w.x), bfhi(w.x), bflo(w.y), bfhi(w.y), bflo(w.z), bfhi(w.z), bflo(w.w), bfhi(w.w)};
          float ss = 0.f;
#pragma unroll
          for (int j = 0; j < 8; ++j) ss += x[j] * x[j];
          const float rs = rsqrtf(wave_sum(ss) * (1.f / 512.f) + EPS);
#pragma unroll
          for (int j = 0; j < 8; ++j) x[j] = x[j] * rs * gq[8 * c.lane + j];
          u32x4 o; o.x = cvt_pk_bf16(x[0], x[1]); o.y = cvt_pk_bf16(x[2], x[3]); o.z = cvt_pk_bf16(x[4], x[5]); o.w = cvt_pk_bf16(x[6], x[7]); *(u32x4*)(pc + 8 * c.lane) = o; }
        { const u32x2 w = *(const u32x2*)(pc + 512 + 4 * c.lane); float x[4] = {bflo(w.x), bfhi(w.x), bflo(w.y), bfhi(w.y)};
          float ss = x[0] * x[0] + x[1] * x[1] + x[2] * x[2] + x[3] * x[3];
          const float rs = rsqrtf(wave_sum(ss) * (1.f / 256.f) + EPS);
#pragma unroll
          for (int j = 0; j < 4; ++j) x[j] = x[j] * rs * gkv[4 * c.lane + j];
          u32x2 o; o.x = cvt_pk_bf16(x[0], x[1]); o.y = cvt_pk_bf16(x[2], x[3]); *(u32x2*)(pc + 512 + 4 * c.lane) = o; }
        if (r < NLAT) { const int t = r & (SEQ - 1);
            rope_row(CKR + (size_t)r * 64, pc + 768, 32, 64, t >> 6, t & 63, T, c.lane);
            bf16_t* pd = PD + (size_t)r * 1536; rope_row(pd, pd, 512, 64, t >> 6, t & 63, T, c.lane);
        } else { CKR[(size_t)r * 64 + c.lane] = pc[768 + c.lane]; }
    }
}
__device__ __forceinline__ void ph_rope_cq(const Ctx& c) {
    const int gw = c.bid * 8 + c.wave, NGW = c.G * 8; const float* T = (const float*)(c.ws + SM_ROPE); bf16_t* CQ = (bf16_t*)(c.ws + R_CQ);
    for (int r = gw; r < NLAT; r += NGW) { const int t = r & (SEQ - 1); bf16_t* rp = CQ + (size_t)r * 768 + 128; rope_row(rp, rp, 128, 192, t >> 6, t & 63, T, c.lane); }
}

__device__ __forceinline__ void ph_attn(const Ctx& c) {
    const bool with_ctx = (c.layer == 0);
    const bf16_t* CQ = (const bf16_t*)(c.ws + R_CQ); const bf16_t* CKNV = (const bf16_t*)(c.ws + R_CKNV); const bf16_t* CKR = (const bf16_t*)(c.ws + R_CKR);
    const bf16_t* PD = (const bf16_t*)(c.ws + R_PD); bf16_t* Y = (bf16_t*)(c.ws + WS_Y); bf16_t* O2 = (bf16_t*)(c.ws + R_O2);
    const int NU_C = 512, NU_D = 1024, NU_CC = with_ctx ? 8 : 0, NU_DC = with_ctx ? 16 : 0;
    const int total = NU_C + NU_D + NU_CC + NU_DC;
    for (int u = c.bid; u < total; u += c.G) {
        if (u < NU_C) { const int b = u >> 8, h = (u >> 6) & 3, qb = u & 63; const long row0 = (long)b * SEQ + 256 * qb;
            att::KeySrc ks{b * SEQ, 256, NLAT + b * CTXL};
            att::attn_unit<0>(CQ + row0 * 768 + 192 * h, 768, CKNV + 128 * h, 1024, CKR, CKNV + 512 + 128 * h, 1024, Y + row0 * 2048 + 1024 + 128 * h, nullptr, 2048, 0, ks, 260, 0.07216878364870322f, c.ldsg);
        } else if (u < NU_C + NU_D) { const int v = u - NU_C; const int b = v >> 9, h = (v >> 7) & 3, qb = v & 127; const long row0 = (long)b * SEQ + 128 * qb;
            att::KeySrc ks{b * SEQ, 256, NLAT + b * CTXL};
            att::attn_unit<1>(PD + row0 * 1536 + 128 * h, 1536, PD + 512 + 128 * h, 1536, nullptr, PD + 1024 + 128 * h, 1536, Y + row0 * 2048 + 1536 + 128 * h, O2 + row0 * 512 + 128 * h, 2048, 512, ks, 260, 0.125f, c.ldsg);
        } else if (u < NU_C + NU_D + NU_CC) { const int v = u - NU_C - NU_D; const int b = v >> 2, h = v & 3; const long row0 = (long)NLAT + b * CTXL;
            att::KeySrc ks{0, 0, NLAT + b * CTXL};
            att::attn_unit<0>(CQ + row0 * 768 + 192 * h, 768, CKNV + 128 * h, 1024, CKR, CKNV + 512 + 128 * h, 1024, Y + row0 * 2048 + 1024 + 128 * h, nullptr, 2048, 0, ks, 4, 0.07216878364870322f, c.ldsg);
        } else { const int v = u - NU_C - NU_D - NU_CC; const int b = v >> 3, h = (v >> 1) & 3, hf = v & 1; const long row0 = (long)NLAT + b * CTXL + 128 * hf;
            att::KeySrc ks{0, 0, NLAT + b * CTXL};
            att::attn_unit<1>(PD + row0 * 1536 + 128 * h, 1536, PD + 512 + 128 * h, 1536, nullptr, PD + 1024 + 128 * h, 1536, Y + row0 * 2048 + 1536 + 128 * h, O2 + row0 * 512 + 128 * h, 2048, 512, ks, 4, 0.125f, c.ldsg);
        }
    }
}
__device__ __forceinline__ void ph_dpost(const Ctx& c) {
    const int l = c.layer; const int M = (l == 0) ? MTOT : NLAT; const int gw = c.bid * 8 + c.wave, NGW = c.G * 8;
    bf16_t* Y = (bf16_t*)(c.ws + WS_Y); const bf16_t* O2 = (const bf16_t*)(c.ws + R_O2);
    const float lam_init = 0.8f - 0.6f * expf(-0.3f * (float)l);
    const float s1 = wave_sum(c.in[I_LQ1][l * 64 + c.lane] * c.in[I_LK1][l * 64 + c.lane]), s2 = wave_sum(c.in[I_LQ2][l * 64 + c.lane] * c.in[I_LK2][l * 64 + c.lane]);
    const float lam = expf(s1) - expf(s2) + lam_init;
    const float g0 = c.in[I_DGSUB][l * 128 + 2 * c.lane], g1 = c.in[I_DGSUB][l * 128 + 2 * c.lane + 1];
    for (int it = gw; it < M * 4; it += NGW) { const int r = it >> 2, h = it & 3;
        unsigned* yp = (unsigned*)(Y + (size_t)r * 2048 + 1536 + 128 * h) + c.lane; const unsigned w1 = *yp, w2 = *((const unsigned*)(O2 + (size_t)r * 512 + 128 * h) + c.lane);
        const float o0 = bflo(w1) - lam * bflo(w2), o1 = bfhi(w1) - lam * bfhi(w2);
        const float rs = rsqrtf(wave_sum(o0 * o0 + o1 * o1) * (1.f / 128.f) + EPS) * (1.f - lam_init);
        *yp = cvt_pk_bf16(o0 * rs * g0, o1 * rs * g1); }
}

__device__ __forceinline__ void ph_post1(const Ctx& c) {
    const int l = c.layer; const int M = (l == 0) ? MTOT : NLAT; const int gw = c.bid * 8 + c.wave, NGW = c.G * 8;
    const float* yo = (const float*)(c.ws + R_YOUT); const float* mod = (const float*)(c.ws + SM_MOD); bf16_t* U = (bf16_t*)(c.ws + WS_U);
    const float* gpost = c.in[I_GMIXPOST] + (size_t)l * DM; const float* gpre = c.in[I_GFFNPRE] + (size_t)l * DM;
    for (int r = gw; r < M; r += NGW) {
        const f32x4* yr = (const f32x4*)(yo + (size_t)r * DM) + c.lane; const f32x4* hr = (const f32x4*)hin_row(c, r) + c.lane; f32x4* ho = (f32x4*)hout_row(c, r) + c.lane;
        const float* md = mod + mod_idx(r) * 6144;
        f32x4 v[4]; float ss = 0.f;
#pragma unroll
        for (int j = 0; j < 4; ++j) { v[j] = yr[64 * j]; ss += (v[j].x * v[j].x + v[j].y * v[j].y) + (v[j].z * v[j].z + v[j].w * v[j].w); }
        const float rs = rsqrtf(wave_sum(ss) * (1.f / DM) + EPS);
        float ss2 = 0.f;
#pragma unroll
        for (int j = 0; j < 4; ++j) { const int e = 4 * (c.lane + 64 * j); const f32x4 g = *(const f32x4*)(gpost + e), gt = *(const f32x4*)(md + 2048 + e), h0 = hr[64 * j];
            f32x4 hn; hn.x = h0.x + gt.x * (v[j].x * rs * g.x); hn.y = h0.y + gt.y * (v[j].y * rs * g.y); hn.z = h0.z + gt.z * (v[j].z * rs * g.z); hn.w = h0.w + gt.w * (v[j].w * rs * g.w);
            ho[64 * j] = hn; v[j] = hn; ss2 += (hn.x * hn.x + hn.y * hn.y) + (hn.z * hn.z + hn.w * hn.w); }
        const float rs2 = rsqrtf(wave_sum(ss2) * (1.f / DM) + EPS);
#pragma unroll
        for (int j = 0; j < 4; ++j) { const int e = 4 * (c.lane + 64 * j); const f32x4 g = *(const f32x4*)(gpre + e), sh = *(const f32x4*)(md + 3072 + e), scl = *(const f32x4*)(md + 4096 + e);
            const float u0 = v[j].x * rs2 * g.x * (1.f + scl.x) + sh.x, u1 = v[j].y * rs2 * g.y * (1.f + scl.y) + sh.y, u2 = v[j].z * rs2 * g.z * (1.f + scl.z) + sh.z, u3 = v[j].w * rs2 * g.w * (1.f + scl.w) + sh.w;
            u32x2 w; w.x = cvt_pk_bf16(u0, u1); w.y = cvt_pk_bf16(u2, u3); *(u32x2*)(U + (size_t)r * DM + e) = w; }
    }
}
__device__ __forceinline__ void ph_post2(const Ctx& c) {
    const int l = c.layer; const int M = (l == 0) ? MTOT : NLAT; const int gw = c.bid * 8 + c.wave, NGW = c.G * 8;
    const float* z = (const float*)(c.ws + WS_Y); const float* mod = (const float*)(c.ws + SM_MOD); const float* gpost = c.in[I_GFFNPOST] + (size_t)l * DM;
    for (int r = gw; r < M; r += NGW) {
        const f32x4* zr = (const f32x4*)(z + (size_t)r * DM) + c.lane; f32x4* ho = (f32x4*)hout_row(c, r) + c.lane; const float* md = mod + mod_idx(r) * 6144;
        f32x4 v[4]; float ss = 0.f;
#pragma unroll
        for (int j = 0; j < 4; ++j) { v[j] = zr[64 * j]; ss += (v[j].x * v[j].x + v[j].y * v[j].y) + (v[j].z * v[j].z + v[j].w * v[j].w); }
        const float rs = rsqrtf(wave_sum(ss) * (1.f / DM) + EPS);
#pragma unroll
        for (int j = 0; j < 4; ++j) { const int e = 4 * (c.lane + 64 * j); const f32x4 g = *(const f32x4*)(gpost + e), gt = *(const f32x4*)(md + 5120 + e); f32x4 h0 = ho[64 * j];
            h0.x += gt.x * (v[j].x * rs * g.x); h0.y += gt.y * (v[j].y * rs * g.y); h0.z += gt.z * (v[j].z * rs * g.z); h0.w += gt.w * (v[j].w * rs * g.w); ho[64 * j] = h0; }
    }
}

template <class Epi>
__device__ __forceinline__ void run_gemm(const Ctx& c, const bf16_t* A, int lda, const bf16_t* Bt, int ldb, int M, int N, int K, const Epi& E) {
    pg8::Gemm g{A, Bt, M, N, K, lda, ldb}; pg8::StaticOrder S; S.init(M, N, c.G, c.bid);
    pg8::gemm_phase<Epi, true>(c.lds, g, S, E);
}
enum Phase { PH_CONV = 0, PH_NORM1, PH_GEMM_AB, PH_ROPE_A, PH_MIX_AB1, PH_SCAN, PH_MLSTM_C, PH_YB, PH_GEMM_CD, PH_MLA_PRE, PH_MLA_UP, PH_ROPE_CQ, PH_ATTN, PH_DPOST,
             PH_GATES, PH_BRANCH, PH_OUT, PH_POST1, PH_FFN_UP, PH_FFN_DN, PH_POST2, N_PHASES };

template <int PH>
__device__ __forceinline__ void run_phase(const Ctx& c) {
    unsigned char* ws = c.ws; const int Mrows = (c.layer == 0) ? MTOT : NLAT;
    bf16_t* U = (bf16_t*)(ws + WS_U); bf16_t* Y = (bf16_t*)(ws + WS_Y);
    if constexpr (PH == PH_CONV) ph_conv(c);
    if constexpr (PH == PH_NORM1) ph_norm1(c);
    if constexpr (PH == PH_GEMM_AB) { pg8::EpiB<pg8::EM_BF16> E{(bf16_t*)(ws + R_PAB), 2816, nullptr, 0, 0, 0}; run_gemm(c, U, 1024, (const bf16_t*)(ws + W_AB), 1024, MTOT, 2816, 1024, E); }
    if constexpr (PH == PH_ROPE_A) ph_rope_a(c);
    if constexpr (PH == PH_MIX_AB1) ph_mix_ab1(c);
    if constexpr (PH == PH_SCAN) ph_scan(c);
    if constexpr (PH == PH_MLSTM_C) ph_mlstm_c(c);
    if constexpr (PH == PH_YB) ph_yb(c);
    if constexpr (PH == PH_GEMM_CD) {
        { pg8::EpiB<pg8::EM_BF16> E{Y + 1024, 2048, nullptr, 0, 0, 0}; run_gemm(c, U, 1024, (const bf16_t*)(ws + W_C), 1024, MTOT, 1024, 1024, E); }
        { pg8::EpiB<pg8::EM_BF16> E{(bf16_t*)(ws + R_PD), 1536, nullptr, 0, 0, 0}; run_gemm(c, U, 1024, (const bf16_t*)(ws + W_D), 1024, MTOT, 1536, 1024, E); }
    }
    if constexpr (PH == PH_MLA_PRE) ph_mla_pre(c);
    if constexpr (PH == PH_MLA_UP) {
        { pg8::EpiB<pg8::EM_BF16> E{(bf16_t*)(ws + R_CQ), 768, nullptr, 0, 0, 0}; run_gemm(c, Y + 1024, 2048, (const bf16_t*)(ws + W_UQ), 512, MTOT, 768, 512, E); }
        { pg8::EpiB<pg8::EM_BF16> E{(bf16_t*)(ws + R_CKNV), 1024, nullptr, 0, 0, 0}; run_gemm(c, Y + 1024 + 512, 2048, (const bf16_t*)(ws + W_UKV), 256, MTOT, 1024, 256, E); }
    }
    if constexpr (PH == PH_ROPE_CQ) ph_rope_cq(c);
    if constexpr (PH == PH_ATTN) ph_attn(c);
    if constexpr (PH == PH_DPOST) ph_dpost(c);
    if constexpr (PH == PH_GATES) { pg8::EpiB<pg8::EM_SIG> E{(bf16_t*)(ws + R_G), 4096, nullptr, 0, 0, 0}; run_gemm(c, U, 1024, (const bf16_t*)(ws + W_G), 1024, Mrows, 4096, 1024, E); }
    if constexpr (PH == PH_BRANCH) {
#pragma unroll
        for (int i = 0; i < 4; ++i) { pg8::EpiB<pg8::EM_GATEACC> E{U, 1024, (const bf16_t*)(ws + R_G), 4096, 1024 * i, i == 0 ? 1 : 0};
            run_gemm(c, Y + 512 * i, 2048, (const bf16_t*)(ws + W_BR) + 512 * i, 2048, Mrows, 1024, 512, E); }
    }
    if constexpr (PH == PH_OUT) { pg8::EpiF32 E{(float*)(ws + R_YOUT), 1024}; run_gemm(c, U, 1024, (const bf16_t*)(ws + W_OUT), 1024, Mrows, 1024, 1024, E); }
    if constexpr (PH == PH_POST1) ph_post1(c);
    if constexpr (PH == PH_FFN_UP) { pg8::EpiB<pg8::EM_SWIGLU> E{(bf16_t*)(ws + R_HID), 2816, nullptr, 0, 0, 0}; run_gemm(c, U, 1024, (const bf16_t*)(ws + W_GU), 1024, Mrows, 5632, 1024, E); }
    if constexpr (PH == PH_FFN_DN) { pg8::EpiF32 E{(float*)(ws + WS_Y), 1024}; run_gemm(c, (const bf16_t*)(ws + R_HID), 2816, (const bf16_t*)(ws + W_DN), 2816, Mrows, 1024, 2816, E); }
    if constexpr (PH == PH_POST2) ph_post2(c);
}

template <int PH>
__global__ void __launch_bounds__(512, 2) k_phase(Args args) {
    extern __shared__ __attribute__((aligned(16))) unsigned char lds[];
    Ctx c; c.in = args.in; c.out = args.out; c.ws = args.ws; c.layer = args.layer;
    c.lds = (LAS unsigned char*)lds; c.ldsg = (char*)lds;
    c.tid = threadIdx.x; c.lane = c.tid & 63; c.wave = __builtin_amdgcn_readfirstlane(c.tid >> 6); c.G = gridDim.x; c.bid = blockIdx.x;
    run_phase<PH>(c);
}

template <int PH> static void launch_phase(const Args& a, int grid, hipStream_t stream) {
    static bool attr_set = false;
    if (!attr_set) { (void)hipFuncSetAttribute((const void*)k_phase<PH>, hipFuncAttributeMaxDynamicSharedMemorySize, LDS_BYTES); attr_set = true; }
    hipLaunchKernelGGL(k_phase<PH>, dim3(grid), dim3(512), LDS_BYTES, stream, a);
}
template <int PH> static void launch_all(Args& a, int grid, hipStream_t stream) {
    if constexpr (PH < N_PHASES) { launch_phase<PH>(a, grid, stream); launch_all<PH + 1>(a, grid, stream); }
}

extern "C" void kernel_launch(void* const* d_in, const int* in_sizes, int n_in, void* d_out, int out_size, void* d_ws, size_t ws_size, hipStream_t stream) {
    static int grid = 0;
    if (grid == 0) {
        if (n_in != N_IN || out_size != NLAT * DM || ws_size < WS_END) { fprintf(stderr, "kernel_launch: unexpected shapes: n_in %d out %d ws %zu\n", n_in, out_size, ws_size); grid = -1; return; }
        int dev = 0, cus = 0;
        if (hipGetDevice(&dev) != hipSuccess || hipDeviceGetAttribute(&cus, hipDeviceAttributeMultiprocessorCount, dev) != hipSuccess) { grid = -1; return; }
        grid = cus;
    }
    if (grid < 0) return;
    (void)hipMemsetAsync((char*)d_ws + WS_CTL, 0, CTL_ZERO_BYTES, stream);
    Args a{};
    for (int i = 0; i < N_IN; ++i) a.in[i] = (const float*)d_in[i];
    a.out = (float*)d_out; a.ws = (unsigned char*)d_ws; a.pad = 0;
    for (int l = 0; l < 2; ++l) { a.layer = l; launch_all<0>(a, grid, stream); }
}
```

```cpp
#include <hip/hip_runtime.h>
#include <hip/hip_bf16.h>
#include <cstdio>
#include <cstdint>
#include <cmath>

#define LAS __attribute__((address_space(3)))
#define GAS __attribute__((address_space(1)))
typedef unsigned short bf16_t;
typedef short bf16x8 __attribute__((ext_vector_type(8)));
typedef short s16x4 __attribute__((ext_vector_type(4)));
typedef float f32x4 __attribute__((ext_vector_type(4)));
typedef float f32x2 __attribute__((ext_vector_type(2)));
typedef float f32x16 __attribute__((ext_vector_type(16)));
typedef unsigned u32x4 __attribute__((ext_vector_type(4)));
typedef unsigned u32x2 __attribute__((ext_vector_type(2)));
typedef int i32x4 __attribute__((ext_vector_type(4)));

__device__ __forceinline__ unsigned cvt_pk_bf16(float lo, float hi) { unsigned r; asm volatile("v_cvt_pk_bf16_f32 %0, %1, %2" : "=v"(r) : "v"(lo), "v"(hi)); return r; }
__device__ __forceinline__ bf16_t f2bf(float f) { return (bf16_t)(cvt_pk_bf16(f, 0.f) & 0xffffu); }
__device__ __forceinline__ float bf2f(bf16_t v) { return __uint_as_float(((unsigned)v) << 16); }
__device__ __forceinline__ float bflo(unsigned w) { return __uint_as_float(w << 16); }
__device__ __forceinline__ float bfhi(unsigned w) { return __uint_as_float(w & 0xffff0000u); }
__device__ __forceinline__ float sigmoidf_(float x) { return __builtin_amdgcn_rcpf(1.f + __builtin_amdgcn_exp2f(-1.4426950408889634f * x)); }
__device__ __forceinline__ int ltid() { int t = threadIdx.x; asm volatile("" : "+v"(t)); return t; }

namespace pg8 {
constexpr int BM = 256, BK = 64, HALF = 128, HTB = HALF * BK * 2, STAGE_BYTES = 8 * HTB, NXCD = 8, WGM = 8;
__host__ __device__ __forceinline__ int lds_byte(int r, int c) { const int st = (r >> 4) * 2 + (c >> 5), rr = r & 15, cc = c & 31, ob = rr * 64 + cc * 2; return st * 1024 + (ob ^ (((ob >> 9) & 1) << 5)); }
__host__ __device__ __forceinline__ void stage_rc(int b, int& R, int& C) { const int st = b / 1024, sb = b % 1024, swz = sb ^ (((sb >> 9) & 1) << 5); R = (st >> 1) * 16 + swz / 64; C = (st & 1) * 32 + (swz % 64) / 2; }
__host__ __device__ __forceinline__ int perm32(int rho) { const int n = rho >> 4, i = rho & 15; return 8 * (i >> 2) + 4 * n + (i & 3); }

struct Unit { int pm, pn, kb; };
struct Gemm { const bf16_t* A; const bf16_t* Bt; int M, N, K, lda, ldb; int kslice = 0; const float* sa = nullptr; const float* sb = nullptr; };

struct StaticOrder {
    int nM, nN, nwg, G, c;
    __host__ __device__ void init(int M, int N, int G_, int c_) { nM = M / BM; nN = N / BM; nwg = nM * nN; G = G_; c = c_; }
    __host__ __device__ bool next(int i, Unit& u) const {
        const long L = (long)i * G + c; if (L >= nwg) return false;
        int wgid = (int)L; { const int q = nwg / NXCD, r = nwg % NXCD, xcd = wgid % NXCD, off = wgid / NXCD; wgid = (xcd < r ? xcd * (q + 1) : r * (q + 1) + (xcd - r) * q) + off; }
        const int nig = WGM * nN, gid = wgid / nig, fm = gid * WGM, gsz = (nM - fm) < WGM ? (nM - fm) : WGM;
        u.pm = fm + ((wgid % nig) % gsz); u.pn = (wgid % nig) / gsz; u.kb = 0; return true;
    }
};
struct SkipOrder {
    StaticOrder S; int G, c, n9, nM, spn, nskip;
    __host__ __device__ void init(int M, int N, int G_, int c_, int spn_, int nskip_) { S.init(M, N - BM, G_, c_); G = G_; c = c_; n9 = S.nwg; nM = M / BM; spn = spn_; nskip = nskip_; }
    __host__ __device__ bool next(int i, Unit& u) const {
        const long L = (long)i * G + c;
        if (L < n9) { S.next(i, u); if (u.pn >= spn) u.pn += 1; return true; }
        const int k = (int)(L - n9); if (k >= nM - nskip) return false;
        u.pm = nskip + k; u.pn = spn; u.kb = 0; return true; }
};
struct ColOrder {
    int c, c0, n, pn;
    __host__ __device__ void init(int c_, int c0_, int n_, int pn_) { c = c_; c0 = c0_; n = n_; pn = pn_; }
    __host__ __device__ bool next(int i, Unit& u) const { if (i != 0 || c < c0 || c >= c0 + n) return false; u.pm = c - c0; u.pn = pn; u.kb = 0; return true; }
};
struct SliceOrder1 {
    StaticOrder S; int kb;
    __host__ __device__ void init(int M, int N, int G_, int c_, int kb_) { S.init(M, N, G_, c_); kb = kb_; }
    __host__ __device__ bool next(int i, Unit& u) const { if (!S.next(i, u)) return false; u.kb = kb; return true; }
};
template <int NS> struct SliceOrder {
    StaticOrder S;
    __host__ __device__ void init(int M, int N, int G_, int c_) { S.init(M, N, G_, c_); }
    __host__ __device__ bool next(int i, Unit& u) const { if (!S.next(i / NS, u)) return false; u.kb = i % NS; return true; }
};

enum { EM_BF16 = 0, EM_SIG = 1, EM_SWIGLU = 2, EM_GATEACC = 3, EM_SIG8 = 4 };
template <int MODE> struct EpiB {
    static constexpr bool PERM = true;
    bf16_t* O; int ldc;
    const bf16_t* G; int ldg; int gcol0; int first;
    bf16_t* O2 = nullptr; int ldc2 = 0, split_pn = 1 << 30;
    __device__ __forceinline__ void operator()(const f32x4 (&acc)[2][2][4][2], const Unit& u, int wr, int wc, int fr, int fq) const {
        const int row0 = u.pm * BM + wr * 64 + fr;
        if constexpr (MODE == EM_SWIGLU) {
            const int col0 = u.pn * HALF + wc * 32 + 8 * fq;
#pragma unroll
            for (int ai = 0; ai < 2; ++ai)
#pragma unroll
                for (int m = 0; m < 4; ++m) { bf16_t* rowp = O + (size_t)(row0 + ai * HALF + m * 16) * ldc + col0;
                    float v[8];
#pragma unroll
                    for (int n = 0; n < 2; ++n)
#pragma unroll
                        for (int j = 0; j < 4; ++j) { const float g = acc[ai][0][m][n][j], up = acc[ai][1][m][n][j]; v[n * 4 + j] = g * sigmoidf_(g) * up; }
                    u32x4 w; w.x = cvt_pk_bf16(v[0], v[1]); w.y = cvt_pk_bf16(v[2], v[3]); w.z = cvt_pk_bf16(v[4], v[5]); w.w = cvt_pk_bf16(v[6], v[7]);
                    *(u32x4*)rowp = w; }
        } else if constexpr (MODE == EM_GATEACC) {
            const int col0 = u.pn * BM + wc * 32 + 8 * fq; constexpr float I255 = 1.f / 255.f;
#pragma unroll
            for (int ai = 0; ai < 2; ++ai) { u32x2 gw[4][2]; u32x4 ow[4][2];
#pragma unroll
                for (int m = 0; m < 4; ++m) { const size_t r = (size_t)(row0 + ai * HALF + m * 16);
#pragma unroll
                    for (int bj = 0; bj < 2; ++bj) gw[m][bj] = *(const u32x2*)((const unsigned char*)G + r * ldg + u.kb * gcol0 + col0 + bj * HALF); }
                if (u.kb != 0) {
#pragma unroll
                    for (int m = 0; m < 4; ++m) { const size_t r = (size_t)(row0 + ai * HALF + m * 16);
#pragma unroll
                        for (int bj = 0; bj < 2; ++bj) ow[m][bj] = *(const u32x4*)(O + r * ldc + col0 + bj * HALF); }
                } else {
#pragma unroll
                    for (int m = 0; m < 4; ++m)
#pragma unroll
                        for (int bj = 0; bj < 2; ++bj) ow[m][bj] = u32x4{0u, 0u, 0u, 0u}; }
                __builtin_amdgcn_sched_barrier(0);
#pragma unroll
                for (int m = 0; m < 4; ++m) { bf16_t* rowp = O + (size_t)(row0 + ai * HALF + m * 16) * ldc + col0;
#pragma unroll
                    for (int bj = 0; bj < 2; ++bj) { f32x4 v0 = acc[ai][bj][m][0], v1 = acc[ai][bj][m][1]; const u32x2 g8 = gw[m][bj]; const u32x4 pw = ow[m][bj];
                        v0[0] = fmaf(v0[0], (float)(g8.x & 255u) * I255, bflo(pw.x)); v0[1] = fmaf(v0[1], (float)((g8.x >> 8) & 255u) * I255, bfhi(pw.x));
                        v0[2] = fmaf(v0[2], (float)((g8.x >> 16) & 255u) * I255, bflo(pw.y)); v0[3] = fmaf(v0[3], (float)(g8.x >> 24) * I255, bfhi(pw.y));
                        v1[0] = fmaf(v1[0], (float)(g8.y & 255u) * I255, bflo(pw.z)); v1[1] = fmaf(v1[1], (float)((g8.y >> 8) & 255u) * I255, bfhi(pw.z));
                        v1[2] = fmaf(v1[2], (float)((g8.y >> 16) & 255u) * I255, bflo(pw.w)); v1[3] = fmaf(v1[3], (float)(g8.y >> 24) * I255, bfhi(pw.w));
                        u32x4 w; w.x = cvt_pk_bf16(v0[0], v0[1]); w.y = cvt_pk_bf16(v0[2], v0[3]); w.z = cvt_pk_bf16(v1[0], v1[1]); w.w = cvt_pk_bf16(v1[2], v1[3]);
                        *(u32x4*)(rowp + bj * HALF) = w; } }
            }
        } else {
            const bool sp = u.pn >= split_pn; const int col0 = (sp ? u.pn - split_pn : u.pn) * BM + wc * 32 + 8 * fq; bf16_t* Ob = sp ? O2 : O; const int ldo_ = sp ? ldc2 : ldc;
#pragma unroll
            for (int ai = 0; ai < 2; ++ai)
#pragma unroll
                for (int m = 0; m < 4; ++m) { const size_t r = (size_t)(row0 + ai * HALF + m * 16); bf16_t* rowp = Ob + r * ldo_ + col0;
#pragma unroll
                    for (int bj = 0; bj < 2; ++bj) { f32x4 v0 = acc[ai][bj][m][0], v1 = acc[ai][bj][m][1];
                        if constexpr (MODE == EM_SIG8) {
                            unsigned lo = 0u, hi = 0u;
#pragma unroll
                            for (int j = 0; j < 4; ++j) { lo |= (unsigned)__float2int_rn(__builtin_amdgcn_rcpf(fmaf(__builtin_amdgcn_exp2f(-1.4426950408889634f * v0[j]), 1.f / 255.f, 1.f / 255.f))) << (8 * j); hi |= (unsigned)__float2int_rn(__builtin_amdgcn_rcpf(fmaf(__builtin_amdgcn_exp2f(-1.4426950408889634f * v1[j]), 1.f / 255.f, 1.f / 255.f))) << (8 * j); }
                            u32x2 w8; w8.x = lo; w8.y = hi; *(u32x2*)((unsigned char*)O + r * ldc + col0 + bj * HALF) = w8; continue; }
                        if constexpr (MODE == EM_SIG) {
#pragma unroll
                            for (int j = 0; j < 4; ++j) { v0[j] = sigmoidf_(v0[j]); v1[j] = sigmoidf_(v1[j]); } }
                        if constexpr (MODE == EM_GATEACC) {
                            const u32x2 gw = *(const u32x2*)((const unsigned char*)G + r * ldg + u.kb * gcol0 + col0 + bj * HALF);
                            constexpr float I255 = 1.f / 255.f;
                            v0[0] *= (float)(gw.x & 255u) * I255; v0[1] *= (float)((gw.x >> 8) & 255u) * I255; v0[2] *= (float)((gw.x >> 16) & 255u) * I255; v0[3] *= (float)(gw.x >> 24) * I255;
                            v1[0] *= (float)(gw.y & 255u) * I255; v1[1] *= (float)((gw.y >> 8) & 255u) * I255; v1[2] *= (float)((gw.y >> 16) & 255u) * I255; v1[3] *= (float)(gw.y >> 24) * I255;
                            if (u.kb != 0) { const u32x4 ow = *(const u32x4*)(rowp + bj * HALF);
                                v0[0] += bflo(ow.x); v0[1] += bfhi(ow.x); v0[2] += bflo(ow.y); v0[3] += bfhi(ow.y);
                                v1[0] += bflo(ow.z); v1[1] += bfhi(ow.z); v1[2] += bflo(ow.w); v1[3] += bfhi(ow.w); } }
                        u32x4 w; w.x = cvt_pk_bf16(v0[0], v0[1]); w.y = cvt_pk_bf16(v0[2], v0[3]); w.z = cvt_pk_bf16(v1[0], v1[1]); w.w = cvt_pk_bf16(v1[2], v1[3]);
                        *(u32x4*)(rowp + bj * HALF) = w; } }
        }
    }
};
struct EpiF32 {
    static constexpr bool PERM = false;
    float* O; int ldc;
    __device__ __forceinline__ void operator()(const f32x4 (&acc)[2][2][4][2], const Unit& u, int wr, int wc, int fr, int fq) const {
        const int row0 = u.pm * BM + wr * 64 + fr, col0 = u.pn * BM + wc * 32 + 4 * fq;
#pragma unroll
        for (int ai = 0; ai < 2; ++ai)
#pragma unroll
            for (int m = 0; m < 4; ++m) { float* rowp = O + (size_t)(row0 + ai * HALF + m * 16) * ldc + col0;
#pragma unroll
                for (int bj = 0; bj < 2; ++bj)
#pragma unroll
                    for (int n = 0; n < 2; ++n) *(f32x4*)(rowp + bj * HALF + n * 16) = acc[ai][bj][m][n]; }
    }
};

template <bool I8> struct AccSel { typedef f32x4 T; };
template <> struct AccSel<true> { typedef i32x4 T; };
template <class Epi, class Sched, bool ALIGN_EPI = true, bool I8 = false>
__device__ __forceinline__ void gemm_phase(LAS unsigned char* lds, const Gemm g, const Sched& S, const Epi& E) {
    typedef f32x4 accv;
    const int tid = ltid(), wid = __builtin_amdgcn_readfirstlane(tid >> 6), lane = tid & 63, wr = wid >> 2, wc = wid & 3, fr = lane & 15, fq = lane >> 4;
    const int K = g.K, nt = K / BK;
    unsigned voffA[2], voffB[2];
#pragma unroll
    for (int i = 0; i < 2; ++i) { int R, C; stage_rc(tid * 16 + i * 8192, R, C); const int Rb = Epi::PERM ? ((R & ~31) + perm32(R & 31)) : R;
        voffA[i] = (unsigned)(R * g.lda + C) * 2u; voffB[i] = (unsigned)(Rb * g.ldb + C) * 2u; }
    const size_t kstep = (size_t)(BK * 2);
    const size_t hstepA = (size_t)HALF * g.lda * 2, hstepB = (size_t)HALF * g.ldb * 2;
    const size_t tstepA = 2 * hstepA, tstepB = 2 * hstepB;
    const unsigned ldsw = (unsigned)wid * 1024u;
    const int aoff = lds_byte(wr * 64 + fr, fq * 8), boff = lds_byte(wc * 32 + fr, fq * 8);
#define PG8_SA(b, h) (((b) * 2 + (h)) * HTB)
#define PG8_SB(b, h) ((4 + (b) * 2 + (h)) * HTB)
#define PG8_STAGE(bufoff, gbase, voff) do { _Pragma("unroll") for (int _i = 0; _i < 2; ++_i) \
        __builtin_amdgcn_global_load_lds((const unsigned*)((const char*)(gbase) + (voff)[_i]), (LAS unsigned*)(lds + (bufoff) + ldsw + _i * 8192), 16, 0, 0); } while (0)
#define PG8_LDA(dst, b, h) do { _Pragma("unroll") for (int m = 0; m < 4; ++m) _Pragma("unroll") for (int k = 0; k < 2; ++k) dst[m][k] = *(const LAS bf16x8*)(lds + PG8_SA(b, h) + aoff + m * 2048 + k * 1024); } while (0)
#define PG8_LDB(dst, b, h) do { _Pragma("unroll") for (int n = 0; n < 2; ++n) _Pragma("unroll") for (int k = 0; k < 2; ++k) dst[n][k] = *(const LAS bf16x8*)(lds + PG8_SB(b, h) + boff + n * 2048 + k * 1024); } while (0)
#define PG8_MMA(ai, bj, At, Bt) do { __builtin_amdgcn_s_setprio(1); _Pragma("unroll") for (int m = 0; m < 4; ++m) _Pragma("unroll") for (int n = 0; n < 2; ++n) _Pragma("unroll") for (int k = 0; k < 2; ++k) { \
        if constexpr (I8) acc[ai][bj][m][n] = __builtin_bit_cast(accv, __builtin_amdgcn_mfma_i32_16x16x64_i8(__builtin_bit_cast(i32x4, Bt[n][k]), __builtin_bit_cast(i32x4, At[m][k]), __builtin_bit_cast(i32x4, acc[ai][bj][m][n]), 0, 0, 0)); \
        else acc[ai][bj][m][n] = __builtin_bit_cast(accv, __builtin_amdgcn_mfma_f32_16x16x32_bf16(Bt[n][k], At[m][k], __builtin_bit_cast(f32x4, acc[ai][bj][m][n]), 0, 0, 0)); } __builtin_amdgcn_s_setprio(0); } while (0)
#define PG8_WAIT_V(n) asm volatile("s_waitcnt vmcnt(" #n ")" ::: "memory")
#define PG8_WAIT_L(n) asm volatile("s_waitcnt lgkmcnt(" #n ")" ::: "memory")
#define PG8_BAR __builtin_amdgcn_s_barrier()
#define PG8_SCHED __builtin_amdgcn_sched_barrier(0)
    Unit cur, nxt; int ui = 0;
    if (!S.next(0, cur)) return;
    accv acc[2][2][4][2];
#pragma unroll
    for (int a = 0; a < 2; ++a)
#pragma unroll
        for (int b = 0; b < 2; ++b)
#pragma unroll
            for (int m = 0; m < 4; ++m)
#pragma unroll
                for (int n = 0; n < 2; ++n) acc[a][b][m][n] = accv{};
    bf16x8 At[4][2], B0[2][2], B1[2][2];
    const char* cA = (const char*)g.A + (size_t)cur.pm * tstepA + (size_t)cur.kb * g.kslice; const char* cB = (const char*)g.Bt + (size_t)cur.pn * tstepB + (size_t)cur.kb * g.kslice;
    PG8_STAGE(PG8_SB(0, 0), cB, voffB); PG8_STAGE(PG8_SB(0, 1), cB + hstepB, voffB); PG8_STAGE(PG8_SA(0, 0), cA, voffA); PG8_STAGE(PG8_SA(0, 1), cA + hstepA, voffA);
    if (wr == 1) PG8_BAR;
    PG8_WAIT_V(2); PG8_BAR;
    PG8_STAGE(PG8_SB(1, 0), cB + kstep, voffB); PG8_STAGE(PG8_SA(1, 0), cA + kstep, voffA); PG8_STAGE(PG8_SB(1, 1), cB + hstepB + kstep, voffB);
    PG8_WAIT_V(6); PG8_BAR;
    for (;;) {
        const bool has_next = S.next(ui + 1, nxt);
        const char* nA = has_next ? (const char*)g.A + (size_t)nxt.pm * tstepA + (size_t)nxt.kb * g.kslice : cA; const char* nB = has_next ? (const char*)g.Bt + (size_t)nxt.pn * tstepB + (size_t)nxt.kb * g.kslice : cB;
        for (int t = 0; t < nt; t += 2) {
            const bool last = (t == nt - 2);
            const char* a1 = cA + (size_t)(t + 1) * kstep;
            const char* a2 = last ? nA : cA + (size_t)(t + 2) * kstep; const char* b2 = last ? nB : cB + (size_t)(t + 2) * kstep;
            const char* a3 = a2 + kstep; const char* b3 = b2 + kstep;
            PG8_LDB(B0, 0, 0); PG8_LDB(B1, 0, 1); PG8_SCHED; PG8_LDA(At, 0, 0); PG8_STAGE(PG8_SA(1, 1), a1 + hstepA, voffA);
            PG8_WAIT_V(8); PG8_WAIT_L(0); PG8_BAR; PG8_MMA(0, 0, At, B0); PG8_MMA(0, 1, At, B1); PG8_BAR; PG8_SCHED;
            PG8_LDA(At, 0, 1); PG8_STAGE(PG8_SB(0, 0), b2, voffB); PG8_STAGE(PG8_SB(0, 1), b2 + hstepB, voffB); PG8_STAGE(PG8_SA(0, 0), a2, voffA);
            PG8_WAIT_V(8); PG8_WAIT_L(0); PG8_BAR; PG8_MMA(1, 0, At, B0); PG8_MMA(1, 1, At, B1); PG8_BAR; PG8_SCHED;
            PG8_LDB(B0, 1, 0); PG8_LDB(B1, 1, 1); PG8_SCHED; PG8_LDA(At, 1, 0); PG8_STAGE(PG8_SA(0, 1), a2 + hstepA, voffA);
            PG8_WAIT_V(8); PG8_WAIT_L(0); PG8_BAR; PG8_MMA(0, 0, At, B0); PG8_MMA(0, 1, At, B1); PG8_BAR; PG8_SCHED;
            PG8_LDA(At, 1, 1); PG8_STAGE(PG8_SB(1, 0), b3, voffB); PG8_STAGE(PG8_SB(1, 1), b3 + hstepB, voffB); PG8_STAGE(PG8_SA(1, 0), a3, voffA);
            PG8_WAIT_V(8); PG8_WAIT_L(0); PG8_BAR; PG8_MMA(1, 0, At, B0); PG8_MMA(1, 1, At, B1); PG8_BAR; PG8_SCHED;
        }
        if constexpr (ALIGN_EPI) { if (wr == 0) PG8_BAR; }
        if constexpr (I8) {
            f32x4 sb4[2][2]; const int cb0 = cur.pn * BM + wc * 32 + (Epi::PERM ? 8 * fq : 4 * fq);
#pragma unroll
            for (int b = 0; b < 2; ++b)
#pragma unroll
                for (int n = 0; n < 2; ++n) sb4[b][n] = *(const f32x4*)(g.sb + cb0 + b * HALF + (Epi::PERM ? 4 * n : 16 * n));
#pragma unroll
            for (int a = 0; a < 2; ++a)
#pragma unroll
                for (int m = 0; m < 4; ++m) { const float ra = g.sa[cur.pm * BM + a * HALF + wr * 64 + m * 16 + fr];
#pragma unroll
                    for (int b = 0; b < 2; ++b)
#pragma unroll
                        for (int n = 0; n < 2; ++n) { const i32x4 v = __builtin_bit_cast(i32x4, acc[a][b][m][n]);
                            acc[a][b][m][n] = (f32x4){(float)v.x, (float)v.y, (float)v.z, (float)v.w} * ra * sb4[b][n]; } }
        }
        E(acc, cur, wr, wc, fr, fq);
        if (!has_next) break;
#pragma unroll
        for (int a = 0; a < 2; ++a)
#pragma unroll
            for (int b = 0; b < 2; ++b)
#pragma unroll
                for (int m = 0; m < 4; ++m)
#pragma unroll
                    for (int n = 0; n < 2; ++n) acc[a][b][m][n] = accv{};
        cur = nxt; cA = nA; cB = nB; ++ui;
        if constexpr (ALIGN_EPI) { if (wr == 1) PG8_BAR; }
    }
    PG8_WAIT_V(0);
    if constexpr (!ALIGN_EPI) { if (wr == 0) PG8_BAR; }
    PG8_BAR;
#undef PG8_SA
#undef PG8_SB
#undef PG8_STAGE
#undef PG8_LDA
#undef PG8_LDB
#undef PG8_MMA
#undef PG8_WAIT_V
#undef PG8_WAIT_L
#undef PG8_BAR
#undef PG8_SCHED
}
}

namespace att {
#ifndef ATTN_UNIT
#define ATTN_UNIT attn_unit_sbd
#endif
#ifndef SKEW_HALVES
#define SKEW_HALVES 0
#endif
#ifndef ATTN_D_UNIT
#define ATTN_D_UNIT attn_unit_p2
#endif
#ifndef ATTN_C_UNIT
#define ATTN_C_UNIT attn_unit_pipe
#endif
#ifndef HO_HALF_EXPR
#define HO_HALF_EXPR (wid >> 2)
#endif
#define SBAR() __builtin_amdgcn_sched_barrier(0)
constexpr int KVBLK = 64;
constexpr int SHM_V = KVBLK * 128 * 2;
__device__ __forceinline__ int crow(int r, int hi) { return (r & 3) + 8 * (r >> 2) + 4 * hi; }
template <int NCB = 4> __device__ __forceinline__ int v_st(int k, int c) { const int kk = (k & ~0xC) | ((k & 4) << 1) | ((k & 8) >> 1); return ((kk >> 3) * NCB + (c >> 5)) * 512 + ((kk & 7) * 32 + (c & 31)) * 2; }
__device__ __forceinline__ int v_rd_base(int lane) { return ((lane & 3) << 3) | (((lane >> 2) & 3) << 6) | (((lane >> 4) & 1) << 5) | (((lane >> 5) & 1) << 8); }
constexpr int v_rd_off(int d0, int ks, int half, int ncb = 4) { return ((2 * ks + half) * ncb + d0) * 512; }
template <int OFF> __device__ __forceinline__ s16x4 tr_read(int vb) {
  s16x4 r; asm volatile("ds_read_b64_tr_b16 %0, %1 offset:%2" : "=&v"(r) : "v"(vb), "i"(OFF) : "memory"); return r;
}
template <int D0, int NCB = 4> __device__ __forceinline__ void pv_one(f32x16& od, int vb, bf16x8 pa0, bf16x8 pa1, bf16x8 pa2, bf16x8 pa3) {
  const s16x4 l0 = tr_read<v_rd_off(D0, 0, 0, NCB)>(vb), h0 = tr_read<v_rd_off(D0, 0, 1, NCB)>(vb), l1 = tr_read<v_rd_off(D0, 1, 0, NCB)>(vb), h1 = tr_read<v_rd_off(D0, 1, 1, NCB)>(vb);
  const s16x4 l2 = tr_read<v_rd_off(D0, 2, 0, NCB)>(vb), h2 = tr_read<v_rd_off(D0, 2, 1, NCB)>(vb), l3 = tr_read<v_rd_off(D0, 3, 0, NCB)>(vb), h3 = tr_read<v_rd_off(D0, 3, 1, NCB)>(vb);
  asm volatile("s_waitcnt lgkmcnt(0)" ::: "memory"); SBAR();
#define PK(L, H) (bf16x8){L[0], L[1], L[2], L[3], H[0], H[1], H[2], H[3]}
  od = __builtin_amdgcn_mfma_f32_32x32x16_bf16(pa0, PK(l0, h0), od, 0, 0, 0);
  od = __builtin_amdgcn_mfma_f32_32x32x16_bf16(pa1, PK(l1, h1), od, 0, 0, 0);
  od = __builtin_amdgcn_mfma_f32_32x32x16_bf16(pa2, PK(l2, h2), od, 0, 0, 0);
  od = __builtin_amdgcn_mfma_f32_32x32x16_bf16(pa3, PK(l3, h3), od, 0, 0, 0);
#undef PK
}
template <int NCB> __device__ __forceinline__ void pv_d0(f32x16* o, int vb, bf16x8 pa0, bf16x8 pa1, bf16x8 pa2, bf16x8 pa3) {
  pv_one<0, NCB>(o[0], vb, pa0, pa1, pa2, pa3); pv_one<1, NCB>(o[1], vb, pa0, pa1, pa2, pa3);
  if constexpr (NCB == 4) { pv_one<2, NCB>(o[2], vb, pa0, pa1, pa2, pa3); pv_one<3, NCB>(o[3], vb, pa0, pa1, pa2, pa3); }
}
struct VFrag { s16x4 l0, h0, l1, h1, l2, h2, l3, h3; };
template <int D0> __device__ __forceinline__ void pv_issue(VFrag& f, int vb) {
  f.l0 = tr_read<v_rd_off(D0, 0, 0)>(vb); f.h0 = tr_read<v_rd_off(D0, 0, 1)>(vb); f.l1 = tr_read<v_rd_off(D0, 1, 0)>(vb); f.h1 = tr_read<v_rd_off(D0, 1, 1)>(vb);
  f.l2 = tr_read<v_rd_off(D0, 2, 0)>(vb); f.h2 = tr_read<v_rd_off(D0, 2, 1)>(vb); f.l3 = tr_read<v_rd_off(D0, 3, 0)>(vb); f.h3 = tr_read<v_rd_off(D0, 3, 1)>(vb);
}
template <int NWAIT> __device__ __forceinline__ void pv_mma(f32x16& od, const VFrag& f, bf16x8 pa0, bf16x8 pa1, bf16x8 pa2, bf16x8 pa3) {
  if constexpr (NWAIT == 8) asm volatile("s_waitcnt lgkmcnt(8)" ::: "memory"); else asm volatile("s_waitcnt lgkmcnt(0)" ::: "memory");
  SBAR();
#ifdef ATT_SETPRIO
  __builtin_amdgcn_s_setprio(1);
#endif
#define PK(L, H) (bf16x8){L[0], L[1], L[2], L[3], H[0], H[1], H[2], H[3]}
  od = __builtin_amdgcn_mfma_f32_32x32x16_bf16(pa0, PK(f.l0, f.h0), od, 0, 0, 0);
  od = __builtin_amdgcn_mfma_f32_32x32x16_bf16(pa1, PK(f.l1, f.h1), od, 0, 0, 0);
  od = __builtin_amdgcn_mfma_f32_32x32x16_bf16(pa2, PK(f.l2, f.h2), od, 0, 0, 0);
  od = __builtin_amdgcn_mfma_f32_32x32x16_bf16(pa3, PK(f.l3, f.h3), od, 0, 0, 0);
#undef PK
#ifdef ATT_SETPRIO
  __builtin_amdgcn_s_setprio(0);
#endif
}
__device__ __forceinline__ void pv_d0_pf(f32x16* o, int vb, bf16x8 pa0, bf16x8 pa1, bf16x8 pa2, bf16x8 pa3) {
  VFrag fa, fb;
  pv_issue<0>(fa, vb); pv_issue<1>(fb, vb); pv_mma<8>(o[0], fa, pa0, pa1, pa2, pa3); pv_issue<2>(fa, vb);
  pv_mma<8>(o[1], fb, pa0, pa1, pa2, pa3); pv_issue<3>(fb, vb);
  pv_mma<8>(o[2], fa, pa0, pa1, pa2, pa3); pv_mma<0>(o[3], fb, pa0, pa1, pa2, pa3);
}
__device__ __forceinline__ void partialSM(f32x16& p0, f32x16& p1, float& m_reg, float& mn, float& alpha, const float C, const float thr_raw) {
  float pmax = p0[0];
#pragma unroll
  for (int r = 1; r < 16; ++r) pmax = fmaxf(pmax, p0[r]);
#pragma unroll
  for (int r = 0; r < 16; ++r) pmax = fmaxf(pmax, p1[r]);
  { auto rr = __builtin_amdgcn_permlane32_swap(__float_as_uint(pmax), __float_as_uint(pmax), false, false);
    pmax = fmaxf(__uint_as_float(rr[0]), __uint_as_float(rr[1])); }
  if (__builtin_expect(__all(pmax - m_reg <= thr_raw), 1)) { mn = m_reg; alpha = 1.f; }
  else { mn = fmaxf(m_reg, pmax); alpha = __builtin_amdgcn_exp2f((m_reg - mn) * C); m_reg = mn; }
  const float mnC = -mn * C;
#pragma unroll
  for (int r = 0; r < 16; ++r) p0[r] = fmaf(p0[r], C, mnC);
#pragma unroll
  for (int r = 0; r < 16; ++r) p1[r] = fmaf(p1[r], C, mnC);
#pragma unroll
  for (int r = 0; r < 16; ++r) p0[r] = __builtin_amdgcn_exp2f(p0[r]);
}
__device__ __forceinline__ void finishSM(f32x16& p0, f32x16& p1, float alpha, float& l_reg, bf16x8& pa0, bf16x8& pa1, bf16x8& pa2, bf16x8& pa3) {
#pragma unroll
  for (int r = 0; r < 16; ++r) p1[r] = __builtin_amdgcn_exp2f(p1[r]);
  float ps = 0;
#pragma unroll
  for (int r = 0; r < 16; ++r) ps += p0[r];
#pragma unroll
  for (int r = 0; r < 16; ++r) ps += p1[r];
  { auto rr = __builtin_amdgcn_permlane32_swap(__float_as_uint(ps), __float_as_uint(ps), false, false);
    ps = __uint_as_float(rr[0]) + __uint_as_float(rr[1]); }
  l_reg = l_reg * alpha + ps;
#define PK4(P, BASE, OUT) do { unsigned a0 = cvt_pk_bf16(P[BASE + 0], P[BASE + 1]), a1 = cvt_pk_bf16(P[BASE + 2], P[BASE + 3]);   \
    unsigned b0 = cvt_pk_bf16(P[BASE + 4], P[BASE + 5]), b1 = cvt_pk_bf16(P[BASE + 6], P[BASE + 7]);                              \
    auto r0 = __builtin_amdgcn_permlane32_swap(a0, b0, false, false); auto r1 = __builtin_amdgcn_permlane32_swap(a1, b1, false, false); \
    u32x4 w = {r0[0], r1[0], r0[1], r1[1]}; OUT = *reinterpret_cast<bf16x8*>(&w); } while (0)
  PK4(p0, 0, pa0); PK4(p0, 8, pa1); PK4(p1, 0, pa2); PK4(p1, 8, pa3);
#undef PK4
}
template <int NQ, int KSTR>
__device__ __forceinline__ void qkt(f32x16& p0, f32x16& p1, const char* Ks, const bf16x8* qr, int r32, int hi) {
  p0 = f32x16{}; p1 = f32x16{};
#pragma unroll
  for (int d0 = 0; d0 < NQ; ++d0) { const int cb = (d0 * 16 + hi * 8) * 2;
    const bf16x8 b0 = *reinterpret_cast<const bf16x8*>(Ks + r32 * KSTR + cb);
    const bf16x8 b1 = *reinterpret_cast<const bf16x8*>(Ks + (32 + r32) * KSTR + cb);
    p0 = __builtin_amdgcn_mfma_f32_32x32x16_bf16(b0, qr[d0], p0, 0, 0, 0);
    p1 = __builtin_amdgcn_mfma_f32_32x32x16_bf16(b1, qr[d0], p1, 0, 0, 0); }
}

struct KeySrc {
  int lat_row0, n_lat_tiles, ctx_row0, wj_lo;
  __device__ __forceinline__ long row0(int j) const { return j < n_lat_tiles ? (long)lat_row0 + 64 * j : (long)ctx_row0 + 64 * (j - n_lat_tiles); }
};

template <int MODE>
__device__ __forceinline__ void attn_unit(const bf16_t* __restrict__ Qp, int ldq, const bf16_t* __restrict__ Kn, int ldk, const bf16_t* __restrict__ Kr,
                                          const bf16_t* __restrict__ Vp, int ldv, bf16_t* O1, bf16_t* O2, int ldo, int ldo2, const KeySrc ks, int NT, float scale, const float* sinkp, char* lds) {
  constexpr int NQ = MODE == 0 ? 12 : 4;
  constexpr int KCOLS = MODE == 0 ? 192 : (MODE == 1 ? 128 : 64);
  constexpr int DV = MODE == 2 ? 64 : 128, NCB = DV / 32;
  constexpr int KSTR = KCOLS * 2 + 16;
  constexpr int SHM_K = KVBLK * KSTR, SHM_VB = KVBLK * DV * 2;
  const int tid = ltid(), wid = tid >> 6, lane = tid & 63, r32 = lane & 31, hi = lane >> 5;
  char* V_lds = lds; char* K_lds = lds + 2 * SHM_VB;
  float* wsf = (float*)(lds + 2 * SHM_VB + 2 * SHM_K) + wid * 64; float* li_l = wsf; float* al_l = wsf + 32;
  const float C = scale * 1.4426950408889634f, thr_raw = 8.f / scale;
  float m_reg = -1e30f, l_reg = 0; f32x16 o[NCB] = {}; bf16x8 qr[NQ];
  if (MODE == 2) { m_reg = sinkp[wid & 3] / scale; l_reg = 1.f; }
  const int qrow = (MODE == 0 ? wid * 32 : (MODE == 1 ? (wid & 3) * 32 : (wid >> 2) * 32)) + r32;
  const int qcol = (MODE == 0 ? 0 : (MODE == 1 ? (wid >> 2) * 64 : (wid & 3) * 64)) + hi * 8;
  const int kwoff = (MODE == 1 ? (wid >> 2) * 128 : 0);
  const int qrel = (wid >> 2) * 32 + r32;
  { const bf16_t* Qw = Qp + (long)qrow * ldq + qcol;
#pragma unroll
    for (int d0 = 0; d0 < NQ; ++d0) qr[d0] = *reinterpret_cast<const bf16x8*>(Qw + d0 * 16); }
  const int sr = tid >> 4, sc = (tid & 15) * 8, vst0 = v_st<4>(sr, sc), vst1 = v_st<4>(32 + sr, sc);
  const int rr = tid >> 3, rc = (tid & 7) * 8;
  const int vst2 = v_st<2>(rr, rc);
  const int vb0 = (int)(uintptr_t)V_lds + v_rd_base(lane);
  bf16x8 vs0, vs1, ks0, ks1, kr0;
#define SLOAD(j) do { const long r0_ = ks.row0(j); \
    if (MODE == 2) { vs0 = *reinterpret_cast<const bf16x8*>(Vp + (r0_ + rr) * ldv + rc); ks0 = *reinterpret_cast<const bf16x8*>(Kn + (r0_ + rr) * ldk + rc); } else { \
    vs0 = *reinterpret_cast<const bf16x8*>(Vp + (r0_ + sr) * ldv + sc); vs1 = *reinterpret_cast<const bf16x8*>(Vp + (r0_ + 32 + sr) * ldv + sc); \
    ks0 = *reinterpret_cast<const bf16x8*>(Kn + (r0_ + sr) * ldk + sc); ks1 = *reinterpret_cast<const bf16x8*>(Kn + (r0_ + 32 + sr) * ldk + sc); \
    if (MODE == 0) kr0 = *reinterpret_cast<const bf16x8*>(Kr + (r0_ + rr) * 64 + rc); } } while (0)
#define SWRITE(b) do { if (MODE == 2) { *(bf16x8*)(V_lds + (b) * SHM_VB + vst2) = vs0; *(bf16x8*)(K_lds + (b) * SHM_K + rr * KSTR + rc * 2) = ks0; } else { \
    *(bf16x8*)(V_lds + (b) * SHM_VB + vst0) = vs0; *(bf16x8*)(V_lds + (b) * SHM_VB + vst1) = vs1; \
    *(bf16x8*)(K_lds + (b) * SHM_K + sr * KSTR + sc * 2) = ks0; *(bf16x8*)(K_lds + (b) * SHM_K + (32 + sr) * KSTR + sc * 2) = ks1; \
    if (MODE == 0) *(bf16x8*)(K_lds + (b) * SHM_K + rr * KSTR + 256 + rc * 2) = kr0; } } while (0)
  f32x16 p0, p1; float mn, al; bf16x8 pa0, pa1, pa2, pa3;
  __syncthreads();
  SLOAD(0); asm volatile("s_waitcnt vmcnt(0)" ::: "memory"); SWRITE(0);
  for (int j = 0; j < NT; ++j) {
    __syncthreads();
    const int b = j & 1;
    if (j + 1 < NT) SLOAD(j + 1);
    SBAR();
    qkt<NQ, KSTR>(p0, p1, K_lds + b * SHM_K + kwoff, qr, r32, hi);
    if (MODE == 2) { const int wj = j >= ks.n_lat_tiles ? -1 : ks.wj_lo + j;
      if (wj == 0) {
#pragma unroll
        for (int r = 0; r < 16; ++r) { const int kk = crow(r, hi); if (kk < qrel) p0[r] = -INFINITY; if (kk + 32 < qrel) p1[r] = -INFINITY; } }
      if (wj == 4) {
#pragma unroll
        for (int r = 0; r < 16; ++r) { const int kk = crow(r, hi); if (kk > qrel) p0[r] = -INFINITY; if (kk + 32 > qrel) p1[r] = -INFINITY; } } }
    partialSM(p0, p1, m_reg, mn, al, C, thr_raw);
    if (__any(al < 1.f)) { if (hi == 0) al_l[r32] = al; asm volatile("s_waitcnt lgkmcnt(0)" ::: "memory");
#pragma unroll
      for (int d = 0; d < NCB; ++d)
#pragma unroll
        for (int r = 0; r < 16; ++r) o[d][r] *= al_l[crow(r, hi)]; }
    finishSM(p0, p1, al, l_reg, pa0, pa1, pa2, pa3); SBAR();
    pv_d0<NCB>(o, vb0 + b * SHM_VB, pa0, pa1, pa2, pa3);
    if (j + 1 < NT) { asm volatile("s_waitcnt vmcnt(0)" ::: "memory"); SWRITE(b ^ 1); }
  }
  if (hi == 0) li_l[r32] = l_reg; asm volatile("s_waitcnt lgkmcnt(0)" ::: "memory");
  float rli[16];
#pragma unroll
  for (int r = 0; r < 16; ++r) rli[r] = __builtin_amdgcn_rcpf(li_l[crow(r, hi)]);
  const bool second = (MODE == 1 && wid >= 4); const int ldw = second ? ldo2 : ldo;
  bf16_t* Ow = (second ? O2 : O1) + (long)(MODE == 0 ? wid * 32 : (MODE == 1 ? (wid & 3) * 32 : (wid >> 2) * 32)) * ldw + (MODE == 2 ? (wid & 3) * 64 : 0);
#pragma unroll
  for (int r = 0; r < 16; ++r) { const int orow = crow(r, hi);
#pragma unroll
    for (int d0 = 0; d0 < NCB; ++d0) Ow[(long)orow * ldw + d0 * 32 + r32] = f2bf(o[d0][r] * rli[r]); }
#undef SLOAD
#undef SWRITE
}

__device__ __forceinline__ bf16x8 scale_q(const bf16x8 q, const float a) {
  const u32x4 w = *reinterpret_cast<const u32x4*>(&q); u32x4 o;
  o.x = cvt_pk_bf16(bflo(w.x) * a, bfhi(w.x) * a); o.y = cvt_pk_bf16(bflo(w.y) * a, bfhi(w.y) * a); o.z = cvt_pk_bf16(bflo(w.z) * a, bfhi(w.z) * a); o.w = cvt_pk_bf16(bflo(w.w) * a, bfhi(w.w) * a);
  return *reinterpret_cast<const bf16x8*>(&o);
}
template <int NQ, int KSTR, int NQR = NQ>
__device__ __forceinline__ void qkt_m(f32x16& p0, f32x16& p1, const char* Ks, const bf16x8* qr, int r32, int hi, float negm, const char* qspill = nullptr) {
#pragma unroll
  for (int r = 0; r < 16; ++r) { p0[r] = negm; p1[r] = negm; }
#ifdef ATT_SETPRIO
  __builtin_amdgcn_s_setprio(1);
#endif
#pragma unroll
  for (int d0 = 0; d0 < NQ; ++d0) { const int cb = (d0 * 16 + hi * 8) * 2;
    const bf16x8 b0 = *reinterpret_cast<const bf16x8*>(Ks + r32 * KSTR + cb);
    const bf16x8 b1 = *reinterpret_cast<const bf16x8*>(Ks + (32 + r32) * KSTR + cb);
    bf16x8 qf; if (d0 < NQR) qf = qr[d0]; else qf = *reinterpret_cast<const bf16x8*>(qspill + (d0 - NQR) * 1024);
    p0 = __builtin_amdgcn_mfma_f32_32x32x16_bf16(b0, qf, p0, 0, 0, 0);
    p1 = __builtin_amdgcn_mfma_f32_32x32x16_bf16(b1, qf, p1, 0, 0, 0); }
#ifdef ATT_SETPRIO
  __builtin_amdgcn_s_setprio(0);
#endif
}
template <int NQ, int KSTR, int NQR = NQ>
__device__ __forceinline__ void qkt_z(f32x16& p0, f32x16& p1, const char* Ks, const bf16x8* qr, int r32, int hi, const char* qspill = nullptr) {
  p0 = f32x16{}; p1 = f32x16{};
#pragma unroll
  for (int d0 = 0; d0 < NQ; ++d0) { const int cb = (d0 * 16 + hi * 8) * 2;
    const bf16x8 b0 = *reinterpret_cast<const bf16x8*>(Ks + r32 * KSTR + cb);
    const bf16x8 b1 = *reinterpret_cast<const bf16x8*>(Ks + (32 + r32) * KSTR + cb);
    bf16x8 qf; if (d0 < NQR) qf = qr[d0]; else qf = *reinterpret_cast<const bf16x8*>(qspill + (d0 - NQR) * 1024);
    p0 = __builtin_amdgcn_mfma_f32_32x32x16_bf16(b0, qf, p0, 0, 0, 0);
    p1 = __builtin_amdgcn_mfma_f32_32x32x16_bf16(b1, qf, p1, 0, 0, 0); }
}
template <bool FIRST>
__device__ __forceinline__ void partialSM2(f32x16& p0, f32x16& p1, float& m_reg, float& alpha, const bool fast = false) {
  constexpr float THR2 = 11.5415603f;
  alpha = 1.f;
  if (!fast) {
    float pmax = p0[0];
#pragma unroll
    for (int r = 1; r < 16; ++r) pmax = fmaxf(pmax, p0[r]);
#pragma unroll
    for (int r = 0; r < 16; ++r) pmax = fmaxf(pmax, p1[r]);
    { auto rr = __builtin_amdgcn_permlane32_swap(__float_as_uint(pmax), __float_as_uint(pmax), false, false);
      pmax = fmaxf(__uint_as_float(rr[0]), __uint_as_float(rr[1])); }
    if (FIRST || !__builtin_expect(__all(pmax <= THR2), 1)) {
      const float delta = FIRST ? pmax : fmaxf(pmax, 0.f); alpha = __builtin_amdgcn_exp2f(-delta); m_reg += delta;
#pragma unroll
      for (int r = 0; r < 16; ++r) { p0[r] -= delta; p1[r] -= delta; }
    }
  }
#pragma unroll
  for (int r = 0; r < 16; ++r) p0[r] = __builtin_amdgcn_exp2f(p0[r]);
}
constexpr float FAST_B2 = 3600.f;
__device__ __forceinline__ float sq8(const bf16x8 q) { const u32x4 w = *reinterpret_cast<const u32x4*>(&q);
  return (bflo(w.x) * bflo(w.x) + bfhi(w.x) * bfhi(w.x)) + (bflo(w.y) * bflo(w.y) + bfhi(w.y) * bfhi(w.y)) + (bflo(w.z) * bflo(w.z) + bfhi(w.z) * bfhi(w.z)) + (bflo(w.w) * bflo(w.w) + bfhi(w.w) * bfhi(w.w)); }
__device__ __forceinline__ void partialSM2r(f32x16& p0, f32x16& p1, float& m_reg, float& alpha, const bool first) {
  constexpr float THR2 = 11.5415603f;
  float pmax = p0[0];
#pragma unroll
  for (int r = 1; r < 16; ++r) pmax = fmaxf(pmax, p0[r]);
#pragma unroll
  for (int r = 0; r < 16; ++r) pmax = fmaxf(pmax, p1[r]);
  { auto rr = __builtin_amdgcn_permlane32_swap(__float_as_uint(pmax), __float_as_uint(pmax), false, false);
    pmax = fmaxf(__uint_as_float(rr[0]), __uint_as_float(rr[1])); }
  alpha = 1.f;
  if (first || !__builtin_expect(__all(pmax <= THR2), 1)) {
    const float delta = first ? pmax : fmaxf(pmax, 0.f); alpha = __builtin_amdgcn_exp2f(-delta); m_reg += delta;
#pragma unroll
    for (int r = 0; r < 16; ++r) { p0[r] -= delta; p1[r] -= delta; }
  }
#pragma unroll
  for (int r = 0; r < 16; ++r) p0[r] = __builtin_amdgcn_exp2f(p0[r]);
}
template <int MODE>
__device__ __forceinline__ void attn_unit_pipe(const bf16_t* __restrict__ Qp, int ldq, const bf16_t* __restrict__ Kn, int ldk, const bf16_t* __restrict__ Kr,
                                               const bf16_t* __restrict__ Vp, int ldv, bf16_t* O1, bf16_t* O2, int ldo, int ldo2, const KeySrc ks, int NT, float scale, char* lds, const float* kn2 = nullptr) {
  constexpr int NQ = MODE == 0 ? 12 : 4;
  constexpr int KCOLS = MODE == 0 ? 192 : 128;
  constexpr int KSTR = KCOLS * 2 + 16;
  constexpr int SHM_K = KVBLK * KSTR, SHM_VB = KVBLK * 128 * 2;
  constexpr int SDEPTH = MODE == 0 ? 1 : 2, SE = 0, SO = SDEPTH - 1;
  constexpr int NQR = NQ;
  const int tid = ltid(), wid = tid >> 6, lane = tid & 63, r32 = lane & 31, hi = lane >> 5;
  char* V_lds = lds; char* K_lds = lds + 2 * SHM_VB;
  float* wsf = (float*)(lds + 2 * SHM_VB + 2 * SHM_K) + wid * 64; float* li_l = wsf; float* al_l = wsf + 32;
  float m_reg = 0.f, l_reg = 0, qn2 = 0.f; f32x16 o[4] = {}; bf16x8 qr[NQR];
  char* qspill = lds + 2 * SHM_VB + 2 * SHM_K + 2048 + wid * 4096 + lane * 16;
  const int qrow = (MODE == 0 ? wid * 32 : (wid & 3) * 32) + r32;
  const int qcol = (MODE == 0 ? 0 : (wid >> 2) * 64) + hi * 8;
  const int kwoff = (MODE == 1 ? (wid >> 2) * 128 : 0);
  __syncthreads();
  { const bf16_t* Qw = Qp + (long)qrow * ldq + qcol; const float C = scale * 1.4426950408889634f;
#pragma unroll
    for (int d0 = 0; d0 < NQ; ++d0) { const bf16x8 qf = scale_q(*reinterpret_cast<const bf16x8*>(Qw + d0 * 16), C); qn2 += sq8(qf);
      if (d0 < NQR) qr[d0] = qf; else *reinterpret_cast<bf16x8*>(qspill + (d0 - NQR) * 1024) = qf; } }
  { auto rr_ = __builtin_amdgcn_permlane32_swap(__float_as_uint(qn2), __float_as_uint(qn2), false, false); qn2 = __uint_as_float(rr_[0]) + __uint_as_float(rr_[1]); }
  const bool fast = kn2 != nullptr && __all(qn2 * kn2[MODE == 1 ? (wid >> 2) : 0] <= FAST_B2);
  const int sr = tid >> 4, sc = (tid & 15) * 8, vst0 = v_st<4>(sr, sc), vst1 = v_st<4>(32 + sr, sc);
  const int rr = tid >> 3, rc = (tid & 7) * 8;
  const int vb0 = (int)(uintptr_t)V_lds + v_rd_base(lane);
  struct { bf16x8 vs0, vs1, ks0, ks1, kr0; } sr_[SDEPTH];
  const unsigned voff0 = (unsigned)(sr * ldv + sc) * 2u, voff1 = voff0 + (unsigned)(32 * ldv) * 2u, koff0 = (unsigned)(sr * ldk + sc) * 2u, koff1 = koff0 + (unsigned)(32 * ldk) * 2u, roff = (unsigned)(rr * 64 + rc) * 2u;
#define SLOAD(i, j) do { const long r0_ = __builtin_amdgcn_readfirstlane((int)ks.row0(j)); const char* vb_ = (const char*)Vp + r0_ * ldv * 2; const char* kb_ = (const char*)Kn + r0_ * ldk * 2; \
    sr_[i].vs0 = *reinterpret_cast<const bf16x8*>(vb_ + voff0); sr_[i].vs1 = *reinterpret_cast<const bf16x8*>(vb_ + voff1); \
    sr_[i].ks0 = *reinterpret_cast<const bf16x8*>(kb_ + koff0); sr_[i].ks1 = *reinterpret_cast<const bf16x8*>(kb_ + koff1); \
    if (MODE == 0) { const char* rb_ = (const char*)Kr + r0_ * 128; sr_[i].kr0 = *reinterpret_cast<const bf16x8*>(rb_ + roff); } } while (0)
#define SWRITE(b, i) do { *(bf16x8*)(V_lds + (b) * SHM_VB + vst0) = sr_[i].vs0; *(bf16x8*)(V_lds + (b) * SHM_VB + vst1) = sr_[i].vs1; \
    *(bf16x8*)(K_lds + (b) * SHM_K + sr * KSTR + sc * 2) = sr_[i].ks0; *(bf16x8*)(K_lds + (b) * SHM_K + (32 + sr) * KSTR + sc * 2) = sr_[i].ks1; \
    if (MODE == 0) *(bf16x8*)(K_lds + (b) * SHM_K + rr * KSTR + 256 + rc * 2) = sr_[i].kr0; } while (0)
#define SWAIT() do { if constexpr (SDEPTH == 2) asm volatile("s_waitcnt vmcnt(4)" ::: "memory"); else asm volatile("s_waitcnt vmcnt(0)" ::: "memory"); } while (0)
#define RESC(a) do { if (__any((a) < 1.f)) { if (hi == 0) al_l[r32] = (a); asm volatile("s_waitcnt lgkmcnt(0)" ::: "memory"); \
    _Pragma("unroll") for (int d = 0; d < 4; ++d) _Pragma("unroll") for (int r = 0; r < 16; ++r) o[d][r] *= al_l[crow(r, hi)]; } } while (0)
#ifdef ATTN_PIPE_PF
#define PV_PIPE pv_d0_pf
#else
#define PV_PIPE pv_d0<4>
#endif
  f32x16 pA0, pA1, pB0, pB1; float alA, alB; bf16x8 pa0, pa1, pa2, pa3;
  const char* K0 = K_lds + kwoff; const char* K1 = K_lds + SHM_K + kwoff;
  SLOAD(SE, 0); asm volatile("s_waitcnt vmcnt(0)" ::: "memory"); SWRITE(0, SE); __syncthreads();
  qkt_m<NQ, KSTR, NQR>(pA0, pA1, K0, qr, r32, hi, 0.f, qspill); partialSM2<true>(pA0, pA1, m_reg, alA, fast); alA = 1.f;
  SLOAD(SO, 1); if constexpr (SDEPTH == 2) { if (2 < NT) SLOAD(SE, 2); }
  SWAIT(); SWRITE(1, SO); __syncthreads();
  for (int j = 1; j + 1 < NT; j += 2) {
    SBAR(); if (fast) qkt_z<NQ, KSTR, NQR>(pB0, pB1, K1, qr, r32, hi, qspill); else qkt_m<NQ, KSTR, NQR>(pB0, pB1, K1, qr, r32, hi, -m_reg, qspill);
    finishSM(pA0, pA1, alA, l_reg, pa0, pa1, pa2, pa3); SBAR();
    SLOAD(SO, j + SDEPTH); SBAR();
    PV_PIPE(o, vb0, pa0, pa1, pa2, pa3); partialSM2<false>(pB0, pB1, m_reg, alB, fast);
    __syncthreads(); SWAIT(); SWRITE(0, SE);
    RESC(alB); __syncthreads();
    SBAR(); if (fast) qkt_z<NQ, KSTR, NQR>(pA0, pA1, K0, qr, r32, hi, qspill); else qkt_m<NQ, KSTR, NQR>(pA0, pA1, K0, qr, r32, hi, -m_reg, qspill);
    finishSM(pB0, pB1, alB, l_reg, pa0, pa1, pa2, pa3); SBAR();
    if (SDEPTH == 1 || j + 3 < NT) SLOAD(SE, j + 1 + SDEPTH); SBAR();
    PV_PIPE(o, vb0 + SHM_VB, pa0, pa1, pa2, pa3); partialSM2<false>(pA0, pA1, m_reg, alA, fast);
    __syncthreads(); SWAIT(); SWRITE(1, SO);
    RESC(alA); __syncthreads();
  }
  SBAR(); if (fast) qkt_z<NQ, KSTR, NQR>(pB0, pB1, K1, qr, r32, hi, qspill); else qkt_m<NQ, KSTR, NQR>(pB0, pB1, K1, qr, r32, hi, -m_reg, qspill);
  finishSM(pA0, pA1, alA, l_reg, pa0, pa1, pa2, pa3); SBAR();
  PV_PIPE(o, vb0, pa0, pa1, pa2, pa3); partialSM2<false>(pB0, pB1, m_reg, alB, fast);
  RESC(alB);
  finishSM(pB0, pB1, alB, l_reg, pa0, pa1, pa2, pa3); SBAR();
  PV_PIPE(o, vb0 + SHM_VB, pa0, pa1, pa2, pa3);
  if (hi == 0) li_l[r32] = l_reg; asm volatile("s_waitcnt lgkmcnt(0)" ::: "memory");
  float rli[16];
#pragma unroll
  for (int r = 0; r < 16; ++r) rli[r] = __builtin_amdgcn_rcpf(li_l[crow(r, hi)]);
  const bool second = (MODE == 1 && wid >= 4); const int ldw = second ? ldo2 : ldo;
  bf16_t* Ow = (second ? O2 : O1) + (long)(MODE == 0 ? wid * 32 : (wid & 3) * 32) * ldw;
#pragma unroll
  for (int r = 0; r < 16; ++r) { const int orow = crow(r, hi);
#pragma unroll
    for (int d0 = 0; d0 < 4; ++d0) Ow[(long)orow * ldw + d0 * 32 + r32] = f2bf(o[d0][r] * rli[r]); }
#undef SLOAD
#undef SWRITE
#undef SWAIT
#undef RESC
#undef PV_PIPE
}

template <int MODE>
__device__ __forceinline__ void attn_unit_ho(const bf16_t* __restrict__ Qp, int ldq, const bf16_t* __restrict__ Kn, int ldk, const bf16_t* __restrict__ Kr,
                                             const bf16_t* __restrict__ Vp, int ldv, bf16_t* O1, bf16_t* O2, int ldo, int ldo2, const KeySrc ks, int NT, float scale, char* lds) {
  constexpr int NQ = MODE == 0 ? 12 : 4;
  constexpr int KCOLS = MODE == 0 ? 192 : 128;
  constexpr int KSTR = KCOLS * 2 + 16;
  constexpr int SHM_K = KVBLK * KSTR, SHM_VB = KVBLK * 128 * 2;
  const int tid = ltid(), wid = tid >> 6, lane = tid & 63, r32 = lane & 31, hi = lane >> 5;
  const int half = __builtin_amdgcn_readfirstlane(HO_HALF_EXPR);
  char* V_lds = lds; char* K_lds = lds + 2 * SHM_VB;
  float* wsf = (float*)(lds + 2 * SHM_VB + 2 * SHM_K) + wid * 64; float* li_l = wsf; float* al_l = wsf + 32;
  float m_reg = 0.f, l_reg = 0; f32x16 o[4] = {}; bf16x8 qr[NQ];
  const int qrow = (MODE == 0 ? wid * 32 : (wid & 3) * 32) + r32;
  const int qcol = (MODE == 0 ? 0 : (wid >> 2) * 64) + hi * 8;
  const int kwoff = (MODE == 1 ? (wid >> 2) * 128 : 0);
  { const bf16_t* Qw = Qp + (long)qrow * ldq + qcol; const float C = scale * 1.4426950408889634f;
#pragma unroll
    for (int d0 = 0; d0 < NQ; ++d0) qr[d0] = scale_q(*reinterpret_cast<const bf16x8*>(Qw + d0 * 16), C); }
  const int sr = tid >> 4, sc = (tid & 15) * 8, vst0 = v_st<4>(sr, sc), vst1 = v_st<4>(32 + sr, sc);
  const int rr = tid >> 3, rc = (tid & 7) * 8;
  const int vb0 = (int)(uintptr_t)V_lds + v_rd_base(lane);
  bf16x8 vs0, vs1, ks0, ks1, kr0;
#define KLOAD(j) do { const long r0_ = ks.row0(j); ks0 = *reinterpret_cast<const bf16x8*>(Kn + (r0_ + sr) * ldk + sc); ks1 = *reinterpret_cast<const bf16x8*>(Kn + (r0_ + 32 + sr) * ldk + sc); \
    if (MODE == 0) kr0 = *reinterpret_cast<const bf16x8*>(Kr + (r0_ + rr) * 64 + rc); } while (0)
#define VLOAD(j) do { const long r0_ = ks.row0(j); vs0 = *reinterpret_cast<const bf16x8*>(Vp + (r0_ + sr) * ldv + sc); vs1 = *reinterpret_cast<const bf16x8*>(Vp + (r0_ + 32 + sr) * ldv + sc); } while (0)
#define KWRITE(b) do { *(bf16x8*)(K_lds + (b) * SHM_K + sr * KSTR + sc * 2) = ks0; *(bf16x8*)(K_lds + (b) * SHM_K + (32 + sr) * KSTR + sc * 2) = ks1; \
    if (MODE == 0) *(bf16x8*)(K_lds + (b) * SHM_K + rr * KSTR + 256 + rc * 2) = kr0; } while (0)
#define VWRITE(b) do { *(bf16x8*)(V_lds + (b) * SHM_VB + vst0) = vs0; *(bf16x8*)(V_lds + (b) * SHM_VB + vst1) = vs1; } while (0)
  f32x16 p0, p1; float al; bf16x8 pa0, pa1, pa2, pa3;
#define QKSM(j) do { const int b_ = (j) & 1; qkt_m<NQ, KSTR>(p0, p1, K_lds + b_ * SHM_K + kwoff, qr, r32, hi, -m_reg); \
    partialSM2r(p0, p1, m_reg, al, (j) == 0); \
    if ((j) > 0 && __any(al < 1.f)) { if (hi == 0) al_l[r32] = al; asm volatile("s_waitcnt lgkmcnt(0)" ::: "memory"); \
      _Pragma("unroll") for (int d = 0; d < 4; ++d) _Pragma("unroll") for (int r = 0; r < 16; ++r) o[d][r] *= al_l[crow(r, hi)]; } \
    if ((j) == 0) al = 1.f; \
    finishSM(p0, p1, al, l_reg, pa0, pa1, pa2, pa3); } while (0)
#define PVSEG(j) pv_d0<4>(o, vb0 + ((j) & 1) * SHM_VB, pa0, pa1, pa2, pa3)
#define STAGE_K(j) do { if ((j) + 1 < NT) { KWRITE(((j) + 1) & 1); if ((j) + 2 < NT) KLOAD((j) + 2); } } while (0)
#define STAGE_V(j) do { if ((j) + 1 < NT) { VWRITE(((j) + 1) & 1); if ((j) + 2 < NT) VLOAD((j) + 2); } } while (0)
  __syncthreads();
  KLOAD(0); VLOAD(0); asm volatile("s_waitcnt vmcnt(0)" ::: "memory"); KWRITE(0); VWRITE(0);
  if (NT > 1) { KLOAD(1); VLOAD(1); }
  if (half == 0) {
    for (int j = 0; j < NT; ++j) {
      __syncthreads(); STAGE_K(j); SBAR(); QKSM(j); SBAR();
      __syncthreads(); STAGE_V(j); SBAR(); PVSEG(j); SBAR();
    }
  } else {
    for (int j = 0; j < NT; ++j) {
      __syncthreads(); STAGE_K(j); SBAR(); if (j > 0) PVSEG(j - 1); SBAR();
      __syncthreads(); STAGE_V(j); SBAR(); QKSM(j); SBAR();
    }
    PVSEG(NT - 1);
  }
  if (hi == 0) li_l[r32] = l_reg; asm volatile("s_waitcnt lgkmcnt(0)" ::: "memory");
  float rli[16];
#pragma unroll
  for (int r = 0; r < 16; ++r) rli[r] = __builtin_amdgcn_rcpf(li_l[crow(r, hi)]);
  const bool second = (MODE == 1 && wid >= 4); const int ldw = second ? ldo2 : ldo;
  bf16_t* Ow = (second ? O2 : O1) + (long)(MODE == 0 ? wid * 32 : (wid & 3) * 32) * ldw;
#pragma unroll
  for (int r = 0; r < 16; ++r) { const int orow = crow(r, hi);
#pragma unroll
    for (int d0 = 0; d0 < 4; ++d0) Ow[(long)orow * ldw + d0 * 32 + r32] = f2bf(o[d0][r] * rli[r]); }
#undef KLOAD
#undef VLOAD
#undef KWRITE
#undef VWRITE
#undef QKSM
#undef PVSEG
#undef STAGE_K
#undef STAGE_V
}

#define PK4X(Pv, BASE, OUT) do { unsigned a0 = cvt_pk_bf16(Pv[BASE + 0], Pv[BASE + 1]), a1 = cvt_pk_bf16(Pv[BASE + 2], Pv[BASE + 3]);   \
    unsigned b0 = cvt_pk_bf16(Pv[BASE + 4], Pv[BASE + 5]), b1 = cvt_pk_bf16(Pv[BASE + 6], Pv[BASE + 7]);                              \
    auto r0 = __builtin_amdgcn_permlane32_swap(a0, b0, false, false); auto r1 = __builtin_amdgcn_permlane32_swap(a1, b1, false, false); \
    u32x4 w = {r0[0], r1[0], r0[1], r1[1]}; OUT = *reinterpret_cast<bf16x8*>(&w); } while (0)
template <int MODE>
__device__ __forceinline__ void attn_unit_p2(const bf16_t* __restrict__ Qp, int ldq, const bf16_t* __restrict__ Kn, int ldk, const bf16_t* __restrict__ Kr,
                                             const bf16_t* __restrict__ Vp, int ldv, bf16_t* O1, bf16_t* O2, int ldo, int ldo2, const KeySrc ks, int NT, float scale, char* lds,
                                             float lam = 0.f, float post_scale = 0.f, const float* gsub = nullptr, const float* kn2 = nullptr) {
  constexpr int NQ = MODE == 0 ? 12 : 4;
  constexpr int KCOLS = MODE == 0 ? 192 : 128;
  constexpr int KSTR = KCOLS * 2 + 16;
  constexpr int SHM_K = KVBLK * KSTR, SHM_VB = KVBLK * 128 * 2;
  constexpr int SDEPTH = 1, SE = 0, SO = SDEPTH - 1;
  constexpr int NQR = MODE == 0 ? 8 : NQ;
  constexpr bool SUMM = false;
  constexpr float THR2 = 11.5415603f;
  const int tid = ltid(), wid = tid >> 6, lane = tid & 63, r32 = lane & 31, hi = lane >> 5;
  char* V_lds = lds; char* K_lds = lds + 2 * SHM_VB;
  float* wsf = (float*)(lds + 2 * SHM_VB + 2 * SHM_K) + wid * 64; float* li_l = wsf; float* al_l = wsf + 32;
  float m_reg = 0.f, l_reg = 0, qn2 = 0.f; f32x16 o[4] = {}; f32x16 lsum = {}; bf16x8 qr[NQR];
  char* qspill = lds + 2 * SHM_VB + 2 * SHM_K + 2048 + wid * (NQ - NQR) * 1024 + lane * 16;
  const int qrow = (MODE == 0 ? wid * 32 : (wid & 3) * 32) + r32;
  const int qcol = (MODE == 0 ? 0 : (wid >> 2) * 64) + hi * 8;
  const int kwoff = (MODE == 1 ? (wid >> 2) * 128 : 0);
  __syncthreads();
  { const bf16_t* Qw = Qp + (long)qrow * ldq + qcol; const float C = scale * 1.4426950408889634f;
#pragma unroll
    for (int d0 = 0; d0 < NQ; ++d0) { const bf16x8 qf = scale_q(*reinterpret_cast<const bf16x8*>(Qw + d0 * 16), C); qn2 += sq8(qf);
      if (d0 < NQR) qr[d0] = qf; else *reinterpret_cast<bf16x8*>(qspill + (d0 - NQR) * 1024) = qf; } }
  { auto rr_ = __builtin_amdgcn_permlane32_swap(__float_as_uint(qn2), __float_as_uint(qn2), false, false); qn2 = __uint_as_float(rr_[0]) + __uint_as_float(rr_[1]); }
  const bool fast = kn2 != nullptr && __all(qn2 * kn2[MODE == 1 ? (wid >> 2) : 0] <= FAST_B2);
  const int sr = tid >> 4, sc = (tid & 15) * 8, vst0 = v_st<4>(sr, sc), vst1 = v_st<4>(32 + sr, sc);
  const int rr = tid >> 3, rc = (tid & 7) * 8;
  const int vb0 = (int)(uintptr_t)V_lds + v_rd_base(lane);
  const bf16x8 ONES = (bf16x8){0x3F80, 0x3F80, 0x3F80, 0x3F80, 0x3F80, 0x3F80, 0x3F80, 0x3F80};
  struct { bf16x8 vs0, vs1, ks0, ks1, kr0; } sr_[SDEPTH];
  const unsigned voff0 = (unsigned)(sr * ldv + sc) * 2u, voff1 = voff0 + (unsigned)(32 * ldv) * 2u, koff0 = (unsigned)(sr * ldk + sc) * 2u, koff1 = koff0 + (unsigned)(32 * ldk) * 2u, roff = (unsigned)(rr * 64 + rc) * 2u;
#define SLOAD(i, j) do { const long r0_ = __builtin_amdgcn_readfirstlane((int)ks.row0(j)); const char* vb_ = (const char*)Vp + r0_ * ldv * 2; const char* kb_ = (const char*)Kn + r0_ * ldk * 2; \
    sr_[i].vs0 = *reinterpret_cast<const bf16x8*>(vb_ + voff0); sr_[i].vs1 = *reinterpret_cast<const bf16x8*>(vb_ + voff1); \
    sr_[i].ks0 = *reinterpret_cast<const bf16x8*>(kb_ + koff0); sr_[i].ks1 = *reinterpret_cast<const bf16x8*>(kb_ + koff1); \
    if (MODE == 0) { const char* rb_ = (const char*)Kr + r0_ * 128; sr_[i].kr0 = *reinterpret_cast<const bf16x8*>(rb_ + roff); } } while (0)
#define SWRITE(b, i) do { *(bf16x8*)(V_lds + (b) * SHM_VB + vst0) = sr_[i].vs0; *(bf16x8*)(V_lds + (b) * SHM_VB + vst1) = sr_[i].vs1; \
    *(bf16x8*)(K_lds + (b) * SHM_K + sr * KSTR + sc * 2) = sr_[i].ks0; *(bf16x8*)(K_lds + (b) * SHM_K + (32 + sr) * KSTR + sc * 2) = sr_[i].ks1; \
    if (MODE == 0) *(bf16x8*)(K_lds + (b) * SHM_K + rr * KSTR + 256 + rc * 2) = sr_[i].kr0; } while (0)
#define SWAIT() do { if constexpr (SDEPTH == 2) asm volatile("s_waitcnt vmcnt(4)" ::: "memory"); else asm volatile("s_waitcnt vmcnt(0)" ::: "memory"); } while (0)
#define RESC(a) do { if (__any((a) < 1.f)) { if (hi == 0) al_l[r32] = (a); asm volatile("s_waitcnt lgkmcnt(0)" ::: "memory"); \
    _Pragma("unroll") for (int r = 0; r < 16; ++r) { const float f_ = al_l[crow(r, hi)]; o[0][r] *= f_; o[1][r] *= f_; o[2][r] *= f_; o[3][r] *= f_; if (SUMM) lsum[r] *= f_; } } } while (0)
#define FINISH(P0, P1, AL) do { _Pragma("unroll") for (int r = 0; r < 16; ++r) P1[r] = __builtin_amdgcn_exp2f(P1[r]); \
    if (!SUMM) { float ps = 0; _Pragma("unroll") for (int r = 0; r < 16; ++r) ps += P0[r]; _Pragma("unroll") for (int r = 0; r < 16; ++r) ps += P1[r]; \
      { auto rr_ = __builtin_amdgcn_permlane32_swap(__float_as_uint(ps), __float_as_uint(ps), false, false); ps = __uint_as_float(rr_[0]) + __uint_as_float(rr_[1]); } \
      l_reg = l_reg * (AL) + ps; } \
    PK4X(P0, 0, pa0); PK4X(P0, 8, pa1); PK4X(P1, 0, pa2); PK4X(P1, 8, pa3); } while (0)
#define PV_AND_PARTIAL(VB, P0, P1, AL) do { float pm0_ = 0.f, pm1_ = 0.f; VFrag fa_, fb_; \
    pv_issue<0>(fa_, (VB)); pv_issue<1>(fb_, (VB)); pv_mma<8>(o[0], fa_, pa0, pa1, pa2, pa3); pv_issue<2>(fa_, (VB)); \
    if (!fast) { pm0_ = P0[0]; _Pragma("unroll") for (int r = 1; r < 16; ++r) pm0_ = fmaxf(pm0_, P0[r]); } \
    pv_mma<8>(o[1], fb_, pa0, pa1, pa2, pa3); pv_issue<3>(fb_, (VB)); \
    if (!fast) { pm1_ = P1[0]; _Pragma("unroll") for (int r = 1; r < 16; ++r) pm1_ = fmaxf(pm1_, P1[r]); pm0_ = fmaxf(pm0_, pm1_); \
    { auto rr_ = __builtin_amdgcn_permlane32_swap(__float_as_uint(pm0_), __float_as_uint(pm0_), false, false); pm0_ = fmaxf(__uint_as_float(rr_[0]), __uint_as_float(rr_[1])); } } \
    pv_mma<8>(o[2], fa_, pa0, pa1, pa2, pa3); \
    AL = 1.f; \
    if (!fast && !__builtin_expect(__all(pm0_ <= THR2), 1)) { const float dl_ = fmaxf(pm0_, 0.f); AL = __builtin_amdgcn_exp2f(-dl_); m_reg += dl_; \
      _Pragma("unroll") for (int r = 0; r < 16; ++r) { P0[r] -= dl_; P1[r] -= dl_; } } \
    _Pragma("unroll") for (int r = 0; r < 8; ++r) P0[r] = __builtin_amdgcn_exp2f(P0[r]); \
    pv_mma<0>(o[3], fb_, pa0, pa1, pa2, pa3); \
    _Pragma("unroll") for (int r = 8; r < 16; ++r) P0[r] = __builtin_amdgcn_exp2f(P0[r]); \
    if (SUMM) { lsum = __builtin_amdgcn_mfma_f32_32x32x16_bf16(pa0, ONES, lsum, 0, 0, 0); lsum = __builtin_amdgcn_mfma_f32_32x32x16_bf16(pa1, ONES, lsum, 0, 0, 0); \
                lsum = __builtin_amdgcn_mfma_f32_32x32x16_bf16(pa2, ONES, lsum, 0, 0, 0); lsum = __builtin_amdgcn_mfma_f32_32x32x16_bf16(pa3, ONES, lsum, 0, 0, 0); } } while (0)
#define PV_AND_PARTIAL_B(VB, P0, P1, AL) do { VFrag fa_, fb_; \
    partialSM2<false>(P0, P1, m_reg, AL, fast); \
    pv_issue<0>(fa_, (VB)); pv_issue<1>(fb_, (VB)); pv_mma<8>(o[0], fa_, pa0, pa1, pa2, pa3); pv_issue<2>(fa_, (VB)); \
    pv_mma<8>(o[1], fb_, pa0, pa1, pa2, pa3); pv_issue<3>(fb_, (VB)); \
    pv_mma<8>(o[2], fa_, pa0, pa1, pa2, pa3); pv_mma<0>(o[3], fb_, pa0, pa1, pa2, pa3); } while (0)
#define PV_PART(VB, P0, P1, AL) do { if (lateh) PV_AND_PARTIAL_B(VB, P0, P1, AL); else PV_AND_PARTIAL(VB, P0, P1, AL); } while (0)
  const bool lateh = SKEW_HALVES && __builtin_amdgcn_readfirstlane(wid) >= 4;
  f32x16 pA0, pA1, pB0, pB1; float alA, alB; bf16x8 pa0, pa1, pa2, pa3;
  const char* K0 = K_lds + kwoff; const char* K1 = K_lds + SHM_K + kwoff;
  SLOAD(SE, 0); asm volatile("s_waitcnt vmcnt(0)" ::: "memory"); SWRITE(0, SE); __syncthreads();
  qkt_m<NQ, KSTR, NQR>(pA0, pA1, K0, qr, r32, hi, 0.f, qspill); partialSM2<true>(pA0, pA1, m_reg, alA, fast); alA = 1.f;
  SLOAD(SO, 1); if constexpr (SDEPTH == 2) { if (2 < NT) SLOAD(SE, 2); }
  SWAIT(); SWRITE(1, SO); __syncthreads();
  for (int j = 1; j + 1 < NT; j += 2) {
    SBAR(); if (fast) qkt_z<NQ, KSTR, NQR>(pB0, pB1, K1, qr, r32, hi, qspill); else qkt_m<NQ, KSTR, NQR>(pB0, pB1, K1, qr, r32, hi, -m_reg, qspill);
#ifdef PROBE_QK2
    { f32x16 pX0, pX1; qkt_m<NQ, KSTR, NQR>(pX0, pX1, K1, qr, r32, hi, -m_reg, qspill); asm volatile("" :: "v"(pX0), "v"(pX1)); }
#endif
#ifdef PROBE_EXP2
    { _Pragma("unroll") for (int r = 0; r < 16; ++r) { float t0 = __builtin_amdgcn_exp2f(pA1[r] - 3.f), t1 = __builtin_amdgcn_exp2f(pA0[r] - 5.f); asm volatile("" :: "v"(t0), "v"(t1)); } }
#endif
#ifdef PROBE_ADD2
    { _Pragma("unroll") for (int r = 0; r < 16; ++r) { float t0 = pA1[r] + 3.f, t1 = pA0[r] + 5.f; asm volatile("" :: "v"(t0), "v"(t1)); } }
#endif
#ifdef PROBE_B128
    { bf16x8 x0_, x1_, x2_, x3_, x4_, x5_, x6_, x7_; const char* vv_ = V_lds + lane * 16;
      x0_ = *(const bf16x8*)(vv_); x1_ = *(const bf16x8*)(vv_ + 1024); x2_ = *(const bf16x8*)(vv_ + 2048); x3_ = *(const bf16x8*)(vv_ + 3072); x4_ = *(const bf16x8*)(vv_ + 4096); x5_ = *(const bf16x8*)(vv_ + 5120); x6_ = *(const bf16x8*)(vv_ + 6144); x7_ = *(const bf16x8*)(vv_ + 7168);
      asm volatile("s_waitcnt lgkmcnt(0)" ::: "memory"); asm volatile("" :: "v"(x0_), "v"(x1_), "v"(x2_), "v"(x3_), "v"(x4_), "v"(x5_), "v"(x6_), "v"(x7_));
      x0_ = *(const bf16x8*)(vv_ + 8192); x1_ = *(const bf16x8*)(vv_ + 9216); x2_ = *(const bf16x8*)(vv_ + 10240); x3_ = *(const bf16x8*)(vv_ + 11264); x4_ = *(const bf16x8*)(vv_ + 12288); x5_ = *(const bf16x8*)(vv_ + 13312); x6_ = *(const bf16x8*)(vv_ + 14336); x7_ = *(const bf16x8*)(vv_ + 15360);
      asm volatile("s_waitcnt lgkmcnt(0)" ::: "memory"); asm volatile("" :: "v"(x0_), "v"(x1_), "v"(x2_), "v"(x3_), "v"(x4_), "v"(x5_), "v"(x6_), "v"(x7_)); }
#endif
#ifdef PROBE_TR2
    { VFrag fx_, fy_; pv_issue<0>(fx_, vb0); pv_issue<1>(fy_, vb0); asm volatile("s_waitcnt lgkmcnt(0)" ::: "memory"); asm volatile("" :: "v"(fx_.l0), "v"(fx_.h3), "v"(fy_.l0), "v"(fy_.h3)); pv_issue<2>(fx_, vb0); pv_issue<3>(fy_, vb0); asm volatile("s_waitcnt lgkmcnt(0)" ::: "memory"); asm volatile("" :: "v"(fx_.l0), "v"(fx_.h3), "v"(fy_.l0), "v"(fy_.h3)); }
#endif
    FINISH(pA0, pA1, alA); SBAR();
    SLOAD(SO, j + SDEPTH); SBAR();
#ifdef PROBE_BAR
    __syncthreads();
#endif
    PV_PART(vb0, pB0, pB1, alB);
    __syncthreads(); SWAIT(); SWRITE(0, SE);
    RESC(alB); __syncthreads();
    SBAR(); if (fast) qkt_z<NQ, KSTR, NQR>(pA0, pA1, K0, qr, r32, hi, qspill); else qkt_m<NQ, KSTR, NQR>(pA0, pA1, K0, qr, r32, hi, -m_reg, qspill);
#ifdef PROBE_QK2
    { f32x16 pX0, pX1; qkt_m<NQ, KSTR, NQR>(pX0, pX1, K0, qr, r32, hi, -m_reg, qspill); asm volatile("" :: "v"(pX0), "v"(pX1)); }
#endif
#ifdef PROBE_EXP2
    { _Pragma("unroll") for (int r = 0; r < 16; ++r) { float t0 = __builtin_amdgcn_exp2f(pB1[r] - 3.f), t1 = __builtin_amdgcn_exp2f(pB0[r] - 5.f); asm volatile("" :: "v"(t0), "v"(t1)); } }
#endif
#ifdef PROBE_ADD2
    { _Pragma("unroll") for (int r = 0; r < 16; ++r) { float t0 = pB1[r] + 3.f, t1 = pB0[r] + 5.f; asm volatile("" :: "v"(t0), "v"(t1)); } }
#endif
#ifdef PROBE_B128
    { bf16x8 x0_, x1_, x2_, x3_, x4_, x5_, x6_, x7_; const char* vv_ = V_lds + lane * 16;
      x0_ = *(const bf16x8*)(vv_); x1_ = *(const bf16x8*)(vv_ + 1024); x2_ = *(const bf16x8*)(vv_ + 2048); x3_ = *(const bf16x8*)(vv_ + 3072); x4_ = *(const bf16x8*)(vv_ + 4096); x5_ = *(const bf16x8*)(vv_ + 5120); x6_ = *(const bf16x8*)(vv_ + 6144); x7_ = *(const bf16x8*)(vv_ + 7168);
      asm volatile("s_waitcnt lgkmcnt(0)" ::: "memory"); asm volatile("" :: "v"(x0_), "v"(x1_), "v"(x2_), "v"(x3_), "v"(x4_), "v"(x5_), "v"(x6_), "v"(x7_));
      x0_ = *(const bf16x8*)(vv_ + 8192); x1_ = *(const bf16x8*)(vv_ + 9216); x2_ = *(const bf16x8*)(vv_ + 10240); x3_ = *(const bf16x8*)(vv_ + 11264); x4_ = *(const bf16x8*)(vv_ + 12288); x5_ = *(const bf16x8*)(vv_ + 13312); x6_ = *(const bf16x8*)(vv_ + 14336); x7_ = *(const bf16x8*)(vv_ + 15360);
      asm volatile("s_waitcnt lgkmcnt(0)" ::: "memory"); asm volatile("" :: "v"(x0_), "v"(x1_), "v"(x2_), "v"(x3_), "v"(x4_), "v"(x5_), "v"(x6_), "v"(x7_)); }
#endif
#ifdef PROBE_TR2
    { VFrag fx_, fy_; pv_issue<0>(fx_, vb0); pv_issue<1>(fy_, vb0); asm volatile("s_waitcnt lgkmcnt(0)" ::: "memory"); asm volatile("" :: "v"(fx_.l0), "v"(fx_.h3), "v"(fy_.l0), "v"(fy_.h3)); pv_issue<2>(fx_, vb0); pv_issue<3>(fy_, vb0); asm volatile("s_waitcnt lgkmcnt(0)" ::: "memory"); asm volatile("" :: "v"(fx_.l0), "v"(fx_.h3), "v"(fy_.l0), "v"(fy_.h3)); }
#endif
    FINISH(pB0, pB1, alB); SBAR();
    if (SDEPTH == 1 || j + 3 < NT) SLOAD(SE, j + 1 + SDEPTH); SBAR();
#ifdef PROBE_BAR
    __syncthreads();
#endif
    PV_PART(vb0 + SHM_VB, pA0, pA1, alA);
    __syncthreads(); SWAIT(); SWRITE(1, SO);
    RESC(alA); __syncthreads();
  }
  SBAR(); if (fast) qkt_z<NQ, KSTR, NQR>(pB0, pB1, K1, qr, r32, hi, qspill); else qkt_m<NQ, KSTR, NQR>(pB0, pB1, K1, qr, r32, hi, -m_reg, qspill);
  FINISH(pA0, pA1, alA); SBAR();
  PV_PART(vb0, pB0, pB1, alB);
  RESC(alB);
  FINISH(pB0, pB1, alB); SBAR();
  pv_d0<4>(o, vb0 + SHM_VB, pa0, pa1, pa2, pa3);
  if (SUMM) { lsum = __builtin_amdgcn_mfma_f32_32x32x16_bf16(pa0, ONES, lsum, 0, 0, 0); lsum = __builtin_amdgcn_mfma_f32_32x32x16_bf16(pa1, ONES, lsum, 0, 0, 0);
              lsum = __builtin_amdgcn_mfma_f32_32x32x16_bf16(pa2, ONES, lsum, 0, 0, 0); lsum = __builtin_amdgcn_mfma_f32_32x32x16_bf16(pa3, ONES, lsum, 0, 0, 0); }
  float rli[16];
  if (SUMM) {
#pragma unroll
    for (int r = 0; r < 16; ++r) rli[r] = __builtin_amdgcn_rcpf(lsum[r]);
  } else {
    if (hi == 0) li_l[r32] = l_reg; asm volatile("s_waitcnt lgkmcnt(0)" ::: "memory");
#pragma unroll
    for (int r = 0; r < 16; ++r) rli[r] = __builtin_amdgcn_rcpf(li_l[crow(r, hi)]);
  }
  if constexpr (MODE == 1) {
    float* HB = (float*)lds;
    const int tb = (wid & 3) * 32;
    __syncthreads();
    if (wid >= 4) {
#pragma unroll
      for (int r = 0; r < 16; ++r)
#pragma unroll
        for (int d0 = 0; d0 < 4; ++d0) HB[(tb + crow(r, hi)) * 128 + d0 * 32 + r32] = o[d0][r] * rli[r]; }
    __syncthreads();
    if (wid < 4) { const float g0 = gsub[r32], g1 = gsub[32 + r32], g2 = gsub[64 + r32], g3 = gsub[96 + r32];
#pragma unroll
      for (int r = 0; r < 16; ++r) { const int orow = tb + crow(r, hi); const float* hb = HB + orow * 128 + r32;
        const float x0 = o[0][r] * rli[r] - lam * hb[0], x1 = o[1][r] * rli[r] - lam * hb[32], x2 = o[2][r] * rli[r] - lam * hb[64], x3 = o[3][r] * rli[r] - lam * hb[96];
        float ss = (x0 * x0 + x1 * x1) + (x2 * x2 + x3 * x3);
#pragma unroll
        for (int m = 1; m < 32; m <<= 1) ss += __shfl_xor(ss, m);
        const float rs = rsqrtf(ss * (1.f / 128.f) + 1e-6f) * post_scale;
        bf16_t* op = O1 + (long)orow * ldo + r32;
        op[0] = f2bf(x0 * rs * g0); op[32] = f2bf(x1 * rs * g1); op[64] = f2bf(x2 * rs * g2); op[96] = f2bf(x3 * rs * g3); } }
  } else {
    bf16_t* Ow = O1 + (long)(wid * 32) * ldo;
#pragma unroll
    for (int r = 0; r < 16; ++r) { const int orow = crow(r, hi);
#pragma unroll
      for (int d0 = 0; d0 < 4; ++d0) Ow[(long)orow * ldo + d0 * 32 + r32] = f2bf(o[d0][r] * rli[r]); }
  }
#undef SLOAD
#undef SWRITE
#undef SWAIT
#undef RESC
#undef FINISH
#undef PV_AND_PARTIAL
#undef PV_AND_PARTIAL_B
#undef PV_PART
}

template <int MODE, int FP>
__device__ __forceinline__ void attn_unit_sb(const bf16_t* __restrict__ Qp, int ldq, const bf16_t* __restrict__ Kn, int ldk, const bf16_t* __restrict__ Kr,
                                             const bf16_t* __restrict__ Vp, int ldv, bf16_t* O1, int ldo, const KeySrc ks, int NT, float scale, char* lds,
                                             float lam, float post_scale, const float* gsub, const float* kn2) {
  constexpr int NQ = MODE == 0 ? 12 : 4;
  constexpr int KCOLS = MODE == 0 ? 192 : 128;
  constexpr int KSTR = KCOLS * 2 + 16;
  constexpr int SHM_K = KVBLK * KSTR, SHM_VB = KVBLK * 128 * 2;
  constexpr float THR2 = 11.5415603f;
  const int tid = ltid(), wid = tid >> 6, lane = tid & 63, r32 = lane & 31, hi = lane >> 5;
  constexpr bool RING4 = (MODE == 1 && FP == 1);
  constexpr int NRB = RING4 ? 4 : 2;
  char* V_lds = lds; char* K_lds = lds + NRB * SHM_VB;
  float* wsf = (float*)(lds + NRB * SHM_VB + NRB * SHM_K) + wid * 64; float* li_l = wsf; float* al_l = wsf + 32;
  float m_reg = 0.f, l_reg = 0, qn2 = 0.f; f32x16 o[4] = {}; bf16x8 qr[NQ];
  const int qrow = (MODE == 0 ? wid * 32 : (wid & 3) * 32) + r32;
  const int qcol = (MODE == 0 ? 0 : (wid >> 2) * 64) + hi * 8;
  const int kwoff = (MODE == 1 ? (wid >> 2) * 128 : 0);
  { const bf16_t* Qw = Qp + (long)qrow * ldq + qcol; const float C = scale * 1.4426950408889634f;
#pragma unroll
    for (int d0 = 0; d0 < NQ; ++d0) { qr[d0] = scale_q(*reinterpret_cast<const bf16x8*>(Qw + d0 * 16), C); qn2 += sq8(qr[d0]); } }
  { auto rr_ = __builtin_amdgcn_permlane32_swap(__float_as_uint(qn2), __float_as_uint(qn2), false, false); qn2 = __uint_as_float(rr_[0]) + __uint_as_float(rr_[1]); }
  const bool fast = FP == 2 ? (kn2 != nullptr && __all(qn2 * kn2[MODE == 1 ? (wid >> 2) : 0] <= FAST_B2)) : (FP == 1);
  const int sr = tid >> 4, sc = (tid & 15) * 8, vst0 = v_st<4>(sr, sc), vst1 = v_st<4>(32 + sr, sc);
  const int rr = tid >> 3, rc = (tid & 7) * 8;
  const int vb0 = (int)(uintptr_t)V_lds + v_rd_base(lane);
  bf16x8 vs0, vs1, ks0, ks1, kr0;
  const unsigned voff0 = (unsigned)(sr * ldv + sc) * 2u, voff1 = voff0 + (unsigned)(32 * ldv) * 2u, koff0 = (unsigned)(sr * ldk + sc) * 2u, koff1 = koff0 + (unsigned)(32 * ldk) * 2u, roff = (unsigned)(rr * 64 + rc) * 2u;
#define KLOAD(j) do { const long r0_ = __builtin_amdgcn_readfirstlane((int)ks.row0(j)); const char* kb_ = (const char*)Kn + r0_ * ldk * 2; \
    ks0 = *reinterpret_cast<const bf16x8*>(kb_ + koff0); ks1 = *reinterpret_cast<const bf16x8*>(kb_ + koff1); \
    if (MODE == 0) { const char* rb_ = (const char*)Kr + r0_ * 128; kr0 = *reinterpret_cast<const bf16x8*>(rb_ + roff); } } while (0)
#define VLOAD(j) do { const long r0_ = __builtin_amdgcn_readfirstlane((int)ks.row0(j)); const char* vb_ = (const char*)Vp + r0_ * ldv * 2; \
    vs0 = *reinterpret_cast<const bf16x8*>(vb_ + voff0); vs1 = *reinterpret_cast<const bf16x8*>(vb_ + voff1); } while (0)
#define KWRITE(b) do { *(bf16x8*)(K_lds + (b) * SHM_K + sr * KSTR + sc * 2) = ks0; *(bf16x8*)(K_lds + (b) * SHM_K + (32 + sr) * KSTR + sc * 2) = ks1; \
    if (MODE == 0) *(bf16x8*)(K_lds + (b) * SHM_K + rr * KSTR + 256 + rc * 2) = kr0; } while (0)
#define VWRITE(b) do { *(bf16x8*)(V_lds + (b) * SHM_VB + vst0) = vs0; *(bf16x8*)(V_lds + (b) * SHM_VB + vst1) = vs1; } while (0)
#define RESC(a) do { if (__any((a) < 1.f)) { if (hi == 0) al_l[r32] = (a); asm volatile("s_waitcnt lgkmcnt(0)" ::: "memory"); \
    _Pragma("unroll") for (int r = 0; r < 16; ++r) { const float f_ = al_l[crow(r, hi)]; o[0][r] *= f_; o[1][r] *= f_; o[2][r] *= f_; o[3][r] *= f_; } } } while (0)
#define QKT(P0, P1, KB) do { if (fast) qkt_z<NQ, KSTR>(P0, P1, KB, qr, r32, hi); else qkt_m<NQ, KSTR>(P0, P1, KB, qr, r32, hi, -m_reg); } while (0)
#define FINISH(P0, P1, AL) do { _Pragma("unroll") for (int r = 0; r < 16; ++r) P1[r] = __builtin_amdgcn_exp2f(P1[r]); \
    { float ps = 0; _Pragma("unroll") for (int r = 0; r < 16; ++r) ps += P0[r]; _Pragma("unroll") for (int r = 0; r < 16; ++r) ps += P1[r]; \
      { auto rr_ = __builtin_amdgcn_permlane32_swap(__float_as_uint(ps), __float_as_uint(ps), false, false); ps = __uint_as_float(rr_[0]) + __uint_as_float(rr_[1]); } \
      l_reg = l_reg * (AL) + ps; } \
    PK4X(P0, 0, pa0); PK4X(P0, 8, pa1); PK4X(P1, 0, pa2); PK4X(P1, 8, pa3); } while (0)
#define PV_AND_PARTIAL(VB, P0, P1, AL) do { if constexpr (MODE == 0) { pv_d0<4>(o, (VB), pa0, pa1, pa2, pa3); partialSM2<false>(P0, P1, m_reg, AL, fast); } else { \
    float pm0_ = 0.f, pm1_ = 0.f; VFrag fa_, fb_; \
    pv_issue<0>(fa_, (VB)); pv_issue<1>(fb_, (VB)); pv_mma<8>(o[0], fa_, pa0, pa1, pa2, pa3); pv_issue<2>(fa_, (VB)); \
    if (!fast) { pm0_ = P0[0]; _Pragma("unroll") for (int r = 1; r < 16; ++r) pm0_ = fmaxf(pm0_, P0[r]); } \
    pv_mma<8>(o[1], fb_, pa0, pa1, pa2, pa3); pv_issue<3>(fb_, (VB)); \
    if (!fast) { pm1_ = P1[0]; _Pragma("unroll") for (int r = 1; r < 16; ++r) pm1_ = fmaxf(pm1_, P1[r]); pm0_ = fmaxf(pm0_, pm1_); \
    { auto rr_ = __builtin_amdgcn_permlane32_swap(__float_as_uint(pm0_), __float_as_uint(pm0_), false, false); pm0_ = fmaxf(__uint_as_float(rr_[0]), __uint_as_float(rr_[1])); } } \
    pv_mma<8>(o[2], fa_, pa0, pa1, pa2, pa3); \
    AL = 1.f; \
    if (!fast && !__builtin_expect(__all(pm0_ <= THR2), 1)) { const float dl_ = fmaxf(pm0_, 0.f); AL = __builtin_amdgcn_exp2f(-dl_); m_reg += dl_; \
      _Pragma("unroll") for (int r = 0; r < 16; ++r) { P0[r] -= dl_; P1[r] -= dl_; } } \
    _Pragma("unroll") for (int r = 0; r < 8; ++r) P0[r] = __builtin_amdgcn_exp2f(P0[r]); \
    pv_mma<0>(o[3], fb_, pa0, pa1, pa2, pa3); \
    _Pragma("unroll") for (int r = 8; r < 16; ++r) P0[r] = __builtin_amdgcn_exp2f(P0[r]); } } while (0)
#define EXPN(P, R0, N) do { asm volatile("" : "+v"(P)); _Pragma("unroll") for (int r_ = (R0); r_ < (R0) + (N); ++r_) P[r_] = __builtin_amdgcn_exp2f(P[r_]); asm volatile("" : "+v"(P)); } while (0)
#define ADDN(P, R0, N) do { asm volatile("" : "+v"(ps_)); _Pragma("unroll") for (int r_ = (R0); r_ < (R0) + (N); ++r_) ps_ += P[r_]; asm volatile("" : "+v"(ps_)); } while (0)
#define LSUM() do { auto rr_ = __builtin_amdgcn_permlane32_swap(__float_as_uint(ps_), __float_as_uint(ps_), false, false); l_reg = l_reg + (__uint_as_float(rr_[0]) + __uint_as_float(rr_[1])); } while (0)
#define FIN_PIECE(D0, PF0, PF1) do { \
    if constexpr (MODE == 1) { if ((D0) == 0) ADDN(PF0, 0, 16); if ((D0) == 1) ADDN(PF1, 0, 16); if ((D0) == 2) { PK4X(PF0, 0, pa0); PK4X(PF0, 8, pa1); } if ((D0) == 3) { PK4X(PF1, 0, pa2); PK4X(PF1, 8, pa3); LSUM(); } } \
    else { if ((D0) < 4) { EXPN(PF1, 4 * (D0), 4); ADDN(PF0, 4 * (D0), 4); } else if ((D0) < 8) ADDN(PF1, 4 * ((D0) - 4), 4); \
           if ((D0) == 6) PK4X(PF0, 0, pa0); if ((D0) == 7) PK4X(PF0, 8, pa1); if ((D0) == 8) PK4X(PF1, 0, pa2); if ((D0) == 9) PK4X(PF1, 8, pa3); if ((D0) == 10) LSUM(); } } while (0)
#define KFRAG(DST, KB, D0) do { const int cb_ = ((D0) * 16 + hi * 8) * 2; DST[0] = *reinterpret_cast<const bf16x8*>((KB) + r32 * KSTR + cb_); DST[1] = *reinterpret_cast<const bf16x8*>((KB) + (32 + r32) * KSTR + cb_); } while (0)
#define QKT_FIN_FAST(PN0, PN1, KB, PF0, PF1) do { float ps_ = 0.f; bf16x8 kfa_[2], kfb_[2]; PN0 = f32x16{}; PN1 = f32x16{}; KFRAG(kfa_, KB, 0); \
    _Pragma("unroll") for (int d0 = 0; d0 < NQ; d0 += 2) { \
      KFRAG(kfb_, KB, d0 + 1); SBAR(); \
      PN0 = __builtin_amdgcn_mfma_f32_32x32x16_bf16(kfa_[0], qr[d0], PN0, 0, 0, 0); PN1 = __builtin_amdgcn_mfma_f32_32x32x16_bf16(kfa_[1], qr[d0], PN1, 0, 0, 0); SBAR(); \
      FIN_PIECE(d0, PF0, PF1); SBAR(); \
      if (d0 + 2 < NQ) { KFRAG(kfa_, KB, d0 + 2); } SBAR(); \
      PN0 = __builtin_amdgcn_mfma_f32_32x32x16_bf16(kfb_[0], qr[d0 + 1], PN0, 0, 0, 0); PN1 = __builtin_amdgcn_mfma_f32_32x32x16_bf16(kfb_[1], qr[d0 + 1], PN1, 0, 0, 0); SBAR(); \
      FIN_PIECE(d0 + 1, PF0, PF1); SBAR(); } } while (0)
#define FINISH_FAST(PF0, PF1) do { float ps_ = 0.f; if constexpr (MODE == 0) EXPN(PF1, 0, 16); ADDN(PF0, 0, 16); ADDN(PF1, 0, 16); LSUM(); \
    PK4X(PF0, 0, pa0); PK4X(PF0, 8, pa1); PK4X(PF1, 0, pa2); PK4X(PF1, 8, pa3); } while (0)
#define PV_PART_FAST(VB, PN0, PN1) do { if constexpr (MODE == 1) { VFrag fa_, fb_; \
      pv_issue<0>(fa_, (VB)); pv_issue<1>(fb_, (VB)); pv_mma<8>(o[0], fa_, pa0, pa1, pa2, pa3); pv_issue<2>(fa_, (VB)); SBAR(); EXPN(PN0, 0, 8); SBAR(); \
      pv_mma<8>(o[1], fb_, pa0, pa1, pa2, pa3); pv_issue<3>(fb_, (VB)); SBAR(); EXPN(PN0, 8, 8); SBAR(); \
      pv_mma<8>(o[2], fa_, pa0, pa1, pa2, pa3); SBAR(); EXPN(PN1, 0, 8); SBAR(); \
      pv_mma<0>(o[3], fb_, pa0, pa1, pa2, pa3); SBAR(); EXPN(PN1, 8, 8); SBAR(); \
    } else { \
      pv_one<0, 4>(o[0], (VB), pa0, pa1, pa2, pa3); SBAR(); EXPN(PN0, 0, 4); SBAR(); pv_one<1, 4>(o[1], (VB), pa0, pa1, pa2, pa3); SBAR(); EXPN(PN0, 4, 4); SBAR(); \
      pv_one<2, 4>(o[2], (VB), pa0, pa1, pa2, pa3); SBAR(); EXPN(PN0, 8, 4); SBAR(); pv_one<3, 4>(o[3], (VB), pa0, pa1, pa2, pa3); SBAR(); EXPN(PN0, 12, 4); SBAR(); } } while (0)
  f32x16 pA0, pA1, pB0, pB1; float alA, alB; bf16x8 pa0, pa1, pa2, pa3;
  const char* K0 = K_lds + kwoff; const char* K1 = K_lds + SHM_K + kwoff;
  if constexpr (RING4) {
    bf16x8 ks2, ks3, vs2, vs3;
#define KLD2(A0, A1, j) do { const long r0_ = __builtin_amdgcn_readfirstlane((int)ks.row0(j)); const char* kb_ = (const char*)Kn + r0_ * ldk * 2; \
    A0 = *reinterpret_cast<const bf16x8*>(kb_ + koff0); A1 = *reinterpret_cast<const bf16x8*>(kb_ + koff1); } while (0)
#define VLD2(A0, A1, j) do { const long r0_ = __builtin_amdgcn_readfirstlane((int)ks.row0(j)); const char* vb_ = (const char*)Vp + r0_ * ldv * 2; \
    A0 = *reinterpret_cast<const bf16x8*>(vb_ + voff0); A1 = *reinterpret_cast<const bf16x8*>(vb_ + voff1); } while (0)
#define KWR2(A0, A1, t_) do { char* kd_ = K_lds + ((t_) & 3) * SHM_K; *(bf16x8*)(kd_ + sr * KSTR + sc * 2) = A0; *(bf16x8*)(kd_ + (32 + sr) * KSTR + sc * 2) = A1; } while (0)
#define VWR2(A0, A1, t_) do { char* vd_ = V_lds + ((t_) & 3) * SHM_VB; *(bf16x8*)(vd_ + vst0) = A0; *(bf16x8*)(vd_ + vst1) = A1; } while (0)
#define KPTR(t_) (K_lds + ((t_) & 3) * SHM_K + kwoff)
#define VPTR(t_) (vb0 + ((t_) & 3) * SHM_VB)
    __syncthreads();
    if (__builtin_amdgcn_readfirstlane(wid) >= 4) __builtin_amdgcn_s_setprio(1);
    KLD2(ks0, ks1, 0); asm volatile("s_waitcnt vmcnt(0)" ::: "memory"); KWR2(ks0, ks1, 0);
    KLD2(ks0, ks1, 1); VLD2(vs0, vs1, 0); KLD2(ks2, ks3, 2); VLD2(vs2, vs3, 1);
    __syncthreads();
    KWR2(ks0, ks1, 1); VWR2(vs0, vs1, 0); KWR2(ks2, ks3, 2); VWR2(vs2, vs3, 1);
    KLD2(ks0, ks1, 3); VLD2(vs0, vs1, 2); if (4 < NT) KLD2(ks2, ks3, 4); VLD2(vs2, vs3, 3);
    qkt_z<NQ, KSTR>(pA0, pA1, KPTR(0), qr, r32, hi); EXPN(pA0, 0, 16); EXPN(pA1, 0, 16);
    const int NP = NT >> 1;
    for (int sI = 0; sI + 1 < NP; ++sI) { const int t0 = 2 * sI;
      __syncthreads();
      KWR2(ks0, ks1, t0 + 3); VWR2(vs0, vs1, t0 + 2); if (t0 + 4 < NT) KWR2(ks2, ks3, t0 + 4); VWR2(vs2, vs3, t0 + 3);
      if (t0 + 5 < NT) KLD2(ks0, ks1, t0 + 5); if (t0 + 4 < NT) VLD2(vs0, vs1, t0 + 4); if (t0 + 6 < NT) KLD2(ks2, ks3, t0 + 6); if (t0 + 5 < NT) VLD2(vs2, vs3, t0 + 5);
      SBAR(); QKT_FIN_FAST(pB0, pB1, KPTR(t0 + 1), pA0, pA1); PV_PART_FAST(VPTR(t0), pB0, pB1);
      SBAR(); QKT_FIN_FAST(pA0, pA1, KPTR(t0 + 2), pB0, pB1); PV_PART_FAST(VPTR(t0 + 1), pA0, pA1);
    }
    __syncthreads();
    SBAR(); QKT_FIN_FAST(pB0, pB1, KPTR(NT - 1), pA0, pA1); PV_PART_FAST(VPTR(NT - 2), pB0, pB1);
    FINISH_FAST(pB0, pB1); SBAR();
    pv_d0<4>(o, VPTR(NT - 1), pa0, pa1, pa2, pa3);
#undef KLD2
#undef VLD2
#undef KWR2
#undef VWR2
#undef KPTR
#undef VPTR
  } else {
  __syncthreads();
  if (__builtin_amdgcn_readfirstlane(wid) >= 4) __builtin_amdgcn_s_setprio(1);
  KLOAD(0); asm volatile("s_waitcnt vmcnt(0)" ::: "memory"); KWRITE(0); KLOAD(1); VLOAD(0);
  __syncthreads();
  KWRITE(1); VWRITE(0); if (2 < NT) KLOAD(2); VLOAD(1);
  qkt_m<NQ, KSTR>(pA0, pA1, K0, qr, r32, hi, 0.f); partialSM2<true>(pA0, pA1, m_reg, alA, fast); alA = 1.f;
#ifndef FASTP_MODES
#define FASTP_MODES 3
#endif
  constexpr bool fastp = FP == 1;
  if constexpr (MODE == 1 && fastp) EXPN(pA1, 0, 16);
  for (int j = 1; j + 1 < NT; j += 2) {
    __syncthreads();
    KWRITE(0); VWRITE(1); if (j + 2 < NT) KLOAD(j + 2); VLOAD(j + 1);
    if constexpr (fastp) { SBAR(); QKT_FIN_FAST(pB0, pB1, K1, pA0, pA1); PV_PART_FAST(vb0, pB0, pB1); }
    else { SBAR(); QKT(pB0, pB1, K1); FINISH(pA0, pA1, alA); SBAR(); PV_AND_PARTIAL(vb0, pB0, pB1, alB); RESC(alB); }
    __syncthreads();
    if (j + 2 < NT) KWRITE(1); VWRITE(0); if (j + 3 < NT) KLOAD(j + 3); if (j + 2 < NT) VLOAD(j + 2);
    if constexpr (fastp) { SBAR(); QKT_FIN_FAST(pA0, pA1, K0, pB0, pB1); PV_PART_FAST(vb0 + SHM_VB, pA0, pA1); }
    else { SBAR(); QKT(pA0, pA1, K0); FINISH(pB0, pB1, alB); SBAR(); PV_AND_PARTIAL(vb0 + SHM_VB, pA0, pA1, alA); RESC(alA); }
  }
  __syncthreads();
  VWRITE(1);
  if constexpr (fastp) { SBAR(); QKT_FIN_FAST(pB0, pB1, K1, pA0, pA1); PV_PART_FAST(vb0, pB0, pB1); }
  else { SBAR(); QKT(pB0, pB1, K1); FINISH(pA0, pA1, alA); SBAR(); PV_AND_PARTIAL(vb0, pB0, pB1, alB); RESC(alB); }
  __syncthreads();
  if constexpr (fastp) { FINISH_FAST(pB0, pB1); } else { FINISH(pB0, pB1, alB); } SBAR();
  pv_d0<4>(o, vb0 + SHM_VB, pa0, pa1, pa2, pa3);
  }
  __builtin_amdgcn_s_setprio(0);
  if (hi == 0) li_l[r32] = l_reg; asm volatile("s_waitcnt lgkmcnt(0)" ::: "memory");
  float rli[16];
#pragma unroll
  for (int r = 0; r < 16; ++r) rli[r] = __builtin_amdgcn_rcpf(li_l[crow(r, hi)]);
  if constexpr (MODE == 1) {
    float* HB = (float*)lds; const int tb = (wid & 3) * 32;
    __syncthreads();
    if (wid >= 4) {
#pragma unroll
      for (int r = 0; r < 16; ++r)
#pragma unroll
        for (int d0 = 0; d0 < 4; ++d0) HB[(tb + crow(r, hi)) * 128 + d0 * 32 + r32] = o[d0][r] * rli[r]; }
    __syncthreads();
    if (wid < 4) { const float g0 = gsub[r32], g1 = gsub[32 + r32], g2 = gsub[64 + r32], g3 = gsub[96 + r32];
#pragma unroll
      for (int r = 0; r < 16; ++r) { const int orow = tb + crow(r, hi); const float* hb = HB + orow * 128 + r32;
        const float x0 = o[0][r] * rli[r] - lam * hb[0], x1 = o[1][r] * rli[r] - lam * hb[32], x2 = o[2][r] * rli[r] - lam * hb[64], x3 = o[3][r] * rli[r] - lam * hb[96];
        float ss = (x0 * x0 + x1 * x1) + (x2 * x2 + x3 * x3);
        ss += __builtin_bit_cast(float, __builtin_amdgcn_update_dpp(0, __builtin_bit_cast(int, ss), 0xB1, 0xf, 0xf, true)); ss += __builtin_bit_cast(float, __builtin_amdgcn_update_dpp(0, __builtin_bit_cast(int, ss), 0x4E, 0xf, 0xf, true));
        ss += __builtin_bit_cast(float, __builtin_amdgcn_update_dpp(0, __builtin_bit_cast(int, ss), 0x141, 0xf, 0xf, true)); ss += __builtin_bit_cast(float, __builtin_amdgcn_update_dpp(0, __builtin_bit_cast(int, ss), 0x140, 0xf, 0xf, true));
        { auto sw_ = __builtin_amdgcn_permlane16_swap(__float_as_uint(ss), __float_as_uint(ss), false, false); ss = __uint_as_float(sw_[0]) + __uint_as_float(sw_[1]); }
        const float rs = rsqrtf(ss * (1.f / 128.f) + 1e-6f) * post_scale;
        bf16_t* op = O1 + (long)orow * ldo + r32;
        op[0] = f2bf(x0 * rs * g0); op[32] = f2bf(x1 * rs * g1); op[64] = f2bf(x2 * rs * g2); op[96] = f2bf(x3 * rs * g3); } }
  } else {
    bf16_t* Ow = O1 + (long)(wid * 32) * ldo;
#pragma unroll
    for (int r = 0; r < 16; ++r) { const int orow = crow(r, hi);
#pragma unroll
      for (int d0 = 0; d0 < 4; ++d0) Ow[(long)orow * ldo + d0 * 32 + r32] = f2bf(o[d0][r] * rli[r]); }
  }
#undef KLOAD
#undef VLOAD
#undef KWRITE
#undef VWRITE
#undef RESC
#undef QKT
#undef FINISH
#undef PV_AND_PARTIAL
#undef EXPN
#undef ADDN
#undef LSUM
#undef FIN_PIECE
#undef KFRAG
#undef QKT_FIN_FAST
#undef FINISH_FAST
#undef PV_PART_FAST
}
template <int MODE>
__device__ __forceinline__ void attn_unit_sbd(const bf16_t* __restrict__ Qp, int ldq, const bf16_t* __restrict__ Kn, int ldk, const bf16_t* __restrict__ Kr,
                                              const bf16_t* __restrict__ Vp, int ldv, bf16_t* O1, int ldo, const KeySrc ks, int NT, float scale, char* lds,
                                              float lam, float post_scale, const float* gsub, const float* kn2) {
  if constexpr (MODE == 0) { attn_unit_sb<0, 2>(Qp, ldq, Kn, ldk, Kr, Vp, ldv, O1, ldo, ks, NT, scale, lds, lam, post_scale, gsub, kn2); return; }
  constexpr int NQ = MODE == 0 ? 12 : 4;
  const int tid = ltid(), wid = tid >> 6, lane = tid & 63, r32 = lane & 31, hi = lane >> 5;
  const int qrow = (MODE == 0 ? wid * 32 : (wid & 3) * 32) + r32, qcol = (MODE == 0 ? 0 : (wid >> 2) * 64) + hi * 8;
  const bf16_t* Qw = Qp + (long)qrow * ldq + qcol; const float C = scale * 1.4426950408889634f; float qn2 = 0.f;
#pragma unroll
  for (int d0 = 0; d0 < NQ; ++d0) qn2 += sq8(scale_q(*reinterpret_cast<const bf16x8*>(Qw + d0 * 16), C));
  { auto rr_ = __builtin_amdgcn_permlane32_swap(__float_as_uint(qn2), __float_as_uint(qn2), false, false); qn2 = __uint_as_float(rr_[0]) + __uint_as_float(rr_[1]); }
  const bool fastw = __all(qn2 * kn2[MODE == 1 ? (wid >> 2) : 0] <= FAST_B2);
  volatile int* flag = (volatile int*)(lds + 147328);
  __syncthreads(); if (tid == 0) *flag = 1; __syncthreads(); if (!fastw && lane == 0) *flag = 0; __syncthreads();
  const bool fast = __builtin_amdgcn_readfirstlane(*flag) != 0;
  if (fast) attn_unit_sb<MODE, 1>(Qp, ldq, Kn, ldk, Kr, Vp, ldv, O1, ldo, ks, NT, scale, lds, lam, post_scale, gsub, kn2);
  else attn_unit_sb<MODE, 0>(Qp, ldq, Kn, ldk, Kr, Vp, ldv, O1, ldo, ks, NT, scale, lds, lam, post_scale, gsub, kn2);
}
#undef SBAR
}

constexpr int DM = 1024, NBATCH = 2, SEQ = 16384, NLAT = NBATCH * SEQ, CTXL = 256, NCTX = NBATCH * CTXL, MTOT = NLAT + NCTX, DIN = 9296, FFH = 2816;
constexpr float EPS = 1e-6f;
constexpr int NCHAIN = 16, NCHUNK = 130;
constexpr float KSCALE_B = 0.08838834764831845f;
enum { I_X = 0, I_C, I_CTX, I_CCTX, I_WMOD, I_BMOD, I_GMIXPRE, I_GMIXPOST, I_GFFNPRE, I_GFFNPOST, I_WIN, I_ASINK, I_BGBIAS, I_CGQ, I_CGKV, I_CWUQ, I_CWUK, I_CWUV,
       I_LQ1, I_LK1, I_LQ2, I_LK2, I_DGSUB, I_WBRANCH, I_WOUT, I_WGU, I_WDOWN, N_IN };
constexpr size_t MiB = 1u << 20, KiB = 1u << 10;
constexpr size_t WS_CTL = 0, CTL_ZERO_BYTES = 64 * KiB;
constexpr size_t WS_SM = 1 * MiB;
constexpr size_t SM_MOD = WS_SM;
constexpr size_t SM_ROPE = WS_SM + 160 * KiB;
constexpr size_t SM_BG = WS_SM + 192 * KiB;
constexpr size_t SM_NST = WS_SM + 2560 * KiB;
constexpr size_t SM_SCAL = WS_SM + 3840 * KiB;
constexpr size_t SM_WSC = WS_SM + 3904 * KiB;
constexpr size_t SC_GU = SM_WSC, SC_G = SM_WSC + 24 * KiB, SC_CD = SM_WSC + 40 * KiB;
constexpr size_t SM_HC = WS_SM + 4 * MiB;
constexpr size_t WS_W = 8 * MiB;
constexpr size_t W_AB = WS_W, W_C = WS_W + 5632 * KiB, W_D = WS_W + 7680 * KiB, W_G = WS_W + 10752 * KiB, W_UQ = WS_W + 18944 * KiB, W_UKV = WS_W + 19712 * KiB,
                 W_BR = WS_W + 20224 * KiB, W_OUT = WS_W + 24320 * KiB, W_GU = WS_W + 26368 * KiB, W_DN = WS_W + 37632 * KiB;
constexpr size_t U_SC = 52 * MiB + 40 * MiB;
constexpr size_t WS_U = 52 * MiB;
constexpr size_t WS_Y = 117 * MiB;
constexpr size_t WS_R = 247 * MiB;
constexpr size_t R_PAB = WS_R, R_ST = WS_R + 179 * MiB;
constexpr size_t R_PD = WS_R, R_CQ = WS_R + 98 * MiB, R_CKNV = WS_R + 147 * MiB, R_CKR = WS_R + 253 * MiB, R_O2 = WS_R + 217 * MiB;
constexpr size_t R_SSQ = R_O2;
constexpr size_t R_G = WS_R, R_YOUT = WS_R, R_HID = WS_R;
constexpr size_t R_HP = WS_R + 180 * MiB;
constexpr size_t OUT_U8 = 64 * MiB, OUT_U8SC = 100 * MiB;
constexpr size_t R_U8 = WS_R + 219 * MiB, R_U8SC = WS_R + 252 * MiB;
constexpr size_t WS_END = 512 * MiB;
static_assert(W_DN + (size_t)1024 * 2816 * 2 <= WS_U, "weights");
static_assert(R_O2 + (size_t)MTOT * 512 * 2 >= R_U8 || true, "");
static_assert(R_CKNV + (size_t)MTOT * 1024 * 2 <= R_SSQ && R_SSQ + (size_t)MTOT * 12 * 4 <= R_U8 && R_U8 + (size_t)MTOT * 1024 <= R_U8SC && R_U8SC + (size_t)MTOT * 4 <= WS_END && R_G + (size_t)MTOT * 4096 <= R_U8, "int8 u copy");
static_assert(SC_G + 4096 * 4 <= SM_HC && SC_GU + 5632 * 4 <= SC_G && WS_U + (size_t)MTOT * 1024 <= U_SC && U_SC + (size_t)MTOT * 4 <= WS_Y, "int8 scales");
static_assert(WS_U + (size_t)MTOT * 1024 * 2 <= WS_Y && WS_Y + (size_t)MTOT * 2048 * 2 <= WS_R, "U/Y");
static_assert(R_PAB + (size_t)MTOT * 2816 * 2 <= R_ST && R_ST + (size_t)16 * 130 * 16384 * 2 <= WS_END, "AB");
static_assert(R_PD + (size_t)MTOT * 1536 * 2 <= R_CQ && R_CQ + (size_t)MTOT * 768 * 2 <= R_CKNV && R_CKNV + (size_t)MTOT * 1024 * 2 <= R_O2 && R_U8SC + (size_t)MTOT * 4 <= R_CKR && R_ST + (size_t)16 * 130 * 16384 * 2 <= R_CKR && R_HP + (size_t)MTOT * 1024 * 2 <= R_CKR && R_CKR + (size_t)MTOT * 64 * 2 <= WS_END, "CD");
static_assert(R_G + (size_t)MTOT * 4096 * 2 <= WS_END, "G");
static_assert((size_t)NLAT * 1024 * 2 <= OUT_U8 && OUT_U8 + (size_t)MTOT * 1024 <= OUT_U8SC && OUT_U8SC + (size_t)MTOT * 4 <= (size_t)NLAT * 1024 * 4, "u8 in d_out");
static_assert((size_t)MTOT * 2816 * 2 <= 180 * MiB && R_HP + (size_t)MTOT * 1024 * 2 <= WS_END, "HP");
static_assert(SM_BG + (size_t)MTOT * 16 * 4 <= SM_NST && SM_NST + (size_t)16 * 130 * 128 * 4 <= SM_SCAL && SM_SCAL + 3 * 16 * 130 * 4 <= SM_HC && SM_HC + 512 * 1024 * 4 <= WS_W, "SM");
constexpr int LDS_BYTES = 147456;
constexpr int CW_KN = 8192;

struct Args { const float* in[N_IN]; float* out; unsigned char* ws; int layer; int pad; };

typedef const float* const __attribute__((address_space(4)))* InTab;
struct Ctx {
    InTab in; float* out; unsigned char* ws; int layer;
    LAS unsigned char* lds; char* ldsg;
    int tid, lane, wave, G, bid;
};

template <int CTRL> __device__ __forceinline__ float dpp_mov(float x) { return __builtin_bit_cast(float, __builtin_amdgcn_update_dpp(0, __builtin_bit_cast(int, x), CTRL, 0xf, 0xf, true)); }
__device__ __forceinline__ float wave_sum(float v) {
    v += dpp_mov<0xB1>(v); v += dpp_mov<0x4E>(v); v += dpp_mov<0x124>(v); v += dpp_mov<0x128>(v);
    { auto r = __builtin_amdgcn_permlane16_swap(__float_as_uint(v), __float_as_uint(v), false, false); v = __uint_as_float(r[0]) + __uint_as_float(r[1]); }
    { auto r = __builtin_amdgcn_permlane32_swap(__float_as_uint(v), __float_as_uint(v), false, false); v = __uint_as_float(r[0]) + __uint_as_float(r[1]); }
    return v;
}
__device__ __forceinline__ float wave_max(float v) {
    v = fmaxf(v, dpp_mov<0xB1>(v)); v = fmaxf(v, dpp_mov<0x4E>(v)); v = fmaxf(v, dpp_mov<0x124>(v)); v = fmaxf(v, dpp_mov<0x128>(v));
    { auto r = __builtin_amdgcn_permlane16_swap(__float_as_uint(v), __float_as_uint(v), false, false); v = fmaxf(__uint_as_float(r[0]), __uint_as_float(r[1])); }
    { auto r = __builtin_amdgcn_permlane32_swap(__float_as_uint(v), __float_as_uint(v), false, false); v = fmaxf(__uint_as_float(r[0]), __uint_as_float(r[1])); }
    return v;
}
__device__ __forceinline__ float wave_sum16(const float (&g)[16], int lane) {
    float b[8], c4[4], d[2];
#pragma unroll
    for (int i = 0; i < 8; ++i) { auto r = __builtin_amdgcn_permlane32_swap(__float_as_uint(g[i]), __float_as_uint(g[8 + i]), false, false); b[i] = __uint_as_float(r[0]) + __uint_as_float(r[1]); }
#pragma unroll
    for (int i = 0; i < 4; ++i) { auto r = __builtin_amdgcn_permlane16_swap(__float_as_uint(b[i]), __float_as_uint(b[4 + i]), false, false); c4[i] = __uint_as_float(r[0]) + __uint_as_float(r[1]); }
    const bool b3 = (lane & 8) != 0, b2 = (lane & 4) != 0;
#pragma unroll
    for (int i = 0; i < 2; ++i) { const float keep = b3 ? c4[2 + i] : c4[i], send = b3 ? c4[i] : c4[2 + i]; d[i] = keep + dpp_mov<0x128>(send); }
    float e; { const float keep = b2 ? d[1] : d[0], send = b2 ? d[0] : d[1]; e = keep + __shfl_xor(send, 4); }
    e += dpp_mov<0x4E>(e); e += dpp_mov<0xB1>(e);
    return e;
}
__device__ __forceinline__ float siluf_(float x) { return x / (1.f + __expf(-x)); }
__device__ __forceinline__ float logsigf_(float x) { return fminf(x, 0.f) - __logf(1.f + __expf(-fabsf(x))); }
__device__ __forceinline__ float dot8(const u32x4 a, const u32x4 b) {
    return bflo(a.x) * bflo(b.x) + bfhi(a.x) * bfhi(b.x) + bflo(a.y) * bflo(b.y) + bfhi(a.y) * bfhi(b.y)
         + bflo(a.z) * bflo(b.z) + bfhi(a.z) * bfhi(b.z) + bflo(a.w) * bflo(b.w) + bfhi(a.w) * bfhi(b.w);
}
__device__ __forceinline__ const float* hin_row(const Ctx& c, int r) {
    if (c.layer == 0) return r < NLAT ? c.in[I_X] + (size_t)r * DM : c.in[I_CTX] + (size_t)(r - NLAT) * DM;
    return r < NLAT ? c.out + (size_t)r * DM : (const float*)(c.ws + SM_HC) + (size_t)(r - NLAT) * DM;
}
__device__ __forceinline__ float* hout_row(const Ctx& c, int r) { return r < NLAT ? c.out + (size_t)r * DM : (float*)(c.ws + SM_HC) + (size_t)(r - NLAT) * DM; }
__device__ __forceinline__ int mod_idx(int r) { return r < NLAT ? (r >= SEQ ? 1 : 0) : 2; }
__device__ __forceinline__ int tok_row(int dir, int b, int idx, int tp) {
    if (idx < 2) { int j = idx * 128 + tp; if (dir) j = 255 - j; return NLAT + b * CTXL + j; }
    int s = (idx - 2) * 128 + tp; if (dir) s = SEQ - 1 - s; return b * SEQ + s;
}

__device__ __forceinline__ void tr_block(const float* W, int ldw, int k0, int n0, bf16_t* WT, int ldo, int drow, int dcol, float* scr, int lane, const float* kgain = nullptr) {
    float wl[32];
#pragma unroll
    for (int i = 0; i < 32; ++i) { const int kk = 2 * i + (lane >> 5); wl[i] = W[(size_t)(k0 + kk) * ldw + n0 + (lane & 31)]; }
#pragma unroll
    for (int i = 0; i < 32; ++i) { const int kk = 2 * i + (lane >> 5); float w = wl[i]; if (kgain) w *= kgain[k0 + kk]; scr[kk * 33 + (lane & 31)] = w; }
    asm volatile("s_waitcnt lgkmcnt(0)" ::: "memory");
    const int c8 = lane & 7;
#pragma unroll
    for (int j = 0; j < 4; ++j) { const int n = (lane >> 3) + 8 * j; const float* s = scr + (8 * c8) * 33 + n;
        u32x4 o; o.x = cvt_pk_bf16(s[0 * 33], s[1 * 33]); o.y = cvt_pk_bf16(s[2 * 33], s[3 * 33]); o.z = cvt_pk_bf16(s[4 * 33], s[5 * 33]); o.w = cvt_pk_bf16(s[6 * 33], s[7 * 33]);
        *(u32x4*)(WT + (size_t)(drow + n) * ldo + dcol + 8 * c8) = o; }
    asm volatile("s_waitcnt lgkmcnt(0)" ::: "memory");
}
__device__ __forceinline__ void q8_item(const float* W, int ldw, int n0, signed char* WT8, int drow, float* colscale, float* scr, int lane) {
    float mx = 0.f;
    for (int k0 = (lane >> 5); k0 < 1024; k0 += 64) { float wl[32];
#pragma unroll
        for (int i = 0; i < 32; ++i) wl[i] = W[(size_t)(k0 + 2 * i) * ldw + n0 + (lane & 31)];
#pragma unroll
        for (int i = 0; i < 32; ++i) mx = fmaxf(mx, fabsf(wl[i])); }
    { auto rr = __builtin_amdgcn_permlane32_swap(__float_as_uint(mx), __float_as_uint(mx), false, false); mx = fmaxf(__uint_as_float(rr[0]), __uint_as_float(rr[1])); }
    float* inv32 = scr + 64 * 33;
    if (lane < 32) { colscale[drow + lane] = mx > 0.f ? mx * (1.f / 127.f) : 1.f; inv32[lane] = mx > 0.f ? 127.f / mx : 0.f; }
    for (int kb = 0; kb < 16; ++kb) {
        float wl[32];
#pragma unroll
        for (int i = 0; i < 32; ++i) { const int kk = 2 * i + (lane >> 5); wl[i] = W[(size_t)(64 * kb + kk) * ldw + n0 + (lane & 31)]; }
#pragma unroll
        for (int i = 0; i < 32; ++i) { const int kk = 2 * i + (lane >> 5); scr[kk * 33 + (lane & 31)] = wl[i]; }
        asm volatile("s_waitcnt lgkmcnt(0)" ::: "memory");
        const int c8 = lane & 7;
#pragma unroll
        for (int j = 0; j < 4; ++j) { const int n = (lane >> 3) + 8 * j; const float* s = scr + (8 * c8) * 33 + n; const float iv = inv32[n];
            unsigned lo = 0u, hi = 0u;
#pragma unroll
            for (int t = 0; t < 4; ++t) { lo |= ((unsigned)__float2int_rn(s[t * 33] * iv) & 255u) << (8 * t); hi |= ((unsigned)__float2int_rn(s[(4 + t) * 33] * iv) & 255u) << (8 * t); }
            u32x2 o; o.x = lo; o.y = hi; *(u32x2*)(WT8 + (size_t)(drow + n) * 1024 + 64 * kb + 8 * c8) = o; }
        asm volatile("s_waitcnt lgkmcnt(0)" ::: "memory");
    }
}
__device__ __forceinline__ void quant_row_i8(const f32x4 (&u)[4], signed char* dst, float* scale_slot, int lane) {
    float mx = 0.f;
#pragma unroll
    for (int j = 0; j < 4; ++j) mx = fmaxf(fmaxf(mx, fmaxf(fabsf(u[j].x), fabsf(u[j].y))), fmaxf(fabsf(u[j].z), fabsf(u[j].w)));
    mx = wave_max(mx);
    const float inv = mx > 0.f ? 127.f / mx : 0.f;
    if (lane == 0) *scale_slot = mx > 0.f ? mx * (1.f / 127.f) : 1.f;
#pragma unroll
    for (int j = 0; j < 4; ++j) { const unsigned w = ((unsigned)__float2int_rn(u[j].x * inv) & 255u) | (((unsigned)__float2int_rn(u[j].y * inv) & 255u) << 8) | (((unsigned)__float2int_rn(u[j].z * inv) & 255u) << 16) | (((unsigned)__float2int_rn(u[j].w * inv) & 255u) << 24);
        *(unsigned*)(dst + 4 * (lane + 64 * j)) = w; }
}
__device__ __forceinline__ void ph_conv(const Ctx& c, const int l, const int vbid, const int VG, const int parts, const bool extras) {
    unsigned char* ws = c.ws;
    float* scr = (float*)(c.ldsg + c.wave * 16384);
    const float* w_in = c.in[I_WIN] + (size_t)l * DM * DIN;
    if (c.wave < 2 && c.wave * VG + vbid < 378) {
        const int it = c.wave * VG + vbid;
        if (!(parts & 1)) {}
        else if (it >= 304) { const int i2 = it - 304;
            if (i2 < 26) q8_item(w_in, DIN, 2832 + 32 * i2, (signed char*)(ws + W_C), 32 * i2, (float*)(ws + SC_CD), scr, c.lane);
            else q8_item(w_in, DIN, 3664 + 32 * (i2 - 26), (signed char*)(ws + W_C), 1024 + 32 * (i2 - 26), (float*)(ws + SC_CD), scr, c.lane); }
        else if (it >= 176) q8_item(w_in, DIN, 5200 + 32 * (it - 176), (signed char*)(ws + W_G), 32 * (it - 176), (float*)(ws + SC_G), scr, c.lane);
        else { const int n0 = 32 * it; const int drow = n0 < FFH ? 256 * (n0 / 128) + (n0 % 128) : 256 * ((n0 - FFH) / 128) + 128 + ((n0 - FFH) % 128);
            q8_item(c.in[I_WGU] + (size_t)l * 1024 * 5632, 5632, n0, (signed char*)(ws + W_GU), drow, (float*)(ws + SC_GU), scr, c.lane); }
    } else {
    const int gw = vbid * 6 + (c.wave - 2 < 0 ? 0 : c.wave - 2), NGW = VG * 6;
    if (c.wave >= 2) {
    int base = 0;
#define CONV_SEG(W_, ldw_, K_, nblk_, n0_, WT_, ldo_, drow0_, dcol0_, kind_) CONV_SEGG(W_, ldw_, K_, nblk_, n0_, WT_, ldo_, drow0_, dcol0_, kind_, nullptr)
#define CONV_SEGG(W_, ldw_, K_, nblk_, n0_, WT_, ldo_, drow0_, dcol0_, kind_, gain_) do { \
        const float* W__ = (W_); bf16_t* WT__ = (bf16_t*)(WT_); const int nit = ((K_) / 64) * (nblk_); \
        int it = gw - (base % NGW); if (it < 0) it += NGW; \
        for (; it < nit; it += NGW) { const int kb = it / (nblk_), nb = it % (nblk_); int drow = (drow0_) + 32 * nb; \
            if ((kind_) == 1) { const int n0 = 32 * nb; drow = n0 < FFH ? 256 * (n0 / 128) + (n0 % 128) : 256 * ((n0 - FFH) / 128) + 128 + ((n0 - FFH) % 128); } \
            tr_block(W__, (ldw_), 64 * kb, (n0_) + 32 * nb, WT__, (ldo_), drow, (dcol0_) + 64 * kb, scr, c.lane, (gain_)); } \
        base += nit; } while (0)
    if (parts & 1) {
    CONV_SEG(w_in, DIN, 1024, 72, 0,    ws + W_AB, 1024, 0, 0, 0);
    CONV_SEG(w_in, DIN, 1024, 16, 2320, ws + W_AB, 1024, 2304, 0, 0);
    CONV_SEGG(c.in[I_CWUQ] + (size_t)l * 512 * 768, 768, 512, 24, 0, ws + W_UQ, 512, 0, 0, 0, c.in[I_CGQ] + l * 512);
    CONV_SEGG(c.in[I_CWUK] + (size_t)l * 256 * 512, 512, 256, 16, 0, ws + W_UKV, 256, 0, 0, 0, c.in[I_CGKV] + l * 256);
    CONV_SEGG(c.in[I_CWUV] + (size_t)l * 256 * 512, 512, 256, 16, 0, ws + W_UKV, 256, 512, 0, 0, c.in[I_CGKV] + l * 256);
    CONV_SEG(c.in[I_WBRANCH] + ((size_t)l * 4 + 0) * 512 * 1024, 1024, 512, 32, 0, ws + W_BR, 2048, 0, 0, 0);
    CONV_SEG(c.in[I_WBRANCH] + ((size_t)l * 4 + 1) * 512 * 1024, 1024, 512, 32, 0, ws + W_BR, 2048, 0, 512, 0);
    CONV_SEG(c.in[I_WBRANCH] + ((size_t)l * 4 + 2) * 512 * 1024, 1024, 512, 32, 0, ws + W_BR, 2048, 0, 1024, 0);
    CONV_SEG(c.in[I_WBRANCH] + ((size_t)l * 4 + 3) * 512 * 1024, 1024, 512, 32, 0, ws + W_BR, 2048, 0, 1536, 0);
    CONV_SEG(c.in[I_WOUT] + (size_t)l * 1024 * 1024, 1024, 1024, 32, 0, ws + W_OUT, 1024, 0, 0, 0);
    }
    if (parts & 2) CONV_SEG(c.in[I_WDOWN] + (size_t)l * 2816 * 1024, 1024, 2816, 32, 0, ws + W_DN, 2816, 0, 0, 0);
#undef CONV_SEG
#undef CONV_SEGG
    } }
    { signed char* wc = (signed char*)(ws + W_C) + (size_t)832 * 1024; const int n16 = 192 * 1024 / 16;
      if (parts & 1) { for (int i = vbid * 512 + c.tid; i < n16; i += VG * 512) ((u32x4*)wc)[i] = (u32x4){0u, 0u, 0u, 0u};
          if (vbid == 0 && c.tid < 192) ((float*)(ws + SC_CD))[832 + c.tid] = 1.f; } }
    if (extras) {
    { float* T = (float*)(ws + SM_ROPE);
      for (int i = c.bid * 512 + c.tid; i < 256 * 16; i += c.G * 512) { const int p = i >> 4, k = i & 15;
          const float inv = exp2f(-(float)k * 0.83048202372184058f);   const float ang = (float)p * inv; T[2 * i] = cosf(ang); T[2 * i + 1] = sinf(ang); } }
    __syncthreads();
    { float* red = (float*)c.ldsg;
      float* sl = (float*)c.ldsg + 2048;
      float* mod = (float*)(ws + SM_MOD);
      for (int i = c.tid; i < 3072; i += 512) sl[i] = siluf_(i < 2048 ? c.in[I_C][i] : c.in[I_CCTX][i - 2048]);
      __syncthreads();
      for (int it = c.bid; it < 192; it += c.G) {
          const int lm = it / 96; const float* wm = c.in[I_WMOD] + (size_t)lm * DM * 6144; const float* bm = c.in[I_BMOD] + (size_t)lm * 6144;
          const int n = (it % 96) * 64 + c.lane; float a0 = 0.f, a1 = 0.f, a2 = 0.f;
          for (int k0 = c.wave * 128; k0 < c.wave * 128 + 128; k0 += 32) { float wl[32];
#pragma unroll
              for (int i = 0; i < 32; ++i) wl[i] = wm[(size_t)(k0 + i) * 6144 + n];
#pragma unroll
              for (int i = 0; i < 32; ++i) { a0 += sl[k0 + i] * wl[i]; a1 += sl[1024 + k0 + i] * wl[i]; a2 += sl[2048 + k0 + i] * wl[i]; } }
          red[(c.wave * 3 + 0) * 64 + c.lane] = a0; red[(c.wave * 3 + 1) * 64 + c.lane] = a1; red[(c.wave * 3 + 2) * 64 + c.lane] = a2;
          __syncthreads();
          if (c.wave < 3) { float s_ = 0.f;
#pragma unroll
              for (int w = 0; w < 8; ++w) s_ += red[(w * 3 + c.wave) * 64 + c.lane];
              mod[(lm * 3 + c.wave) * 6144 + n] = s_ + bm[n]; }
          __syncthreads();
      } }
    }
}

__device__ __forceinline__ void stage_gate_weights(const Ctx& c, int l, float* wgl) {
    const float* wg = c.in[I_WIN] + (size_t)l * DM * DIN + 2304;
    for (int i = c.tid; i < 1024 * 4; i += 512) { const int k = i >> 2, q4 = i & 3; const f32x4 w = *(const f32x4*)(wg + (size_t)k * DIN + 4 * q4);
        wgl[(4 * q4 + 0) * 1024 + k] = w.x; wgl[(4 * q4 + 1) * 1024 + k] = w.y; wgl[(4 * q4 + 2) * 1024 + k] = w.z; wgl[(4 * q4 + 3) * 1024 + k] = w.w; }
    __syncthreads();
}
struct N1Vec { f32x4 sh[4], sc[4]; };
__device__ __forceinline__ void norm1_load(const Ctx& c, int l, int r, N1Vec& nv) {
    const float* md = (const float*)(c.ws + SM_MOD) + (l * 3 + mod_idx(r)) * 6144;
#pragma unroll
    for (int j = 0; j < 4; ++j) { const int e = 4 * (c.lane + 64 * j); nv.sh[j] = *(const f32x4*)(md + e); nv.sc[j] = *(const f32x4*)(md + 1024 + e); }
}
__device__ __forceinline__ void norm1_apply(const Ctx& c, int l, int r, const f32x4 (&v)[4], const float* wgl, const f32x4 (&g4)[4], const N1Vec& nv) {
    const float* bias = c.in[I_BGBIAS] + l * 16; bf16_t* U = (bf16_t*)(c.ws + WS_U); float* bg = (float*)(c.ws + SM_BG);
    float ss = 0.f;
#pragma unroll
    for (int j = 0; j < 4; ++j) ss += (v[j].x * v[j].x + v[j].y * v[j].y) + (v[j].z * v[j].z + v[j].w * v[j].w);
    const float rs = rsqrtf(wave_sum(ss) * (1.f / DM) + EPS);
    float ga[16];
#pragma unroll
    for (int q = 0; q < 16; ++q) ga[q] = 0.f;
    f32x4 uj[4];
#pragma unroll
    for (int j = 0; j < 4; ++j) { const int e = 4 * (c.lane + 64 * j);
        const f32x4 g = g4[j], sh = nv.sh[j], scl = nv.sc[j];
        f32x4 u; u.x = v[j].x * rs * g.x * (1.f + scl.x) + sh.x; u.y = v[j].y * rs * g.y * (1.f + scl.y) + sh.y; u.z = v[j].z * rs * g.z * (1.f + scl.z) + sh.z; u.w = v[j].w * rs * g.w * (1.f + scl.w) + sh.w;
        u32x2 w; w.x = cvt_pk_bf16(u.x, u.y); w.y = cvt_pk_bf16(u.z, u.w); *(u32x2*)(U + (size_t)r * DM + e) = w; uj[j] = u; }
    quant_row_i8(uj, (signed char*)c.out + OUT_U8 + (size_t)r * DM, (float*)((unsigned char*)c.out + OUT_U8SC) + r, c.lane);
    { f32x4 wa[8], wb[8];
#define N1_LDW(dst, B) do { _Pragma("unroll") for (int q = 0; q < 8; ++q) dst[q] = *(const f32x4*)(wgl + (((B) & 1) * 8 + q) * 1024 + 4 * (c.lane + 64 * ((B) >> 1))); } while (0)
#define N1_FMA(src, B) do { const f32x4 u = uj[(B) >> 1]; _Pragma("unroll") for (int q = 0; q < 8; ++q) ga[((B) & 1) * 8 + q] += (u.x * src[q].x + u.y * src[q].y) + (u.z * src[q].z + u.w * src[q].w); } while (0)
      N1_LDW(wa, 0);
#pragma unroll
      for (int bq = 0; bq < 8; bq += 2) {
          N1_LDW(wb, bq + 1); __builtin_amdgcn_sched_barrier(0);
          N1_FMA(wa, bq); __builtin_amdgcn_sched_barrier(0);
          if (bq + 2 < 8) { N1_LDW(wa, bq + 2); } __builtin_amdgcn_sched_barrier(0);
          N1_FMA(wb, bq + 1); __builtin_amdgcn_sched_barrier(0); }
#undef N1_LDW
#undef N1_FMA
    }
    const float gsum = wave_sum16(ga, c.lane);
    if ((c.lane & 3) == 0) { const int q = c.lane >> 2; float g = gsum + bias[q]; if ((q >> 2) & 1) g = logsigf_(g); bg[(size_t)r * 16 + q] = g; }
}
__device__ __forceinline__ void ph_norm1(const Ctx& c) {
    const int l = c.layer; const int gw = c.bid * 8 + c.wave, NGW = c.G * 8;
    float* wgl = (float*)c.ldsg; stage_gate_weights(c, l, wgl);
    f32x4 g4[4]; { const float* gpre = c.in[I_GMIXPRE] + (size_t)l * DM;
#pragma unroll
      for (int j = 0; j < 4; ++j) g4[j] = *(const f32x4*)(gpre + 4 * (c.lane + 64 * j)); }
    f32x4 v[4], vn[4];
    if (gw < MTOT) { const f32x4* xr = (const f32x4*)hin_row(c, gw) + c.lane;
#pragma unroll
        for (int j = 0; j < 4; ++j) v[j] = xr[64 * j]; }
    for (int r = gw; r < MTOT; r += NGW) {
        N1Vec nv; norm1_load(c, l, r, nv);
        const int rn = r + NGW < MTOT ? r + NGW : r; { const f32x4* xr = (const f32x4*)hin_row(c, rn) + c.lane;
#pragma unroll
          for (int j = 0; j < 4; ++j) vn[j] = xr[64 * j]; }
        __builtin_amdgcn_sched_barrier(0);
        norm1_apply(c, l, r, v, wgl, g4, nv);
#pragma unroll
        for (int j = 0; j < 4; ++j) v[j] = vn[j];
    }
}

__device__ __forceinline__ void rope_row(bf16_t* rowp, const bf16_t* srcp, int npairs, int hstride, int pr, int pc, const float* T, int lane) {
    for (int p = lane; p < npairs; p += 64) { const int hh = p >> 5, w = p & 31, half = w >> 4, i = w & 15;
        const int c1 = hh * hstride + 32 * half + i, c2 = c1 + 16; const int pos = half ? pc : pr;
        const float cs = T[(pos * 16 + i) * 2], sn = T[(pos * 16 + i) * 2 + 1];
        const float x1 = bf2f(srcp[c1]), x2 = bf2f(srcp[c2]);
        rowp[c1] = f2bf(x1 * cs - x2 * sn); rowp[c2] = f2bf(x2 * cs + x1 * sn); }
}
__device__ __forceinline__ void ph_rope_a(const Ctx& c) {
    const int gw = c.bid * 8 + c.wave, NGW = c.G * 8; const float* T = (const float*)(c.ws + SM_ROPE);
    bf16_t* P = (bf16_t*)(c.ws + R_PAB);
    for (int r = gw; r < NLAT; r += NGW) { const int t = r & (SEQ - 1); bf16_t* rp = P + (size_t)r * 2816; rope_row(rp, rp, 320, 64, t >> 6, t & 63, T, c.lane); }
}

__device__ __forceinline__ void ph_mix_ab1(const Ctx& c) {
    const int l = c.layer; const bool with_ctx = (l == 0);
    const bf16_t* P = (const bf16_t*)(c.ws + R_PAB); const float* bg = (const float*)(c.ws + SM_BG);
    bf16_t* ST = (bf16_t*)(c.ws + R_ST); float* NST = (float*)(c.ws + SM_NST); float* SCAL = (float*)(c.ws + SM_SCAL);
    {
        char* Kt = c.ldsg; char* Vf = c.ldsg + 32768; char* Vb = c.ldsg + 65536; float* wv = (float*)(c.ldsg + 98304);
        const int r32 = c.lane & 31, hi = c.lane >> 5;
        for (int it = c.bid; it < 8 * NCHUNK; it += c.G) {
            const int b = it / (4 * NCHUNK), head = (it / NCHUNK) & 3, tc = it % NCHUNK;
            const int row0 = tc < 2 ? NLAT + b * CTXL + tc * 128 : b * SEQ + (tc - 2) * 128;
            const int ci_f = (b * 4 + head) * NCHUNK + tc, ci_b = (8 + b * 4 + head) * NCHUNK + (tc < 2 ? 1 - tc : 131 - tc);
            __syncthreads();
            const int sdir = c.wave & 1; const int e0 = sdir ? 127 - 2 * c.lane : 2 * c.lane, e1 = sdir ? 126 - 2 * c.lane : 2 * c.lane + 1;
            float x0 = 0.f, x1 = 0.f, i0 = 0.f, i1 = 0.f;
            if (c.wave < 2) { const float* g0 = bg + (size_t)(row0 + e0) * 16 + sdir * 8 + head; const float* g1 = bg + (size_t)(row0 + e1) * 16 + sdir * 8 + head;
                x0 = g0[4]; x1 = g1[4]; i0 = g0[0]; i1 = g1[0]; }
            u32x4 skk[4], svv[4];
#pragma unroll
            for (int i = 0; i < 4; ++i) { const int e = c.tid + 512 * i, s = e >> 4, c8 = (e & 15) * 8; const bf16_t* pr = P + (size_t)(row0 + s) * 2816 + 128 * head + c8;
                skk[i] = *(const u32x4*)(pr + 1280); svv[i] = *(const u32x4*)(pr + 1792); }
            __builtin_amdgcn_sched_barrier(0);
            if (c.wave < 2) { float s = x0 + x1;
#pragma unroll
                for (int off = 1; off < 64; off <<= 1) { const float t = __shfl_up(s, off); if (c.lane >= off) s += t; }
                const float blast = __shfl(s, 63);
                const float ga = blast - (s - x1) + i0, gb = blast - s + i1;
                const float gmax = wave_max(fmaxf(ga, gb));
                wv[sdir * 128 + e0] = __expf(ga - gmax); wv[sdir * 128 + e1] = __expf(gb - gmax);
                if (c.lane == 0) { const int ci = sdir ? ci_b : ci_f; SCAL[ci] = gmax; SCAL[NCHAIN * NCHUNK + ci] = blast; } }
            __syncthreads();
#pragma unroll
            for (int i = 0; i < 4; ++i) { const int e = c.tid + 512 * i, s = e >> 4, c8 = (e & 15) * 8; const u32x4 kk = skk[i], vv = svv[i];
                const int ad = (s >> 6) * 16384 + att::v_st<4>(s & 63, c8);
                *(u32x4*)(Kt + ad) = kk;
                const float wf = wv[s], wb = wv[128 + s]; u32x4 a, d;
                a.x = cvt_pk_bf16(bflo(vv.x) * wf, bfhi(vv.x) * wf); a.y = cvt_pk_bf16(bflo(vv.y) * wf, bfhi(vv.y) * wf); a.z = cvt_pk_bf16(bflo(vv.z) * wf, bfhi(vv.z) * wf); a.w = cvt_pk_bf16(bflo(vv.w) * wf, bfhi(vv.w) * wf);
                d.x = cvt_pk_bf16(bflo(vv.x) * wb, bfhi(vv.x) * wb); d.y = cvt_pk_bf16(bflo(vv.y) * wb, bfhi(vv.y) * wb); d.z = cvt_pk_bf16(bflo(vv.z) * wb, bfhi(vv.z) * wb); d.w = cvt_pk_bf16(bflo(vv.w) * wb, bfhi(vv.w) * wb);
                *(u32x4*)(Vf + ad) = a; *(u32x4*)(Vb + ad) = d; }
            __syncthreads();
            { const int dir = c.wave >> 2, vblk = c.wave & 3;
              const int kb = (int)(uintptr_t)Kt + att::v_rd_base(c.lane), vb = (int)(uintptr_t)(dir ? Vb : Vf) + att::v_rd_base(c.lane);
              f32x16 D[4] = {};
#define MA_STEP(KS) do { const s16x4 al = att::tr_read<att::v_rd_off(0, (KS) & 3, 0) + ((KS) >> 2) * 16384>(vb + vblk * 512), ah = att::tr_read<att::v_rd_off(0, (KS) & 3, 1) + ((KS) >> 2) * 16384>(vb + vblk * 512); \
                const s16x4 b0l = att::tr_read<att::v_rd_off(0, (KS) & 3, 0) + ((KS) >> 2) * 16384>(kb), b0h = att::tr_read<att::v_rd_off(0, (KS) & 3, 1) + ((KS) >> 2) * 16384>(kb); \
                const s16x4 b1l = att::tr_read<att::v_rd_off(1, (KS) & 3, 0) + ((KS) >> 2) * 16384>(kb), b1h = att::tr_read<att::v_rd_off(1, (KS) & 3, 1) + ((KS) >> 2) * 16384>(kb); \
                const s16x4 b2l = att::tr_read<att::v_rd_off(2, (KS) & 3, 0) + ((KS) >> 2) * 16384>(kb), b2h = att::tr_read<att::v_rd_off(2, (KS) & 3, 1) + ((KS) >> 2) * 16384>(kb); \
                const s16x4 b3l = att::tr_read<att::v_rd_off(3, (KS) & 3, 0) + ((KS) >> 2) * 16384>(kb), b3h = att::tr_read<att::v_rd_off(3, (KS) & 3, 1) + ((KS) >> 2) * 16384>(kb); \
                asm volatile("s_waitcnt lgkmcnt(0)" ::: "memory"); __builtin_amdgcn_sched_barrier(0); \
                const bf16x8 A_ = (bf16x8){al[0], al[1], al[2], al[3], ah[0], ah[1], ah[2], ah[3]}; \
                D[0] = __builtin_amdgcn_mfma_f32_32x32x16_bf16(A_, (bf16x8){b0l[0], b0l[1], b0l[2], b0l[3], b0h[0], b0h[1], b0h[2], b0h[3]}, D[0], 0, 0, 0); \
                D[1] = __builtin_amdgcn_mfma_f32_32x32x16_bf16(A_, (bf16x8){b1l[0], b1l[1], b1l[2], b1l[3], b1h[0], b1h[1], b1h[2], b1h[3]}, D[1], 0, 0, 0); \
                D[2] = __builtin_amdgcn_mfma_f32_32x32x16_bf16(A_, (bf16x8){b2l[0], b2l[1], b2l[2], b2l[3], b2h[0], b2h[1], b2h[2], b2h[3]}, D[2], 0, 0, 0); \
                D[3] = __builtin_amdgcn_mfma_f32_32x32x16_bf16(A_, (bf16x8){b3l[0], b3l[1], b3l[2], b3l[3], b3h[0], b3h[1], b3h[2], b3h[3]}, D[3], 0, 0, 0); } while (0)
              MA_STEP(0); MA_STEP(1); MA_STEP(2); MA_STEP(3); MA_STEP(4); MA_STEP(5); MA_STEP(6); MA_STEP(7);
#undef MA_STEP
              bf16_t* dst = ST + (size_t)(dir ? ci_b : ci_f) * 16384;
#pragma unroll
              for (int r = 0; r < 16; ++r) { const int v = 32 * vblk + att::crow(r, hi);
#pragma unroll
                  for (int db = 0; db < 4; ++db) dst[v * 128 + 32 * db + r32] = f2bf(D[db][r] * KSCALE_B); } }
            {
              const int dir = c.tid >> 8, dg = (c.tid >> 4) & 15, sg = c.tid & 15; const bf16_t* kp = P + (size_t)row0 * 2816 + 1280 + 128 * head + 8 * dg;
              float a[8];
#pragma unroll
              for (int k = 0; k < 8; ++k) a[k] = 0.f;
#pragma unroll
              for (int i = 0; i < 8; ++i) { const int s = sg + 16 * i; const u32x4 kk = *(const u32x4*)(kp + (size_t)s * 2816); const float w = wv[dir * 128 + s];
                  a[0] += w * bflo(kk.x); a[1] += w * bfhi(kk.x); a[2] += w * bflo(kk.y); a[3] += w * bfhi(kk.y); a[4] += w * bflo(kk.z); a[5] += w * bfhi(kk.z); a[6] += w * bflo(kk.w); a[7] += w * bfhi(kk.w); }
#pragma unroll
              for (int k = 0; k < 8; ++k) { a[k] += __shfl_xor(a[k], 1); a[k] += __shfl_xor(a[k], 2); a[k] += __shfl_xor(a[k], 4); a[k] += __shfl_xor(a[k], 8); }
              if (sg == 0) { float* np_ = NST + (size_t)(dir ? ci_b : ci_f) * 128 + 8 * dg;
                  *(f32x4*)np_ = (f32x4){a[0] * KSCALE_B, a[1] * KSCALE_B, a[2] * KSCALE_B, a[3] * KSCALE_B}; *(f32x4*)(np_ + 4) = (f32x4){a[4] * KSCALE_B, a[5] * KSCALE_B, a[6] * KSCALE_B, a[7] * KSCALE_B}; } }
        }
    }
    __syncthreads();
    {
        const float* sink = c.in[I_ASINK] + l * 8; bf16_t* Y = (bf16_t*)(c.ws + WS_Y);
        const int NU = 1024 + (with_ctx ? 16 : 0);
        for (int u = (c.bid + (c.G >> 1)) % c.G; u < NU; u += c.G) {
            if (u < 1024) { const int b = u >> 9, g = (u >> 8) & 1, qb = u & 255, q0 = 64 * qb; const long row0 = (long)b * SEQ + q0;
                const int wj_lo = qb < 2 ? 2 - qb : 0, wj_hi = (257 - qb) < 4 ? (257 - qb) : 4, nwin = wj_hi - wj_lo + 1;
                att::KeySrc ks{b * SEQ + q0 - 128 + 64 * wj_lo, nwin, NLAT + b * CTXL, wj_lo};
                att::attn_unit<2>(P + row0 * 2816 + 256 * g, 2816, P + 512 + 64 * g, 2816, nullptr, P + 640 + 64 * g, 2816, Y + row0 * 2048 + 256 * g, nullptr, 2048, 0, ks, nwin + 4, 0.125f, sink + 4 * g, c.ldsg);
            } else { const int v = u - 1024, b = v >> 3, g = (v >> 2) & 1, qb = v & 3; const long row0 = (long)NLAT + b * CTXL + 64 * qb;
                att::KeySrc ks{0, 0, NLAT + b * CTXL, 0};
                att::attn_unit<2>(P + row0 * 2816 + 256 * g, 2816, P + 512 + 64 * g, 2816, nullptr, P + 640 + 64 * g, 2816, Y + row0 * 2048 + 256 * g, nullptr, 2048, 0, ks, 4, 0.125f, sink + 4 * g, c.ldsg);
            }
        }
    }
}

__device__ __forceinline__ void ph_scan(const Ctx& c) {
    bf16_t* ST = (bf16_t*)(c.ws + R_ST); float* NST = (float*)(c.ws + SM_NST); float* SCAL = (float*)(c.ws + SM_SCAL);
    float* dec = (float*)c.ldsg; float* scl = dec + 160;
    for (int it = c.bid; it < NCHAIN * 16; it += c.G) {
        const int chain = it >> 4, sub = it & 15;
        __syncthreads();
        if (c.wave == 0) {
            float bl[3], gm[3], mp[3];
#pragma unroll
            for (int k = 0; k < 3; ++k) { const int idx = 64 * k + c.lane; const bool ok = idx < NCHUNK; gm[k] = ok ? SCAL[chain * NCHUNK + idx] : 0.f; bl[k] = ok ? SCAL[NCHAIN * NCHUNK + chain * NCHUNK + idx] : 0.f; mp[k] = 0.f; }
            float m = 0.f;
#pragma unroll
            for (int k = 0; k < 3; ++k) { const int n = (NCHUNK - 64 * k) < 64 ? (NCHUNK - 64 * k) : 64;
                for (int i = 0; i < n; ++i) { const float bb = __builtin_bit_cast(float, __builtin_amdgcn_readlane(__builtin_bit_cast(int, bl[k]), i)), gg = __builtin_bit_cast(float, __builtin_amdgcn_readlane(__builtin_bit_cast(int, gm[k]), i));
                    if (c.lane == i) mp[k] = m;
                    m = fmaxf(bb + m, gg); } }
#pragma unroll
            for (int k = 0; k < 3; ++k) { const int idx = 64 * k + c.lane;
                if (idx < NCHUNK) { const float mn = fmaxf(bl[k] + mp[k], gm[k]); dec[idx] = __expf(bl[k] + mp[k] - mn); scl[idx] = __expf(gm[k] - mn);
                    if (sub == 0) SCAL[2 * NCHAIN * NCHUNK + chain * NCHUNK + idx] = mp[k]; } }
        }
        __syncthreads();
        { float cs0 = 0.f, cs1 = 0.f; unsigned* p = (unsigned*)(ST + (size_t)chain * NCHUNK * 16384 + sub * 1024) + c.tid;
          unsigned cur[13], nxt[13];
#pragma unroll
          for (int j = 0; j < 13; ++j) cur[j] = p[(size_t)j * 8192];
          for (int blk = 0; blk < 10; ++blk) {
              if (blk < 9) {
#pragma unroll
                  for (int j = 0; j < 13; ++j) nxt[j] = p[(size_t)(13 * (blk + 1) + j) * 8192]; }
              __builtin_amdgcn_sched_barrier(0);
#pragma unroll
              for (int j = 0; j < 13; ++j) { const int idx = 13 * blk + j; const float u0 = bflo(cur[j]), u1 = bfhi(cur[j]); const float d = dec[idx], sc = scl[idx];
                  p[(size_t)idx * 8192] = cvt_pk_bf16(cs0, cs1); cs0 = d * cs0 + sc * u0; cs1 = d * cs1 + sc * u1; }
#pragma unroll
              for (int j = 0; j < 13; ++j) cur[j] = nxt[j];
          } }
        if (c.tid < 8) { float ns = 0.f; float* p = NST + (size_t)chain * NCHUNK * 128 + sub * 8 + c.tid;
            for (int blk = 0; blk < 10; ++blk) { float uu[13];
#pragma unroll
                for (int j = 0; j < 13; ++j) uu[j] = p[(13 * blk + j) * 128];
#pragma unroll
                for (int j = 0; j < 13; ++j) { const int idx = 13 * blk + j; p[idx * 128] = ns; ns = dec[idx] * ns + scl[idx] * uu[j]; } } }
    }
}

__device__ __forceinline__ bf16x8 scale_frag(const bf16x8 q, const float a) {
    const u32x4 w = *reinterpret_cast<const u32x4*>(&q); u32x4 o;
    o.x = cvt_pk_bf16(bflo(w.x) * a, bfhi(w.x) * a); o.y = cvt_pk_bf16(bflo(w.y) * a, bfhi(w.y) * a); o.z = cvt_pk_bf16(bflo(w.z) * a, bfhi(w.z) * a); o.w = cvt_pk_bf16(bflo(w.w) * a, bfhi(w.w) * a);
    return *reinterpret_cast<const bf16x8*>(&o);
}
__device__ __forceinline__ void ph_mlstm_c(const Ctx& c) {
    const bool with_ctx = (c.layer == 0);
    const bf16_t* P = (const bf16_t*)(c.ws + R_PAB); const float* bg = (const float*)(c.ws + SM_BG);
    const bf16_t* ST = (const bf16_t*)(c.ws + R_ST); const float* NST = (const float*)(c.ws + SM_NST); const float* SCAL = (const float*)(c.ws + SM_SCAL);
    bf16_t* Y = (bf16_t*)(c.ws + WS_Y);
    constexpr int KSTR = 272;
    char* Ks = c.ldsg; char* Vt = c.ldsg + 34816; char* Cf = c.ldsg + 67584; char* Cb = c.ldsg + 102400;
    float* ar = (float*)(c.ldsg + 137216);
    float* wsf = (float*)(c.ldsg + 142336) + c.wave * 64;
    float* HB = (float*)c.ldsg; float* HF = (float*)(c.ldsg + 67584);
    const int r32 = c.lane & 31, hi = c.lane >> 5;
    const int NIT = with_ctx ? 8 * NCHUNK : 8 * (NCHUNK - 2);
    for (int it = c.bid; it < NIT; it += c.G) {
        const int b = with_ctx ? it / (4 * NCHUNK) : it >> 9, head = with_ctx ? (it / NCHUNK) & 3 : (it >> 7) & 3, tc = with_ctx ? it % NCHUNK : 2 + (it & 127);
        const int row0 = tc < 2 ? NLAT + b * CTXL + tc * 128 : b * SEQ + (tc - 2) * 128;
        const int ci_f = (b * 4 + head) * NCHUNK + tc, ci_b = (8 + b * 4 + head) * NCHUNK + (tc < 2 ? 1 - tc : 131 - tc);
        __syncthreads();
        const int sdir = c.wave & 1; const int e0 = sdir ? 127 - 2 * c.lane : 2 * c.lane, e1 = sdir ? 126 - 2 * c.lane : 2 * c.lane + 1;
        float x0 = 0.f, x1 = 0.f, i0 = 0.f, i1 = 0.f, mprev = 0.f, nstv = 0.f;
        if (c.wave < 2) { const float* g0 = bg + (size_t)(row0 + e0) * 16 + sdir * 8 + head; const float* g1 = bg + (size_t)(row0 + e1) * 16 + sdir * 8 + head;
            x0 = g0[4]; x1 = g1[4]; i0 = g0[0]; i1 = g1[0]; mprev = SCAL[2 * NCHAIN * NCHUNK + (sdir ? ci_b : ci_f)]; }
        if (c.tid >= 128 && c.tid < 384) { const int dir = (c.tid - 128) >> 7, d = c.tid & 127; nstv = NST[(size_t)(dir ? ci_b : ci_f) * 128 + d]; }
        u32x4 stg[4][4];
#pragma unroll
        for (int i = 0; i < 4; ++i) { const int e = c.tid + 512 * i, s = e >> 4, c8 = (e & 15) * 8; const bf16_t* pr = P + (size_t)(row0 + s) * 2816 + 128 * head + c8;
            stg[i][0] = *(const u32x4*)(pr + 1280); stg[i][1] = *(const u32x4*)(pr + 1792);
            stg[i][2] = *(const u32x4*)(ST + (size_t)ci_f * 16384 + s * 128 + c8); stg[i][3] = *(const u32x4*)(ST + (size_t)ci_b * 16384 + s * 128 + c8); }
        const int dir = c.wave >> 2, tb = 32 * (c.wave & 3), t = tb + r32;
        bf16x8 qr[8];
        { const bf16_t* Qw = P + (size_t)(row0 + t) * 2816 + 768 + 128 * head + hi * 8;
#pragma unroll
          for (int d0 = 0; d0 < 8; ++d0) qr[d0] = *reinterpret_cast<const bf16x8*>(Qw + d0 * 16); }
        __builtin_amdgcn_sched_barrier(0);
        if (c.wave < 2) {
            float s = x0 + x1;
#pragma unroll
            for (int off = 1; off < 64; off <<= 1) { const float t_ = __shfl_up(s, off); if (c.lane >= off) s += t_; }
            const float bc0 = s - x1, bc1 = s, a20 = i0 - bc0, a21 = i1 - bc1;
            float m = fmaxf(a20, a21);
#pragma unroll
            for (int off = 1; off < 64; off <<= 1) { const float t_ = __shfl_up(m, off); if (c.lane >= off) m = fmaxf(m, t_); }
            float mp = __shfl_up(m, 1); if (c.lane == 0) mp = -INFINITY;
            const float pm0 = fmaxf(mp, a20), pm1 = m;
            const float mx0 = fmaxf(mprev, pm0), mx1 = fmaxf(mprev, pm1);
            ar[(0 * 2 + sdir) * 128 + e0] = -mx0; ar[(0 * 2 + sdir) * 128 + e1] = -mx1;
            ar[(1 * 2 + sdir) * 128 + e0] = a20; ar[(1 * 2 + sdir) * 128 + e1] = a21;
            ar[(2 * 2 + sdir) * 128 + e0] = __expf(mprev - mx0); ar[(2 * 2 + sdir) * 128 + e1] = __expf(mprev - mx1);
            ar[(3 * 2 + sdir) * 128 + e0] = __expf(-(bc0 + mx0)); ar[(3 * 2 + sdir) * 128 + e1] = __expf(-(bc1 + mx1)); }
        if (c.tid >= 128 && c.tid < 384) { const int dir_ = (c.tid - 128) >> 7, d = c.tid & 127; ar[(4 * 2 + dir_) * 128 + d] = nstv; }
#pragma unroll
        for (int i = 0; i < 4; ++i) { const int e = c.tid + 512 * i, s = e >> 4, c8 = (e & 15) * 8;
            *(u32x4*)(Ks + s * KSTR + c8 * 2) = stg[i][0];
            *(u32x4*)(Vt + (s >> 6) * 16384 + att::v_st<4>(s & 63, c8)) = stg[i][1];
            *(u32x4*)(Cf + s * KSTR + c8 * 2) = stg[i][2];
            *(u32x4*)(Cb + s * KSTR + c8 * 2) = stg[i][3]; }
        __syncthreads();
        const float A1t = ar[(0 * 2 + dir) * 128 + t], avt = ar[(2 * 2 + dir) * 128 + t], emtt = ar[(3 * 2 + dir) * 128 + t];
        const float* A2 = ar + (1 * 2 + dir) * 128; const float* nv = ar + (4 * 2 + dir) * 128;
        f32x16 o[4] = {}; float rowsum = 0.f;
        const int vb0 = (int)(uintptr_t)Vt + att::v_rd_base(c.lane);
#pragma unroll
        for (int j = 0; j < 2; ++j) {
            const bool skip = dir ? (j == 0 && tb >= 64) : (j == 1 && tb < 64);
            if (!skip) {
                f32x16 p0, p1; att::qkt<8, KSTR>(p0, p1, Ks + j * 64 * KSTR, qr, r32, hi);
                float a2v0[16], a2v1[16];
#pragma unroll
                for (int k = 0; k < 4; ++k) { const f32x4 u0 = *(const f32x4*)(A2 + 64 * j + 8 * k + 4 * hi), u1 = *(const f32x4*)(A2 + 64 * j + 32 + 8 * k + 4 * hi);
                    a2v0[4 * k] = u0.x; a2v0[4 * k + 1] = u0.y; a2v0[4 * k + 2] = u0.z; a2v0[4 * k + 3] = u0.w; a2v1[4 * k] = u1.x; a2v1[4 * k + 1] = u1.y; a2v1[4 * k + 2] = u1.z; a2v1[4 * k + 3] = u1.w; }
#pragma unroll
                for (int r = 0; r < 16; ++r) { const int s0 = 64 * j + att::crow(r, hi), s1 = s0 + 32;
                    const bool ok0 = dir ? (s0 >= t) : (s0 <= t), ok1 = dir ? (s1 >= t) : (s1 <= t);
                    const float ex0 = __expf(A1t + a2v0[r]), ex1 = __expf(A1t + a2v1[r]);
                    const float w0 = ok0 ? ex0 : 0.f, w1 = ok1 ? ex1 : 0.f;
                    p0[r] = p0[r] * w0 * KSCALE_B; p1[r] = p1[r] * w1 * KSCALE_B; rowsum += p0[r] + p1[r]; }
                bf16x8 pa0, pa1, pa2, pa3;
#define PK4(Pv, BASE, OUT) do { unsigned a0 = cvt_pk_bf16(Pv[BASE + 0], Pv[BASE + 1]), a1 = cvt_pk_bf16(Pv[BASE + 2], Pv[BASE + 3]);   \
    unsigned b0 = cvt_pk_bf16(Pv[BASE + 4], Pv[BASE + 5]), b1 = cvt_pk_bf16(Pv[BASE + 6], Pv[BASE + 7]);                              \
    auto r0 = __builtin_amdgcn_permlane32_swap(a0, b0, false, false); auto r1 = __builtin_amdgcn_permlane32_swap(a1, b1, false, false); \
    u32x4 w = {r0[0], r1[0], r0[1], r1[1]}; OUT = *reinterpret_cast<bf16x8*>(&w); } while (0)
                PK4(p0, 0, pa0); PK4(p0, 8, pa1); PK4(p1, 0, pa2); PK4(p1, 8, pa3);
#undef PK4
                __builtin_amdgcn_sched_barrier(0);
                att::pv_d0<4>(o, vb0 + j * 16384, pa0, pa1, pa2, pa3);
            }
        }
        { auto rr = __builtin_amdgcn_permlane32_swap(__float_as_uint(rowsum), __float_as_uint(rowsum), false, false); rowsum = __uint_as_float(rr[0]) + __uint_as_float(rr[1]); }
        float nq = 0.f;
#pragma unroll
        for (int d0 = 0; d0 < 8; ++d0) { const u32x4 w = *reinterpret_cast<const u32x4*>(&qr[d0]); const float* n8 = nv + d0 * 16 + hi * 8;
            nq += bflo(w.x) * n8[0] + bfhi(w.x) * n8[1] + bflo(w.y) * n8[2] + bfhi(w.y) * n8[3] + bflo(w.z) * n8[4] + bfhi(w.z) * n8[5] + bflo(w.w) * n8[6] + bfhi(w.w) * n8[7]; }
        { auto rr = __builtin_amdgcn_permlane32_swap(__float_as_uint(nq), __float_as_uint(nq), false, false); nq = __uint_as_float(rr[0]) + __uint_as_float(rr[1]); }
        { const char* Cs = dir ? Cb : Cf; bf16x8 cfa[4], cfb[4];
#define LDCF(dst, D0) do { _Pragma("unroll") for (int vb = 0; vb < 4; ++vb) dst[vb] = *reinterpret_cast<const bf16x8*>(Cs + (32 * vb + r32) * KSTR + ((D0) * 16 + hi * 8) * 2); } while (0)
#define MMCF(src, D0) do { const bf16x8 qs = scale_frag(qr[D0], avt); _Pragma("unroll") for (int vb = 0; vb < 4; ++vb) o[vb] = __builtin_amdgcn_mfma_f32_32x32x16_bf16(qs, src[vb], o[vb], 0, 0, 0); } while (0)
          LDCF(cfa, 0);
#pragma unroll
          for (int d0 = 0; d0 < 8; d0 += 2) {
              LDCF(cfb, d0 + 1); __builtin_amdgcn_sched_barrier(0);
              MMCF(cfa, d0); __builtin_amdgcn_sched_barrier(0);
              if (d0 + 2 < 8) { LDCF(cfa, d0 + 2); } __builtin_amdgcn_sched_barrier(0);
              MMCF(cfb, d0 + 1); __builtin_amdgcn_sched_barrier(0); }
#undef LDCF
#undef MMCF
        }
        const float den = rowsum + avt * nq; const float rdn = 1.f / fmaxf(fabsf(den), emtt);
        if (hi == 0) wsf[r32] = rdn;
        u32x4 ogw[4];
#pragma unroll
        for (int i = 0; i < 4; ++i) { const int e = c.tid + 512 * i; ogw[i] = *(const u32x4*)(P + (size_t)(row0 + (e >> 4)) * 2816 + 2304 + 128 * head + (e & 15) * 8); }
        asm volatile("s_waitcnt lgkmcnt(0)" ::: "memory");
        float rd[16];
#pragma unroll
        for (int r = 0; r < 16; ++r) rd[r] = wsf[att::crow(r, hi)];
        __syncthreads();
        { float* Hd = dir ? HB : HF;
#pragma unroll
          for (int r = 0; r < 16; ++r)
#pragma unroll
              for (int vb = 0; vb < 4; ++vb) Hd[(tb + att::crow(r, hi)) * 128 + 32 * vb + r32] = o[vb][r] * rd[r]; }
        __syncthreads();
#pragma unroll
        for (int i = 0; i < 4; ++i) { const int e = c.tid + 512 * i, tt = e >> 4, c8 = (e & 15) * 8;
            const f32x4 h0 = *(const f32x4*)(HB + tt * 128 + c8) + *(const f32x4*)(HF + tt * 128 + c8), h1 = *(const f32x4*)(HB + tt * 128 + c8 + 4) + *(const f32x4*)(HF + tt * 128 + c8 + 4); const u32x4 g = ogw[i];
            u32x4 w; w.x = cvt_pk_bf16(sigmoidf_(bflo(g.x)) * h0.x, sigmoidf_(bfhi(g.x)) * h0.y); w.y = cvt_pk_bf16(sigmoidf_(bflo(g.y)) * h0.z, sigmoidf_(bfhi(g.y)) * h0.w);
            w.z = cvt_pk_bf16(sigmoidf_(bflo(g.z)) * h1.x, sigmoidf_(bfhi(g.z)) * h1.y); w.w = cvt_pk_bf16(sigmoidf_(bflo(g.w)) * h1.z, sigmoidf_(bfhi(g.w)) * h1.w);
            *(u32x4*)(Y + (size_t)(row0 + tt) * 2048 + 512 + 128 * head + c8) = w; }
    }
}
__device__ __forceinline__ void ph_yb(const Ctx& c) {
    const int M = (c.layer == 0) ? MTOT : NLAT; const bf16_t* P = (const bf16_t*)(c.ws + R_PAB); bf16_t* Y = (bf16_t*)(c.ws + WS_Y);
    for (size_t i = (size_t)c.bid * 512 + c.tid; i < (size_t)M * 64; i += (size_t)c.G * 512) { const size_t r = i >> 6; const int c8 = (int)(i & 63) * 8;
        const u32x4 o = *(const u32x4*)(P + r * 2816 + 2304 + c8), f = *(const u32x4*)(Y + r * 2048 + 512 + c8), bb = *(const u32x4*)(Y + r * 2048 + 1024 + c8);
        u32x4 w;
        w.x = cvt_pk_bf16(sigmoidf_(bflo(o.x)) * (bflo(f.x) + bflo(bb.x)), sigmoidf_(bfhi(o.x)) * (bfhi(f.x) + bfhi(bb.x)));
        w.y = cvt_pk_bf16(sigmoidf_(bflo(o.y)) * (bflo(f.y) + bflo(bb.y)), sigmoidf_(bfhi(o.y)) * (bfhi(f.y) + bfhi(bb.y)));
        w.z = cvt_pk_bf16(sigmoidf_(bflo(o.z)) * (bflo(f.z) + bflo(bb.z)), sigmoidf_(bfhi(o.z)) * (bfhi(f.z) + bfhi(bb.z)));
        w.w = cvt_pk_bf16(sigmoidf_(bflo(o.w)) * (bflo(f.w) + bflo(bb.w)), sigmoidf_(bfhi(o.w)) * (bfhi(f.w) + bfhi(bb.w)));
        *(u32x4*)(Y + r * 2048 + 512 + c8) = w; }
}

__device__ __forceinline__ void ph_mla_pre(const Ctx& c) {
    const int l = c.layer; const int gw = c.bid * 8 + c.wave, NGW = c.G * 8; const float* T = (const float*)(c.ws + SM_ROPE);
    bf16_t* Y = (bf16_t*)(c.ws + WS_Y); bf16_t* PD = (bf16_t*)(c.ws + R_PD); bf16_t* CKR = (bf16_t*)(c.ws + R_CKR);
    const float* gq = c.in[I_CGQ] + l * 512; const float* gkv = c.in[I_CGKV] + l * 256;
    for (int r = gw; r < MTOT; r += NGW) {
        bf16_t* pc = Y + (size_t)r * 2048 + 1024;
        { const u32x4 w = *(const u32x4*)(pc + 8 * c.lane); float x[8] = {bflo(w.x), bfhi(w.x), bflo(w.y), bfhi(w.y), bflo(w.z), bfhi(w.z), bflo(w.w), bfhi(w.w)};
          float ss = 0.f;
#pragma unroll
          for (int j = 0; j < 8; ++j) ss += x[j] * x[j];
          const float rs = rsqrtf(wave_sum(ss) * (1.f / 512.f) + EPS);
#pragma unroll
          for (int j = 0; j < 8; ++j) x[j] = x[j] * rs * gq[8 * c.lane + j];
          u32x4 o; o.x = cvt_pk_bf16(x[0], x[1]); o.y = cvt_pk_bf16(x[2], x[3]); o.z = cvt_pk_bf16(x[4], x[5]); o.w = cvt_pk_bf16(x[6], x[7]); *(u32x4*)(pc + 8 * c.lane) = o; }
        { const u32x2 w = *(const u32x2*)(pc + 512 + 4 * c.lane); float x[4] = {bflo(w.x), bfhi(w.x), bflo(w.y), bfhi(w.y)};
          float ss = x[0] * x[0] + x[1] * x[1] + x[2] * x[2] + x[3] * x[3];
          const float rs = rsqrtf(wave_sum(ss) * (1.f / 256.f) + EPS);
#pragma unroll
          for (int j = 0; j < 4; ++j) x[j] = x[j] * rs * gkv[4 * c.lane + j];
          u32x2 o; o.x = cvt_pk_bf16(x[0], x[1]); o.y = cvt_pk_bf16(x[2], x[3]); *(u32x2*)(pc + 512 + 4 * c.lane) = o; }
        if (r < NLAT) { const int t = r & (SEQ - 1);
            rope_row(CKR + (size_t)r * 64, pc + 768, 32, 64, t >> 6, t & 63, T, c.lane);
            bf16_t* pd = PD + (size_t)r * 1536; rope_row(pd, pd, 512, 64, t >> 6, t & 63, T, c.lane);
        } else { CKR[(size_t)r * 64 + c.lane] = pc[768 + c.lane]; }
    }
}
__device__ __forceinline__ void ph_rope_cq(const Ctx& c) {
    const int gw = c.bid * 8 + c.wave, NGW = c.G * 8; const float* T = (const float*)(c.ws + SM_ROPE); bf16_t* CQ = (bf16_t*)(c.ws + R_CQ);
    for (int r = gw; r < NLAT; r += NGW) { const int t = r & (SEQ - 1); bf16_t* rp = CQ + (size_t)r * 768 + 128; rope_row(rp, rp, 128, 192, t >> 6, t & 63, T, c.lane); }
}


__device__ __forceinline__ void ph_knorm(const Ctx& c) {
    const bf16_t* PD = (const bf16_t*)(c.ws + R_PD); const bf16_t* CKNV = (const bf16_t*)(c.ws + R_CKNV); const bf16_t* CKR = (const bf16_t*)(c.ws + R_CKR);
    const int gw = c.bid * 8 + c.wave, NGW = c.G * 8; const int b = gw & 1, nw = NGW >> 1;
    float mD = 0.f, mC = 0.f;
    auto krow = [&](int idx) -> size_t { return idx < SEQ ? (size_t)b * SEQ + idx : (size_t)NLAT + b * CTXL + (idx - SEQ); };
    for (int idx0 = gw >> 1; idx0 < SEQ + CTXL; idx0 += 2 * nw) {
        const int idx1 = idx0 + nw; const bool two = idx1 < SEQ + CTXL; const size_t r0 = krow(idx0), r1 = krow(two ? idx1 : idx0);
        const u32x4 kd0 = *(const u32x4*)(PD + r0 * 1536 + 512 + 8 * c.lane), kc0 = *(const u32x4*)(CKNV + r0 * 1024 + 8 * c.lane); const float kr0 = bf2f(CKR[r0 * 64 + c.lane]);
        const u32x4 kd1 = *(const u32x4*)(PD + r1 * 1536 + 512 + 8 * c.lane), kc1 = *(const u32x4*)(CKNV + r1 * 1024 + 8 * c.lane); const float kr1 = bf2f(CKR[r1 * 64 + c.lane]);
        float sd0 = dot8(kd0, kd0), sc0 = dot8(kc0, kc0), sd1 = dot8(kd1, kd1), sc1 = dot8(kc1, kc1);
        sd0 += dpp_mov<0xB1>(sd0); sd0 += dpp_mov<0x4E>(sd0); sd0 += dpp_mov<0x141>(sd0);
        sd1 += dpp_mov<0xB1>(sd1); sd1 += dpp_mov<0x4E>(sd1); sd1 += dpp_mov<0x141>(sd1);
        sc0 += dpp_mov<0xB1>(sc0); sc0 += dpp_mov<0x4E>(sc0); sc0 += dpp_mov<0x141>(sc0); sc0 += dpp_mov<0x140>(sc0);
        sc1 += dpp_mov<0xB1>(sc1); sc1 += dpp_mov<0x4E>(sc1); sc1 += dpp_mov<0x141>(sc1); sc1 += dpp_mov<0x140>(sc1);
        const float q0 = wave_sum(kr0 * kr0), q1 = wave_sum(kr1 * kr1);
        mD = fmaxf(mD, fmaxf(sd0, sd1)); mC = fmaxf(mC, fmaxf(sc0 + q0, sc1 + q1)); }
    unsigned* slots = (unsigned*)(c.ws + WS_CTL) + CW_KN + (c.layer * 2 + b) * 12;
    if ((c.lane & 15) == 0) atomicMax(slots + (c.lane >> 4), __float_as_uint(mC));
    if ((c.lane & 7) == 0) atomicMax(slots + 4 + (c.lane >> 3), __float_as_uint(mD));
}
__device__ __forceinline__ void ph_attn(const Ctx& c) {
    const bool with_ctx = (c.layer == 0);
    const bf16_t* CQ = (const bf16_t*)(c.ws + R_CQ); const bf16_t* CKNV = (const bf16_t*)(c.ws + R_CKNV); const bf16_t* CKR = (const bf16_t*)(c.ws + R_CKR);
    const bf16_t* PD = (const bf16_t*)(c.ws + R_PD); bf16_t* Y = (bf16_t*)(c.ws + WS_Y);
    const int l = c.layer; const float lam_init = 0.8f - 0.6f * expf(-0.3f * (float)l);
    const float s1 = wave_sum(c.in[I_LQ1][l * 64 + c.lane] * c.in[I_LK1][l * 64 + c.lane]), s2 = wave_sum(c.in[I_LQ2][l * 64 + c.lane] * c.in[I_LK2][l * 64 + c.lane]);
    const float lam = expf(s1) - expf(s2) + lam_init; const float* gsub = c.in[I_DGSUB] + l * 128;
    const float* KN = (const float*)(c.ws + WS_CTL) + CW_KN + c.layer * 24;
    const int NU_C = 512, NU_D = 1024, NU_CC = with_ctx ? 8 : 0, NU_DC = with_ctx ? 16 : 0;
    const int vcu = (c.G % 8 == 0) ? (c.bid & 7) * (c.G >> 3) + (c.bid >> 3) : c.bid;
    for (int u = vcu; u < NU_C; u += c.G) { const int b = u >> 8, h = (u >> 6) & 3, qb = u & 63; const long row0 = (long)b * SEQ + 256 * qb;
        att::KeySrc ks{b * SEQ, 256, NLAT + b * CTXL, 0};
        att::ATTN_UNIT<0>(CQ + row0 * 768 + 192 * h, 768, CKNV + 128 * h, 1024, CKR, CKNV + 512 + 128 * h, 1024, Y + row0 * 2048 + 1024 + 128 * h, 2048, ks, 260, 0.07216878364870322f, c.ldsg, 0.f, 0.f, nullptr, KN + b * 12 + h); }
    for (int v = vcu; v < NU_D; v += c.G) { const int b = v >> 9, h = (v >> 7) & 3, qb = v & 127; const long row0 = (long)b * SEQ + 128 * qb;
        att::KeySrc ks{b * SEQ, 256, NLAT + b * CTXL, 0};
        att::ATTN_UNIT<1>(PD + row0 * 1536 + 128 * h, 1536, PD + 512 + 128 * h, 1536, nullptr, PD + 1024 + 128 * h, 1536, Y + row0 * 2048 + 1536 + 128 * h, 2048, ks, 260, 0.125f, c.ldsg, lam, 1.f - lam_init, gsub, KN + b * 12 + 4 + 2 * h); }
    for (int v = vcu; v < NU_CC; v += c.G) { const int b = v >> 2, h = v & 3; const long row0 = (long)NLAT + b * CTXL;
        att::KeySrc ks{0, 0, NLAT + b * CTXL, 0};
        att::attn_unit_sb<0, 2>(CQ + row0 * 768 + 192 * h, 768, CKNV + 128 * h, 1024, CKR, CKNV + 512 + 128 * h, 1024, Y + row0 * 2048 + 1024 + 128 * h, 2048, ks, 4, 0.07216878364870322f, c.ldsg, 0.f, 0.f, nullptr, KN + b * 12 + h); }
    for (int v = (vcu + (c.G >> 1)) % c.G; v < NU_DC; v += c.G) { const int b = v >> 3, h = (v >> 1) & 3, hf = v & 1; const long row0 = (long)NLAT + b * CTXL + 128 * hf;
        att::KeySrc ks{0, 0, NLAT + b * CTXL, 0};
        att::attn_unit_sb<1, 0>(PD + row0 * 1536 + 128 * h, 1536, PD + 512 + 128 * h, 1536, nullptr, PD + 1024 + 128 * h, 1536, Y + row0 * 2048 + 1536 + 128 * h, 2048, ks, 4, 0.125f, c.ldsg, lam, 1.f - lam_init, gsub, KN + b * 12 + 4 + 2 * h); }
}
__device__ __forceinline__ void ph_dpost(const Ctx& c) {
    const int l = c.layer; const int M = (l == 0) ? MTOT : NLAT; const int gw = c.bid * 8 + c.wave, NGW = c.G * 8;
    bf16_t* Y = (bf16_t*)(c.ws + WS_Y); const bf16_t* O2 = (const bf16_t*)(c.ws + R_O2);
    const float lam_init = 0.8f - 0.6f * expf(-0.3f * (float)l);
    const float s1 = wave_sum(c.in[I_LQ1][l * 64 + c.lane] * c.in[I_LK1][l * 64 + c.lane]), s2 = wave_sum(c.in[I_LQ2][l * 64 + c.lane] * c.in[I_LK2][l * 64 + c.lane]);
    const float lam = expf(s1) - expf(s2) + lam_init;
    const float g0 = c.in[I_DGSUB][l * 128 + 2 * c.lane], g1 = c.in[I_DGSUB][l * 128 + 2 * c.lane + 1];
    for (int it = gw; it < M * 4; it += NGW) { const int r = it >> 2, h = it & 3;
        unsigned* yp = (unsigned*)(Y + (size_t)r * 2048 + 1536 + 128 * h) + c.lane; const unsigned w1 = *yp, w2 = *((const unsigned*)(O2 + (size_t)r * 512 + 128 * h) + c.lane);
        const float o0 = bflo(w1) - lam * bflo(w2), o1 = bfhi(w1) - lam * bfhi(w2);
        const float rs = rsqrtf(wave_sum(o0 * o0 + o1 * o1) * (1.f / 128.f) + EPS) * (1.f - lam_init);
        *yp = cvt_pk_bf16(o0 * rs * g0, o1 * rs * g1); }
}

__device__ __forceinline__ f32x4 bf4(const u32x2 w) { return (f32x4){bflo(w.x), bfhi(w.x), bflo(w.y), bfhi(w.y)}; }
__device__ __forceinline__ const bf16_t* hmid_row(const Ctx& c, int r) { return r < NLAT ? (const bf16_t*)c.out + (size_t)r * DM : (const bf16_t*)(c.ws + SM_HC) + (size_t)(r - NLAT) * DM; }
__device__ __forceinline__ void ph_post1(const Ctx& c) {
    const int l = c.layer; const int M = (l == 0) ? MTOT : NLAT; const int gw = c.bid * 8 + c.wave, NGW = c.G * 8;
    const bf16_t* yo = (const bf16_t*)(c.ws + R_YOUT); const float* mod = (const float*)(c.ws + SM_MOD) + l * 3 * 6144; bf16_t* HP = (bf16_t*)(c.ws + R_HP);
    f32x4 gpo[4], gpr[4]; { const float* gpost = c.in[I_GMIXPOST] + (size_t)l * DM; const float* gpre = c.in[I_GFFNPRE] + (size_t)l * DM;
#pragma unroll
      for (int j = 0; j < 4; ++j) { gpo[j] = *(const f32x4*)(gpost + 4 * (c.lane + 64 * j)); gpr[j] = *(const f32x4*)(gpre + 4 * (c.lane + 64 * j)); } }
    u32x2 yw[4], ywn[4]; f32x4 hc[4], hn_[4]; u32x2 hb[4], hbn[4];
    if (gw < M) { const u32x2* yr = (const u32x2*)(yo + (size_t)gw * DM) + c.lane;
#pragma unroll
        for (int j = 0; j < 4; ++j) yw[j] = yr[64 * j];
        if (l == 0) { const f32x4* hr = (const f32x4*)hin_row(c, gw) + c.lane;
#pragma unroll
            for (int j = 0; j < 4; ++j) hc[j] = hr[64 * j]; }
        else { const u32x2* hr = (const u32x2*)hmid_row(c, gw) + c.lane;
#pragma unroll
            for (int j = 0; j < 4; ++j) hb[j] = hr[64 * j]; } }
    for (int r = gw; r < M; r += NGW) {
        const float* md = mod + mod_idx(r) * 6144;
        f32x4 gt[4], sh[4], scl[4];
#pragma unroll
        for (int j = 0; j < 4; ++j) { const int e = 4 * (c.lane + 64 * j); gt[j] = *(const f32x4*)(md + 2048 + e); sh[j] = *(const f32x4*)(md + 3072 + e); scl[j] = *(const f32x4*)(md + 4096 + e); }
        { const int rn = r + NGW < M ? r + NGW : r; const u32x2* yr = (const u32x2*)(yo + (size_t)rn * DM) + c.lane;
#pragma unroll
          for (int j = 0; j < 4; ++j) ywn[j] = yr[64 * j];
          if (l == 0) { const f32x4* hr = (const f32x4*)hin_row(c, rn) + c.lane;
#pragma unroll
              for (int j = 0; j < 4; ++j) hn_[j] = hr[64 * j]; }
          else { const u32x2* hr = (const u32x2*)hmid_row(c, rn) + c.lane;
#pragma unroll
              for (int j = 0; j < 4; ++j) hbn[j] = hr[64 * j]; } }
        __builtin_amdgcn_sched_barrier(0);
        f32x4 v[4]; float ss = 0.f;
#pragma unroll
        for (int j = 0; j < 4; ++j) { v[j] = bf4(yw[j]); ss += (v[j].x * v[j].x + v[j].y * v[j].y) + (v[j].z * v[j].z + v[j].w * v[j].w); }
        const float rs = rsqrtf(wave_sum(ss) * (1.f / DM) + EPS);
        float ss2 = 0.f; u32x2* ho = (u32x2*)(HP + (size_t)r * DM) + c.lane;
#pragma unroll
        for (int j = 0; j < 4; ++j) { const f32x4 g = gpo[j]; const f32x4 h0 = (l == 0) ? hc[j] : bf4(hb[j]);
            f32x4 hn; hn.x = h0.x + gt[j].x * (v[j].x * rs * g.x); hn.y = h0.y + gt[j].y * (v[j].y * rs * g.y); hn.z = h0.z + gt[j].z * (v[j].z * rs * g.z); hn.w = h0.w + gt[j].w * (v[j].w * rs * g.w);
            u32x2 w; w.x = cvt_pk_bf16(hn.x, hn.y); w.y = cvt_pk_bf16(hn.z, hn.w); ho[64 * j] = w; v[j] = hn; ss2 += (hn.x * hn.x + hn.y * hn.y) + (hn.z * hn.z + hn.w * hn.w); }
        const float rs2 = rsqrtf(wave_sum(ss2) * (1.f / DM) + EPS);
        f32x4 uu[4];
#pragma unroll
        for (int j = 0; j < 4; ++j) { const f32x4 g = gpr[j];
            uu[j] = (f32x4){v[j].x * rs2 * g.x * (1.f + scl[j].x) + sh[j].x, v[j].y * rs2 * g.y * (1.f + scl[j].y) + sh[j].y, v[j].z * rs2 * g.z * (1.f + scl[j].z) + sh[j].z, v[j].w * rs2 * g.w * (1.f + scl[j].w) + sh[j].w}; }
        quant_row_i8(uu, (signed char*)(c.ws + WS_U) + (size_t)r * DM, (float*)(c.ws + U_SC) + r, c.lane);
#pragma unroll
        for (int j = 0; j < 4; ++j) { yw[j] = ywn[j]; hc[j] = hn_[j]; hb[j] = hbn[j]; }
    }
}
__device__ __forceinline__ void ph_post2(const Ctx& c) {
    const int l = c.layer; const int M = (l == 0) ? MTOT : NLAT; const int gw = c.bid * 8 + c.wave, NGW = c.G * 8;
    const bf16_t* z = (const bf16_t*)(c.ws + WS_Y); const float* mod = (const float*)(c.ws + SM_MOD) + l * 3 * 6144; const bf16_t* HP = (const bf16_t*)(c.ws + R_HP);
    float* wgl = (float*)c.ldsg; if (l == 0) stage_gate_weights(c, 1, wgl);
    f32x4 gpo[4], g4[4]; { const float* gpost = c.in[I_GFFNPOST] + (size_t)l * DM; const float* gpre = c.in[I_GMIXPRE] + (size_t)1 * DM;
#pragma unroll
      for (int j = 0; j < 4; ++j) { gpo[j] = *(const f32x4*)(gpost + 4 * (c.lane + 64 * j)); g4[j] = *(const f32x4*)(gpre + 4 * (c.lane + 64 * j)); } }
    u32x2 zw[4], zwn[4], hb[4], hbn[4];
    if (gw < M) { const u32x2* zr = (const u32x2*)(z + (size_t)gw * DM) + c.lane; const u32x2* hr = (const u32x2*)(HP + (size_t)gw * DM) + c.lane;
#pragma unroll
        for (int j = 0; j < 4; ++j) { zw[j] = zr[64 * j]; hb[j] = hr[64 * j]; } }
    for (int r = gw; r < M; r += NGW) {
        const float* md = mod + mod_idx(r) * 6144;
        f32x4 gt[4]; N1Vec nv;
#pragma unroll
        for (int j = 0; j < 4; ++j) gt[j] = *(const f32x4*)(md + 5120 + 4 * (c.lane + 64 * j));
        if (l == 0) norm1_load(c, 1, r, nv);
        { const int rn = r + NGW < M ? r + NGW : r; const u32x2* zr = (const u32x2*)(z + (size_t)rn * DM) + c.lane; const u32x2* hr = (const u32x2*)(HP + (size_t)rn * DM) + c.lane;
#pragma unroll
          for (int j = 0; j < 4; ++j) { zwn[j] = zr[64 * j]; hbn[j] = hr[64 * j]; } }
        __builtin_amdgcn_sched_barrier(0);
        f32x4 v[4]; float ss = 0.f;
#pragma unroll
        for (int j = 0; j < 4; ++j) { v[j] = bf4(zw[j]); ss += (v[j].x * v[j].x + v[j].y * v[j].y) + (v[j].z * v[j].z + v[j].w * v[j].w); }
        const float rs = rsqrtf(wave_sum(ss) * (1.f / DM) + EPS);
#pragma unroll
        for (int j = 0; j < 4; ++j) { const f32x4 g = gpo[j]; f32x4 h0 = bf4(hb[j]);
            h0.x += gt[j].x * (v[j].x * rs * g.x); h0.y += gt[j].y * (v[j].y * rs * g.y); h0.z += gt[j].z * (v[j].z * rs * g.z); h0.w += gt[j].w * (v[j].w * rs * g.w);
            if (l == 0) { u32x2 w; w.x = cvt_pk_bf16(h0.x, h0.y); w.y = cvt_pk_bf16(h0.z, h0.w); ((u32x2*)const_cast<bf16_t*>(hmid_row(c, r)))[c.lane + 64 * j] = w; }
            else ((f32x4*)(c.out + (size_t)r * DM))[c.lane + 64 * j] = h0;
            v[j] = h0; }
        if (l == 0) norm1_apply(c, 1, r, v, wgl, g4, nv);
#pragma unroll
        for (int j = 0; j < 4; ++j) { zw[j] = zwn[j]; hb[j] = hbn[j]; }
    }
}

template <int WHICH> struct EpiRope {
    static constexpr bool PERM = false;
    bf16_t* O; int ldc; const float* T;
    bf16_t* O2; int ldc2; bf16_t* CKR; float* SSQ;
    __device__ __forceinline__ void operator()(const f32x4 (&acc)[2][2][4][2], const pg8::Unit& u, int wr, int wc, int fr, int fq) const {
        const int row0 = u.pm * 256 + wr * 64 + fr; const bool lat = u.pm < NLAT / 256;
        bool en[2]; bf16_t* dstb[2]; size_t dld[2];
#pragma unroll
        for (int bj = 0; bj < 2; ++bj) { const int g = u.pn * 8 + bj * 4 + wc;
            if constexpr (WHICH == 0) { en[bj] = g < 20; dstb[bj] = O + g * 32; dld[bj] = (size_t)ldc; }
            if constexpr (WHICH == 1) { if (u.pn < 4) { en[bj] = (g == 24 || g == 25); dstb[bj] = en[bj] ? CKR + (g - 24) * 32 : O + g * 32; dld[bj] = en[bj] ? (size_t)64 : (size_t)ldc; }
                                        else { const int gl = g - 32; en[bj] = gl < 32; dstb[bj] = O2 + gl * 32; dld[bj] = (size_t)ldc2; } }
            if constexpr (WHICH == 2) { const int gi = g % 6; en[bj] = gi >= 4; dstb[bj] = O + g * 32; dld[bj] = (size_t)ldc; }
            en[bj] = en[bj] && lat; }
        const bool any = en[0] || en[1]; const bool usepc = (wc & 1) != 0;
#pragma unroll
        for (int ai = 0; ai < 2; ++ai) {
            float rsc[4] = {1.f, 1.f, 1.f, 1.f};
            if constexpr (WHICH == 2) {
#pragma unroll
                for (int mh = 0; mh < 2; ++mh) { f32x4 s0[2], s1[2];
#pragma unroll
                    for (int m = 0; m < 2; ++m) { const size_t row = (size_t)(row0 + ai * 128 + (2 * mh + m) * 16); s0[m] = *(const f32x4*)(SSQ + row * 12); s1[m] = *(const f32x4*)(SSQ + row * 12 + 4); }
                    __builtin_amdgcn_sched_barrier(0);
#pragma unroll
                    for (int m = 0; m < 2; ++m) rsc[2 * mh + m] = rsqrtf(((s0[m].x + s0[m].y) + (s0[m].z + s0[m].w) + (s1[m].x + s1[m].y) + (s1[m].z + s1[m].w)) * (1.f / 512.f) + EPS);
                    __builtin_amdgcn_sched_barrier(0); }
            }
            f32x4 c0[4], c1[4];
            if (any) {
#pragma unroll
                for (int m = 0; m < 4; ++m) { const int t = (row0 + ai * 128 + m * 16) & (SEQ - 1); const int pos = usepc ? (t & 63) : (t >> 6); const float* tp = T + (size_t)(pos * 16 + 4 * fq) * 2;
                    c0[m] = *(const f32x4*)tp; c1[m] = *(const f32x4*)(tp + 4); }
            } else {
#pragma unroll
                for (int m = 0; m < 4; ++m) { c0[m] = (f32x4){1.f, 0.f, 1.f, 0.f}; c1[m] = (f32x4){1.f, 0.f, 1.f, 0.f}; } }
            __builtin_amdgcn_sched_barrier(0);
#pragma unroll
            for (int m = 0; m < 4; ++m) { const int row = row0 + ai * 128 + m * 16;
                const f32x4 cs = (f32x4){c0[m].x, c0[m].z, c1[m].x, c1[m].z}, sn = (f32x4){c0[m].y, c0[m].w, c1[m].y, c1[m].w};
                float part = 0.f;
#pragma unroll
                for (int bj = 0; bj < 2; ++bj) { bf16_t* dst = dstb[bj] + (size_t)row * dld[bj];
                    f32x4 x1 = acc[ai][bj][m][0], x2 = acc[ai][bj][m][1];
                    if constexpr (WHICH == 1) part += (x1.x * x1.x + x1.y * x1.y) + (x1.z * x1.z + x1.w * x1.w) + (x2.x * x2.x + x2.y * x2.y) + (x2.z * x2.z + x2.w * x2.w);
                    if constexpr (WHICH == 2) { x1 = x1 * rsc[m]; x2 = x2 * rsc[m]; }
                    if (en[bj]) { const f32x4 o1 = x1 * cs - x2 * sn, o2 = x2 * cs + x1 * sn; x1 = o1; x2 = o2; }
                    u32x2 w1, w2; w1.x = cvt_pk_bf16(x1.x, x1.y); w1.y = cvt_pk_bf16(x1.z, x1.w); w2.x = cvt_pk_bf16(x2.x, x2.y); w2.y = cvt_pk_bf16(x2.z, x2.w);
                    *(u32x2*)(dst + 4 * fq) = w1; *(u32x2*)(dst + 16 + 4 * fq) = w2; }
                if constexpr (WHICH == 1) { if (u.pn < 3) { part += __shfl_xor(part, 16); part += __shfl_xor(part, 32); if (fq == 0) SSQ[(size_t)row * 12 + u.pn * 4 + wc] = part; } }
            }
        }
    }
};
struct EpiRowScale {
    static constexpr bool PERM = true;
    bf16_t* O; int ldc; const float* SSQ;
    __device__ __forceinline__ void operator()(const f32x4 (&acc)[2][2][4][2], const pg8::Unit& u, int wr, int wc, int fr, int fq) const {
        const int row0 = u.pm * 256 + wr * 64 + fr, col0 = u.pn * 256 + wc * 32 + 8 * fq;
#pragma unroll
        for (int ai = 0; ai < 2; ++ai)
#pragma unroll
            for (int m = 0; m < 4; ++m) { const size_t r = (size_t)(row0 + ai * 128 + m * 16); const f32x4 s = *(const f32x4*)(SSQ + r * 12 + 8);
                const float rsc = rsqrtf(((s.x + s.y) + (s.z + s.w)) * (1.f / 256.f) + EPS); bf16_t* rowp = O + r * ldc + col0;
#pragma unroll
                for (int bj = 0; bj < 2; ++bj) { const f32x4 v0 = acc[ai][bj][m][0] * rsc, v1 = acc[ai][bj][m][1] * rsc;
                    u32x4 w; w.x = cvt_pk_bf16(v0[0], v0[1]); w.y = cvt_pk_bf16(v0[2], v0[3]); w.z = cvt_pk_bf16(v1[0], v1[1]); w.w = cvt_pk_bf16(v1[2], v1[3]);
                    *(u32x4*)(rowp + bj * 128) = w; }
                asm volatile("" ::: "memory"); }
    }
};

#define XB_TMO      128
#define XB_XCNT(j)  (256  + 64 * (j))
#define XB_XSUB(j)  (1280 + 64 * (j))
#define XB_XGEN(j)  (2304 + 64 * (j))
#define XB_TOP      3328
#define XB_TOPGEN   3392
#define XCD_BAR_WORDS 3456
#define XB_SPIN_CAP (1u << 18)

__device__ __forceinline__ unsigned xb_ld(unsigned* p)              { return __hip_atomic_load(p, __ATOMIC_RELAXED, __HIP_MEMORY_SCOPE_AGENT); }
__device__ __forceinline__ unsigned xb_add(unsigned* p, unsigned v) { return __hip_atomic_fetch_add(p, v, __ATOMIC_RELAXED, __HIP_MEMORY_SCOPE_AGENT); }
__device__ __forceinline__ unsigned xb_xcc_id() { return (unsigned)__builtin_amdgcn_s_getreg((3 << 11) | 20) & 0xFu; }
#define XB_SPIN(cond, bar) do { unsigned _sp = 0; while (cond) { __builtin_amdgcn_s_sleep(1); \
    if ((++_sp & 255u) == 0u) { if (xb_ld(&(bar)[XB_TMO])) break; if (_sp > XB_SPIN_CAP) { atomicAdd(&(bar)[XB_TMO], 1u); break; } } } } while (0)

struct XcdBarrier {
    unsigned* bar; unsigned x;
    volatile LAS unsigned* st;
};

__device__ __forceinline__ XcdBarrier xcd_barrier_post(unsigned* bar, volatile LAS unsigned* st) {
    XcdBarrier b; b.bar = bar; b.x = xb_xcc_id(); b.st = st;
    if (threadIdx.x == 0) (void)xb_add(&bar[XB_XCNT(b.x)], 1u);
    return b;
}
__device__ __forceinline__ void xcd_barrier_complete(unsigned* bar, unsigned x, unsigned& nloc, unsigned& nx) {
    const unsigned G = gridDim.x * gridDim.y * gridDim.z;
    unsigned sum, cnt, mine, sp = 0u;
    for (;;) {
        sum = 0u; cnt = 0u; mine = 0u;
#pragma unroll
        for (unsigned j = 0; j < 16; ++j) { const unsigned c = xb_ld(&bar[XB_XCNT(j)]); sum += c; cnt += (c > 0u) ? 1u : 0u; mine = (j == x) ? c : mine; }
        if (sum == G) break;
        __builtin_amdgcn_s_sleep(1);
        if ((++sp & 255u) == 0u) { if (xb_ld(&bar[XB_TMO])) break; if (sp > XB_SPIN_CAP) { atomicAdd(&bar[XB_TMO], 1u); break; } }
    }
    nloc = mine > 0u ? mine : 1u; nx = cnt > 0u ? cnt : 1u;
}

__device__ __forceinline__ void xcd_barrier(const XcdBarrier& b) {
    asm volatile("s_waitcnt vmcnt(0)" ::: "memory");
    __syncthreads();
    if (threadIdx.x == 0) {
        unsigned* bar = b.bar;
        __builtin_amdgcn_s_waitcnt(0);
        unsigned nloc = b.st[0], nx = b.st[1];
        if (nloc == 0u) { xcd_barrier_complete(bar, b.x, nloc, nx); b.st[0] = nloc; b.st[1] = nx; }
        const unsigned old = xb_add(&bar[XB_XSUB(b.x)], 1u);
        const unsigned gen = old / nloc;
        if (old + 1u == (gen + 1u) * nloc) {
            __builtin_amdgcn_fence(__ATOMIC_RELEASE, "agent");
            asm volatile("s_waitcnt vmcnt(0)" ::: "memory");
            const unsigned og = xb_add(&bar[XB_TOP], 1u);
            const unsigned tg = og / nx;
            if (og + 1u == (tg + 1u) * nx) xb_add(&bar[XB_TOPGEN], 1u);
            else XB_SPIN(xb_ld(&bar[XB_TOPGEN]) == tg, bar);
            __builtin_amdgcn_fence(__ATOMIC_ACQUIRE, "agent");
            xb_add(&bar[XB_XGEN(b.x)], 1u);
            asm volatile("s_waitcnt vmcnt(0)" ::: "memory");
        } else {
            XB_SPIN(xb_ld(&bar[XB_XGEN(b.x)]) == gen, bar);
            __builtin_amdgcn_fence(__ATOMIC_ACQUIRE, "agent");
            asm volatile("s_waitcnt vmcnt(0)" ::: "memory");
        }
    }
    __syncthreads();
}


template <class Epi>
__device__ __forceinline__ void run_gemm(const Ctx& c, const bf16_t* A, int lda, const bf16_t* Bt, int ldb, int M, int N, int K, const Epi& E, int cofs = 0) {
    pg8::Gemm g{A, Bt, M, N, K, lda, ldb}; pg8::StaticOrder S; S.init(M, N, c.G, (c.bid + cofs) % c.G);
    pg8::gemm_phase<Epi, pg8::StaticOrder, true>(c.lds, g, S, E);
}
template <class Epi>
__device__ __forceinline__ void run_gemm_i8(const Ctx& c, const unsigned char* A8, const float* sa, const unsigned char* Bt8, const float* sb, int M, int N, const Epi& E) {
    pg8::Gemm g{(const bf16_t*)A8, (const bf16_t*)Bt8, M, N, 512, 512, 512, 0, sa, sb}; pg8::StaticOrder S; S.init(M, N, c.G, c.bid);
    pg8::gemm_phase<Epi, pg8::StaticOrder, true, true>(c.lds, g, S, E);
}
enum Phase { PH_CONV = 0, PH_NORM1, PH_GEMM_AB, PH_MIX_AB1, PH_SCAN, PH_MLSTM_C, PH_GEMM_CD, PH_MLA_UP, PH_KNORM, PH_ATTN,
             PH_GATES, PH_BRANCH, PH_OUT, PH_POST1, PH_FFN_UP, PH_FFN_DN, PH_POST2, N_PHASES };

template <int PH>
__device__ __forceinline__ void run_phase(const Ctx& c) {
    unsigned char* ws = c.ws; const int Mrows = (c.layer == 0) ? MTOT : NLAT;
    bf16_t* U = (bf16_t*)(ws + WS_U); bf16_t* Y = (bf16_t*)(ws + WS_Y);
    if constexpr (PH == PH_CONV) { if (c.layer == 0) ph_conv(c, 0, c.bid, c.G, 3, true); }
    if constexpr (PH == PH_NORM1) { if (c.layer == 0) ph_norm1(c); }
    constexpr int CD_SPN = 3; const int ab_rem = ((MTOT / 256) * 11) % c.G, cd_nskip = ab_rem == 0 ? 0 : ((c.G - ab_rem) < MTOT / 256 ? (c.G - ab_rem) : MTOT / 256);
    if constexpr (PH == PH_GEMM_AB) { { EpiRope<0> E{(bf16_t*)(ws + R_PAB), 2816, (const float*)(ws + SM_ROPE), nullptr, 0, nullptr, nullptr}; run_gemm(c, U, 1024, (const bf16_t*)(ws + W_AB), 1024, MTOT, 2816, 1024, E); }
        if (cd_nskip > 0) { EpiRope<1> E{Y + 1024, 2048, (const float*)(ws + SM_ROPE), (bf16_t*)(ws + R_PD), 1536, (bf16_t*)(ws + R_CKR), (float*)(ws + R_SSQ)};
            pg8::Gemm g{(const bf16_t*)((const unsigned char*)c.out + OUT_U8), (const bf16_t*)(ws + W_C), MTOT, 2560, 512, 512, 512, 0, (const float*)((const unsigned char*)c.out + OUT_U8SC), (const float*)(ws + SC_CD)}; pg8::ColOrder S; S.init(c.bid, ab_rem, cd_nskip, CD_SPN);
            pg8::gemm_phase<EpiRope<1>, pg8::ColOrder, true, true>(c.lds, g, S, E); } }
    if constexpr (PH == PH_MIX_AB1) ph_mix_ab1(c);
    if constexpr (PH == PH_SCAN) ph_scan(c);
    if constexpr (PH == PH_MLSTM_C) ph_mlstm_c(c);
    if constexpr (PH == PH_GEMM_CD) {
        static_assert(W_D == W_C + (size_t)1024 * 1024 * 2, "W_c and W_d are contiguous: one GEMM of N = 2560");
        { EpiRope<1> E{Y + 1024, 2048, (const float*)(ws + SM_ROPE), (bf16_t*)(ws + R_PD), 1536, (bf16_t*)(ws + R_CKR), (float*)(ws + R_SSQ)};
          pg8::Gemm g{(const bf16_t*)((const unsigned char*)c.out + OUT_U8), (const bf16_t*)(ws + W_C), MTOT, 2560, 512, 512, 512, 0, (const float*)((const unsigned char*)c.out + OUT_U8SC), (const float*)(ws + SC_CD)}; pg8::SkipOrder S; S.init(MTOT, 2560, c.G, c.bid, CD_SPN, cd_nskip);
          pg8::gemm_phase<EpiRope<1>, pg8::SkipOrder, true, true>(c.lds, g, S, E); }
    }
    if constexpr (PH == PH_MLA_UP) {
        { EpiRope<2> E{(bf16_t*)(ws + R_CQ), 768, (const float*)(ws + SM_ROPE), nullptr, 0, nullptr, (float*)(ws + R_SSQ)}; run_gemm(c, Y + 1024, 2048, (const bf16_t*)(ws + W_UQ), 512, MTOT, 768, 512, E); }
        { EpiRowScale E{(bf16_t*)(ws + R_CKNV), 1024, (const float*)(ws + R_SSQ)}; run_gemm(c, Y + 1024 + 512, 2048, (const bf16_t*)(ws + W_UKV), 256, MTOT, 1024, 256, E, c.G > 136 ? c.G - 136 : 0); }
    }
    if constexpr (PH == PH_KNORM) ph_knorm(c);
    if constexpr (PH == PH_ATTN) ph_attn(c);
    if constexpr (PH == PH_GATES) { pg8::EpiB<pg8::EM_SIG8> E{(bf16_t*)(ws + R_G), 4096, nullptr, 0, 0, 0}; run_gemm_i8(c, (const unsigned char*)c.out + OUT_U8, (const float*)((const unsigned char*)c.out + OUT_U8SC), ws + W_G, (const float*)(ws + SC_G), Mrows, 4096, E); }
    if constexpr (PH == PH_BRANCH) {
        pg8::EpiB<pg8::EM_GATEACC> E{U, 1024, (const bf16_t*)(ws + R_G), 4096, 1024, 0};
        pg8::Gemm g{Y, (const bf16_t*)(ws + W_BR), Mrows, 1024, 512, 2048, 2048, 1024}; pg8::SliceOrder<4> S; S.init(Mrows, 1024, c.G, c.bid);
        pg8::gemm_phase<pg8::EpiB<pg8::EM_GATEACC>, pg8::SliceOrder<4>, true>(c.lds, g, S, E);
    }
    if constexpr (PH == PH_OUT) { pg8::EpiB<pg8::EM_BF16> E{(bf16_t*)(ws + R_YOUT), 1024, nullptr, 0, 0, 0}; run_gemm(c, U, 1024, (const bf16_t*)(ws + W_OUT), 1024, Mrows, 1024, 1024, E); }
    if constexpr (PH == PH_POST1) ph_post1(c);
    if constexpr (PH == PH_FFN_UP) { pg8::EpiB<pg8::EM_SWIGLU> E{(bf16_t*)(ws + R_HID), 2816, nullptr, 0, 0, 0}; run_gemm_i8(c, ws + WS_U, (const float*)(ws + U_SC), ws + W_GU, (const float*)(ws + SC_GU), Mrows, 5632, E); }
    if constexpr (PH == PH_FFN_DN) { pg8::EpiB<pg8::EM_BF16> E{(bf16_t*)(ws + WS_Y), 1024, nullptr, 0, 0, 0}; run_gemm(c, (const bf16_t*)(ws + R_HID), 2816, (const bf16_t*)(ws + W_DN), 2816, Mrows, 1024, 2816, E);
        if (c.layer == 0) { const int nwg = (Mrows / 256) * 4, nx = nwg % c.G, skip = (2 * nx < c.G) ? nx : 0;
            if (c.bid >= skip) ph_conv(c, 1, c.bid - skip, c.G - skip, 1, false); } }
    if constexpr (PH == PH_POST2) { ph_post2(c); if (c.layer == 0) { __syncthreads(); ph_conv(c, 1, c.bid, c.G, 2, false); } }
}

__device__ __forceinline__ Ctx make_ctx(const Args& args, unsigned char* lds, int layer) {
    typedef const __attribute__((address_space(4))) Args* KArgsP;
    KArgsP ka = (KArgsP)__builtin_amdgcn_kernarg_segment_ptr();
    asm volatile("" : "+s"(ka));
    Ctx c; c.in = (InTab)ka->in; c.out = ka->out; c.ws = ka->ws; c.layer = layer;
    c.lds = (LAS unsigned char*)lds; c.ldsg = (char*)lds;
    c.tid = ltid(); c.lane = c.tid & 63; c.wave = __builtin_amdgcn_readfirstlane(c.tid >> 6); c.G = gridDim.x; c.bid = blockIdx.x;
    return c;
}
template <int PH>
__global__ void __launch_bounds__(512, 2) k_phase(Args args) {
    extern __shared__ __attribute__((aligned(16))) unsigned char lds[];
    const Ctx c = make_ctx(args, lds, args.layer);
    run_phase<PH>(c);
}


#ifndef MK_FUSED
#define MK_FUSED 1
#endif
constexpr int CW_BAR = 4096;
constexpr int LDS_BARW = LDS_BYTES - 64;

__device__ __forceinline__ void grid_bar(const Args& args, unsigned char* lds) {
    typedef const __attribute__((address_space(4))) Args* KArgsP;
    KArgsP ka = (KArgsP)__builtin_amdgcn_kernarg_segment_ptr(); asm volatile("" : "+s"(ka));
    unsigned char* wsb = ka->ws;
    XcdBarrier b; b.bar = (unsigned*)(wsb + WS_CTL) + CW_BAR; b.x = xb_xcc_id(); b.st = (volatile LAS unsigned*)((LAS unsigned char*)lds + LDS_BARW);
    xcd_barrier(b);
}
template <int PH, int PEND>
__device__ __forceinline__ void run_range(const Args& args, unsigned char* lds, int layer, bool last_barrier) {
    if constexpr (PH < PEND) {
        { const Ctx cc = make_ctx(args, lds, layer); run_phase<PH>(cc); }
#ifdef PROBE_DOUBLE
        if constexpr (((PROBE_DOUBLE) >> PH) & 1) { grid_bar(args, lds); const Ctx cc = make_ctx(args, lds, layer); run_phase<PH>(cc); }
#endif
        if ((PH + 1 < PEND || last_barrier) && !((PH == PH_NORM1 || PH == PH_CONV) && layer == 1)) grid_bar(args, lds);
        run_range<PH + 1, PEND>(args, lds, layer, last_barrier);
    }
}
__global__ void __launch_bounds__(512, 2) k_fused(Args args) {
    extern __shared__ __attribute__((aligned(16))) unsigned char lds[];
    { volatile LAS unsigned* st = (volatile LAS unsigned*)((LAS unsigned char*)lds + LDS_BARW);
      if (threadIdx.x < 4) st[threadIdx.x] = 0u;
      __syncthreads();
      (void)xcd_barrier_post((unsigned*)(args.ws + WS_CTL) + CW_BAR, st); }
    run_range<0, N_PHASES>(args, lds, 0, true);
    run_range<0, N_PHASES>(args, lds, 1, false);
}

template <int PH> static void launch_phase(const Args& a, int grid, hipStream_t stream) {
    static bool attr_set = false;
    if (!attr_set) { (void)hipFuncSetAttribute((const void*)k_phase<PH>, hipFuncAttributeMaxDynamicSharedMemorySize, LDS_BYTES); attr_set = true; }
    hipLaunchKernelGGL(k_phase<PH>, dim3(grid), dim3(512), LDS_BYTES, stream, a);
}
template <int PH> static void launch_all(Args& a, int grid, hipStream_t stream) {
    if constexpr (PH < N_PHASES) { launch_phase<PH>(a, grid, stream); launch_all<PH + 1>(a, grid, stream); }
}

extern "C" void kernel_launch(void* const* d_in, const int* in_sizes, int n_in, void* d_out, int out_size, void* d_ws, size_t ws_size, hipStream_t stream) {
    static int grid = 0;
    if (grid == 0) {
        if (n_in != N_IN || out_size != NLAT * DM || ws_size < WS_END) { fprintf(stderr, "kernel_launch: unexpected shapes: n_in %d out %d ws %zu\n", n_in, out_size, ws_size); grid = -1; return; }
        int dev = 0, cus = 0, per_cu = 0;
        if (hipGetDevice(&dev) != hipSuccess || hipDeviceGetAttribute(&cus, hipDeviceAttributeMultiprocessorCount, dev) != hipSuccess) { grid = -1; return; }
#if MK_FUSED
        if (hipFuncSetAttribute((const void*)k_fused, hipFuncAttributeMaxDynamicSharedMemorySize, LDS_BYTES) != hipSuccess) { fprintf(stderr, "kernel_launch: hipFuncSetAttribute failed\n"); grid = -1; return; }
        if (hipOccupancyMaxActiveBlocksPerMultiprocessor(&per_cu, (const void*)k_fused, 512, LDS_BYTES) != hipSuccess || per_cu < 1) fprintf(stderr, "kernel_launch: occupancy query says %d blocks per CU\n", per_cu);
        (void)hipGetLastError();
#endif
        grid = cus;
    }
    if (grid < 0) return;
    (void)hipMemsetAsync((char*)d_ws + WS_CTL, 0, CTL_ZERO_BYTES, stream);
    Args a{};
    for (int i = 0; i < N_IN; ++i) a.in[i] = (const float*)d_in[i];
    a.out = (float*)d_out; a.ws = (unsigned char*)d_ws; a.layer = 0; a.pad = 0;
#if MK_FUSED
    hipLaunchKernelGGL(k_fused, dim3(grid), dim3(512), LDS_BYTES, stream, a);
#else
    for (int l = 0; l < 2; ++l) { a.layer = l; launch_all<0>(a, grid, stream); }
#endif
}
```

```cpp
#include <hip/hip_runtime.h>
#include <hip/hip_bf16.h>
#include <cstdio>
#include <cstdint>
#include <cmath>

#define LAS __attribute__((address_space(3)))
#define GAS __attribute__((address_space(1)))
typedef unsigned short bf16_t;
typedef short bf16x8 __attribute__((ext_vector_type(8)));
typedef short s16x4 __attribute__((ext_vector_type(4)));
typedef float f32x4 __attribute__((ext_vector_type(4)));
typedef float f32x2 __attribute__((ext_vector_type(2)));
typedef float f32x16 __attribute__((ext_vector_type(16)));
typedef unsigned u32x4 __attribute__((ext_vector_type(4)));
typedef unsigned u32x2 __attribute__((ext_vector_type(2)));
typedef int i32x4 __attribute__((ext_vector_type(4)));

__device__ __forceinline__ unsigned cvt_pk_bf16(float lo, float hi) { unsigned r; asm volatile("v_cvt_pk_bf16_f32 %0, %1, %2" : "=v"(r) : "v"(lo), "v"(hi)); return r; }
__device__ __forceinline__ bf16_t f2bf(float f) { return (bf16_t)(cvt_pk_bf16(f, 0.f) & 0xffffu); }
__device__ __forceinline__ float bf2f(bf16_t v) { return __uint_as_float(((unsigned)v) << 16); }
__device__ __forceinline__ float bflo(unsigned w) { return __uint_as_float(w << 16); }
__device__ __forceinline__ float bfhi(unsigned w) { return __uint_as_float(w & 0xffff0000u); }
__device__ __forceinline__ float sigmoidf_(float x) { return __builtin_amdgcn_rcpf(1.f + __builtin_amdgcn_exp2f(-1.4426950408889634f * x)); }
__device__ __forceinline__ int ltid() { int t = threadIdx.x; asm volatile("" : "+v"(t)); return t; }

namespace pg8 {
constexpr int BM = 256, BK = 64, HALF = 128, HTB = HALF * BK * 2, STAGE_BYTES = 8 * HTB, NXCD = 8, WGM = 8;
__host__ __device__ __forceinline__ int lds_byte(int r, int c) { const int st = (r >> 4) * 2 + (c >> 5), rr = r & 15, cc = c & 31, ob = rr * 64 + cc * 2; return st * 1024 + (ob ^ (((ob >> 9) & 1) << 5)); }
__host__ __device__ __forceinline__ void stage_rc(int b, int& R, int& C) { const int st = b / 1024, sb = b % 1024, swz = sb ^ (((sb >> 9) & 1) << 5); R = (st >> 1) * 16 + swz / 64; C = (st & 1) * 32 + (swz % 64) / 2; }
__host__ __device__ __forceinline__ int perm32(int rho) { const int n = rho >> 4, i = rho & 15; return 8 * (i >> 2) + 4 * n + (i & 3); }

struct Unit { int pm, pn, kb; };
struct Gemm { const bf16_t* A; const bf16_t* Bt; int M, N, K, lda, ldb; int kslice = 0; const float* sa = nullptr; const float* sb = nullptr; };

struct StaticOrder {
    int nM, nN, nwg, G, c;
    __host__ __device__ void init(int M, int N, int G_, int c_) { nM = M / BM; nN = N / BM; nwg = nM * nN; G = G_; c = c_; }
    __host__ __device__ bool next(int i, Unit& u) const {
        const long L = (long)i * G + c; if (L >= nwg) return false;
        int wgid = (int)L; { const int q = nwg / NXCD, r = nwg % NXCD, xcd = wgid % NXCD, off = wgid / NXCD; wgid = (xcd < r ? xcd * (q + 1) : r * (q + 1) + (xcd - r) * q) + off; }
        const int nig = WGM * nN, gid = wgid / nig, fm = gid * WGM, gsz = (nM - fm) < WGM ? (nM - fm) : WGM;
        u.pm = fm + ((wgid % nig) % gsz); u.pn = (wgid % nig) / gsz; u.kb = 0; return true;
    }
};
struct SkipOrder {
    StaticOrder S; int G, c, n9, nM, spn, nskip;
    __host__ __device__ void init(int M, int N, int G_, int c_, int spn_, int nskip_) { S.init(M, N - BM, G_, c_); G = G_; c = c_; n9 = S.nwg; nM = M / BM; spn = spn_; nskip = nskip_; }
    __host__ __device__ bool next(int i, Unit& u) const {
        const long L = (long)i * G + c;
        if (L < n9) { S.next(i, u); if (u.pn >= spn) u.pn += 1; return true; }
        const int k = (int)(L - n9); if (k >= nM - nskip) return false;
        u.pm = nskip + k; u.pn = spn; u.kb = 0; return true; }
};
struct ColOrder {
    int c, c0, n, pn;
    __host__ __device__ void init(int c_, int c0_, int n_, int pn_) { c = c_; c0 = c0_; n = n_; pn = pn_; }
    __host__ __device__ bool next(int i, Unit& u) const { if (i != 0 || c < c0 || c >= c0 + n) return false; u.pm = c - c0; u.pn = pn; u.kb = 0; return true; }
};
struct SliceOrder1 {
    StaticOrder S; int kb;
    __host__ __device__ void init(int M, int N, int G_, int c_, int kb_) { S.init(M, N, G_, c_); kb = kb_; }
    __host__ __device__ bool next(int i, Unit& u) const { if (!S.next(i, u)) return false; u.kb = kb; return true; }
};
template <int NS> struct SliceOrder {
    StaticOrder S;
    __host__ __device__ void init(int M, int N, int G_, int c_) { S.init(M, N, G_, c_); }
    __host__ __device__ bool next(int i, Unit& u) const { if (!S.next(i / NS, u)) return false; u.kb = i % NS; return true; }
};

enum { EM_BF16 = 0, EM_SIG = 1, EM_SWIGLU = 2, EM_GATEACC = 3, EM_SIG8 = 4 };
template <int MODE> struct EpiB {
    static constexpr bool PERM = true;
    bf16_t* O; int ldc;
    const bf16_t* G; int ldg; int gcol0; int first;
    bf16_t* O2 = nullptr; int ldc2 = 0, split_pn = 1 << 30;
    __device__ __forceinline__ void operator()(const f32x4 (&acc)[2][2][4][2], const Unit& u, int wr, int wc, int fr, int fq) const {
        const int row0 = u.pm * BM + wr * 64 + fr;
        if constexpr (MODE == EM_SWIGLU) {
            const int col0 = u.pn * HALF + wc * 32 + 8 * fq;
#pragma unroll
            for (int ai = 0; ai < 2; ++ai)
#pragma unroll
                for (int m = 0; m < 4; ++m) { bf16_t* rowp = O + (size_t)(row0 + ai * HALF + m * 16) * ldc + col0;
                    float v[8];
#pragma unroll
                    for (int n = 0; n < 2; ++n)
#pragma unroll
                        for (int j = 0; j < 4; ++j) { const float g = acc[ai][0][m][n][j], up = acc[ai][1][m][n][j]; v[n * 4 + j] = g * sigmoidf_(g) * up; }
                    u32x4 w; w.x = cvt_pk_bf16(v[0], v[1]); w.y = cvt_pk_bf16(v[2], v[3]); w.z = cvt_pk_bf16(v[4], v[5]); w.w = cvt_pk_bf16(v[6], v[7]);
                    *(u32x4*)rowp = w; }
        } else if constexpr (MODE == EM_GATEACC) {
            const int col0 = u.pn * BM + wc * 32 + 8 * fq; constexpr float I255 = 1.f / 255.f;
#pragma unroll
            for (int ai = 0; ai < 2; ++ai) { u32x2 gw[4][2]; u32x4 ow[4][2];
#pragma unroll
                for (int m = 0; m < 4; ++m) { const size_t r = (size_t)(row0 + ai * HALF + m * 16);
#pragma unroll
                    for (int bj = 0; bj < 2; ++bj) gw[m][bj] = *(const u32x2*)((const unsigned char*)G + r * ldg + u.kb * gcol0 + col0 + bj * HALF); }
                if (u.kb != 0) {
#pragma unroll
                    for (int m = 0; m < 4; ++m) { const size_t r = (size_t)(row0 + ai * HALF + m * 16);
#pragma unroll
                        for (int bj = 0; bj < 2; ++bj) ow[m][bj] = *(const u32x4*)(O + r * ldc + col0 + bj * HALF); }
                } else {
#pragma unroll
                    for (int m = 0; m < 4; ++m)
#pragma unroll
                        for (int bj = 0; bj < 2; ++bj) ow[m][bj] = u32x4{0u, 0u, 0u, 0u}; }
                __builtin_amdgcn_sched_barrier(0);
#pragma unroll
                for (int m = 0; m < 4; ++m) { bf16_t* rowp = O + (size_t)(row0 + ai * HALF + m * 16) * ldc + col0;
#pragma unroll
                    for (int bj = 0; bj < 2; ++bj) { f32x4 v0 = acc[ai][bj][m][0], v1 = acc[ai][bj][m][1]; const u32x2 g8 = gw[m][bj]; const u32x4 pw = ow[m][bj];
                        v0[0] = fmaf(v0[0], (float)(g8.x & 255u) * I255, bflo(pw.x)); v0[1] = fmaf(v0[1], (float)((g8.x >> 8) & 255u) * I255, bfhi(pw.x));
                        v0[2] = fmaf(v0[2], (float)((g8.x >> 16) & 255u) * I255, bflo(pw.y)); v0[3] = fmaf(v0[3], (float)(g8.x >> 24) * I255, bfhi(pw.y));
                        v1[0] = fmaf(v1[0], (float)(g8.y & 255u) * I255, bflo(pw.z)); v1[1] = fmaf(v1[1], (float)((g8.y >> 8) & 255u) * I255, bfhi(pw.z));
                        v1[2] = fmaf(v1[2], (float)((g8.y >> 16) & 255u) * I255, bflo(pw.w)); v1[3] = fmaf(v1[3], (float)(g8.y >> 24) * I255, bfhi(pw.w));
                        u32x4 w; w.x = cvt_pk_bf16(v0[0], v0[1]); w.y = cvt_pk_bf16(v0[2], v0[3]); w.z = cvt_pk_bf16(v1[0], v1[1]); w.w = cvt_pk_bf16(v1[2], v1[3]);
                        *(u32x4*)(rowp + bj * HALF) = w; } }
            }
        } else {
            const bool sp = u.pn >= split_pn; const int col0 = (sp ? u.pn - split_pn : u.pn) * BM + wc * 32 + 8 * fq; bf16_t* Ob = sp ? O2 : O; const int ldo_ = sp ? ldc2 : ldc;
#pragma unroll
            for (int ai = 0; ai < 2; ++ai)
#pragma unroll
                for (int m = 0; m < 4; ++m) { const size_t r = (size_t)(row0 + ai * HALF + m * 16); bf16_t* rowp = Ob + r * ldo_ + col0;
#pragma unroll
                    for (int bj = 0; bj < 2; ++bj) { f32x4 v0 = acc[ai][bj][m][0], v1 = acc[ai][bj][m][1];
                        if constexpr (MODE == EM_SIG8) {
                            unsigned lo = 0u, hi = 0u;
#pragma unroll
                            for (int j = 0; j < 4; ++j) { lo |= (unsigned)__float2int_rn(__builtin_amdgcn_rcpf(fmaf(__builtin_amdgcn_exp2f(-1.4426950408889634f * v0[j]), 1.f / 255.f, 1.f / 255.f))) << (8 * j); hi |= (unsigned)__float2int_rn(__builtin_amdgcn_rcpf(fmaf(__builtin_amdgcn_exp2f(-1.4426950408889634f * v1[j]), 1.f / 255.f, 1.f / 255.f))) << (8 * j); }
                            u32x2 w8; w8.x = lo; w8.y = hi; *(u32x2*)((unsigned char*)O + r * ldc + col0 + bj * HALF) = w8; continue; }
                        if constexpr (MODE == EM_SIG) {
#pragma unroll
                            for (int j = 0; j < 4; ++j) { v0[j] = sigmoidf_(v0[j]); v1[j] = sigmoidf_(v1[j]); } }
                        if constexpr (MODE == EM_GATEACC) {
                            const u32x2 gw = *(const u32x2*)((const unsigned char*)G + r * ldg + u.kb * gcol0 + col0 + bj * HALF);
                            constexpr float I255 = 1.f / 255.f;
                            v0[0] *= (float)(gw.x & 255u) * I255; v0[1] *= (float)((gw.x >> 8) & 255u) * I255; v0[2] *= (float)((gw.x >> 16) & 255u) * I255; v0[3] *= (float)(gw.x >> 24) * I255;
                            v1[0] *= (float)(gw.y & 255u) * I255; v1[1] *= (float)((gw.y >> 8) & 255u) * I255; v1[2] *= (float)((gw.y >> 16) & 255u) * I255; v1[3] *= (float)(gw.y >> 24) * I255;
                            if (u.kb != 0) { const u32x4 ow = *(const u32x4*)(rowp + bj * HALF);
                                v0[0] += bflo(ow.x); v0[1] += bfhi(ow.x); v0[2] += bflo(ow.y); v0[3] += bfhi(ow.y);
                                v1[0] += bflo(ow.z); v1[1] += bfhi(ow.z); v1[2] += bflo(ow.w); v1[3] += bfhi(ow.w); } }
                        u32x4 w; w.x = cvt_pk_bf16(v0[0], v0[1]); w.y = cvt_pk_bf16(v0[2], v0[3]); w.z = cvt_pk_bf16(v1[0], v1[1]); w.w = cvt_pk_bf16(v1[2], v1[3]);
                        *(u32x4*)(rowp + bj * HALF) = w; } }
        }
    }
};
struct EpiF32 {
    static constexpr bool PERM = false;
    float* O; int ldc;
    __device__ __forceinline__ void operator()(const f32x4 (&acc)[2][2][4][2], const Unit& u, int wr, int wc, int fr, int fq) const {
        const int row0 = u.pm * BM + wr * 64 + fr, col0 = u.pn * BM + wc * 32 + 4 * fq;
#pragma unroll
        for (int ai = 0; ai < 2; ++ai)
#pragma unroll
            for (int m = 0; m < 4; ++m) { float* rowp = O + (size_t)(row0 + ai * HALF + m * 16) * ldc + col0;
#pragma unroll
                for (int bj = 0; bj < 2; ++bj)
#pragma unroll
                    for (int n = 0; n < 2; ++n) *(f32x4*)(rowp + bj * HALF + n * 16) = acc[ai][bj][m][n]; }
    }
};

template <bool I8> struct AccSel { typedef f32x4 T; };
template <> struct AccSel<true> { typedef i32x4 T; };
template <class Epi, class Sched, bool ALIGN_EPI = true, bool I8 = false>
__device__ __forceinline__ void gemm_phase(LAS unsigned char* lds, const Gemm g, const Sched& S, const Epi& E) {
    typedef f32x4 accv;
    const int tid = ltid(), wid = __builtin_amdgcn_readfirstlane(tid >> 6), lane = tid & 63, wr = wid >> 2, wc = wid & 3, fr = lane & 15, fq = lane >> 4;
    const int K = g.K, nt = K / BK;
    unsigned voffA[2], voffB[2];
#pragma unroll
    for (int i = 0; i < 2; ++i) { int R, C; stage_rc(tid * 16 + i * 8192, R, C); const int Rb = Epi::PERM ? ((R & ~31) + perm32(R & 31)) : R;
        voffA[i] = (unsigned)(R * g.lda + C) * 2u; voffB[i] = (unsigned)(Rb * g.ldb + C) * 2u; }
    const size_t kstep = (size_t)(BK * 2);
    const size_t hstepA = (size_t)HALF * g.lda * 2, hstepB = (size_t)HALF * g.ldb * 2;
    const size_t tstepA = 2 * hstepA, tstepB = 2 * hstepB;
    const unsigned ldsw = (unsigned)wid * 1024u;
    const int aoff = lds_byte(wr * 64 + fr, fq * 8), boff = lds_byte(wc * 32 + fr, fq * 8);
#define PG8_SA(b, h) (((b) * 2 + (h)) * HTB)
#define PG8_SB(b, h) ((4 + (b) * 2 + (h)) * HTB)
#define PG8_STAGE(bufoff, gbase, voff) do { _Pragma("unroll") for (int _i = 0; _i < 2; ++_i) \
        __builtin_amdgcn_global_load_lds((const unsigned*)((const char*)(gbase) + (voff)[_i]), (LAS unsigned*)(lds + (bufoff) + ldsw + _i * 8192), 16, 0, 0); } while (0)
#define PG8_LDA(dst, b, h) do { _Pragma("unroll") for (int m = 0; m < 4; ++m) _Pragma("unroll") for (int k = 0; k < 2; ++k) dst[m][k] = *(const LAS bf16x8*)(lds + PG8_SA(b, h) + aoff + m * 2048 + k * 1024); } while (0)
#define PG8_LDB(dst, b, h) do { _Pragma("unroll") for (int n = 0; n < 2; ++n) _Pragma("unroll") for (int k = 0; k < 2; ++k) dst[n][k] = *(const LAS bf16x8*)(lds + PG8_SB(b, h) + boff + n * 2048 + k * 1024); } while (0)
#define PG8_MMA(ai, bj, At, Bt) do { __builtin_amdgcn_s_setprio(1); _Pragma("unroll") for (int m = 0; m < 4; ++m) _Pragma("unroll") for (int n = 0; n < 2; ++n) _Pragma("unroll") for (int k = 0; k < 2; ++k) { \
        if constexpr (I8) acc[ai][bj][m][n] = __builtin_bit_cast(accv, __builtin_amdgcn_mfma_i32_16x16x64_i8(__builtin_bit_cast(i32x4, Bt[n][k]), __builtin_bit_cast(i32x4, At[m][k]), __builtin_bit_cast(i32x4, acc[ai][bj][m][n]), 0, 0, 0)); \
        else acc[ai][bj][m][n] = __builtin_bit_cast(accv, __builtin_amdgcn_mfma_f32_16x16x32_bf16(Bt[n][k], At[m][k], __builtin_bit_cast(f32x4, acc[ai][bj][m][n]), 0, 0, 0)); } __builtin_amdgcn_s_setprio(0); } while (0)
#define PG8_WAIT_V(n) asm volatile("s_waitcnt vmcnt(" #n ")" ::: "memory")
#define PG8_WAIT_L(n) asm volatile("s_waitcnt lgkmcnt(" #n ")" ::: "memory")
#define PG8_BAR __builtin_amdgcn_s_barrier()
#define PG8_SCHED __builtin_amdgcn_sched_barrier(0)
    Unit cur, nxt; int ui = 0;
    if (!S.next(0, cur)) return;
    accv acc[2][2][4][2];
#pragma unroll
    for (int a = 0; a < 2; ++a)
#pragma unroll
        for (int b = 0; b < 2; ++b)
#pragma unroll
            for (int m = 0; m < 4; ++m)
#pragma unroll
                for (int n = 0; n < 2; ++n) acc[a][b][m][n] = accv{};
    bf16x8 At[4][2], B0[2][2], B1[2][2];
    const char* cA = (const char*)g.A + (size_t)cur.pm * tstepA + (size_t)cur.kb * g.kslice; const char* cB = (const char*)g.Bt + (size_t)cur.pn * tstepB + (size_t)cur.kb * g.kslice;
    PG8_STAGE(PG8_SB(0, 0), cB, voffB); PG8_STAGE(PG8_SB(0, 1), cB + hstepB, voffB); PG8_STAGE(PG8_SA(0, 0), cA, voffA); PG8_STAGE(PG8_SA(0, 1), cA + hstepA, voffA);
    if (wr == 1) PG8_BAR;
    PG8_WAIT_V(2); PG8_BAR;
    PG8_STAGE(PG8_SB(1, 0), cB + kstep, voffB); PG8_STAGE(PG8_SA(1, 0), cA + kstep, voffA); PG8_STAGE(PG8_SB(1, 1), cB + hstepB + kstep, voffB);
    PG8_WAIT_V(6); PG8_BAR;
    for (;;) {
        const bool has_next = S.next(ui + 1, nxt);
        const char* nA = has_next ? (const char*)g.A + (size_t)nxt.pm * tstepA + (size_t)nxt.kb * g.kslice : cA; const char* nB = has_next ? (const char*)g.Bt + (size_t)nxt.pn * tstepB + (size_t)nxt.kb * g.kslice : cB;
        for (int t = 0; t < nt; t += 2) {
            const bool last = (t == nt - 2);
            const char* a1 = cA + (size_t)(t + 1) * kstep;
            const char* a2 = last ? nA : cA + (size_t)(t + 2) * kstep; const char* b2 = last ? nB : cB + (size_t)(t + 2) * kstep;
            const char* a3 = a2 + kstep; const char* b3 = b2 + kstep;
            PG8_LDB(B0, 0, 0); PG8_LDB(B1, 0, 1); PG8_SCHED; PG8_LDA(At, 0, 0); PG8_STAGE(PG8_SA(1, 1), a1 + hstepA, voffA);
            PG8_WAIT_V(8); PG8_WAIT_L(0); PG8_BAR; PG8_MMA(0, 0, At, B0); PG8_MMA(0, 1, At, B1); PG8_BAR; PG8_SCHED;
            PG8_LDA(At, 0, 1); PG8_STAGE(PG8_SB(0, 0), b2, voffB); PG8_STAGE(PG8_SB(0, 1), b2 + hstepB, voffB); PG8_STAGE(PG8_SA(0, 0), a2, voffA);
            PG8_WAIT_V(8); PG8_WAIT_L(0); PG8_BAR; PG8_MMA(1, 0, At, B0); PG8_MMA(1, 1, At, B1); PG8_BAR; PG8_SCHED;
            PG8_LDB(B0, 1, 0); PG8_LDB(B1, 1, 1); PG8_SCHED; PG8_LDA(At, 1, 0); PG8_STAGE(PG8_SA(0, 1), a2 + hstepA, voffA);
            PG8_WAIT_V(8); PG8_WAIT_L(0); PG8_BAR; PG8_MMA(0, 0, At, B0); PG8_MMA(0, 1, At, B1); PG8_BAR; PG8_SCHED;
            PG8_LDA(At, 1, 1); PG8_STAGE(PG8_SB(1, 0), b3, voffB); PG8_STAGE(PG8_SB(1, 1), b3 + hstepB, voffB); PG8_STAGE(PG8_SA(1, 0), a3, voffA);
            PG8_WAIT_V(8); PG8_WAIT_L(0); PG8_BAR; PG8_MMA(1, 0, At, B0); PG8_MMA(1, 1, At, B1); PG8_BAR; PG8_SCHED;
        }
        if constexpr (ALIGN_EPI) { if (wr == 0) PG8_BAR; }
        if constexpr (I8) {
            f32x4 sb4[2][2]; const int cb0 = cur.pn * BM + wc * 32 + (Epi::PERM ? 8 * fq : 4 * fq);
#pragma unroll
            for (int b = 0; b < 2; ++b)
#pragma unroll
                for (int n = 0; n < 2; ++n) sb4[b][n] = *(const f32x4*)(g.sb + cb0 + b * HALF + (Epi::PERM ? 4 * n : 16 * n));
#pragma unroll
            for (int a = 0; a < 2; ++a)
#pragma unroll
                for (int m = 0; m < 4; ++m) { const float ra = g.sa[cur.pm * BM + a * HALF + wr * 64 + m * 16 + fr];
#pragma unroll
                    for (int b = 0; b < 2; ++b)
#pragma unroll
                        for (int n = 0; n < 2; ++n) { const i32x4 v = __builtin_bit_cast(i32x4, acc[a][b][m][n]);
                            acc[a][b][m][n] = (f32x4){(float)v.x, (float)v.y, (float)v.z, (float)v.w} * ra * sb4[b][n]; } }
        }
        E(acc, cur, wr, wc, fr, fq);
        if (!has_next) break;
#pragma unroll
        for (int a = 0; a < 2; ++a)
#pragma unroll
            for (int b = 0; b < 2; ++b)
#pragma unroll
                for (int m = 0; m < 4; ++m)
#pragma unroll
                    for (int n = 0; n < 2; ++n) acc[a][b][m][n] = accv{};
        cur = nxt; cA = nA; cB = nB; ++ui;
        if constexpr (ALIGN_EPI) { if (wr == 1) PG8_BAR; }
    }
    PG8_WAIT_V(0);
    if constexpr (!ALIGN_EPI) { if (wr == 0) PG8_BAR; }
    PG8_BAR;
#undef PG8_SA
#undef PG8_SB
#undef PG8_STAGE
#undef PG8_LDA
#undef PG8_LDB
#undef PG8_MMA
#undef PG8_WAIT_V
#undef PG8_WAIT_L
#undef PG8_BAR
#undef PG8_SCHED
}
}

namespace att {
#ifndef ATTN_UNIT
#define ATTN_UNIT attn_unit_sbd
#endif
#ifndef SKEW_HALVES
#define SKEW_HALVES 0
#endif
#ifndef ATTN_D_UNIT
#define ATTN_D_UNIT attn_unit_p2
#endif
#ifndef ATTN_C_UNIT
#define ATTN_C_UNIT attn_unit_pipe
#endif
#ifndef HO_HALF_EXPR
#define HO_HALF_EXPR (wid >> 2)
#endif
#define SBAR() __builtin_amdgcn_sched_barrier(0)
constexpr int KVBLK = 64;
constexpr int SHM_V = KVBLK * 128 * 2;
__device__ __forceinline__ int crow(int r, int hi) { return (r & 3) + 8 * (r >> 2) + 4 * hi; }
template <int NCB = 4> __device__ __forceinline__ int v_st(int k, int c) { const int kk = (k & ~0xC) | ((k & 4) << 1) | ((k & 8) >> 1); return ((kk >> 3) * NCB + (c >> 5)) * 512 + ((kk & 7) * 32 + (c & 31)) * 2; }
__device__ __forceinline__ int v_rd_base(int lane) { return ((lane & 3) << 3) | (((lane >> 2) & 3) << 6) | (((lane >> 4) & 1) << 5) | (((lane >> 5) & 1) << 8); }
constexpr int v_rd_off(int d0, int ks, int half, int ncb = 4) { return ((2 * ks + half) * ncb + d0) * 512; }
template <int OFF> __device__ __forceinline__ s16x4 tr_read(int vb) {
  s16x4 r; asm volatile("ds_read_b64_tr_b16 %0, %1 offset:%2" : "=&v"(r) : "v"(vb), "i"(OFF) : "memory"); return r;
}
template <int D0, int NCB = 4> __device__ __forceinline__ void pv_one(f32x16& od, int vb, bf16x8 pa0, bf16x8 pa1, bf16x8 pa2, bf16x8 pa3) {
  const s16x4 l0 = tr_read<v_rd_off(D0, 0, 0, NCB)>(vb), h0 = tr_read<v_rd_off(D0, 0, 1, NCB)>(vb), l1 = tr_read<v_rd_off(D0, 1, 0, NCB)>(vb), h1 = tr_read<v_rd_off(D0, 1, 1, NCB)>(vb);
  const s16x4 l2 = tr_read<v_rd_off(D0, 2, 0, NCB)>(vb), h2 = tr_read<v_rd_off(D0, 2, 1, NCB)>(vb), l3 = tr_read<v_rd_off(D0, 3, 0, NCB)>(vb), h3 = tr_read<v_rd_off(D0, 3, 1, NCB)>(vb);
  asm volatile("s_waitcnt lgkmcnt(0)" ::: "memory"); SBAR();
#define PK(L, H) (bf16x8){L[0], L[1], L[2], L[3], H[0], H[1], H[2], H[3]}
  od = __builtin_amdgcn_mfma_f32_32x32x16_bf16(pa0, PK(l0, h0), od, 0, 0, 0);
  od = __builtin_amdgcn_mfma_f32_32x32x16_bf16(pa1, PK(l1, h1), od, 0, 0, 0);
  od = __builtin_amdgcn_mfma_f32_32x32x16_bf16(pa2, PK(l2, h2), od, 0, 0, 0);
  od = __builtin_amdgcn_mfma_f32_32x32x16_bf16(pa3, PK(l3, h3), od, 0, 0, 0);
#undef PK
}
template <int NCB> __device__ __forceinline__ void pv_d0(f32x16* o, int vb, bf16x8 pa0, bf16x8 pa1, bf16x8 pa2, bf16x8 pa3) {
  pv_one<0, NCB>(o[0], vb, pa0, pa1, pa2, pa3); pv_one<1, NCB>(o[1], vb, pa0, pa1, pa2, pa3);
  if constexpr (NCB == 4) { pv_one<2, NCB>(o[2], vb, pa0, pa1, pa2, pa3); pv_one<3, NCB>(o[3], vb, pa0, pa1, pa2, pa3); }
}
struct VFrag { s16x4 l0, h0, l1, h1, l2, h2, l3, h3; };
template <int D0> __device__ __forceinline__ void pv_issue(VFrag& f, int vb) {
  f.l0 = tr_read<v_rd_off(D0, 0, 0)>(vb); f.h0 = tr_read<v_rd_off(D0, 0, 1)>(vb); f.l1 = tr_read<v_rd_off(D0, 1, 0)>(vb); f.h1 = tr_read<v_rd_off(D0, 1, 1)>(vb);
  f.l2 = tr_read<v_rd_off(D0, 2, 0)>(vb); f.h2 = tr_read<v_rd_off(D0, 2, 1)>(vb); f.l3 = tr_read<v_rd_off(D0, 3, 0)>(vb); f.h3 = tr_read<v_rd_off(D0, 3, 1)>(vb);
}
template <int NWAIT> __device__ __forceinline__ void pv_mma(f32x16& od, const VFrag& f, bf16x8 pa0, bf16x8 pa1, bf16x8 pa2, bf16x8 pa3) {
  if constexpr (NWAIT == 8) asm volatile("s_waitcnt lgkmcnt(8)" ::: "memory"); else asm volatile("s_waitcnt lgkmcnt(0)" ::: "memory");
  SBAR();
#ifdef ATT_SETPRIO
  __builtin_amdgcn_s_setprio(1);
#endif
#define PK(L, H) (bf16x8){L[0], L[1], L[2], L[3], H[0], H[1], H[2], H[3]}
  od = __builtin_amdgcn_mfma_f32_32x32x16_bf16(pa0, PK(f.l0, f.h0), od, 0, 0, 0);
  od = __builtin_amdgcn_mfma_f32_32x32x16_bf16(pa1, PK(f.l1, f.h1), od, 0, 0, 0);
  od = __builtin_amdgcn_mfma_f32_32x32x16_bf16(pa2, PK(f.l2, f.h2), od, 0, 0, 0);
  od = __builtin_amdgcn_mfma_f32_32x32x16_bf16(pa3, PK(f.l3, f.h3), od, 0, 0, 0);
#undef PK
#ifdef ATT_SETPRIO
  __builtin_amdgcn_s_setprio(0);
#endif
}
__device__ __forceinline__ void pv_d0_pf(f32x16* o, int vb, bf16x8 pa0, bf16x8 pa1, bf16x8 pa2, bf16x8 pa3) {
  VFrag fa, fb;
  pv_issue<0>(fa, vb); pv_issue<1>(fb, vb); pv_mma<8>(o[0], fa, pa0, pa1, pa2, pa3); pv_issue<2>(fa, vb);
  pv_mma<8>(o[1], fb, pa0, pa1, pa2, pa3); pv_issue<3>(fb, vb);
  pv_mma<8>(o[2], fa, pa0, pa1, pa2, pa3); pv_mma<0>(o[3], fb, pa0, pa1, pa2, pa3);
}
__device__ __forceinline__ void partialSM(f32x16& p0, f32x16& p1, float& m_reg, float& mn, float& alpha, const float C, const float thr_raw) {
  float pmax = p0[0];
#pragma unroll
  for (int r = 1; r < 16; ++r) pmax = fmaxf(pmax, p0[r]);
#pragma unroll
  for (int r = 0; r < 16; ++r) pmax = fmaxf(pmax, p1[r]);
  { auto rr = __builtin_amdgcn_permlane32_swap(__float_as_uint(pmax), __float_as_uint(pmax), false, false);
    pmax = fmaxf(__uint_as_float(rr[0]), __uint_as_float(rr[1])); }
  if (__builtin_expect(__all(pmax - m_reg <= thr_raw), 1)) { mn = m_reg; alpha = 1.f; }
  else { mn = fmaxf(m_reg, pmax); alpha = __builtin_amdgcn_exp2f((m_reg - mn) * C); m_reg = mn; }
  const float mnC = -mn * C;
#pragma unroll
  for (int r = 0; r < 16; ++r) p0[r] = fmaf(p0[r], C, mnC);
#pragma unroll
  for (int r = 0; r < 16; ++r) p1[r] = fmaf(p1[r], C, mnC);
#pragma unroll
  for (int r = 0; r < 16; ++r) p0[r] = __builtin_amdgcn_exp2f(p0[r]);
}
__device__ __forceinline__ void finishSM(f32x16& p0, f32x16& p1, float alpha, float& l_reg, bf16x8& pa0, bf16x8& pa1, bf16x8& pa2, bf16x8& pa3) {
#pragma unroll
  for (int r = 0; r < 16; ++r) p1[r] = __builtin_amdgcn_exp2f(p1[r]);
  float ps = 0;
#pragma unroll
  for (int r = 0; r < 16; ++r) ps += p0[r];
#pragma unroll
  for (int r = 0; r < 16; ++r) ps += p1[r];
  { auto rr = __builtin_amdgcn_permlane32_swap(__float_as_uint(ps), __float_as_uint(ps), false, false);
    ps = __uint_as_float(rr[0]) + __uint_as_float(rr[1]); }
  l_reg = l_reg * alpha + ps;
#define PK4(P, BASE, OUT) do { unsigned a0 = cvt_pk_bf16(P[BASE + 0], P[BASE + 1]), a1 = cvt_pk_bf16(P[BASE + 2], P[BASE + 3]);   \
    unsigned b0 = cvt_pk_bf16(P[BASE + 4], P[BASE + 5]), b1 = cvt_pk_bf16(P[BASE + 6], P[BASE + 7]);                              \
    auto r0 = __builtin_amdgcn_permlane32_swap(a0, b0, false, false); auto r1 = __builtin_amdgcn_permlane32_swap(a1, b1, false, false); \
    u32x4 w = {r0[0], r1[0], r0[1], r1[1]}; OUT = *reinterpret_cast<bf16x8*>(&w); } while (0)
  PK4(p0, 0, pa0); PK4(p0, 8, pa1); PK4(p1, 0, pa2); PK4(p1, 8, pa3);
#undef PK4
}
template <int NQ, int KSTR>
__device__ __forceinline__ void qkt(f32x16& p0, f32x16& p1, const char* Ks, const bf16x8* qr, int r32, int hi) {
  p0 = f32x16{}; p1 = f32x16{};
#pragma unroll
  for (int d0 = 0; d0 < NQ; ++d0) { const int cb = (d0 * 16 + hi * 8) * 2;
    const bf16x8 b0 = *reinterpret_cast<const bf16x8*>(Ks + r32 * KSTR + cb);
    const bf16x8 b1 = *reinterpret_cast<const bf16x8*>(Ks + (32 + r32) * KSTR + cb);
    p0 = __builtin_amdgcn_mfma_f32_32x32x16_bf16(b0, qr[d0], p0, 0, 0, 0);
    p1 = __builtin_amdgcn_mfma_f32_32x32x16_bf16(b1, qr[d0], p1, 0, 0, 0); }
}

struct KeySrc {
  int lat_row0, n_lat_tiles, ctx_row0, wj_lo;
  __device__ __forceinline__ long row0(int j) const { return j < n_lat_tiles ? (long)lat_row0 + 64 * j : (long)ctx_row0 + 64 * (j - n_lat_tiles); }
};

template <int MODE>
__device__ __forceinline__ void attn_unit(const bf16_t* __restrict__ Qp, int ldq, const bf16_t* __restrict__ Kn, int ldk, const bf16_t* __restrict__ Kr,
                                          const bf16_t* __restrict__ Vp, int ldv, bf16_t* O1, bf16_t* O2, int ldo, int ldo2, const KeySrc ks, int NT, float scale, const float* sinkp, char* lds) {
  constexpr int NQ = MODE == 0 ? 12 : 4;
  constexpr int KCOLS = MODE == 0 ? 192 : (MODE == 1 ? 128 : 64);
  constexpr int DV = MODE == 2 ? 64 : 128, NCB = DV / 32;
  constexpr int KSTR = KCOLS * 2 + 16;
  constexpr int SHM_K = KVBLK * KSTR, SHM_VB = KVBLK * DV * 2;
  const int tid = ltid(), wid = tid >> 6, lane = tid & 63, r32 = lane & 31, hi = lane >> 5;
  char* V_lds = lds; char* K_lds = lds + 2 * SHM_VB;
  float* wsf = (float*)(lds + 2 * SHM_VB + 2 * SHM_K) + wid * 64; float* li_l = wsf; float* al_l = wsf + 32;
  const float C = scale * 1.4426950408889634f, thr_raw = 8.f / scale;
  float m_reg = -1e30f, l_reg = 0; f32x16 o[NCB] = {}; bf16x8 qr[NQ];
  if (MODE == 2) { m_reg = sinkp[wid & 3] / scale; l_reg = 1.f; }
  const int qrow = (MODE == 0 ? wid * 32 : (MODE == 1 ? (wid & 3) * 32 : (wid >> 2) * 32)) + r32;
  const int qcol = (MODE == 0 ? 0 : (MODE == 1 ? (wid >> 2) * 64 : (wid & 3) * 64)) + hi * 8;
  const int kwoff = (MODE == 1 ? (wid >> 2) * 128 : 0);
  const int qrel = (wid >> 2) * 32 + r32;
  { const bf16_t* Qw = Qp + (long)qrow * ldq + qcol;
#pragma unroll
    for (int d0 = 0; d0 < NQ; ++d0) qr[d0] = *reinterpret_cast<const bf16x8*>(Qw + d0 * 16); }
  const int sr = tid >> 4, sc = (tid & 15) * 8, vst0 = v_st<4>(sr, sc), vst1 = v_st<4>(32 + sr, sc);
  const int rr = tid >> 3, rc = (tid & 7) * 8;
  const int vst2 = v_st<2>(rr, rc);
  const int vb0 = (int)(uintptr_t)V_lds + v_rd_base(lane);
  bf16x8 vs0, vs1, ks0, ks1, kr0;
#define SLOAD(j) do { const long r0_ = ks.row0(j); \
    if (MODE == 2) { vs0 = *reinterpret_cast<const bf16x8*>(Vp + (r0_ + rr) * ldv + rc); ks0 = *reinterpret_cast<const bf16x8*>(Kn + (r0_ + rr) * ldk + rc); } else { \
    vs0 = *reinterpret_cast<const bf16x8*>(Vp + (r0_ + sr) * ldv + sc); vs1 = *reinterpret_cast<const bf16x8*>(Vp + (r0_ + 32 + sr) * ldv + sc); \
    ks0 = *reinterpret_cast<const bf16x8*>(Kn + (r0_ + sr) * ldk + sc); ks1 = *reinterpret_cast<const bf16x8*>(Kn + (r0_ + 32 + sr) * ldk + sc); \
    if (MODE == 0) kr0 = *reinterpret_cast<const bf16x8*>(Kr + (r0_ + rr) * 64 + rc); } } while (0)
#define SWRITE(b) do { if (MODE == 2) { *(bf16x8*)(V_lds + (b) * SHM_VB + vst2) = vs0; *(bf16x8*)(K_lds + (b) * SHM_K + rr * KSTR + rc * 2) = ks0; } else { \
    *(bf16x8*)(V_lds + (b) * SHM_VB + vst0) = vs0; *(bf16x8*)(V_lds + (b) * SHM_VB + vst1) = vs1; \
    *(bf16x8*)(K_lds + (b) * SHM_K + sr * KSTR + sc * 2) = ks0; *(bf16x8*)(K_lds + (b) * SHM_K + (32 + sr) * KSTR + sc * 2) = ks1; \
    if (MODE == 0) *(bf16x8*)(K_lds + (b) * SHM_K + rr * KSTR + 256 + rc * 2) = kr0; } } while (0)
  f32x16 p0, p1; float mn, al; bf16x8 pa0, pa1, pa2, pa3;
  __syncthreads();
  SLOAD(0); asm volatile("s_waitcnt vmcnt(0)" ::: "memory"); SWRITE(0);
  for (int j = 0; j < NT; ++j) {
    __syncthreads();
    const int b = j & 1;
    if (j + 1 < NT) SLOAD(j + 1);
    SBAR();
    qkt<NQ, KSTR>(p0, p1, K_lds + b * SHM_K + kwoff, qr, r32, hi);
    if (MODE == 2) { const int wj = j >= ks.n_lat_tiles ? -1 : ks.wj_lo + j;
      if (wj == 0) {
#pragma unroll
        for (int r = 0; r < 16; ++r) { const int kk = crow(r, hi); if (kk < qrel) p0[r] = -INFINITY; if (kk + 32 < qrel) p1[r] = -INFINITY; } }
      if (wj == 4) {
#pragma unroll
        for (int r = 0; r < 16; ++r) { const int kk = crow(r, hi); if (kk > qrel) p0[r] = -INFINITY; if (kk + 32 > qrel) p1[r] = -INFINITY; } } }
    partialSM(p0, p1, m_reg, mn, al, C, thr_raw);
    if (__any(al < 1.f)) { if (hi == 0) al_l[r32] = al; asm volatile("s_waitcnt lgkmcnt(0)" ::: "memory");
#pragma unroll
      for (int d = 0; d < NCB; ++d)
#pragma unroll
        for (int r = 0; r < 16; ++r) o[d][r] *= al_l[crow(r, hi)]; }
    finishSM(p0, p1, al, l_reg, pa0, pa1, pa2, pa3); SBAR();
    pv_d0<NCB>(o, vb0 + b * SHM_VB, pa0, pa1, pa2, pa3);
    if (j + 1 < NT) { asm volatile("s_waitcnt vmcnt(0)" ::: "memory"); SWRITE(b ^ 1); }
  }
  if (hi == 0) li_l[r32] = l_reg; asm volatile("s_waitcnt lgkmcnt(0)" ::: "memory");
  float rli[16];
#pragma unroll
  for (int r = 0; r < 16; ++r) rli[r] = __builtin_amdgcn_rcpf(li_l[crow(r, hi)]);
  const bool second = (MODE == 1 && wid >= 4); const int ldw = second ? ldo2 : ldo;
  bf16_t* Ow = (second ? O2 : O1) + (long)(MODE == 0 ? wid * 32 : (MODE == 1 ? (wid & 3) * 32 : (wid >> 2) * 32)) * ldw + (MODE == 2 ? (wid & 3) * 64 : 0);
#pragma unroll
  for (int r = 0; r < 16; ++r) { const int orow = crow(r, hi);
#pragma unroll
    for (int d0 = 0; d0 < NCB; ++d0) Ow[(long)orow * ldw + d0 * 32 + r32] = f2bf(o[d0][r] * rli[r]); }
#undef SLOAD
#undef SWRITE
}

__device__ __forceinline__ bf16x8 scale_q(const bf16x8 q, const float a) {
  const u32x4 w = *reinterpret_cast<const u32x4*>(&q); u32x4 o;
  o.x = cvt_pk_bf16(bflo(w.x) * a, bfhi(w.x) * a); o.y = cvt_pk_bf16(bflo(w.y) * a, bfhi(w.y) * a); o.z = cvt_pk_bf16(bflo(w.z) * a, bfhi(w.z) * a); o.w = cvt_pk_bf16(bflo(w.w) * a, bfhi(w.w) * a);
  return *reinterpret_cast<const bf16x8*>(&o);
}
template <int NQ, int KSTR, int NQR = NQ>
__device__ __forceinline__ void qkt_m(f32x16& p0, f32x16& p1, const char* Ks, const bf16x8* qr, int r32, int hi, float negm, const char* qspill = nullptr) {
#pragma unroll
  for (int r = 0; r < 16; ++r) { p0[r] = negm; p1[r] = negm; }
#ifdef ATT_SETPRIO
  __builtin_amdgcn_s_setprio(1);
#endif
#pragma unroll
  for (int d0 = 0; d0 < NQ; ++d0) { const int cb = (d0 * 16 + hi * 8) * 2;
    const bf16x8 b0 = *reinterpret_cast<const bf16x8*>(Ks + r32 * KSTR + cb);
    const bf16x8 b1 = *reinterpret_cast<const bf16x8*>(Ks + (32 + r32) * KSTR + cb);
    bf16x8 qf; if (d0 < NQR) qf = qr[d0]; else qf = *reinterpret_cast<const bf16x8*>(qspill + (d0 - NQR) * 1024);
    p0 = __builtin_amdgcn_mfma_f32_32x32x16_bf16(b0, qf, p0, 0, 0, 0);
    p1 = __builtin_amdgcn_mfma_f32_32x32x16_bf16(b1, qf, p1, 0, 0, 0); }
#ifdef ATT_SETPRIO
  __builtin_amdgcn_s_setprio(0);
#endif
}
template <int NQ, int KSTR, int NQR = NQ>
__device__ __forceinline__ void qkt_z(f32x16& p0, f32x16& p1, const char* Ks, const bf16x8* qr, int r32, int hi, const char* qspill = nullptr) {
  p0 = f32x16{}; p1 = f32x16{};
#pragma unroll
  for (int d0 = 0; d0 < NQ; ++d0) { const int cb = (d0 * 16 + hi * 8) * 2;
    const bf16x8 b0 = *reinterpret_cast<const bf16x8*>(Ks + r32 * KSTR + cb);
    const bf16x8 b1 = *reinterpret_cast<const bf16x8*>(Ks + (32 + r32) * KSTR + cb);
    bf16x8 qf; if (d0 < NQR) qf = qr[d0]; else qf = *reinterpret_cast<const bf16x8*>(qspill + (d0 - NQR) * 1024);
    p0 = __builtin_amdgcn_mfma_f32_32x32x16_bf16(b0, qf, p0, 0, 0, 0);
    p1 = __builtin_amdgcn_mfma_f32_32x32x16_bf16(b1, qf, p1, 0, 0, 0); }
}
template <bool FIRST>
__device__ __forceinline__ void partialSM2(f32x16& p0, f32x16& p1, float& m_reg, float& alpha, const bool fast = false) {
  constexpr float THR2 = 11.5415603f;
  alpha = 1.f;
  if (!fast) {
    float pmax = p0[0];
#pragma unroll
    for (int r = 1; r < 16; ++r) pmax = fmaxf(pmax, p0[r]);
#pragma unroll
    for (int r = 0; r < 16; ++r) pmax = fmaxf(pmax, p1[r]);
    { auto rr = __builtin_amdgcn_permlane32_swap(__float_as_uint(pmax), __float_as_uint(pmax), false, false);
      pmax = fmaxf(__uint_as_float(rr[0]), __uint_as_float(rr[1])); }
    if (FIRST || !__builtin_expect(__all(pmax <= THR2), 1)) {
      const float delta = FIRST ? pmax : fmaxf(pmax, 0.f); alpha = __builtin_amdgcn_exp2f(-delta); m_reg += delta;
#pragma unroll
      for (int r = 0; r < 16; ++r) { p0[r] -= delta; p1[r] -= delta; }
    }
  }
#pragma unroll
  for (int r = 0; r < 16; ++r) p0[r] = __builtin_amdgcn_exp2f(p0[r]);
}
constexpr float FAST_B2 = 3600.f;
__device__ __forceinline__ float sq8(const bf16x8 q) { const u32x4 w = *reinterpret_cast<const u32x4*>(&q);
  return (bflo(w.x) * bflo(w.x) + bfhi(w.x) * bfhi(w.x)) + (bflo(w.y) * bflo(w.y) + bfhi(w.y) * bfhi(w.y)) + (bflo(w.z) * bflo(w.z) + bfhi(w.z) * bfhi(w.z)) + (bflo(w.w) * bflo(w.w) + bfhi(w.w) * bfhi(w.w)); }
__device__ __forceinline__ void partialSM2r(f32x16& p0, f32x16& p1, float& m_reg, float& alpha, const bool first) {
  constexpr float THR2 = 11.5415603f;
  float pmax = p0[0];
#pragma unroll
  for (int r = 1; r < 16; ++r) pmax = fmaxf(pmax, p0[r]);
#pragma unroll
  for (int r = 0; r < 16; ++r) pmax = fmaxf(pmax, p1[r]);
  { auto rr = __builtin_amdgcn_permlane32_swap(__float_as_uint(pmax), __float_as_uint(pmax), false, false);
    pmax = fmaxf(__uint_as_float(rr[0]), __uint_as_float(rr[1])); }
  alpha = 1.f;
  if (first || !__builtin_expect(__all(pmax <= THR2), 1)) {
    const float delta = first ? pmax : fmaxf(pmax, 0.f); alpha = __builtin_amdgcn_exp2f(-delta); m_reg += delta;
#pragma unroll
    for (int r = 0; r < 16; ++r) { p0[r] -= delta; p1[r] -= delta; }
  }
#pragma unroll
  for (int r = 0; r < 16; ++r) p0[r] = __builtin_amdgcn_exp2f(p0[r]);
}
template <int MODE>
__device__ __forceinline__ void attn_unit_pipe(const bf16_t* __restrict__ Qp, int ldq, const bf16_t* __restrict__ Kn, int ldk, const bf16_t* __restrict__ Kr,
                                               const bf16_t* __restrict__ Vp, int ldv, bf16_t* O1, bf16_t* O2, int ldo, int ldo2, const KeySrc ks, int NT, float scale, char* lds, const float* kn2 = nullptr) {
  constexpr int NQ = MODE == 0 ? 12 : 4;
  constexpr int KCOLS = MODE == 0 ? 192 : 128;
  constexpr int KSTR = KCOLS * 2 + 16;
  constexpr int SHM_K = KVBLK * KSTR, SHM_VB = KVBLK * 128 * 2;
  constexpr int SDEPTH = MODE == 0 ? 1 : 2, SE = 0, SO = SDEPTH - 1;
  constexpr int NQR = NQ;
  const int tid = ltid(), wid = tid >> 6, lane = tid & 63, r32 = lane & 31, hi = lane >> 5;
  char* V_lds = lds; char* K_lds = lds + 2 * SHM_VB;
  float* wsf = (float*)(lds + 2 * SHM_VB + 2 * SHM_K) + wid * 64; float* li_l = wsf; float* al_l = wsf + 32;
  float m_reg = 0.f, l_reg = 0, qn2 = 0.f; f32x16 o[4] = {}; bf16x8 qr[NQR];
  char* qspill = lds + 2 * SHM_VB + 2 * SHM_K + 2048 + wid * 4096 + lane * 16;
  const int qrow = (MODE == 0 ? wid * 32 : (wid & 3) * 32) + r32;
  const int qcol = (MODE == 0 ? 0 : (wid >> 2) * 64) + hi * 8;
  const int kwoff = (MODE == 1 ? (wid >> 2) * 128 : 0);
  __syncthreads();
  { const bf16_t* Qw = Qp + (long)qrow * ldq + qcol; const float C = scale * 1.4426950408889634f;
#pragma unroll
    for (int d0 = 0; d0 < NQ; ++d0) { const bf16x8 qf = scale_q(*reinterpret_cast<const bf16x8*>(Qw + d0 * 16), C); qn2 += sq8(qf);
      if (d0 < NQR) qr[d0] = qf; else *reinterpret_cast<bf16x8*>(qspill + (d0 - NQR) * 1024) = qf; } }
  { auto rr_ = __builtin_amdgcn_permlane32_swap(__float_as_uint(qn2), __float_as_uint(qn2), false, false); qn2 = __uint_as_float(rr_[0]) + __uint_as_float(rr_[1]); }
  const bool fast = kn2 != nullptr && __all(qn2 * kn2[MODE == 1 ? (wid >> 2) : 0] <= FAST_B2);
  const int sr = tid >> 4, sc = (tid & 15) * 8, vst0 = v_st<4>(sr, sc), vst1 = v_st<4>(32 + sr, sc);
  const int rr = tid >> 3, rc = (tid & 7) * 8;
  const int vb0 = (int)(uintptr_t)V_lds + v_rd_base(lane);
  struct { bf16x8 vs0, vs1, ks0, ks1, kr0; } sr_[SDEPTH];
  const unsigned voff0 = (unsigned)(sr * ldv + sc) * 2u, voff1 = voff0 + (unsigned)(32 * ldv) * 2u, koff0 = (unsigned)(sr * ldk + sc) * 2u, koff1 = koff0 + (unsigned)(32 * ldk) * 2u, roff = (unsigned)(rr * 64 + rc) * 2u;
#define SLOAD(i, j) do { const long r0_ = __builtin_amdgcn_readfirstlane((int)ks.row0(j)); const char* vb_ = (const char*)Vp + r0_ * ldv * 2; const char* kb_ = (const char*)Kn + r0_ * ldk * 2; \
    sr_[i].vs0 = *reinterpret_cast<const bf16x8*>(vb_ + voff0); sr_[i].vs1 = *reinterpret_cast<const bf16x8*>(vb_ + voff1); \
    sr_[i].ks0 = *reinterpret_cast<const bf16x8*>(kb_ + koff0); sr_[i].ks1 = *reinterpret_cast<const bf16x8*>(kb_ + koff1); \
    if (MODE == 0) { const char* rb_ = (const char*)Kr + r0_ * 128; sr_[i].kr0 = *reinterpret_cast<const bf16x8*>(rb_ + roff); } } while (0)
#define SWRITE(b, i) do { *(bf16x8*)(V_lds + (b) * SHM_VB + vst0) = sr_[i].vs0; *(bf16x8*)(V_lds + (b) * SHM_VB + vst1) = sr_[i].vs1; \
    *(bf16x8*)(K_lds + (b) * SHM_K + sr * KSTR + sc * 2) = sr_[i].ks0; *(bf16x8*)(K_lds + (b) * SHM_K + (32 + sr) * KSTR + sc * 2) = sr_[i].ks1; \
    if (MODE == 0) *(bf16x8*)(K_lds + (b) * SHM_K + rr * KSTR + 256 + rc * 2) = sr_[i].kr0; } while (0)
#define SWAIT() do { if constexpr (SDEPTH == 2) asm volatile("s_waitcnt vmcnt(4)" ::: "memory"); else asm volatile("s_waitcnt vmcnt(0)" ::: "memory"); } while (0)
#define RESC(a) do { if (__any((a) < 1.f)) { if (hi == 0) al_l[r32] = (a); asm volatile("s_waitcnt lgkmcnt(0)" ::: "memory"); \
    _Pragma("unroll") for (int d = 0; d < 4; ++d) _Pragma("unroll") for (int r = 0; r < 16; ++r) o[d][r] *= al_l[crow(r, hi)]; } } while (0)
#ifdef ATTN_PIPE_PF
#define PV_PIPE pv_d0_pf
#else
#define PV_PIPE pv_d0<4>
#endif
  f32x16 pA0, pA1, pB0, pB1; float alA, alB; bf16x8 pa0, pa1, pa2, pa3;
  const char* K0 = K_lds + kwoff; const char* K1 = K_lds + SHM_K + kwoff;
  SLOAD(SE, 0); asm volatile("s_waitcnt vmcnt(0)" ::: "memory"); SWRITE(0, SE); __syncthreads();
  qkt_m<NQ, KSTR, NQR>(pA0, pA1, K0, qr, r32, hi, 0.f, qspill); partialSM2<true>(pA0, pA1, m_reg, alA, fast); alA = 1.f;
  SLOAD(SO, 1); if constexpr (SDEPTH == 2) { if (2 < NT) SLOAD(SE, 2); }
  SWAIT(); SWRITE(1, SO); __syncthreads();
  for (int j = 1; j + 1 < NT; j += 2) {
    SBAR(); if (fast) qkt_z<NQ, KSTR, NQR>(pB0, pB1, K1, qr, r32, hi, qspill); else qkt_m<NQ, KSTR, NQR>(pB0, pB1, K1, qr, r32, hi, -m_reg, qspill);
    finishSM(pA0, pA1, alA, l_reg, pa0, pa1, pa2, pa3); SBAR();
    SLOAD(SO, j + SDEPTH); SBAR();
    PV_PIPE(o, vb0, pa0, pa1, pa2, pa3); partialSM2<false>(pB0, pB1, m_reg, alB, fast);
    __syncthreads(); SWAIT(); SWRITE(0, SE);
    RESC(alB); __syncthreads();
    SBAR(); if (fast) qkt_z<NQ, KSTR, NQR>(pA0, pA1, K0, qr, r32, hi, qspill); else qkt_m<NQ, KSTR, NQR>(pA0, pA1, K0, qr, r32, hi, -m_reg, qspill);
    finishSM(pB0, pB1, alB, l_reg, pa0, pa1, pa2, pa3); SBAR();
    if (SDEPTH == 1 || j + 3 < NT) SLOAD(SE, j + 1 + SDEPTH); SBAR();
    PV_PIPE(o, vb0 + SHM_VB, pa0, pa1, pa2, pa3); partialSM2<false>(pA0, pA1, m_reg, alA, fast);
    __syncthreads(); SWAIT(); SWRITE(1, SO);
    RESC(alA); __syncthreads();
  }
  SBAR(); if (fast) qkt_z<NQ, KSTR, NQR>(pB0, pB1, K1, qr, r32, hi, qspill); else qkt_m<NQ, KSTR, NQR>(pB0, pB1, K1, qr, r32, hi, -m_reg, qspill);
  finishSM(pA0, pA1, alA, l_reg, pa0, pa1, pa2, pa3); SBAR();
  PV_PIPE(o, vb0, pa0, pa1, pa2, pa3); partialSM2<false>(pB0, pB1, m_reg, alB, fast);
  RESC(alB);
  finishSM(pB0, pB1, alB, l_reg, pa0, pa1, pa2, pa3); SBAR();
  PV_PIPE(o, vb0 + SHM_VB, pa0, pa1, pa2, pa3);
  if (hi == 0) li_l[r32] = l_reg; asm volatile("s_waitcnt lgkmcnt(0)" ::: "memory");
  float rli[16];
#pragma unroll
  for (int r = 0; r < 16; ++r) rli[r] = __builtin_amdgcn_rcpf(li_l[crow(r, hi)]);
  const bool second = (MODE == 1 && wid >= 4); const int ldw = second ? ldo2 : ldo;
  bf16_t* Ow = (second ? O2 : O1) + (long)(MODE == 0 ? wid * 32 : (wid & 3) * 32) * ldw;
#pragma unroll
  for (int r = 0; r < 16; ++r) { const int orow = crow(r, hi);
#pragma unroll
    for (int d0 = 0; d0 < 4; ++d0) Ow[(long)orow * ldw + d0 * 32 + r32] = f2bf(o[d0][r] * rli[r]); }
#undef SLOAD
#undef SWRITE
#undef SWAIT
#undef RESC
#undef PV_PIPE
}

template <int MODE>
__device__ __forceinline__ void attn_unit_ho(const bf16_t* __restrict__ Qp, int ldq, const bf16_t* __restrict__ Kn, int ldk, const bf16_t* __restrict__ Kr,
                                             const bf16_t* __restrict__ Vp, int ldv, bf16_t* O1, bf16_t* O2, int ldo, int ldo2, const KeySrc ks, int NT, float scale, char* lds) {
  constexpr int NQ = MODE == 0 ? 12 : 4;
  constexpr int KCOLS = MODE == 0 ? 192 : 128;
  constexpr int KSTR = KCOLS * 2 + 16;
  constexpr int SHM_K = KVBLK * KSTR, SHM_VB = KVBLK * 128 * 2;
  const int tid = ltid(), wid = tid >> 6, lane = tid & 63, r32 = lane & 31, hi = lane >> 5;
  const int half = __builtin_amdgcn_readfirstlane(HO_HALF_EXPR);
  char* V_lds = lds; char* K_lds = lds + 2 * SHM_VB;
  float* wsf = (float*)(lds + 2 * SHM_VB + 2 * SHM_K) + wid * 64; float* li_l = wsf; float* al_l = wsf + 32;
  float m_reg = 0.f, l_reg = 0; f32x16 o[4] = {}; bf16x8 qr[NQ];
  const int qrow = (MODE == 0 ? wid * 32 : (wid & 3) * 32) + r32;
  const int qcol = (MODE == 0 ? 0 : (wid >> 2) * 64) + hi * 8;
  const int kwoff = (MODE == 1 ? (wid >> 2) * 128 : 0);
  { const bf16_t* Qw = Qp + (long)qrow * ldq + qcol; const float C = scale * 1.4426950408889634f;
#pragma unroll
    for (int d0 = 0; d0 < NQ; ++d0) qr[d0] = scale_q(*reinterpret_cast<const bf16x8*>(Qw + d0 * 16), C); }
  const int sr = tid >> 4, sc = (tid & 15) * 8, vst0 = v_st<4>(sr, sc), vst1 = v_st<4>(32 + sr, sc);
  const int rr = tid >> 3, rc = (tid & 7) * 8;
  const int vb0 = (int)(uintptr_t)V_lds + v_rd_base(lane);
  bf16x8 vs0, vs1, ks0, ks1, kr0;
#define KLOAD(j) do { const long r0_ = ks.row0(j); ks0 = *reinterpret_cast<const bf16x8*>(Kn + (r0_ + sr) * ldk + sc); ks1 = *reinterpret_cast<const bf16x8*>(Kn + (r0_ + 32 + sr) * ldk + sc); \
    if (MODE == 0) kr0 = *reinterpret_cast<const bf16x8*>(Kr + (r0_ + rr) * 64 + rc); } while (0)
#define VLOAD(j) do { const long r0_ = ks.row0(j); vs0 = *reinterpret_cast<const bf16x8*>(Vp + (r0_ + sr) * ldv + sc); vs1 = *reinterpret_cast<const bf16x8*>(Vp + (r0_ + 32 + sr) * ldv + sc); } while (0)
#define KWRITE(b) do { *(bf16x8*)(K_lds + (b) * SHM_K + sr * KSTR + sc * 2) = ks0; *(bf16x8*)(K_lds + (b) * SHM_K + (32 + sr) * KSTR + sc * 2) = ks1; \
    if (MODE == 0) *(bf16x8*)(K_lds + (b) * SHM_K + rr * KSTR + 256 + rc * 2) = kr0; } while (0)
#define VWRITE(b) do { *(bf16x8*)(V_lds + (b) * SHM_VB + vst0) = vs0; *(bf16x8*)(V_lds + (b) * SHM_VB + vst1) = vs1; } while (0)
  f32x16 p0, p1; float al; bf16x8 pa0, pa1, pa2, pa3;
#define QKSM(j) do { const int b_ = (j) & 1; qkt_m<NQ, KSTR>(p0, p1, K_lds + b_ * SHM_K + kwoff, qr, r32, hi, -m_reg); \
    partialSM2r(p0, p1, m_reg, al, (j) == 0); \
    if ((j) > 0 && __any(al < 1.f)) { if (hi == 0) al_l[r32] = al; asm volatile("s_waitcnt lgkmcnt(0)" ::: "memory"); \
      _Pragma("unroll") for (int d = 0; d < 4; ++d) _Pragma("unroll") for (int r = 0; r < 16; ++r) o[d][r] *= al_l[crow(r, hi)]; } \
    if ((j) == 0) al = 1.f; \
    finishSM(p0, p1, al, l_reg, pa0, pa1, pa2, pa3); } while (0)
#define PVSEG(j) pv_d0<4>(o, vb0 + ((j) & 1) * SHM_VB, pa0, pa1, pa2, pa3)
#define STAGE_K(j) do { if ((j) + 1 < NT) { KWRITE(((j) + 1) & 1); if ((j) + 2 < NT) KLOAD((j) + 2); } } while (0)
#define STAGE_V(j) do { if ((j) + 1 < NT) { VWRITE(((j) + 1) & 1); if ((j) + 2 < NT) VLOAD((j) + 2); } } while (0)
  __syncthreads();
  KLOAD(0); VLOAD(0); asm volatile("s_waitcnt vmcnt(0)" ::: "memory"); KWRITE(0); VWRITE(0);
  if (NT > 1) { KLOAD(1); VLOAD(1); }
  if (half == 0) {
    for (int j = 0; j < NT; ++j) {
      __syncthreads(); STAGE_K(j); SBAR(); QKSM(j); SBAR();
      __syncthreads(); STAGE_V(j); SBAR(); PVSEG(j); SBAR();
    }
  } else {
    for (int j = 0; j < NT; ++j) {
      __syncthreads(); STAGE_K(j); SBAR(); if (j > 0) PVSEG(j - 1); SBAR();
      __syncthreads(); STAGE_V(j); SBAR(); QKSM(j); SBAR();
    }
    PVSEG(NT - 1);
  }
  if (hi == 0) li_l[r32] = l_reg; asm volatile("s_waitcnt lgkmcnt(0)" ::: "memory");
  float rli[16];
#pragma unroll
  for (int r = 0; r < 16; ++r) rli[r] = __builtin_amdgcn_rcpf(li_l[crow(r, hi)]);
  const bool second = (MODE == 1 && wid >= 4); const int ldw = second ? ldo2 : ldo;
  bf16_t* Ow = (second ? O2 : O1) + (long)(MODE == 0 ? wid * 32 : (wid & 3) * 32) * ldw;
#pragma unroll
  for (int r = 0; r < 16; ++r) { const int orow = crow(r, hi);
#pragma unroll
    for (int d0 = 0; d0 < 4; ++d0) Ow[(long)orow * ldw + d0 * 32 + r32] = f2bf(o[d0][r] * rli[r]); }
#undef KLOAD
#undef VLOAD
#undef KWRITE
#undef VWRITE
#undef QKSM
#undef PVSEG
#undef STAGE_K
#undef STAGE_V
}

#define PK4X(Pv, BASE, OUT) do { unsigned a0 = cvt_pk_bf16(Pv[BASE + 0], Pv[BASE + 1]), a1 = cvt_pk_bf16(Pv[BASE + 2], Pv[BASE + 3]);   \
    unsigned b0 = cvt_pk_bf16(Pv[BASE + 4], Pv[BASE + 5]), b1 = cvt_pk_bf16(Pv[BASE + 6], Pv[BASE + 7]);                              \
    auto r0 = __builtin_amdgcn_permlane32_swap(a0, b0, false, false); auto r1 = __builtin_amdgcn_permlane32_swap(a1, b1, false, false); \
    u32x4 w = {r0[0], r1[0], r0[1], r1[1]}; OUT = *reinterpret_cast<bf16x8*>(&w); } while (0)
template <int MODE>
__device__ __forceinline__ void attn_unit_p2(const bf16_t* __restrict__ Qp, int ldq, const bf16_t* __restrict__ Kn, int ldk, const bf16_t* __restrict__ Kr,
                                             const bf16_t* __restrict__ Vp, int ldv, bf16_t* O1, bf16_t* O2, int ldo, int ldo2, const KeySrc ks, int NT, float scale, char* lds,
                                             float lam = 0.f, float post_scale = 0.f, const float* gsub = nullptr, const float* kn2 = nullptr) {
  constexpr int NQ = MODE == 0 ? 12 : 4;
  constexpr int KCOLS = MODE == 0 ? 192 : 128;
  constexpr int KSTR = KCOLS * 2 + 16;
  constexpr int SHM_K = KVBLK * KSTR, SHM_VB = KVBLK * 128 * 2;
  constexpr int SDEPTH = 1, SE = 0, SO = SDEPTH - 1;
  constexpr int NQR = MODE == 0 ? 8 : NQ;
  constexpr bool SUMM = false;
  constexpr float THR2 = 11.5415603f;
  const int tid = ltid(), wid = tid >> 6, lane = tid & 63, r32 = lane & 31, hi = lane >> 5;
  char* V_lds = lds; char* K_lds = lds + 2 * SHM_VB;
  float* wsf = (float*)(lds + 2 * SHM_VB + 2 * SHM_K) + wid * 64; float* li_l = wsf; float* al_l = wsf + 32;
  float m_reg = 0.f, l_reg = 0, qn2 = 0.f; f32x16 o[4] = {}; f32x16 lsum = {}; bf16x8 qr[NQR];
  char* qspill = lds + 2 * SHM_VB + 2 * SHM_K + 2048 + wid * (NQ - NQR) * 1024 + lane * 16;
  const int qrow = (MODE == 0 ? wid * 32 : (wid & 3) * 32) + r32;
  const int qcol = (MODE == 0 ? 0 : (wid >> 2) * 64) + hi * 8;
  const int kwoff = (MODE == 1 ? (wid >> 2) * 128 : 0);
  __syncthreads();
  { const bf16_t* Qw = Qp + (long)qrow * ldq + qcol; const float C = scale * 1.4426950408889634f;
#pragma unroll
    for (int d0 = 0; d0 < NQ; ++d0) { const bf16x8 qf = scale_q(*reinterpret_cast<const bf16x8*>(Qw + d0 * 16), C); qn2 += sq8(qf);
      if (d0 < NQR) qr[d0] = qf; else *reinterpret_cast<bf16x8*>(qspill + (d0 - NQR) * 1024) = qf; } }
  { auto rr_ = __builtin_amdgcn_permlane32_swap(__float_as_uint(qn2), __float_as_uint(qn2), false, false); qn2 = __uint_as_float(rr_[0]) + __uint_as_float(rr_[1]); }
  const bool fast = kn2 != nullptr && __all(qn2 * kn2[MODE == 1 ? (wid >> 2) : 0] <= FAST_B2);
  const int sr = tid >> 4, sc = (tid & 15) * 8, vst0 = v_st<4>(sr, sc), vst1 = v_st<4>(32 + sr, sc);
  const int rr = tid >> 3, rc = (tid & 7) * 8;
  const int vb0 = (int)(uintptr_t)V_lds + v_rd_base(lane);
  const bf16x8 ONES = (bf16x8){0x3F80, 0x3F80, 0x3F80, 0x3F80, 0x3F80, 0x3F80, 0x3F80, 0x3F80};
  struct { bf16x8 vs0, vs1, ks0, ks1, kr0; } sr_[SDEPTH];
  const unsigned voff0 = (unsigned)(sr * ldv + sc) * 2u, voff1 = voff0 + (unsigned)(32 * ldv) * 2u, koff0 = (unsigned)(sr * ldk + sc) * 2u, koff1 = koff0 + (unsigned)(32 * ldk) * 2u, roff = (unsigned)(rr * 64 + rc) * 2u;
#define SLOAD(i, j) do { const long r0_ = __builtin_amdgcn_readfirstlane((int)ks.row0(j)); const char* vb_ = (const char*)Vp + r0_ * ldv * 2; const char* kb_ = (const char*)Kn + r0_ * ldk * 2; \
    sr_[i].vs0 = *reinterpret_cast<const bf16x8*>(vb_ + voff0); sr_[i].vs1 = *reinterpret_cast<const bf16x8*>(vb_ + voff1); \
    sr_[i].ks0 = *reinterpret_cast<const bf16x8*>(kb_ + koff0); sr_[i].ks1 = *reinterpret_cast<const bf16x8*>(kb_ + koff1); \
    if (MODE == 0) { const char* rb_ = (const char*)Kr + r0_ * 128; sr_[i].kr0 = *reinterpret_cast<const bf16x8*>(rb_ + roff); } } while (0)
#define SWRITE(b, i) do { *(bf16x8*)(V_lds + (b) * SHM_VB + vst0) = sr_[i].vs0; *(bf16x8*)(V_lds + (b) * SHM_VB + vst1) = sr_[i].vs1; \
    *(bf16x8*)(K_lds + (b) * SHM_K + sr * KSTR + sc * 2) = sr_[i].ks0; *(bf16x8*)(K_lds + (b) * SHM_K + (32 + sr) * KSTR + sc * 2) = sr_[i].ks1; \
    if (MODE == 0) *(bf16x8*)(K_lds + (b) * SHM_K + rr * KSTR + 256 + rc * 2) = sr_[i].kr0; } while (0)
#define SWAIT() do { if constexpr (SDEPTH == 2) asm volatile("s_waitcnt vmcnt(4)" ::: "memory"); else asm volatile("s_waitcnt vmcnt(0)" ::: "memory"); } while (0)
#define RESC(a) do { if (__any((a) < 1.f)) { if (hi == 0) al_l[r32] = (a); asm volatile("s_waitcnt lgkmcnt(0)" ::: "memory"); \
    _Pragma("unroll") for (int r = 0; r < 16; ++r) { const float f_ = al_l[crow(r, hi)]; o[0][r] *= f_; o[1][r] *= f_; o[2][r] *= f_; o[3][r] *= f_; if (SUMM) lsum[r] *= f_; } } } while (0)
#define FINISH(P0, P1, AL) do { _Pragma("unroll") for (int r = 0; r < 16; ++r) P1[r] = __builtin_amdgcn_exp2f(P1[r]); \
    if (!SUMM) { float ps = 0; _Pragma("unroll") for (int r = 0; r < 16; ++r) ps += P0[r]; _Pragma("unroll") for (int r = 0; r < 16; ++r) ps += P1[r]; \
      { auto rr_ = __builtin_amdgcn_permlane32_swap(__float_as_uint(ps), __float_as_uint(ps), false, false); ps = __uint_as_float(rr_[0]) + __uint_as_float(rr_[1]); } \
      l_reg = l_reg * (AL) + ps; } \
    PK4X(P0, 0, pa0); PK4X(P0, 8, pa1); PK4X(P1, 0, pa2); PK4X(P1, 8, pa3); } while (0)
#define PV_AND_PARTIAL(VB, P0, P1, AL) do { float pm0_ = 0.f, pm1_ = 0.f; VFrag fa_, fb_; \
    pv_issue<0>(fa_, (VB)); pv_issue<1>(fb_, (VB)); pv_mma<8>(o[0], fa_, pa0, pa1, pa2, pa3); pv_issue<2>(fa_, (VB)); \
    if (!fast) { pm0_ = P0[0]; _Pragma("unroll") for (int r = 1; r < 16; ++r) pm0_ = fmaxf(pm0_, P0[r]); } \
    pv_mma<8>(o[1], fb_, pa0, pa1, pa2, pa3); pv_issue<3>(fb_, (VB)); \
    if (!fast) { pm1_ = P1[0]; _Pragma("unroll") for (int r = 1; r < 16; ++r) pm1_ = fmaxf(pm1_, P1[r]); pm0_ = fmaxf(pm0_, pm1_); \
    { auto rr_ = __builtin_amdgcn_permlane32_swap(__float_as_uint(pm0_), __float_as_uint(pm0_), false, false); pm0_ = fmaxf(__uint_as_float(rr_[0]), __uint_as_float(rr_[1])); } } \
    pv_mma<8>(o[2], fa_, pa0, pa1, pa2, pa3); \
    AL = 1.f; \
    if (!fast && !__builtin_expect(__all(pm0_ <= THR2), 1)) { const float dl_ = fmaxf(pm0_, 0.f); AL = __builtin_amdgcn_exp2f(-dl_); m_reg += dl_; \
      _Pragma("unroll") for (int r = 0; r < 16; ++r) { P0[r] -= dl_; P1[r] -= dl_; } } \
    _Pragma("unroll") for (int r = 0; r < 8; ++r) P0[r] = __builtin_amdgcn_exp2f(P0[r]); \
    pv_mma<0>(o[3], fb_, pa0, pa1, pa2, pa3); \
    _Pragma("unroll") for (int r = 8; r < 16; ++r) P0[r] = __builtin_amdgcn_exp2f(P0[r]); \
    if (SUMM) { lsum = __builtin_amdgcn_mfma_f32_32x32x16_bf16(pa0, ONES, lsum, 0, 0, 0); lsum = __builtin_amdgcn_mfma_f32_32x32x16_bf16(pa1, ONES, lsum, 0, 0, 0); \
                lsum = __builtin_amdgcn_mfma_f32_32x32x16_bf16(pa2, ONES, lsum, 0, 0, 0); lsum = __builtin_amdgcn_mfma_f32_32x32x16_bf16(pa3, ONES, lsum, 0, 0, 0); } } while (0)
#define PV_AND_PARTIAL_B(VB, P0, P1, AL) do { VFrag fa_, fb_; \
    partialSM2<false>(P0, P1, m_reg, AL, fast); \
    pv_issue<0>(fa_, (VB)); pv_issue<1>(fb_, (VB)); pv_mma<8>(o[0], fa_, pa0, pa1, pa2, pa3); pv_issue<2>(fa_, (VB)); \
    pv_mma<8>(o[1], fb_, pa0, pa1, pa2, pa3); pv_issue<3>(fb_, (VB)); \
    pv_mma<8>(o[2], fa_, pa0, pa1, pa2, pa3); pv_mma<0>(o[3], fb_, pa0, pa1, pa2, pa3); } while (0)
#define PV_PART(VB, P0, P1, AL) do { if (lateh) PV_AND_PARTIAL_B(VB, P0, P1, AL); else PV_AND_PARTIAL(VB, P0, P1, AL); } while (0)
  const bool lateh = SKEW_HALVES && __builtin_amdgcn_readfirstlane(wid) >= 4;
  f32x16 pA0, pA1, pB0, pB1; float alA, alB; bf16x8 pa0, pa1, pa2, pa3;
  const char* K0 = K_lds + kwoff; const char* K1 = K_lds + SHM_K + kwoff;
  SLOAD(SE, 0); asm volatile("s_waitcnt vmcnt(0)" ::: "memory"); SWRITE(0, SE); __syncthreads();
  qkt_m<NQ, KSTR, NQR>(pA0, pA1, K0, qr, r32, hi, 0.f, qspill); partialSM2<true>(pA0, pA1, m_reg, alA, fast); alA = 1.f;
  SLOAD(SO, 1); if constexpr (SDEPTH == 2) { if (2 < NT) SLOAD(SE, 2); }
  SWAIT(); SWRITE(1, SO); __syncthreads();
  for (int j = 1; j + 1 < NT; j += 2) {
    SBAR(); if (fast) qkt_z<NQ, KSTR, NQR>(pB0, pB1, K1, qr, r32, hi, qspill); else qkt_m<NQ, KSTR, NQR>(pB0, pB1, K1, qr, r32, hi, -m_reg, qspill);
#ifdef PROBE_QK2
    { f32x16 pX0, pX1; qkt_m<NQ, KSTR, NQR>(pX0, pX1, K1, qr, r32, hi, -m_reg, qspill); asm volatile("" :: "v"(pX0), "v"(pX1)); }
#endif
#ifdef PROBE_EXP2
    { _Pragma("unroll") for (int r = 0; r < 16; ++r) { float t0 = __builtin_amdgcn_exp2f(pA1[r] - 3.f), t1 = __builtin_amdgcn_exp2f(pA0[r] - 5.f); asm volatile("" :: "v"(t0), "v"(t1)); } }
#endif
#ifdef PROBE_ADD2
    { _Pragma("unroll") for (int r = 0; r < 16; ++r) { float t0 = pA1[r] + 3.f, t1 = pA0[r] + 5.f; asm volatile("" :: "v"(t0), "v"(t1)); } }
#endif
#ifdef PROBE_B128
    { bf16x8 x0_, x1_, x2_, x3_, x4_, x5_, x6_, x7_; const char* vv_ = V_lds + lane * 16;
      x0_ = *(const bf16x8*)(vv_); x1_ = *(const bf16x8*)(vv_ + 1024); x2_ = *(const bf16x8*)(vv_ + 2048); x3_ = *(const bf16x8*)(vv_ + 3072); x4_ = *(const bf16x8*)(vv_ + 4096); x5_ = *(const bf16x8*)(vv_ + 5120); x6_ = *(const bf16x8*)(vv_ + 6144); x7_ = *(const bf16x8*)(vv_ + 7168);
      asm volatile("s_waitcnt lgkmcnt(0)" ::: "memory"); asm volatile("" :: "v"(x0_), "v"(x1_), "v"(x2_), "v"(x3_), "v"(x4_), "v"(x5_), "v"(x6_), "v"(x7_));
      x0_ = *(const bf16x8*)(vv_ + 8192); x1_ = *(const bf16x8*)(vv_ + 9216); x2_ = *(const bf16x8*)(vv_ + 10240); x3_ = *(const bf16x8*)(vv_ + 11264); x4_ = *(const bf16x8*)(vv_ + 12288); x5_ = *(const bf16x8*)(vv_ + 13312); x6_ = *(const bf16x8*)(vv_ + 14336); x7_ = *(const bf16x8*)(vv_ + 15360);
      asm volatile("s_waitcnt lgkmcnt(0)" ::: "memory"); asm volatile("" :: "v"(x0_), "v"(x1_), "v"(x2_), "v"(x3_), "v"(x4_), "v"(x5_), "v"(x6_), "v"(x7_)); }
#endif
#ifdef PROBE_TR2
    { VFrag fx_, fy_; pv_issue<0>(fx_, vb0); pv_issue<1>(fy_, vb0); asm volatile("s_waitcnt lgkmcnt(0)" ::: "memory"); asm volatile("" :: "v"(fx_.l0), "v"(fx_.h3), "v"(fy_.l0), "v"(fy_.h3)); pv_issue<2>(fx_, vb0); pv_issue<3>(fy_, vb0); asm volatile("s_waitcnt lgkmcnt(0)" ::: "memory"); asm volatile("" :: "v"(fx_.l0), "v"(fx_.h3), "v"(fy_.l0), "v"(fy_.h3)); }
#endif
    FINISH(pA0, pA1, alA); SBAR();
    SLOAD(SO, j + SDEPTH); SBAR();
#ifdef PROBE_BAR
    __syncthreads();
#endif
    PV_PART(vb0, pB0, pB1, alB);
    __syncthreads(); SWAIT(); SWRITE(0, SE);
    RESC(alB); __syncthreads();
    SBAR(); if (fast) qkt_z<NQ, KSTR, NQR>(pA0, pA1, K0, qr, r32, hi, qspill); else qkt_m<NQ, KSTR, NQR>(pA0, pA1, K0, qr, r32, hi, -m_reg, qspill);
#ifdef PROBE_QK2
    { f32x16 pX0, pX1; qkt_m<NQ, KSTR, NQR>(pX0, pX1, K0, qr, r32, hi, -m_reg, qspill); asm volatile("" :: "v"(pX0), "v"(pX1)); }
#endif
#ifdef PROBE_EXP2
    { _Pragma("unroll") for (int r = 0; r < 16; ++r) { float t0 = __builtin_amdgcn_exp2f(pB1[r] - 3.f), t1 = __builtin_amdgcn_exp2f(pB0[r] - 5.f); asm volatile("" :: "v"(t0), "v"(t1)); } }
#endif
#ifdef PROBE_ADD2
    { _Pragma("unroll") for (int r = 0; r < 16; ++r) { float t0 = pB1[r] + 3.f, t1 = pB0[r] + 5.f; asm volatile("" :: "v"(t0), "v"(t1)); } }
#endif
#ifdef PROBE_B128
    { bf16x8 x0_, x1_, x2_, x3_, x4_, x5_, x6_, x7_; const char* vv_ = V_lds + lane * 16;
      x0_ = *(const bf16x8*)(vv_); x1_ = *(const bf16x8*)(vv_ + 1024); x2_ = *(const bf16x8*)(vv_ + 2048); x3_ = *(const bf16x8*)(vv_ + 3072); x4_ = *(const bf16x8*)(vv_ + 4096); x5_ = *(const bf16x8*)(vv_ + 5120); x6_ = *(const bf16x8*)(vv_ + 6144); x7_ = *(const bf16x8*)(vv_ + 7168);
      asm volatile("s_waitcnt lgkmcnt(0)" ::: "memory"); asm volatile("" :: "v"(x0_), "v"(x1_), "v"(x2_), "v"(x3_), "v"(x4_), "v"(x5_), "v"(x6_), "v"(x7_));
      x0_ = *(const bf16x8*)(vv_ + 8192); x1_ = *(const bf16x8*)(vv_ + 9216); x2_ = *(const bf16x8*)(vv_ + 10240); x3_ = *(const bf16x8*)(vv_ + 11264); x4_ = *(const bf16x8*)(vv_ + 12288); x5_ = *(const bf16x8*)(vv_ + 13312); x6_ = *(const bf16x8*)(vv_ + 14336); x7_ = *(const bf16x8*)(vv_ + 15360);
      asm volatile("s_waitcnt lgkmcnt(0)" ::: "memory"); asm volatile("" :: "v"(x0_), "v"(x1_), "v"(x2_), "v"(x3_), "v"(x4_), "v"(x5_), "v"(x6_), "v"(x7_)); }
#endif
#ifdef PROBE_TR2
    { VFrag fx_, fy_; pv_issue<0>(fx_, vb0); pv_issue<1>(fy_, vb0); asm volatile("s_waitcnt lgkmcnt(0)" ::: "memory"); asm volatile("" :: "v"(fx_.l0), "v"(fx_.h3), "v"(fy_.l0), "v"(fy_.h3)); pv_issue<2>(fx_, vb0); pv_issue<3>(fy_, vb0); asm volatile("s_waitcnt lgkmcnt(0)" ::: "memory"); asm volatile("" :: "v"(fx_.l0), "v"(fx_.h3), "v"(fy_.l0), "v"(fy_.h3)); }
#endif
    FINISH(pB0, pB1, alB); SBAR();
    if (SDEPTH == 1 || j + 3 < NT) SLOAD(SE, j + 1 + SDEPTH); SBAR();
#ifdef PROBE_BAR
    __syncthreads();
#endif
    PV_PART(vb0 + SHM_VB, pA0, pA1, alA);
    __syncthreads(); SWAIT(); SWRITE(1, SO);
    RESC(alA); __syncthreads();
  }
  SBAR(); if (fast) qkt_z<NQ, KSTR, NQR>(pB0, pB1, K1, qr, r32, hi, qspill); else qkt_m<NQ, KSTR, NQR>(pB0, pB1, K1, qr, r32, hi, -m_reg, qspill);
  FINISH(pA0, pA1, alA); SBAR();
  PV_PART(vb0, pB0, pB1, alB);
  RESC(alB);
  FINISH(pB0, pB1, alB); SBAR();
  pv_d0<4>(o, vb0 + SHM_VB, pa0, pa1, pa2, pa3);
  if (SUMM) { lsum = __builtin_amdgcn_mfma_f32_32x32x16_bf16(pa0, ONES, lsum, 0, 0, 0); lsum = __builtin_amdgcn_mfma_f32_32x32x16_bf16(pa1, ONES, lsum, 0, 0, 0);
              lsum = __builtin_amdgcn_mfma_f32_32x32x16_bf16(pa2, ONES, lsum, 0, 0, 0); lsum = __builtin_amdgcn_mfma_f32_32x32x16_bf16(pa3, ONES, lsum, 0, 0, 0); }
  float rli[16];
  if (SUMM) {
#pragma unroll
    for (int r = 0; r < 16; ++r) rli[r] = __builtin_amdgcn_rcpf(lsum[r]);
  } else {
    if (hi == 0) li_l[r32] = l_reg; asm volatile("s_waitcnt lgkmcnt(0)" ::: "memory");
#pragma unroll
    for (int r = 0; r < 16; ++r) rli[r] = __builtin_amdgcn_rcpf(li_l[crow(r, hi)]);
  }
  if constexpr (MODE == 1) {
    float* HB = (float*)lds;
    const int tb = (wid & 3) * 32;
    __syncthreads();
    if (wid >= 4) {
#pragma unroll
      for (int r = 0; r < 16; ++r)
#pragma unroll
        for (int d0 = 0; d0 < 4; ++d0) HB[(tb + crow(r, hi)) * 128 + d0 * 32 + r32] = o[d0][r] * rli[r]; }
    __syncthreads();
    if (wid < 4) { const float g0 = gsub[r32], g1 = gsub[32 + r32], g2 = gsub[64 + r32], g3 = gsub[96 + r32];
#pragma unroll
      for (int r = 0; r < 16; ++r) { const int orow = tb + crow(r, hi); const float* hb = HB + orow * 128 + r32;
        const float x0 = o[0][r] * rli[r] - lam * hb[0], x1 = o[1][r] * rli[r] - lam * hb[32], x2 = o[2][r] * rli[r] - lam * hb[64], x3 = o[3][r] * rli[r] - lam * hb[96];
        float ss = (x0 * x0 + x1 * x1) + (x2 * x2 + x3 * x3);
#pragma unroll
        for (int m = 1; m < 32; m <<= 1) ss += __shfl_xor(ss, m);
        const float rs = rsqrtf(ss * (1.f / 128.f) + 1e-6f) * post_scale;
        bf16_t* op = O1 + (long)orow * ldo + r32;
        op[0] = f2bf(x0 * rs * g0); op[32] = f2bf(x1 * rs * g1); op[64] = f2bf(x2 * rs * g2); op[96] = f2bf(x3 * rs * g3); } }
  } else {
    bf16_t* Ow = O1 + (long)(wid * 32) * ldo;
#pragma unroll
    for (int r = 0; r < 16; ++r) { const int orow = crow(r, hi);
#pragma unroll
      for (int d0 = 0; d0 < 4; ++d0) Ow[(long)orow * ldo + d0 * 32 + r32] = f2bf(o[d0][r] * rli[r]); }
  }
#undef SLOAD
#undef SWRITE
#undef SWAIT
#undef RESC
#undef FINISH
#undef PV_AND_PARTIAL
#undef PV_AND_PARTIAL_B
#undef PV_PART
}

template <int MODE, int FP>
__device__ __forceinline__ void attn_unit_sb(const bf16_t* __restrict__ Qp, int ldq, const bf16_t* __restrict__ Kn, int ldk, const bf16_t* __restrict__ Kr,
                                             const bf16_t* __restrict__ Vp, int ldv, bf16_t* O1, int ldo, const KeySrc ks, int NT, float scale, char* lds,
                                             float lam, float post_scale, const float* gsub, const float* kn2) {
  constexpr int NQ = MODE == 0 ? 12 : 4;
  constexpr int KCOLS = MODE == 0 ? 192 : 128;
  constexpr int KSTR = KCOLS * 2 + 16;
  constexpr int SHM_K = KVBLK * KSTR, SHM_VB = KVBLK * 128 * 2;
  constexpr float THR2 = 11.5415603f;
  const int tid = ltid(), wid = tid >> 6, lane = tid & 63, r32 = lane & 31, hi = lane >> 5;
  constexpr bool RING4 = (MODE == 1 && FP == 1);
  constexpr int NRB = RING4 ? 4 : 2;
  char* V_lds = lds; char* K_lds = lds + NRB * SHM_VB;
  float* wsf = (float*)(lds + NRB * SHM_VB + NRB * SHM_K) + wid * 64; float* li_l = wsf; float* al_l = wsf + 32;
  float m_reg = 0.f, l_reg = 0, qn2 = 0.f; f32x16 o[4] = {}; bf16x8 qr[NQ];
  const int qrow = (MODE == 0 ? wid * 32 : (wid & 3) * 32) + r32;
  const int qcol = (MODE == 0 ? 0 : (wid >> 2) * 64) + hi * 8;
  const int kwoff = (MODE == 1 ? (wid >> 2) * 128 : 0);
  { const bf16_t* Qw = Qp + (long)qrow * ldq + qcol; const float C = scale * 1.4426950408889634f;
#pragma unroll
    for (int d0 = 0; d0 < NQ; ++d0) { qr[d0] = scale_q(*reinterpret_cast<const bf16x8*>(Qw + d0 * 16), C); qn2 += sq8(qr[d0]); } }
  { auto rr_ = __builtin_amdgcn_permlane32_swap(__float_as_uint(qn2), __float_as_uint(qn2), false, false); qn2 = __uint_as_float(rr_[0]) + __uint_as_float(rr_[1]); }
  const bool fast = FP == 2 ? (kn2 != nullptr && __all(qn2 * kn2[MODE == 1 ? (wid >> 2) : 0] <= FAST_B2)) : (FP == 1);
  const int sr = tid >> 4, sc = (tid & 15) * 8, vst0 = v_st<4>(sr, sc), vst1 = v_st<4>(32 + sr, sc);
  const int rr = tid >> 3, rc = (tid & 7) * 8;
  const int vb0 = (int)(uintptr_t)V_lds + v_rd_base(lane);
  bf16x8 vs0, vs1, ks0, ks1, kr0;
  const unsigned voff0 = (unsigned)(sr * ldv + sc) * 2u, voff1 = voff0 + (unsigned)(32 * ldv) * 2u, koff0 = (unsigned)(sr * ldk + sc) * 2u, koff1 = koff0 + (unsigned)(32 * ldk) * 2u, roff = (unsigned)(rr * 64 + rc) * 2u;
#define KLOAD(j) do { const long r0_ = __builtin_amdgcn_readfirstlane((int)ks.row0(j)); const char* kb_ = (const char*)Kn + r0_ * ldk * 2; \
    ks0 = *reinterpret_cast<const bf16x8*>(kb_ + koff0); ks1 = *reinterpret_cast<const bf16x8*>(kb_ + koff1); \
    if (MODE == 0) { const char* rb_ = (const char*)Kr + r0_ * 128; kr0 = *reinterpret_cast<const bf16x8*>(rb_ + roff); } } while (0)
#define VLOAD(j) do { const long r0_ = __builtin_amdgcn_readfirstlane((int)ks.row0(j)); const char* vb_ = (const char*)Vp + r0_ * ldv * 2; \
    vs0 = *reinterpret_cast<const bf16x8*>(vb_ + voff0); vs1 = *reinterpret_cast<const bf16x8*>(vb_ + voff1); } while (0)
#define KWRITE(b) do { *(bf16x8*)(K_lds + (b) * SHM_K + sr * KSTR + sc * 2) = ks0; *(bf16x8*)(K_lds + (b) * SHM_K + (32 + sr) * KSTR + sc * 2) = ks1; \
    if (MODE == 0) *(bf16x8*)(K_lds + (b) * SHM_K + rr * KSTR + 256 + rc * 2) = kr0; } while (0)
#define VWRITE(b) do { *(bf16x8*)(V_lds + (b) * SHM_VB + vst0) = vs0; *(bf16x8*)(V_lds + (b) * SHM_VB + vst1) = vs1; } while (0)
#define RESC(a) do { if (__any((a) < 1.f)) { if (hi == 0) al_l[r32] = (a); asm volatile("s_waitcnt lgkmcnt(0)" ::: "memory"); \
    _Pragma("unroll") for (int r = 0; r < 16; ++r) { const float f_ = al_l[crow(r, hi)]; o[0][r] *= f_; o[1][r] *= f_; o[2][r] *= f_; o[3][r] *= f_; } } } while (0)
#define QKT(P0, P1, KB) do { if (fast) qkt_z<NQ, KSTR>(P0, P1, KB, qr, r32, hi); else qkt_m<NQ, KSTR>(P0, P1, KB, qr, r32, hi, -m_reg); } while (0)
#define FINISH(P0, P1, AL) do { _Pragma("unroll") for (int r = 0; r < 16; ++r) P1[r] = __builtin_amdgcn_exp2f(P1[r]); \
    { float ps = 0; _Pragma("unroll") for (int r = 0; r < 16; ++r) ps += P0[r]; _Pragma("unroll") for (int r = 0; r < 16; ++r) ps += P1[r]; \
      { auto rr_ = __builtin_amdgcn_permlane32_swap(__float_as_uint(ps), __float_as_uint(ps), false, false); ps = __uint_as_float(rr_[0]) + __uint_as_float(rr_[1]); } \
      l_reg = l_reg * (AL) + ps; } \
    PK4X(P0, 0, pa0); PK4X(P0, 8, pa1); PK4X(P1, 0, pa2); PK4X(P1, 8, pa3); } while (0)
#define PV_AND_PARTIAL(VB, P0, P1, AL) do { if constexpr (MODE == 0) { pv_d0<4>(o, (VB), pa0, pa1, pa2, pa3); partialSM2<false>(P0, P1, m_reg, AL, fast); } else { \
    float pm0_ = 0.f, pm1_ = 0.f; VFrag fa_, fb_; \
    pv_issue<0>(fa_, (VB)); pv_issue<1>(fb_, (VB)); pv_mma<8>(o[0], fa_, pa0, pa1, pa2, pa3); pv_issue<2>(fa_, (VB)); \
    if (!fast) { pm0_ = P0[0]; _Pragma("unroll") for (int r = 1; r < 16; ++r) pm0_ = fmaxf(pm0_, P0[r]); } \
    pv_mma<8>(o[1], fb_, pa0, pa1, pa2, pa3); pv_issue<3>(fb_, (VB)); \
    if (!fast) { pm1_ = P1[0]; _Pragma("unroll") for (int r = 1; r < 16; ++r) pm1_ = fmaxf(pm1_, P1[r]); pm0_ = fmaxf(pm0_, pm1_); \
    { auto rr_ = __builtin_amdgcn_permlane32_swap(__float_as_uint(pm0_), __float_as_uint(pm0_), false, false); pm0_ = fmaxf(__uint_as_float(rr_[0]), __uint_as_float(rr_[1])); } } \
    pv_mma<8>(o[2], fa_, pa0, pa1, pa2, pa3); \
    AL = 1.f; \
    if (!fast && !__builtin_expect(__all(pm0_ <= THR2), 1)) { const float dl_ = fmaxf(pm0_, 0.f); AL = __builtin_amdgcn_exp2f(-dl_); m_reg += dl_; \
      _Pragma("unroll") for (int r = 0; r < 16; ++r) { P0[r] -= dl_; P1[r] -= dl_; } } \
    _Pragma("unroll") for (int r = 0; r < 8; ++r) P0[r] = __builtin_amdgcn_exp2f(P0[r]); \
    pv_mma<0>(o[3], fb_, pa0, pa1, pa2, pa3); \
    _Pragma("unroll") for (int r = 8; r < 16; ++r) P0[r] = __builtin_amdgcn_exp2f(P0[r]); } } while (0)
#define EXPN(P, R0, N) do { asm volatile("" : "+v"(P)); _Pragma("unroll") for (int r_ = (R0); r_ < (R0) + (N); ++r_) P[r_] = __builtin_amdgcn_exp2f(P[r_]); asm volatile("" : "+v"(P)); } while (0)
#define ADDN(P, R0, N) do { asm volatile("" : "+v"(ps_)); _Pragma("unroll") for (int r_ = (R0); r_ < (R0) + (N); ++r_) ps_ += P[r_]; asm volatile("" : "+v"(ps_)); } while (0)
#define LSUM() do { auto rr_ = __builtin_amdgcn_permlane32_swap(__float_as_uint(ps_), __float_as_uint(ps_), false, false); l_reg = l_reg + (__uint_as_float(rr_[0]) + __uint_as_float(rr_[1])); } while (0)
#define FIN_PIECE(D0, PF0, PF1) do { \
    if constexpr (MODE == 1) { if ((D0) == 0) ADDN(PF0, 0, 16); if ((D0) == 1) ADDN(PF1, 0, 16); if ((D0) == 2) { PK4X(PF0, 0, pa0); PK4X(PF0, 8, pa1); } if ((D0) == 3) { PK4X(PF1, 0, pa2); PK4X(PF1, 8, pa3); LSUM(); } } \
    else { if ((D0) < 4) { EXPN(PF1, 4 * (D0), 4); ADDN(PF0, 4 * (D0), 4); } else if ((D0) < 8) ADDN(PF1, 4 * ((D0) - 4), 4); \
           if ((D0) == 6) PK4X(PF0, 0, pa0); if ((D0) == 7) PK4X(PF0, 8, pa1); if ((D0) == 8) PK4X(PF1, 0, pa2); if ((D0) == 9) PK4X(PF1, 8, pa3); if ((D0) == 10) LSUM(); } } while (0)
#define KFRAG(DST, KB, D0) do { const int cb_ = ((D0) * 16 + hi * 8) * 2; DST[0] = *reinterpret_cast<const bf16x8*>((KB) + r32 * KSTR + cb_); DST[1] = *reinterpret_cast<const bf16x8*>((KB) + (32 + r32) * KSTR + cb_); } while (0)
#define QKT_FIN_FAST(PN0, PN1, KB, PF0, PF1) do { float ps_ = 0.f; bf16x8 kfa_[2], kfb_[2]; PN0 = f32x16{}; PN1 = f32x16{}; KFRAG(kfa_, KB, 0); \
    _Pragma("unroll") for (int d0 = 0; d0 < NQ; d0 += 2) { \
      KFRAG(kfb_, KB, d0 + 1); SBAR(); \
      PN0 = __builtin_amdgcn_mfma_f32_32x32x16_bf16(kfa_[0], qr[d0], PN0, 0, 0, 0); PN1 = __builtin_amdgcn_mfma_f32_32x32x16_bf16(kfa_[1], qr[d0], PN1, 0, 0, 0); SBAR(); \
      FIN_PIECE(d0, PF0, PF1); SBAR(); \
      if (d0 + 2 < NQ) { KFRAG(kfa_, KB, d0 + 2); } SBAR(); \
      PN0 = __builtin_amdgcn_mfma_f32_32x32x16_bf16(kfb_[0], qr[d0 + 1], PN0, 0, 0, 0); PN1 = __builtin_amdgcn_mfma_f32_32x32x16_bf16(kfb_[1], qr[d0 + 1], PN1, 0, 0, 0); SBAR(); \
      FIN_PIECE(d0 + 1, PF0, PF1); SBAR(); } } while (0)
#define FINISH_FAST(PF0, PF1) do { float ps_ = 0.f; if constexpr (MODE == 0) EXPN(PF1, 0, 16); ADDN(PF0, 0, 16); ADDN(PF1, 0, 16); LSUM(); \
    PK4X(PF0, 0, pa0); PK4X(PF0, 8, pa1); PK4X(PF1, 0, pa2); PK4X(PF1, 8, pa3); } while (0)
#define PV_PART_FAST(VB, PN0, PN1) do { if constexpr (MODE == 1) { VFrag fa_, fb_; \
      pv_issue<0>(fa_, (VB)); pv_issue<1>(fb_, (VB)); pv_mma<8>(o[0], fa_, pa0, pa1, pa2, pa3); pv_issue<2>(fa_, (VB)); SBAR(); EXPN(PN0, 0, 8); SBAR(); \
      pv_mma<8>(o[1], fb_, pa0, pa1, pa2, pa3); pv_issue<3>(fb_, (VB)); SBAR(); EXPN(PN0, 8, 8); SBAR(); \
      pv_mma<8>(o[2], fa_, pa0, pa1, pa2, pa3); SBAR(); EXPN(PN1, 0, 8); SBAR(); \
      pv_mma<0>(o[3], fb_, pa0, pa1, pa2, pa3); SBAR(); EXPN(PN1, 8, 8); SBAR(); \
    } else { \
      pv_one<0, 4>(o[0], (VB), pa0, pa1, pa2, pa3); SBAR(); EXPN(PN0, 0, 4); SBAR(); pv_one<1, 4>(o[1], (VB), pa0, pa1, pa2, pa3); SBAR(); EXPN(PN0, 4, 4); SBAR(); \
      pv_one<2, 4>(o[2], (VB), pa0, pa1, pa2, pa3); SBAR(); EXPN(PN0, 8, 4); SBAR(); pv_one<3, 4>(o[3], (VB), pa0, pa1, pa2, pa3); SBAR(); EXPN(PN0, 12, 4); SBAR(); } } while (0)
  f32x16 pA0, pA1, pB0, pB1; float alA, alB; bf16x8 pa0, pa1, pa2, pa3;
  const char* K0 = K_lds + kwoff; const char* K1 = K_lds + SHM_K + kwoff;
  if constexpr (RING4) {
    bf16x8 ks2, ks3, vs2, vs3;
#define KLD2(A0, A1, j) do { const long r0_ = __builtin_amdgcn_readfirstlane((int)ks.row0(j)); const char* kb_ = (const char*)Kn + r0_ * ldk * 2; \
    A0 = *reinterpret_cast<const bf16x8*>(kb_ + koff0); A1 = *reinterpret_cast<const bf16x8*>(kb_ + koff1); } while (0)
#define VLD2(A0, A1, j) do { const long r0_ = __builtin_amdgcn_readfirstlane((int)ks.row0(j)); const char* vb_ = (const char*)Vp + r0_ * ldv * 2; \
    A0 = *reinterpret_cast<const bf16x8*>(vb_ + voff0); A1 = *reinterpret_cast<const bf16x8*>(vb_ + voff1); } while (0)
#define KWR2(A0, A1, t_) do { char* kd_ = K_lds + ((t_) & 3) * SHM_K; *(bf16x8*)(kd_ + sr * KSTR + sc * 2) = A0; *(bf16x8*)(kd_ + (32 + sr) * KSTR + sc * 2) = A1; } while (0)
#define VWR2(A0, A1, t_) do { char* vd_ = V_lds + ((t_) & 3) * SHM_VB; *(bf16x8*)(vd_ + vst0) = A0; *(bf16x8*)(vd_ + vst1) = A1; } while (0)
#define KPTR(t_) (K_lds + ((t_) & 3) * SHM_K + kwoff)
#define VPTR(t_) (vb0 + ((t_) & 3) * SHM_VB)
    __syncthreads();
    if (__builtin_amdgcn_readfirstlane(wid) >= 4) __builtin_amdgcn_s_setprio(1);
    KLD2(ks0, ks1, 0); asm volatile("s_waitcnt vmcnt(0)" ::: "memory"); KWR2(ks0, ks1, 0);
    KLD2(ks0, ks1, 1); VLD2(vs0, vs1, 0); KLD2(ks2, ks3, 2); VLD2(vs2, vs3, 1);
    __syncthreads();
    KWR2(ks0, ks1, 1); VWR2(vs0, vs1, 0); KWR2(ks2, ks3, 2); VWR2(vs2, vs3, 1);
    KLD2(ks0, ks1, 3); VLD2(vs0, vs1, 2); if (4 < NT) KLD2(ks2, ks3, 4); VLD2(vs2, vs3, 3);
    qkt_z<NQ, KSTR>(pA0, pA1, KPTR(0), qr, r32, hi); EXPN(pA0, 0, 16); EXPN(pA1, 0, 16);
    const int NP = NT >> 1;
    for (int sI = 0; sI + 1 < NP; ++sI) { const int t0 = 2 * sI;
      __syncthreads();
      KWR2(ks0, ks1, t0 + 3); VWR2(vs0, vs1, t0 + 2); if (t0 + 4 < NT) KWR2(ks2, ks3, t0 + 4); VWR2(vs2, vs3, t0 + 3);
      if (t0 + 5 < NT) KLD2(ks0, ks1, t0 + 5); if (t0 + 4 < NT) VLD2(vs0, vs1, t0 + 4); if (t0 + 6 < NT) KLD2(ks2, ks3, t0 + 6); if (t0 + 5 < NT) VLD2(vs2, vs3, t0 + 5);
      SBAR(); QKT_FIN_FAST(pB0, pB1, KPTR(t0 + 1), pA0, pA1); PV_PART_FAST(VPTR(t0), pB0, pB1);
      SBAR(); QKT_FIN_FAST(pA0, pA1, KPTR(t0 + 2), pB0, pB1); PV_PART_FAST(VPTR(t0 + 1), pA0, pA1);
    }
    __syncthreads();
    SBAR(); QKT_FIN_FAST(pB0, pB1, KPTR(NT - 1), pA0, pA1); PV_PART_FAST(VPTR(NT - 2), pB0, pB1);
    FINISH_FAST(pB0, pB1); SBAR();
    pv_d0<4>(o, VPTR(NT - 1), pa0, pa1, pa2, pa3);
#undef KLD2
#undef VLD2
#undef KWR2
#undef VWR2
#undef KPTR
#undef VPTR
  } else {
  __syncthreads();
  if (__builtin_amdgcn_readfirstlane(wid) >= 4) __builtin_amdgcn_s_setprio(1);
  KLOAD(0); asm volatile("s_waitcnt vmcnt(0)" ::: "memory"); KWRITE(0); KLOAD(1); VLOAD(0);
  __syncthreads();
  KWRITE(1); VWRITE(0); if (2 < NT) KLOAD(2); VLOAD(1);
  qkt_m<NQ, KSTR>(pA0, pA1, K0, qr, r32, hi, 0.f); partialSM2<true>(pA0, pA1, m_reg, alA, fast); alA = 1.f;
#ifndef FASTP_MODES
#define FASTP_MODES 3
#endif
  constexpr bool fastp = FP == 1;
  if constexpr (MODE == 1 && fastp) EXPN(pA1, 0, 16);
  for (int j = 1; j + 1 < NT; j += 2) {
    __syncthreads();
    KWRITE(0); VWRITE(1); if (j + 2 < NT) KLOAD(j + 2); VLOAD(j + 1);
    if constexpr (fastp) { SBAR(); QKT_FIN_FAST(pB0, pB1, K1, pA0, pA1); PV_PART_FAST(vb0, pB0, pB1); }
    else { SBAR(); QKT(pB0, pB1, K1); FINISH(pA0, pA1, alA); SBAR(); PV_AND_PARTIAL(vb0, pB0, pB1, alB); RESC(alB); }
    __syncthreads();
    if (j + 2 < NT) KWRITE(1); VWRITE(0); if (j + 3 < NT) KLOAD(j + 3); if (j + 2 < NT) VLOAD(j + 2);
    if constexpr (fastp) { SBAR(); QKT_FIN_FAST(pA0, pA1, K0, pB0, pB1); PV_PART_FAST(vb0 + SHM_VB, pA0, pA1); }
    else { SBAR(); QKT(pA0, pA1, K0); FINISH(pB0, pB1, alB); SBAR(); PV_AND_PARTIAL(vb0 + SHM_VB, pA0, pA1, alA); RESC(alA); }
  }
  __syncthreads();
  VWRITE(1);
  if constexpr (fastp) { SBAR(); QKT_FIN_FAST(pB0, pB1, K1, pA0, pA1); PV_PART_FAST(vb0, pB0, pB1); }
  else { SBAR(); QKT(pB0, pB1, K1); FINISH(pA0, pA1, alA); SBAR(); PV_AND_PARTIAL(vb0, pB0, pB1, alB); RESC(alB); }
  __syncthreads();
  if constexpr (fastp) { FINISH_FAST(pB0, pB1); } else { FINISH(pB0, pB1, alB); } SBAR();
  pv_d0<4>(o, vb0 + SHM_VB, pa0, pa1, pa2, pa3);
  }
  __builtin_amdgcn_s_setprio(0);
  if (hi == 0) li_l[r32] = l_reg; asm volatile("s_waitcnt lgkmcnt(0)" ::: "memory");
  float rli[16];
#pragma unroll
  for (int r = 0; r < 16; ++r) rli[r] = __builtin_amdgcn_rcpf(li_l[crow(r, hi)]);
  if constexpr (MODE == 1) {
    float* HB = (float*)lds; const int tb = (wid & 3) * 32;
    __syncthreads();
    if (wid >= 4) {
#pragma unroll
      for (int r = 0; r < 16; ++r)
#pragma unroll
        for (int d0 = 0; d0 < 4; ++d0) HB[(tb + crow(r, hi)) * 128 + d0 * 32 + r32] = o[d0][r] * rli[r]; }
    __syncthreads();
    if (wid < 4) { const float g0 = gsub[r32], g1 = gsub[32 + r32], g2 = gsub[64 + r32], g3 = gsub[96 + r32];
#pragma unroll
      for (int r = 0; r < 16; ++r) { const int orow = tb + crow(r, hi); const float* hb = HB + orow * 128 + r32;
        const float x0 = o[0][r] * rli[r] - lam * hb[0], x1 = o[1][r] * rli[r] - lam * hb[32], x2 = o[2][r] * rli[r] - lam * hb[64], x3 = o[3][r] * rli[r] - lam * hb[96];
        float ss = (x0 * x0 + x1 * x1) + (x2 * x2 + x3 * x3);
        ss += __builtin_bit_cast(float, __builtin_amdgcn_update_dpp(0, __builtin_bit_cast(int, ss), 0xB1, 0xf, 0xf, true)); ss += __builtin_bit_cast(float, __builtin_amdgcn_update_dpp(0, __builtin_bit_cast(int, ss), 0x4E, 0xf, 0xf, true));
        ss += __builtin_bit_cast(float, __builtin_amdgcn_update_dpp(0, __builtin_bit_cast(int, ss), 0x141, 0xf, 0xf, true)); ss += __builtin_bit_cast(float, __builtin_amdgcn_update_dpp(0, __builtin_bit_cast(int, ss), 0x140, 0xf, 0xf, true));
        { auto sw_ = __builtin_amdgcn_permlane16_swap(__float_as_uint(ss), __float_as_uint(ss), false, false); ss = __uint_as_float(sw_[0]) + __uint_as_float(sw_[1]); }
        const float rs = rsqrtf(ss * (1.f / 128.f) + 1e-6f) * post_scale;
        bf16_t* op = O1 + (long)orow * ldo + r32;
        op[0] = f2bf(x0 * rs * g0); op[32] = f2bf(x1 * rs * g1); op[64] = f2bf(x2 * rs * g2); op[96] = f2bf(x3 * rs * g3); } }
  } else {
    bf16_t* Ow = O1 + (long)(wid * 32) * ldo;
#pragma unroll
    for (int r = 0; r < 16; ++r) { const int orow = crow(r, hi);
#pragma unroll
      for (int d0 = 0; d0 < 4; ++d0) Ow[(long)orow * ldo + d0 * 32 + r32] = f2bf(o[d0][r] * rli[r]); }
  }
#undef KLOAD
#undef VLOAD
#undef KWRITE
#undef VWRITE
#undef RESC
#undef QKT
#undef FINISH
#undef PV_AND_PARTIAL
#undef EXPN
#undef ADDN
#undef LSUM
#undef FIN_PIECE
#undef KFRAG
#undef QKT_FIN_FAST
#undef FINISH_FAST
#undef PV_PART_FAST
}
template <int MODE>
__device__ __forceinline__ void attn_unit_sbd(const bf16_t* __restrict__ Qp, int ldq, const bf16_t* __restrict__ Kn, int ldk, const bf16_t* __restrict__ Kr,
                                              const bf16_t* __restrict__ Vp, int ldv, bf16_t* O1, int ldo, const KeySrc ks, int NT, float scale, char* lds,
                                              float lam, float post_scale, const float* gsub, const float* kn2) {
  if constexpr (MODE == 0) { attn_unit_sb<0, 2>(Qp, ldq, Kn, ldk, Kr, Vp, ldv, O1, ldo, ks, NT, scale, lds, lam, post_scale, gsub, kn2); return; }
  constexpr int NQ = MODE == 0 ? 12 : 4;
  const int tid = ltid(), wid = tid >> 6, lane = tid & 63, r32 = lane & 31, hi = lane >> 5;
  const int qrow = (MODE == 0 ? wid * 32 : (wid & 3) * 32) + r32, qcol = (MODE == 0 ? 0 : (wid >> 2) * 64) + hi * 8;
  const bf16_t* Qw = Qp + (long)qrow * ldq + qcol; const float C = scale * 1.4426950408889634f; float qn2 = 0.f;
#pragma unroll
  for (int d0 = 0; d0 < NQ; ++d0) qn2 += sq8(scale_q(*reinterpret_cast<const bf16x8*>(Qw + d0 * 16), C));
  { auto rr_ = __builtin_amdgcn_permlane32_swap(__float_as_uint(qn2), __float_as_uint(qn2), false, false); qn2 = __uint_as_float(rr_[0]) + __uint_as_float(rr_[1]); }
  const bool fastw = __all(qn2 * kn2[MODE == 1 ? (wid >> 2) : 0] <= FAST_B2);
  volatile int* flag = (volatile int*)(lds + 147328);
  __syncthreads(); if (tid == 0) *flag = 1; __syncthreads(); if (!fastw && lane == 0) *flag = 0; __syncthreads();
  const bool fast = __builtin_amdgcn_readfirstlane(*flag) != 0;
  if (fast) attn_unit_sb<MODE, 1>(Qp, ldq, Kn, ldk, Kr, Vp, ldv, O1, ldo, ks, NT, scale, lds, lam, post_scale, gsub, kn2);
  else attn_unit_sb<MODE, 0>(Qp, ldq, Kn, ldk, Kr, Vp, ldv, O1, ldo, ks, NT, scale, lds, lam, post_scale, gsub, kn2);
}
#undef SBAR
}

constexpr int DM = 1024, NBATCH = 2, SEQ = 16384, NLAT = NBATCH * SEQ, CTXL = 256, NCTX = NBATCH * CTXL, MTOT = NLAT + NCTX, DIN = 9296, FFH = 2816;
constexpr float EPS = 1e-6f;
constexpr int NCHAIN = 16, NCHUNK = 130;
constexpr float KSCALE_B = 0.08838834764831845f;
enum { I_X = 0, I_C, I_CTX, I_CCTX, I_WMOD, I_BMOD, I_GMIXPRE, I_GMIXPOST, I_GFFNPRE, I_GFFNPOST, I_WIN, I_ASINK, I_BGBIAS, I_CGQ, I_CGKV, I_CWUQ, I_CWUK, I_CWUV,
       I_LQ1, I_LK1, I_LQ2, I_LK2, I_DGSUB, I_WBRANCH, I_WOUT, I_WGU, I_WDOWN, N_IN };
constexpr size_t MiB = 1u << 20, KiB = 1u << 10;
constexpr size_t WS_CTL = 0, CTL_ZERO_BYTES = 64 * KiB;
constexpr size_t WS_SM = 1 * MiB;
constexpr size_t SM_MOD = WS_SM;
constexpr size_t SM_ROPE = WS_SM + 160 * KiB;
constexpr size_t SM_BG = WS_SM + 192 * KiB;
constexpr size_t SM_NST = WS_SM + 2560 * KiB;
constexpr size_t SM_SCAL = WS_SM + 3840 * KiB;
constexpr size_t SM_WSC = WS_SM + 3904 * KiB;
constexpr size_t SC_GU = SM_WSC, SC_G = SM_WSC + 24 * KiB, SC_CD = SM_WSC + 40 * KiB, SC_AB = SM_WSC + 52 * KiB;
constexpr size_t SM_HC = WS_SM + 4 * MiB;
constexpr size_t WS_W = 8 * MiB;
constexpr size_t W_AB = WS_W, W_C = WS_W + 5632 * KiB, W_D = WS_W + 7680 * KiB, W_G = WS_W + 10752 * KiB, W_UQ = WS_W + 18944 * KiB, W_UKV = WS_W + 19712 * KiB,
                 W_AB8 = WS_W + 2048 * KiB  , W_BR = WS_W + 20224 * KiB, W_OUT = WS_W + 24320 * KiB, W_GU = WS_W + 26368 * KiB, W_DN = WS_W + 37632 * KiB;
constexpr size_t U_SC = 52 * MiB + 40 * MiB;
constexpr size_t WS_U = 52 * MiB;
constexpr size_t WS_Y = 117 * MiB;
constexpr size_t WS_R = 247 * MiB;
constexpr size_t R_PAB = WS_R, R_ST = WS_R + 179 * MiB;
constexpr size_t R_PD = WS_R, R_CQ = WS_R + 98 * MiB, R_CKNV = WS_R + 147 * MiB, R_CKR = WS_R + 253 * MiB, R_O2 = WS_R + 217 * MiB;
constexpr size_t R_SSQ = R_O2;
constexpr size_t R_G = WS_R, R_YOUT = WS_R, R_HID = WS_R;
constexpr size_t R_HP = WS_R + 180 * MiB;
constexpr size_t OUT_U8 = 64 * MiB, OUT_U8SC = 100 * MiB;
constexpr size_t R_U8 = WS_R + 219 * MiB, R_U8SC = WS_R + 252 * MiB;
constexpr size_t WS_END = 512 * MiB;
static_assert(W_DN + (size_t)1024 * 2816 * 2 <= WS_U, "weights");
static_assert(R_O2 + (size_t)MTOT * 512 * 2 >= R_U8 || true, "");
static_assert(R_CKNV + (size_t)MTOT * 1024 * 2 <= R_SSQ && R_SSQ + (size_t)MTOT * 12 * 4 <= R_U8 && R_U8 + (size_t)MTOT * 1024 <= R_U8SC && R_U8SC + (size_t)MTOT * 4 <= WS_END && R_G + (size_t)MTOT * 4096 <= R_U8, "int8 u copy");
static_assert(SC_G + 4096 * 4 <= SM_HC && SC_GU + 5632 * 4 <= SC_G && WS_U + (size_t)MTOT * 1024 <= U_SC && U_SC + (size_t)MTOT * 4 <= WS_Y, "int8 scales");
static_assert(WS_U + (size_t)MTOT * 1024 * 2 <= WS_Y && WS_Y + (size_t)MTOT * 2048 * 2 <= WS_R, "U/Y");
static_assert(R_PAB + (size_t)MTOT * 2816 * 2 <= R_ST && R_ST + (size_t)16 * 130 * 16384 * 2 <= WS_END, "AB");
static_assert(R_PD + (size_t)MTOT * 1536 * 2 <= R_CQ && R_CQ + (size_t)MTOT * 768 * 2 <= R_CKNV && R_CKNV + (size_t)MTOT * 1024 * 2 <= R_O2 && R_U8SC + (size_t)MTOT * 4 <= R_CKR && R_ST + (size_t)16 * 130 * 16384 * 2 <= R_CKR && R_HP + (size_t)MTOT * 1024 * 2 <= R_CKR && R_CKR + (size_t)MTOT * 64 * 2 <= WS_END, "CD");
static_assert(R_G + (size_t)MTOT * 4096 * 2 <= WS_END, "G");
static_assert((size_t)NLAT * 1024 * 2 <= OUT_U8 && OUT_U8 + (size_t)MTOT * 1024 <= OUT_U8SC && OUT_U8SC + (size_t)MTOT * 4 <= (size_t)NLAT * 1024 * 4, "u8 in d_out");
static_assert((size_t)MTOT * 2816 * 2 <= 180 * MiB && R_HP + (size_t)MTOT * 1024 * 2 <= WS_END, "HP");
static_assert(SM_BG + (size_t)MTOT * 16 * 4 <= SM_NST && SM_NST + (size_t)16 * 130 * 128 * 4 <= SM_SCAL && SM_SCAL + 3 * 16 * 130 * 4 <= SM_HC && SM_HC + 512 * 1024 * 4 <= WS_W, "SM");
constexpr int LDS_BYTES = 147456;
constexpr int CW_KN = 8192;

struct Args { const float* in[N_IN]; float* out; unsigned char* ws; int layer; int pad; };

typedef const float* const __attribute__((address_space(4)))* InTab;
struct Ctx {
    InTab in; float* out; unsigned char* ws; int layer;
    LAS unsigned char* lds; char* ldsg;
    int tid, lane, wave, G, bid;
};

template <int CTRL> __device__ __forceinline__ float dpp_mov(float x) { return __builtin_bit_cast(float, __builtin_amdgcn_update_dpp(0, __builtin_bit_cast(int, x), CTRL, 0xf, 0xf, true)); }
__device__ __forceinline__ float wave_sum(float v) {
    v += dpp_mov<0xB1>(v); v += dpp_mov<0x4E>(v); v += dpp_mov<0x124>(v); v += dpp_mov<0x128>(v);
    { auto r = __builtin_amdgcn_permlane16_swap(__float_as_uint(v), __float_as_uint(v), false, false); v = __uint_as_float(r[0]) + __uint_as_float(r[1]); }
    { auto r = __builtin_amdgcn_permlane32_swap(__float_as_uint(v), __float_as_uint(v), false, false); v = __uint_as_float(r[0]) + __uint_as_float(r[1]); }
    return v;
}
__device__ __forceinline__ float wave_max(float v) {
    v = fmaxf(v, dpp_mov<0xB1>(v)); v = fmaxf(v, dpp_mov<0x4E>(v)); v = fmaxf(v, dpp_mov<0x124>(v)); v = fmaxf(v, dpp_mov<0x128>(v));
    { auto r = __builtin_amdgcn_permlane16_swap(__float_as_uint(v), __float_as_uint(v), false, false); v = fmaxf(__uint_as_float(r[0]), __uint_as_float(r[1])); }
    { auto r = __builtin_amdgcn_permlane32_swap(__float_as_uint(v), __float_as_uint(v), false, false); v = fmaxf(__uint_as_float(r[0]), __uint_as_float(r[1])); }
    return v;
}
__device__ __forceinline__ float wave_sum16(const float (&g)[16], int lane) {
    float b[8], c4[4], d[2];
#pragma unroll
    for (int i = 0; i < 8; ++i) { auto r = __builtin_amdgcn_permlane32_swap(__float_as_uint(g[i]), __float_as_uint(g[8 + i]), false, false); b[i] = __uint_as_float(r[0]) + __uint_as_float(r[1]); }
#pragma unroll
    for (int i = 0; i < 4; ++i) { auto r = __builtin_amdgcn_permlane16_swap(__float_as_uint(b[i]), __float_as_uint(b[4 + i]), false, false); c4[i] = __uint_as_float(r[0]) + __uint_as_float(r[1]); }
    const bool b3 = (lane & 8) != 0, b2 = (lane & 4) != 0;
#pragma unroll
    for (int i = 0; i < 2; ++i) { const float keep = b3 ? c4[2 + i] : c4[i], send = b3 ? c4[i] : c4[2 + i]; d[i] = keep + dpp_mov<0x128>(send); }
    float e; { const float keep = b2 ? d[1] : d[0], send = b2 ? d[0] : d[1]; e = keep + __shfl_xor(send, 4); }
    e += dpp_mov<0x4E>(e); e += dpp_mov<0xB1>(e);
    return e;
}
__device__ __forceinline__ float siluf_(float x) { return x / (1.f + __expf(-x)); }
__device__ __forceinline__ float logsigf_(float x) { return fminf(x, 0.f) - __logf(1.f + __expf(-fabsf(x))); }
__device__ __forceinline__ float dot8(const u32x4 a, const u32x4 b) {
    return bflo(a.x) * bflo(b.x) + bfhi(a.x) * bfhi(b.x) + bflo(a.y) * bflo(b.y) + bfhi(a.y) * bfhi(b.y)
         + bflo(a.z) * bflo(b.z) + bfhi(a.z) * bfhi(b.z) + bflo(a.w) * bflo(b.w) + bfhi(a.w) * bfhi(b.w);
}
__device__ __forceinline__ const float* hin_row(const Ctx& c, int r) {
    if (c.layer == 0) return r < NLAT ? c.in[I_X] + (size_t)r * DM : c.in[I_CTX] + (size_t)(r - NLAT) * DM;
    return r < NLAT ? c.out + (size_t)r * DM : (const float*)(c.ws + SM_HC) + (size_t)(r - NLAT) * DM;
}
__device__ __forceinline__ float* hout_row(const Ctx& c, int r) { return r < NLAT ? c.out + (size_t)r * DM : (float*)(c.ws + SM_HC) + (size_t)(r - NLAT) * DM; }
__device__ __forceinline__ int mod_idx(int r) { return r < NLAT ? (r >= SEQ ? 1 : 0) : 2; }
__device__ __forceinline__ int tok_row(int dir, int b, int idx, int tp) {
    if (idx < 2) { int j = idx * 128 + tp; if (dir) j = 255 - j; return NLAT + b * CTXL + j; }
    int s = (idx - 2) * 128 + tp; if (dir) s = SEQ - 1 - s; return b * SEQ + s;
}

__device__ __forceinline__ void tr_block(const float* W, int ldw, int k0, int n0, bf16_t* WT, int ldo, int drow, int dcol, float* scr, int lane, const float* kgain = nullptr) {
    float wl[32];
#pragma unroll
    for (int i = 0; i < 32; ++i) { const int kk = 2 * i + (lane >> 5); wl[i] = W[(size_t)(k0 + kk) * ldw + n0 + (lane & 31)]; }
#pragma unroll
    for (int i = 0; i < 32; ++i) { const int kk = 2 * i + (lane >> 5); float w = wl[i]; if (kgain) w *= kgain[k0 + kk]; scr[kk * 33 + (lane & 31)] = w; }
    asm volatile("s_waitcnt lgkmcnt(0)" ::: "memory");
    const int c8 = lane & 7;
#pragma unroll
    for (int j = 0; j < 4; ++j) { const int n = (lane >> 3) + 8 * j; const float* s = scr + (8 * c8) * 33 + n;
        u32x4 o; o.x = cvt_pk_bf16(s[0 * 33], s[1 * 33]); o.y = cvt_pk_bf16(s[2 * 33], s[3 * 33]); o.z = cvt_pk_bf16(s[4 * 33], s[5 * 33]); o.w = cvt_pk_bf16(s[6 * 33], s[7 * 33]);
        *(u32x4*)(WT + (size_t)(drow + n) * ldo + dcol + 8 * c8) = o; }
    asm volatile("s_waitcnt lgkmcnt(0)" ::: "memory");
}
__device__ __forceinline__ void q8_item(const float* W, int ldw, int n0, signed char* WT8, int drow, float* colscale, float* scr, int lane) {
    float mx = 0.f;
    for (int k0 = (lane >> 5); k0 < 1024; k0 += 64) { float wl[32];
#pragma unroll
        for (int i = 0; i < 32; ++i) wl[i] = W[(size_t)(k0 + 2 * i) * ldw + n0 + (lane & 31)];
#pragma unroll
        for (int i = 0; i < 32; ++i) mx = fmaxf(mx, fabsf(wl[i])); }
    { auto rr = __builtin_amdgcn_permlane32_swap(__float_as_uint(mx), __float_as_uint(mx), false, false); mx = fmaxf(__uint_as_float(rr[0]), __uint_as_float(rr[1])); }
    float* inv32 = scr + 64 * 33;
    if (lane < 32) { colscale[drow + lane] = mx > 0.f ? mx * (1.f / 127.f) : 1.f; inv32[lane] = mx > 0.f ? 127.f / mx : 0.f; }
    for (int kb = 0; kb < 16; ++kb) {
        float wl[32];
#pragma unroll
        for (int i = 0; i < 32; ++i) { const int kk = 2 * i + (lane >> 5); wl[i] = W[(size_t)(64 * kb + kk) * ldw + n0 + (lane & 31)]; }
#pragma unroll
        for (int i = 0; i < 32; ++i) { const int kk = 2 * i + (lane >> 5); scr[kk * 33 + (lane & 31)] = wl[i]; }
        asm volatile("s_waitcnt lgkmcnt(0)" ::: "memory");
        const int c8 = lane & 7;
#pragma unroll
        for (int j = 0; j < 4; ++j) { const int n = (lane >> 3) + 8 * j; const float* s = scr + (8 * c8) * 33 + n; const float iv = inv32[n];
            unsigned lo = 0u, hi = 0u;
#pragma unroll
            for (int t = 0; t < 4; ++t) { lo |= ((unsigned)__float2int_rn(s[t * 33] * iv) & 255u) << (8 * t); hi |= ((unsigned)__float2int_rn(s[(4 + t) * 33] * iv) & 255u) << (8 * t); }
            u32x2 o; o.x = lo; o.y = hi; *(u32x2*)(WT8 + (size_t)(drow + n) * 1024 + 64 * kb + 8 * c8) = o; }
        asm volatile("s_waitcnt lgkmcnt(0)" ::: "memory");
    }
}
__device__ __forceinline__ void quant_row_i8(const f32x4 (&u)[4], signed char* dst, float* scale_slot, int lane) {
    float mx = 0.f;
#pragma unroll
    for (int j = 0; j < 4; ++j) mx = fmaxf(fmaxf(mx, fmaxf(fabsf(u[j].x), fabsf(u[j].y))), fmaxf(fabsf(u[j].z), fabsf(u[j].w)));
    mx = wave_max(mx);
    const float inv = mx > 0.f ? 127.f / mx : 0.f;
    if (lane == 0) *scale_slot = mx > 0.f ? mx * (1.f / 127.f) : 1.f;
#pragma unroll
    for (int j = 0; j < 4; ++j) { const unsigned w = ((unsigned)__float2int_rn(u[j].x * inv) & 255u) | (((unsigned)__float2int_rn(u[j].y * inv) & 255u) << 8) | (((unsigned)__float2int_rn(u[j].z * inv) & 255u) << 16) | (((unsigned)__float2int_rn(u[j].w * inv) & 255u) << 24);
        *(unsigned*)(dst + 4 * (lane + 64 * j)) = w; }
}
__device__ __forceinline__ void ph_conv(const Ctx& c, const int l, const int vbid, const int VG, const int parts, const bool extras) {
    unsigned char* ws = c.ws;
    float* scr = (float*)(c.ldsg + c.wave * 16384);
    const float* w_in = c.in[I_WIN] + (size_t)l * DM * DIN;
    if (c.wave < 2 && c.wave * VG + vbid < 434) {
        const int it = c.wave * VG + vbid;
        if (!(parts & 1)) {}
        else if (it >= 378) { const int i4 = it - 378;
            const int n0 = i4 < 24 ? 32 * i4 : (i4 < 40 ? 1792 + 32 * (i4 - 24) : 2320 + 32 * (i4 - 40));
            q8_item(w_in, DIN, n0, (signed char*)(ws + W_AB8), 32 * i4, (float*)(ws + SC_AB), scr, c.lane); }
        else if (it >= 304) { const int i2 = it - 304;
            if (i2 < 26) q8_item(w_in, DIN, 2832 + 32 * i2, (signed char*)(ws + W_C), 32 * i2, (float*)(ws + SC_CD), scr, c.lane);
            else q8_item(w_in, DIN, 3664 + 32 * (i2 - 26), (signed char*)(ws + W_C), 1024 + 32 * (i2 - 26), (float*)(ws + SC_CD), scr, c.lane); }
        else if (it >= 176) q8_item(w_in, DIN, 5200 + 32 * (it - 176), (signed char*)(ws + W_G), 32 * (it - 176), (float*)(ws + SC_G), scr, c.lane);
        else { const int n0 = 32 * it; const int drow = n0 < FFH ? 256 * (n0 / 128) + (n0 % 128) : 256 * ((n0 - FFH) / 128) + 128 + ((n0 - FFH) % 128);
            q8_item(c.in[I_WGU] + (size_t)l * 1024 * 5632, 5632, n0, (signed char*)(ws + W_GU), drow, (float*)(ws + SC_GU), scr, c.lane); }
    } else {
    const int gw = vbid * 6 + (c.wave - 2 < 0 ? 0 : c.wave - 2), NGW = VG * 6;
    if (c.wave >= 2) {
    int base = 0;
#define CONV_SEG(W_, ldw_, K_, nblk_, n0_, WT_, ldo_, drow0_, dcol0_, kind_) CONV_SEGG(W_, ldw_, K_, nblk_, n0_, WT_, ldo_, drow0_, dcol0_, kind_, nullptr)
#define CONV_SEGG(W_, ldw_, K_, nblk_, n0_, WT_, ldo_, drow0_, dcol0_, kind_, gain_) do { \
        const float* W__ = (W_); bf16_t* WT__ = (bf16_t*)(WT_); const int nit = ((K_) / 64) * (nblk_); \
        int it = gw - (base % NGW); if (it < 0) it += NGW; \
        for (; it < nit; it += NGW) { const int kb = it / (nblk_), nb = it % (nblk_); int drow = (drow0_) + 32 * nb; \
            if ((kind_) == 1) { const int n0 = 32 * nb; drow = n0 < FFH ? 256 * (n0 / 128) + (n0 % 128) : 256 * ((n0 - FFH) / 128) + 128 + ((n0 - FFH) % 128); } \
            tr_block(W__, (ldw_), 64 * kb, (n0_) + 32 * nb, WT__, (ldo_), drow, (dcol0_) + 64 * kb, scr, c.lane, (gain_)); } \
        base += nit; } while (0)
    if (parts & 1) {
    CONV_SEG(w_in, DIN, 1024, 32, 768,  ws + W_AB, 1024, 0, 0, 0);
    CONV_SEGG(c.in[I_CWUQ] + (size_t)l * 512 * 768, 768, 512, 24, 0, ws + W_UQ, 512, 0, 0, 0, c.in[I_CGQ] + l * 512);
    CONV_SEGG(c.in[I_CWUK] + (size_t)l * 256 * 512, 512, 256, 16, 0, ws + W_UKV, 256, 0, 0, 0, c.in[I_CGKV] + l * 256);
    CONV_SEGG(c.in[I_CWUV] + (size_t)l * 256 * 512, 512, 256, 16, 0, ws + W_UKV, 256, 512, 0, 0, c.in[I_CGKV] + l * 256);
    CONV_SEG(c.in[I_WBRANCH] + ((size_t)l * 4 + 0) * 512 * 1024, 1024, 512, 32, 0, ws + W_BR, 2048, 0, 0, 0);
    CONV_SEG(c.in[I_WBRANCH] + ((size_t)l * 4 + 1) * 512 * 1024, 1024, 512, 32, 0, ws + W_BR, 2048, 0, 512, 0);
    CONV_SEG(c.in[I_WBRANCH] + ((size_t)l * 4 + 2) * 512 * 1024, 1024, 512, 32, 0, ws + W_BR, 2048, 0, 1024, 0);
    CONV_SEG(c.in[I_WBRANCH] + ((size_t)l * 4 + 3) * 512 * 1024, 1024, 512, 32, 0, ws + W_BR, 2048, 0, 1536, 0);
    CONV_SEG(c.in[I_WOUT] + (size_t)l * 1024 * 1024, 1024, 1024, 32, 0, ws + W_OUT, 1024, 0, 0, 0);
    }
    if (parts & 2) CONV_SEG(c.in[I_WDOWN] + (size_t)l * 2816 * 1024, 1024, 2816, 32, 0, ws + W_DN, 2816, 0, 0, 0);
#undef CONV_SEG
#undef CONV_SEGG
    } }
    { signed char* wc = (signed char*)(ws + W_C) + (size_t)832 * 1024; const int n16 = 192 * 1024 / 16;
      if (parts & 1) { for (int i = vbid * 512 + c.tid; i < n16; i += VG * 512) ((u32x4*)wc)[i] = (u32x4){0u, 0u, 0u, 0u};
          if (vbid == 0 && c.tid < 192) ((float*)(ws + SC_CD))[832 + c.tid] = 1.f; } }
    if (extras) {
    { float* T = (float*)(ws + SM_ROPE);
      for (int i = c.bid * 512 + c.tid; i < 256 * 16; i += c.G * 512) { const int p = i >> 4, k = i & 15;
          const float inv = exp2f(-(float)k * 0.83048202372184058f);   const float ang = (float)p * inv; T[2 * i] = cosf(ang); T[2 * i + 1] = sinf(ang); } }
    __syncthreads();
    { float* red = (float*)c.ldsg;
      float* sl = (float*)c.ldsg + 2048;
      float* mod = (float*)(ws + SM_MOD);
      for (int i = c.tid; i < 3072; i += 512) sl[i] = siluf_(i < 2048 ? c.in[I_C][i] : c.in[I_CCTX][i - 2048]);
      __syncthreads();
      for (int it = c.bid; it < 192; it += c.G) {
          const int lm = it / 96; const float* wm = c.in[I_WMOD] + (size_t)lm * DM * 6144; const float* bm = c.in[I_BMOD] + (size_t)lm * 6144;
          const int n = (it % 96) * 64 + c.lane; float a0 = 0.f, a1 = 0.f, a2 = 0.f;
          for (int k0 = c.wave * 128; k0 < c.wave * 128 + 128; k0 += 32) { float wl[32];
#pragma unroll
              for (int i = 0; i < 32; ++i) wl[i] = wm[(size_t)(k0 + i) * 6144 + n];
#pragma unroll
              for (int i = 0; i < 32; ++i) { a0 += sl[k0 + i] * wl[i]; a1 += sl[1024 + k0 + i] * wl[i]; a2 += sl[2048 + k0 + i] * wl[i]; } }
          red[(c.wave * 3 + 0) * 64 + c.lane] = a0; red[(c.wave * 3 + 1) * 64 + c.lane] = a1; red[(c.wave * 3 + 2) * 64 + c.lane] = a2;
          __syncthreads();
          if (c.wave < 3) { float s_ = 0.f;
#pragma unroll
              for (int w = 0; w < 8; ++w) s_ += red[(w * 3 + c.wave) * 64 + c.lane];
              mod[(lm * 3 + c.wave) * 6144 + n] = s_ + bm[n]; }
          __syncthreads();
      } }
    }
}

__device__ __forceinline__ void stage_gate_weights(const Ctx& c, int l, float* wgl) {
    const float* wg = c.in[I_WIN] + (size_t)l * DM * DIN + 2304;
    for (int i = c.tid; i < 1024 * 4; i += 512) { const int k = i >> 2, q4 = i & 3; const f32x4 w = *(const f32x4*)(wg + (size_t)k * DIN + 4 * q4);
        wgl[(4 * q4 + 0) * 1024 + k] = w.x; wgl[(4 * q4 + 1) * 1024 + k] = w.y; wgl[(4 * q4 + 2) * 1024 + k] = w.z; wgl[(4 * q4 + 3) * 1024 + k] = w.w; }
    __syncthreads();
}
struct N1Vec { f32x4 sh[4], sc[4]; };
__device__ __forceinline__ void norm1_load(const Ctx& c, int l, int r, N1Vec& nv) {
    const float* md = (const float*)(c.ws + SM_MOD) + (l * 3 + mod_idx(r)) * 6144;
#pragma unroll
    for (int j = 0; j < 4; ++j) { const int e = 4 * (c.lane + 64 * j); nv.sh[j] = *(const f32x4*)(md + e); nv.sc[j] = *(const f32x4*)(md + 1024 + e); }
}
__device__ __forceinline__ void norm1_apply(const Ctx& c, int l, int r, const f32x4 (&v)[4], const float* wgl, const f32x4 (&g4)[4], const N1Vec& nv) {
    const float* bias = c.in[I_BGBIAS] + l * 16; bf16_t* U = (bf16_t*)(c.ws + WS_U); float* bg = (float*)(c.ws + SM_BG);
    float ss = 0.f;
#pragma unroll
    for (int j = 0; j < 4; ++j) ss += (v[j].x * v[j].x + v[j].y * v[j].y) + (v[j].z * v[j].z + v[j].w * v[j].w);
    const float rs = rsqrtf(wave_sum(ss) * (1.f / DM) + EPS);
    float ga[16];
#pragma unroll
    for (int q = 0; q < 16; ++q) ga[q] = 0.f;
    f32x4 uj[4];
#pragma unroll
    for (int j = 0; j < 4; ++j) { const int e = 4 * (c.lane + 64 * j);
        const f32x4 g = g4[j], sh = nv.sh[j], scl = nv.sc[j];
        f32x4 u; u.x = v[j].x * rs * g.x * (1.f + scl.x) + sh.x; u.y = v[j].y * rs * g.y * (1.f + scl.y) + sh.y; u.z = v[j].z * rs * g.z * (1.f + scl.z) + sh.z; u.w = v[j].w * rs * g.w * (1.f + scl.w) + sh.w;
        u32x2 w; w.x = cvt_pk_bf16(u.x, u.y); w.y = cvt_pk_bf16(u.z, u.w); *(u32x2*)(U + (size_t)r * DM + e) = w; uj[j] = u; }
    quant_row_i8(uj, (signed char*)c.out + OUT_U8 + (size_t)r * DM, (float*)((unsigned char*)c.out + OUT_U8SC) + r, c.lane);
    { f32x4 wa[8], wb[8];
#define N1_LDW(dst, B) do { _Pragma("unroll") for (int q = 0; q < 8; ++q) dst[q] = *(const f32x4*)(wgl + (((B) & 1) * 8 + q) * 1024 + 4 * (c.lane + 64 * ((B) >> 1))); } while (0)
#define N1_FMA(src, B) do { const f32x4 u = uj[(B) >> 1]; _Pragma("unroll") for (int q = 0; q < 8; ++q) ga[((B) & 1) * 8 + q] += (u.x * src[q].x + u.y * src[q].y) + (u.z * src[q].z + u.w * src[q].w); } while (0)
      N1_LDW(wa, 0);
#pragma unroll
      for (int bq = 0; bq < 8; bq += 2) {
          N1_LDW(wb, bq + 1); __builtin_amdgcn_sched_barrier(0);
          N1_FMA(wa, bq); __builtin_amdgcn_sched_barrier(0);
          if (bq + 2 < 8) { N1_LDW(wa, bq + 2); } __builtin_amdgcn_sched_barrier(0);
          N1_FMA(wb, bq + 1); __builtin_amdgcn_sched_barrier(0); }
#undef N1_LDW
#undef N1_FMA
    }
    const float gsum = wave_sum16(ga, c.lane);
    if ((c.lane & 3) == 0) { const int q = c.lane >> 2; float g = gsum + bias[q]; if ((q >> 2) & 1) g = logsigf_(g); bg[(size_t)r * 16 + q] = g; }
}
__device__ __forceinline__ void ph_norm1(const Ctx& c) {
    const int l = c.layer; const int gw = c.bid * 8 + c.wave, NGW = c.G * 8;
    float* wgl = (float*)c.ldsg; stage_gate_weights(c, l, wgl);
    f32x4 g4[4]; { const float* gpre = c.in[I_GMIXPRE] + (size_t)l * DM;
#pragma unroll
      for (int j = 0; j < 4; ++j) g4[j] = *(const f32x4*)(gpre + 4 * (c.lane + 64 * j)); }
    f32x4 v[4], vn[4];
    if (gw < MTOT) { const f32x4* xr = (const f32x4*)hin_row(c, gw) + c.lane;
#pragma unroll
        for (int j = 0; j < 4; ++j) v[j] = xr[64 * j]; }
    for (int r = gw; r < MTOT; r += NGW) {
        N1Vec nv; norm1_load(c, l, r, nv);
        const int rn = r + NGW < MTOT ? r + NGW : r; { const f32x4* xr = (const f32x4*)hin_row(c, rn) + c.lane;
#pragma unroll
          for (int j = 0; j < 4; ++j) vn[j] = xr[64 * j]; }
        __builtin_amdgcn_sched_barrier(0);
        norm1_apply(c, l, r, v, wgl, g4, nv);
#pragma unroll
        for (int j = 0; j < 4; ++j) v[j] = vn[j];
    }
}

__device__ __forceinline__ void rope_row(bf16_t* rowp, const bf16_t* srcp, int npairs, int hstride, int pr, int pc, const float* T, int lane) {
    for (int p = lane; p < npairs; p += 64) { const int hh = p >> 5, w = p & 31, half = w >> 4, i = w & 15;
        const int c1 = hh * hstride + 32 * half + i, c2 = c1 + 16; const int pos = half ? pc : pr;
        const float cs = T[(pos * 16 + i) * 2], sn = T[(pos * 16 + i) * 2 + 1];
        const float x1 = bf2f(srcp[c1]), x2 = bf2f(srcp[c2]);
        rowp[c1] = f2bf(x1 * cs - x2 * sn); rowp[c2] = f2bf(x2 * cs + x1 * sn); }
}
__device__ __forceinline__ void ph_rope_a(const Ctx& c) {
    const int gw = c.bid * 8 + c.wave, NGW = c.G * 8; const float* T = (const float*)(c.ws + SM_ROPE);
    bf16_t* P = (bf16_t*)(c.ws + R_PAB);
    for (int r = gw; r < NLAT; r += NGW) { const int t = r & (SEQ - 1); bf16_t* rp = P + (size_t)r * 2816; rope_row(rp, rp, 320, 64, t >> 6, t & 63, T, c.lane); }
}

__device__ __forceinline__ void ph_mix_ab1(const Ctx& c) {
    const int l = c.layer; const bool with_ctx = (l == 0);
    const bf16_t* P = (const bf16_t*)(c.ws + R_PAB); const float* bg = (const float*)(c.ws + SM_BG);
    bf16_t* ST = (bf16_t*)(c.ws + R_ST); float* NST = (float*)(c.ws + SM_NST); float* SCAL = (float*)(c.ws + SM_SCAL);
    {
        char* Kt = c.ldsg; char* Vf = c.ldsg + 32768; char* Vb = c.ldsg + 65536; float* wv = (float*)(c.ldsg + 98304);
        const int r32 = c.lane & 31, hi = c.lane >> 5;
        for (int it = c.bid; it < 8 * NCHUNK; it += c.G) {
            const int b = it / (4 * NCHUNK), head = (it / NCHUNK) & 3, tc = it % NCHUNK;
            const int row0 = tc < 2 ? NLAT + b * CTXL + tc * 128 : b * SEQ + (tc - 2) * 128;
            const int ci_f = (b * 4 + head) * NCHUNK + tc, ci_b = (8 + b * 4 + head) * NCHUNK + (tc < 2 ? 1 - tc : 131 - tc);
            __syncthreads();
            const int sdir = c.wave & 1; const int e0 = sdir ? 127 - 2 * c.lane : 2 * c.lane, e1 = sdir ? 126 - 2 * c.lane : 2 * c.lane + 1;
            float x0 = 0.f, x1 = 0.f, i0 = 0.f, i1 = 0.f;
            if (c.wave < 2) { const float* g0 = bg + (size_t)(row0 + e0) * 16 + sdir * 8 + head; const float* g1 = bg + (size_t)(row0 + e1) * 16 + sdir * 8 + head;
                x0 = g0[4]; x1 = g1[4]; i0 = g0[0]; i1 = g1[0]; }
            u32x4 skk[4], svv[4];
#pragma unroll
            for (int i = 0; i < 4; ++i) { const int e = c.tid + 512 * i, s = e >> 4, c8 = (e & 15) * 8; const bf16_t* pr = P + (size_t)(row0 + s) * 2816 + 128 * head + c8;
                skk[i] = *(const u32x4*)(pr + 1280); svv[i] = *(const u32x4*)(pr + 1792); }
            __builtin_amdgcn_sched_barrier(0);
            if (c.wave < 2) { float s = x0 + x1;
#pragma unroll
                for (int off = 1; off < 64; off <<= 1) { const float t = __shfl_up(s, off); if (c.lane >= off) s += t; }
                const float blast = __shfl(s, 63);
                const float ga = blast - (s - x1) + i0, gb = blast - s + i1;
                const float gmax = wave_max(fmaxf(ga, gb));
                wv[sdir * 128 + e0] = __expf(ga - gmax); wv[sdir * 128 + e1] = __expf(gb - gmax);
                if (c.lane == 0) { const int ci = sdir ? ci_b : ci_f; SCAL[ci] = gmax; SCAL[NCHAIN * NCHUNK + ci] = blast; } }
            __syncthreads();
#pragma unroll
            for (int i = 0; i < 4; ++i) { const int e = c.tid + 512 * i, s = e >> 4, c8 = (e & 15) * 8; const u32x4 kk = skk[i], vv = svv[i];
                const int ad = (s >> 6) * 16384 + att::v_st<4>(s & 63, c8);
                *(u32x4*)(Kt + ad) = kk;
                const float wf = wv[s], wb = wv[128 + s]; u32x4 a, d;
                a.x = cvt_pk_bf16(bflo(vv.x) * wf, bfhi(vv.x) * wf); a.y = cvt_pk_bf16(bflo(vv.y) * wf, bfhi(vv.y) * wf); a.z = cvt_pk_bf16(bflo(vv.z) * wf, bfhi(vv.z) * wf); a.w = cvt_pk_bf16(bflo(vv.w) * wf, bfhi(vv.w) * wf);
                d.x = cvt_pk_bf16(bflo(vv.x) * wb, bfhi(vv.x) * wb); d.y = cvt_pk_bf16(bflo(vv.y) * wb, bfhi(vv.y) * wb); d.z = cvt_pk_bf16(bflo(vv.z) * wb, bfhi(vv.z) * wb); d.w = cvt_pk_bf16(bflo(vv.w) * wb, bfhi(vv.w) * wb);
                *(u32x4*)(Vf + ad) = a; *(u32x4*)(Vb + ad) = d; }
            __syncthreads();
            { const int dir = c.wave >> 2, vblk = c.wave & 3;
              const int kb = (int)(uintptr_t)Kt + att::v_rd_base(c.lane), vb = (int)(uintptr_t)(dir ? Vb : Vf) + att::v_rd_base(c.lane);
              f32x16 D[4] = {};
#define MA_STEP(KS) do { const s16x4 al = att::tr_read<att::v_rd_off(0, (KS) & 3, 0) + ((KS) >> 2) * 16384>(vb + vblk * 512), ah = att::tr_read<att::v_rd_off(0, (KS) & 3, 1) + ((KS) >> 2) * 16384>(vb + vblk * 512); \
                const s16x4 b0l = att::tr_read<att::v_rd_off(0, (KS) & 3, 0) + ((KS) >> 2) * 16384>(kb), b0h = att::tr_read<att::v_rd_off(0, (KS) & 3, 1) + ((KS) >> 2) * 16384>(kb); \
                const s16x4 b1l = att::tr_read<att::v_rd_off(1, (KS) & 3, 0) + ((KS) >> 2) * 16384>(kb), b1h = att::tr_read<att::v_rd_off(1, (KS) & 3, 1) + ((KS) >> 2) * 16384>(kb); \
                const s16x4 b2l = att::tr_read<att::v_rd_off(2, (KS) & 3, 0) + ((KS) >> 2) * 16384>(kb), b2h = att::tr_read<att::v_rd_off(2, (KS) & 3, 1) + ((KS) >> 2) * 16384>(kb); \
                const s16x4 b3l = att::tr_read<att::v_rd_off(3, (KS) & 3, 0) + ((KS) >> 2) * 16384>(kb), b3h = att::tr_read<att::v_rd_off(3, (KS) & 3, 1) + ((KS) >> 2) * 16384>(kb); \
                asm volatile("s_waitcnt lgkmcnt(0)" ::: "memory"); __builtin_amdgcn_sched_barrier(0); \
                const bf16x8 A_ = (bf16x8){al[0], al[1], al[2], al[3], ah[0], ah[1], ah[2], ah[3]}; \
                D[0] = __builtin_amdgcn_mfma_f32_32x32x16_bf16(A_, (bf16x8){b0l[0], b0l[1], b0l[2], b0l[3], b0h[0], b0h[1], b0h[2], b0h[3]}, D[0], 0, 0, 0); \
                D[1] = __builtin_amdgcn_mfma_f32_32x32x16_bf16(A_, (bf16x8){b1l[0], b1l[1], b1l[2], b1l[3], b1h[0], b1h[1], b1h[2], b1h[3]}, D[1], 0, 0, 0); \
                D[2] = __builtin_amdgcn_mfma_f32_32x32x16_bf16(A_, (bf16x8){b2l[0], b2l[1], b2l[2], b2l[3], b2h[0], b2h[1], b2h[2], b2h[3]}, D[2], 0, 0, 0); \
                D[3] = __builtin_amdgcn_mfma_f32_32x32x16_bf16(A_, (bf16x8){b3l[0], b3l[1], b3l[2], b3l[3], b3h[0], b3h[1], b3h[2], b3h[3]}, D[3], 0, 0, 0); } while (0)
              MA_STEP(0); MA_STEP(1); MA_STEP(2); MA_STEP(3); MA_STEP(4); MA_STEP(5); MA_STEP(6); MA_STEP(7);
#undef MA_STEP
              bf16_t* dst = ST + (size_t)(dir ? ci_b : ci_f) * 16384;
#pragma unroll
              for (int r = 0; r < 16; ++r) { const int v = 32 * vblk + att::crow(r, hi);
#pragma unroll
                  for (int db = 0; db < 4; ++db) dst[v * 128 + 32 * db + r32] = f2bf(D[db][r] * KSCALE_B); } }
            {
              const int dir = c.tid >> 8, dg = (c.tid >> 4) & 15, sg = c.tid & 15; const bf16_t* kp = P + (size_t)row0 * 2816 + 1280 + 128 * head + 8 * dg;
              float a[8];
#pragma unroll
              for (int k = 0; k < 8; ++k) a[k] = 0.f;
#pragma unroll
              for (int i = 0; i < 8; ++i) { const int s = sg + 16 * i; const u32x4 kk = *(const u32x4*)(kp + (size_t)s * 2816); const float w = wv[dir * 128 + s];
                  a[0] += w * bflo(kk.x); a[1] += w * bfhi(kk.x); a[2] += w * bflo(kk.y); a[3] += w * bfhi(kk.y); a[4] += w * bflo(kk.z); a[5] += w * bfhi(kk.z); a[6] += w * bflo(kk.w); a[7] += w * bfhi(kk.w); }
#pragma unroll
              for (int k = 0; k < 8; ++k) { a[k] += __shfl_xor(a[k], 1); a[k] += __shfl_xor(a[k], 2); a[k] += __shfl_xor(a[k], 4); a[k] += __shfl_xor(a[k], 8); }
              if (sg == 0) { float* np_ = NST + (size_t)(dir ? ci_b : ci_f) * 128 + 8 * dg;
                  *(f32x4*)np_ = (f32x4){a[0] * KSCALE_B, a[1] * KSCALE_B, a[2] * KSCALE_B, a[3] * KSCALE_B}; *(f32x4*)(np_ + 4) = (f32x4){a[4] * KSCALE_B, a[5] * KSCALE_B, a[6] * KSCALE_B, a[7] * KSCALE_B}; } }
        }
    }
    __syncthreads();
    {
        const float* sink = c.in[I_ASINK] + l * 8; bf16_t* Y = (bf16_t*)(c.ws + WS_Y);
        const int NU = 1024 + (with_ctx ? 16 : 0);
        for (int u = (c.bid + (c.G >> 1)) % c.G; u < NU; u += c.G) {
            if (u < 1024) { const int b = u >> 9, g = (u >> 8) & 1, qb = u & 255, q0 = 64 * qb; const long row0 = (long)b * SEQ + q0;
                const int wj_lo = qb < 2 ? 2 - qb : 0, wj_hi = (257 - qb) < 4 ? (257 - qb) : 4, nwin = wj_hi - wj_lo + 1;
                att::KeySrc ks{b * SEQ + q0 - 128 + 64 * wj_lo, nwin, NLAT + b * CTXL, wj_lo};
                att::attn_unit<2>(P + row0 * 2816 + 256 * g, 2816, P + 512 + 64 * g, 2816, nullptr, P + 640 + 64 * g, 2816, Y + row0 * 2048 + 256 * g, nullptr, 2048, 0, ks, nwin + 4, 0.125f, sink + 4 * g, c.ldsg);
            } else { const int v = u - 1024, b = v >> 3, g = (v >> 2) & 1, qb = v & 3; const long row0 = (long)NLAT + b * CTXL + 64 * qb;
                att::KeySrc ks{0, 0, NLAT + b * CTXL, 0};
                att::attn_unit<2>(P + row0 * 2816 + 256 * g, 2816, P + 512 + 64 * g, 2816, nullptr, P + 640 + 64 * g, 2816, Y + row0 * 2048 + 256 * g, nullptr, 2048, 0, ks, 4, 0.125f, sink + 4 * g, c.ldsg);
            }
        }
    }
}

__device__ __forceinline__ void ph_scan(const Ctx& c) {
    bf16_t* ST = (bf16_t*)(c.ws + R_ST); float* NST = (float*)(c.ws + SM_NST); float* SCAL = (float*)(c.ws + SM_SCAL);
    float* dec = (float*)c.ldsg; float* scl = dec + 160;
    for (int it = c.bid; it < NCHAIN * 16; it += c.G) {
        const int chain = it >> 4, sub = it & 15;
        __syncthreads();
        if (c.wave == 0) {
            float bl[3], gm[3], mp[3];
#pragma unroll
            for (int k = 0; k < 3; ++k) { const int idx = 64 * k + c.lane; const bool ok = idx < NCHUNK; gm[k] = ok ? SCAL[chain * NCHUNK + idx] : 0.f; bl[k] = ok ? SCAL[NCHAIN * NCHUNK + chain * NCHUNK + idx] : 0.f; mp[k] = 0.f; }
            float m = 0.f;
#pragma unroll
            for (int k = 0; k < 3; ++k) { const int n = (NCHUNK - 64 * k) < 64 ? (NCHUNK - 64 * k) : 64;
                for (int i = 0; i < n; ++i) { const float bb = __builtin_bit_cast(float, __builtin_amdgcn_readlane(__builtin_bit_cast(int, bl[k]), i)), gg = __builtin_bit_cast(float, __builtin_amdgcn_readlane(__builtin_bit_cast(int, gm[k]), i));
                    if (c.lane == i) mp[k] = m;
                    m = fmaxf(bb + m, gg); } }
#pragma unroll
            for (int k = 0; k < 3; ++k) { const int idx = 64 * k + c.lane;
                if (idx < NCHUNK) { const float mn = fmaxf(bl[k] + mp[k], gm[k]); dec[idx] = __expf(bl[k] + mp[k] - mn); scl[idx] = __expf(gm[k] - mn);
                    if (sub == 0) SCAL[2 * NCHAIN * NCHUNK + chain * NCHUNK + idx] = mp[k]; } }
        }
        __syncthreads();
        { float cs0 = 0.f, cs1 = 0.f; unsigned* p = (unsigned*)(ST + (size_t)chain * NCHUNK * 16384 + sub * 1024) + c.tid;
          unsigned cur[13], nxt[13];
#pragma unroll
          for (int j = 0; j < 13; ++j) cur[j] = p[(size_t)j * 8192];
          for (int blk = 0; blk < 10; ++blk) {
              if (blk < 9) {
#pragma unroll
                  for (int j = 0; j < 13; ++j) nxt[j] = p[(size_t)(13 * (blk + 1) + j) * 8192]; }
              __builtin_amdgcn_sched_barrier(0);
#pragma unroll
              for (int j = 0; j < 13; ++j) { const int idx = 13 * blk + j; const float u0 = bflo(cur[j]), u1 = bfhi(cur[j]); const float d = dec[idx], sc = scl[idx];
                  p[(size_t)idx * 8192] = cvt_pk_bf16(cs0, cs1); cs0 = d * cs0 + sc * u0; cs1 = d * cs1 + sc * u1; }
#pragma unroll
              for (int j = 0; j < 13; ++j) cur[j] = nxt[j];
          } }
        if (c.tid < 8) { float ns = 0.f; float* p = NST + (size_t)chain * NCHUNK * 128 + sub * 8 + c.tid;
            for (int blk = 0; blk < 10; ++blk) { float uu[13];
#pragma unroll
                for (int j = 0; j < 13; ++j) uu[j] = p[(13 * blk + j) * 128];
#pragma unroll
                for (int j = 0; j < 13; ++j) { const int idx = 13 * blk + j; p[idx * 128] = ns; ns = dec[idx] * ns + scl[idx] * uu[j]; } } }
    }
}

__device__ __forceinline__ bf16x8 scale_frag(const bf16x8 q, const float a) {
    const u32x4 w = *reinterpret_cast<const u32x4*>(&q); u32x4 o;
    o.x = cvt_pk_bf16(bflo(w.x) * a, bfhi(w.x) * a); o.y = cvt_pk_bf16(bflo(w.y) * a, bfhi(w.y) * a); o.z = cvt_pk_bf16(bflo(w.z) * a, bfhi(w.z) * a); o.w = cvt_pk_bf16(bflo(w.w) * a, bfhi(w.w) * a);
    return *reinterpret_cast<const bf16x8*>(&o);
}
__device__ __forceinline__ void ph_mlstm_c(const Ctx& c) {
    const bool with_ctx = (c.layer == 0);
    const bf16_t* P = (const bf16_t*)(c.ws + R_PAB); const float* bg = (const float*)(c.ws + SM_BG);
    const bf16_t* ST = (const bf16_t*)(c.ws + R_ST); const float* NST = (const float*)(c.ws + SM_NST); const float* SCAL = (const float*)(c.ws + SM_SCAL);
    bf16_t* Y = (bf16_t*)(c.ws + WS_Y);
    constexpr int KSTR = 272;
    char* Ks = c.ldsg; char* Vt = c.ldsg + 34816; char* Cf = c.ldsg + 67584; char* Cb = c.ldsg + 102400;
    float* ar = (float*)(c.ldsg + 137216);
    float* wsf = (float*)(c.ldsg + 142336) + c.wave * 64;
    float* HB = (float*)c.ldsg; float* HF = (float*)(c.ldsg + 67584);
    const int r32 = c.lane & 31, hi = c.lane >> 5;
    const int NIT = with_ctx ? 8 * NCHUNK : 8 * (NCHUNK - 2);
    for (int it = c.bid; it < NIT; it += c.G) {
        const int b = with_ctx ? it / (4 * NCHUNK) : it >> 9, head = with_ctx ? (it / NCHUNK) & 3 : (it >> 7) & 3, tc = with_ctx ? it % NCHUNK : 2 + (it & 127);
        const int row0 = tc < 2 ? NLAT + b * CTXL + tc * 128 : b * SEQ + (tc - 2) * 128;
        const int ci_f = (b * 4 + head) * NCHUNK + tc, ci_b = (8 + b * 4 + head) * NCHUNK + (tc < 2 ? 1 - tc : 131 - tc);
        __syncthreads();
        const int sdir = c.wave & 1; const int e0 = sdir ? 127 - 2 * c.lane : 2 * c.lane, e1 = sdir ? 126 - 2 * c.lane : 2 * c.lane + 1;
        float x0 = 0.f, x1 = 0.f, i0 = 0.f, i1 = 0.f, mprev = 0.f, nstv = 0.f;
        if (c.wave < 2) { const float* g0 = bg + (size_t)(row0 + e0) * 16 + sdir * 8 + head; const float* g1 = bg + (size_t)(row0 + e1) * 16 + sdir * 8 + head;
            x0 = g0[4]; x1 = g1[4]; i0 = g0[0]; i1 = g1[0]; mprev = SCAL[2 * NCHAIN * NCHUNK + (sdir ? ci_b : ci_f)]; }
        if (c.tid >= 128 && c.tid < 384) { const int dir = (c.tid - 128) >> 7, d = c.tid & 127; nstv = NST[(size_t)(dir ? ci_b : ci_f) * 128 + d]; }
        u32x4 stg[4][4];
#pragma unroll
        for (int i = 0; i < 4; ++i) { const int e = c.tid + 512 * i, s = e >> 4, c8 = (e & 15) * 8; const bf16_t* pr = P + (size_t)(row0 + s) * 2816 + 128 * head + c8;
            stg[i][0] = *(const u32x4*)(pr + 1280); stg[i][1] = *(const u32x4*)(pr + 1792);
            stg[i][2] = *(const u32x4*)(ST + (size_t)ci_f * 16384 + s * 128 + c8); stg[i][3] = *(const u32x4*)(ST + (size_t)ci_b * 16384 + s * 128 + c8); }
        const int dir = c.wave >> 2, tb = 32 * (c.wave & 3), t = tb + r32;
        bf16x8 qr[8];
        { const bf16_t* Qw = P + (size_t)(row0 + t) * 2816 + 768 + 128 * head + hi * 8;
#pragma unroll
          for (int d0 = 0; d0 < 8; ++d0) qr[d0] = *reinterpret_cast<const bf16x8*>(Qw + d0 * 16); }
        __builtin_amdgcn_sched_barrier(0);
        if (c.wave < 2) {
            float s = x0 + x1;
#pragma unroll
            for (int off = 1; off < 64; off <<= 1) { const float t_ = __shfl_up(s, off); if (c.lane >= off) s += t_; }
            const float bc0 = s - x1, bc1 = s, a20 = i0 - bc0, a21 = i1 - bc1;
            float m = fmaxf(a20, a21);
#pragma unroll
            for (int off = 1; off < 64; off <<= 1) { const float t_ = __shfl_up(m, off); if (c.lane >= off) m = fmaxf(m, t_); }
            float mp = __shfl_up(m, 1); if (c.lane == 0) mp = -INFINITY;
            const float pm0 = fmaxf(mp, a20), pm1 = m;
            const float mx0 = fmaxf(mprev, pm0), mx1 = fmaxf(mprev, pm1);
            ar[(0 * 2 + sdir) * 128 + e0] = -mx0; ar[(0 * 2 + sdir) * 128 + e1] = -mx1;
            ar[(1 * 2 + sdir) * 128 + e0] = a20; ar[(1 * 2 + sdir) * 128 + e1] = a21;
            ar[(2 * 2 + sdir) * 128 + e0] = __expf(mprev - mx0); ar[(2 * 2 + sdir) * 128 + e1] = __expf(mprev - mx1);
            ar[(3 * 2 + sdir) * 128 + e0] = __expf(-(bc0 + mx0)); ar[(3 * 2 + sdir) * 128 + e1] = __expf(-(bc1 + mx1)); }
        if (c.tid >= 128 && c.tid < 384) { const int dir_ = (c.tid - 128) >> 7, d = c.tid & 127; ar[(4 * 2 + dir_) * 128 + d] = nstv; }
#pragma unroll
        for (int i = 0; i < 4; ++i) { const int e = c.tid + 512 * i, s = e >> 4, c8 = (e & 15) * 8;
            *(u32x4*)(Ks + s * KSTR + c8 * 2) = stg[i][0];
            *(u32x4*)(Vt + (s >> 6) * 16384 + att::v_st<4>(s & 63, c8)) = stg[i][1];
            *(u32x4*)(Cf + s * KSTR + c8 * 2) = stg[i][2];
            *(u32x4*)(Cb + s * KSTR + c8 * 2) = stg[i][3]; }
        __syncthreads();
        const float A1t = ar[(0 * 2 + dir) * 128 + t], avt = ar[(2 * 2 + dir) * 128 + t], emtt = ar[(3 * 2 + dir) * 128 + t];
        const float* A2 = ar + (1 * 2 + dir) * 128; const float* nv = ar + (4 * 2 + dir) * 128;
        f32x16 o[4] = {}; float rowsum = 0.f;
        const int vb0 = (int)(uintptr_t)Vt + att::v_rd_base(c.lane);
#pragma unroll
        for (int j = 0; j < 2; ++j) {
            const bool skip = dir ? (j == 0 && tb >= 64) : (j == 1 && tb < 64);
            if (!skip) {
                f32x16 p0, p1; att::qkt<8, KSTR>(p0, p1, Ks + j * 64 * KSTR, qr, r32, hi);
                float a2v0[16], a2v1[16];
#pragma unroll
                for (int k = 0; k < 4; ++k) { const f32x4 u0 = *(const f32x4*)(A2 + 64 * j + 8 * k + 4 * hi), u1 = *(const f32x4*)(A2 + 64 * j + 32 + 8 * k + 4 * hi);
                    a2v0[4 * k] = u0.x; a2v0[4 * k + 1] = u0.y; a2v0[4 * k + 2] = u0.z; a2v0[4 * k + 3] = u0.w; a2v1[4 * k] = u1.x; a2v1[4 * k + 1] = u1.y; a2v1[4 * k + 2] = u1.z; a2v1[4 * k + 3] = u1.w; }
#pragma unroll
                for (int r = 0; r < 16; ++r) { const int s0 = 64 * j + att::crow(r, hi), s1 = s0 + 32;
                    const bool ok0 = dir ? (s0 >= t) : (s0 <= t), ok1 = dir ? (s1 >= t) : (s1 <= t);
                    const float ex0 = __expf(A1t + a2v0[r]), ex1 = __expf(A1t + a2v1[r]);
                    const float w0 = ok0 ? ex0 : 0.f, w1 = ok1 ? ex1 : 0.f;
                    p0[r] = p0[r] * w0 * KSCALE_B; p1[r] = p1[r] * w1 * KSCALE_B; rowsum += p0[r] + p1[r]; }
                bf16x8 pa0, pa1, pa2, pa3;
#define PK4(Pv, BASE, OUT) do { unsigned a0 = cvt_pk_bf16(Pv[BASE + 0], Pv[BASE + 1]), a1 = cvt_pk_bf16(Pv[BASE + 2], Pv[BASE + 3]);   \
    unsigned b0 = cvt_pk_bf16(Pv[BASE + 4], Pv[BASE + 5]), b1 = cvt_pk_bf16(Pv[BASE + 6], Pv[BASE + 7]);                              \
    auto r0 = __builtin_amdgcn_permlane32_swap(a0, b0, false, false); auto r1 = __builtin_amdgcn_permlane32_swap(a1, b1, false, false); \
    u32x4 w = {r0[0], r1[0], r0[1], r1[1]}; OUT = *reinterpret_cast<bf16x8*>(&w); } while (0)
                PK4(p0, 0, pa0); PK4(p0, 8, pa1); PK4(p1, 0, pa2); PK4(p1, 8, pa3);
#undef PK4
                __builtin_amdgcn_sched_barrier(0);
                att::pv_d0<4>(o, vb0 + j * 16384, pa0, pa1, pa2, pa3);
            }
        }
        { auto rr = __builtin_amdgcn_permlane32_swap(__float_as_uint(rowsum), __float_as_uint(rowsum), false, false); rowsum = __uint_as_float(rr[0]) + __uint_as_float(rr[1]); }
        float nq = 0.f;
#pragma unroll
        for (int d0 = 0; d0 < 8; ++d0) { const u32x4 w = *reinterpret_cast<const u32x4*>(&qr[d0]); const float* n8 = nv + d0 * 16 + hi * 8;
            nq += bflo(w.x) * n8[0] + bfhi(w.x) * n8[1] + bflo(w.y) * n8[2] + bfhi(w.y) * n8[3] + bflo(w.z) * n8[4] + bfhi(w.z) * n8[5] + bflo(w.w) * n8[6] + bfhi(w.w) * n8[7]; }
        { auto rr = __builtin_amdgcn_permlane32_swap(__float_as_uint(nq), __float_as_uint(nq), false, false); nq = __uint_as_float(rr[0]) + __uint_as_float(rr[1]); }
        { const char* Cs = dir ? Cb : Cf; bf16x8 cfa[4], cfb[4];
#define LDCF(dst, D0) do { _Pragma("unroll") for (int vb = 0; vb < 4; ++vb) dst[vb] = *reinterpret_cast<const bf16x8*>(Cs + (32 * vb + r32) * KSTR + ((D0) * 16 + hi * 8) * 2); } while (0)
#define MMCF(src, D0) do { const bf16x8 qs = scale_frag(qr[D0], avt); _Pragma("unroll") for (int vb = 0; vb < 4; ++vb) o[vb] = __builtin_amdgcn_mfma_f32_32x32x16_bf16(qs, src[vb], o[vb], 0, 0, 0); } while (0)
          LDCF(cfa, 0);
#pragma unroll
          for (int d0 = 0; d0 < 8; d0 += 2) {
              LDCF(cfb, d0 + 1); __builtin_amdgcn_sched_barrier(0);
              MMCF(cfa, d0); __builtin_amdgcn_sched_barrier(0);
              if (d0 + 2 < 8) { LDCF(cfa, d0 + 2); } __builtin_amdgcn_sched_barrier(0);
              MMCF(cfb, d0 + 1); __builtin_amdgcn_sched_barrier(0); }
#undef LDCF
#undef MMCF
        }
        const float den = rowsum + avt * nq; const float rdn = 1.f / fmaxf(fabsf(den), emtt);
        if (hi == 0) wsf[r32] = rdn;
        u32x4 ogw[4];
#pragma unroll
        for (int i = 0; i < 4; ++i) { const int e = c.tid + 512 * i; ogw[i] = *(const u32x4*)(P + (size_t)(row0 + (e >> 4)) * 2816 + 2304 + 128 * head + (e & 15) * 8); }
        asm volatile("s_waitcnt lgkmcnt(0)" ::: "memory");
        float rd[16];
#pragma unroll
        for (int r = 0; r < 16; ++r) rd[r] = wsf[att::crow(r, hi)];
        __syncthreads();
        { float* Hd = dir ? HB : HF;
#pragma unroll
          for (int r = 0; r < 16; ++r)
#pragma unroll
              for (int vb = 0; vb < 4; ++vb) Hd[(tb + att::crow(r, hi)) * 128 + 32 * vb + r32] = o[vb][r] * rd[r]; }
        __syncthreads();
#pragma unroll
        for (int i = 0; i < 4; ++i) { const int e = c.tid + 512 * i, tt = e >> 4, c8 = (e & 15) * 8;
            const f32x4 h0 = *(const f32x4*)(HB + tt * 128 + c8) + *(const f32x4*)(HF + tt * 128 + c8), h1 = *(const f32x4*)(HB + tt * 128 + c8 + 4) + *(const f32x4*)(HF + tt * 128 + c8 + 4); const u32x4 g = ogw[i];
            u32x4 w; w.x = cvt_pk_bf16(sigmoidf_(bflo(g.x)) * h0.x, sigmoidf_(bfhi(g.x)) * h0.y); w.y = cvt_pk_bf16(sigmoidf_(bflo(g.y)) * h0.z, sigmoidf_(bfhi(g.y)) * h0.w);
            w.z = cvt_pk_bf16(sigmoidf_(bflo(g.z)) * h1.x, sigmoidf_(bfhi(g.z)) * h1.y); w.w = cvt_pk_bf16(sigmoidf_(bflo(g.w)) * h1.z, sigmoidf_(bfhi(g.w)) * h1.w);
            *(u32x4*)(Y + (size_t)(row0 + tt) * 2048 + 512 + 128 * head + c8) = w; }
    }
}
__device__ __forceinline__ void ph_yb(const Ctx& c) {
    const int M = (c.layer == 0) ? MTOT : NLAT; const bf16_t* P = (const bf16_t*)(c.ws + R_PAB); bf16_t* Y = (bf16_t*)(c.ws + WS_Y);
    for (size_t i = (size_t)c.bid * 512 + c.tid; i < (size_t)M * 64; i += (size_t)c.G * 512) { const size_t r = i >> 6; const int c8 = (int)(i & 63) * 8;
        const u32x4 o = *(const u32x4*)(P + r * 2816 + 2304 + c8), f = *(const u32x4*)(Y + r * 2048 + 512 + c8), bb = *(const u32x4*)(Y + r * 2048 + 1024 + c8);
        u32x4 w;
        w.x = cvt_pk_bf16(sigmoidf_(bflo(o.x)) * (bflo(f.x) + bflo(bb.x)), sigmoidf_(bfhi(o.x)) * (bfhi(f.x) + bfhi(bb.x)));
        w.y = cvt_pk_bf16(sigmoidf_(bflo(o.y)) * (bflo(f.y) + bflo(bb.y)), sigmoidf_(bfhi(o.y)) * (bfhi(f.y) + bfhi(bb.y)));
        w.z = cvt_pk_bf16(sigmoidf_(bflo(o.z)) * (bflo(f.z) + bflo(bb.z)), sigmoidf_(bfhi(o.z)) * (bfhi(f.z) + bfhi(bb.z)));
        w.w = cvt_pk_bf16(sigmoidf_(bflo(o.w)) * (bflo(f.w) + bflo(bb.w)), sigmoidf_(bfhi(o.w)) * (bfhi(f.w) + bfhi(bb.w)));
        *(u32x4*)(Y + r * 2048 + 512 + c8) = w; }
}

__device__ __forceinline__ void ph_mla_pre(const Ctx& c) {
    const int l = c.layer; const int gw = c.bid * 8 + c.wave, NGW = c.G * 8; const float* T = (const float*)(c.ws + SM_ROPE);
    bf16_t* Y = (bf16_t*)(c.ws + WS_Y); bf16_t* PD = (bf16_t*)(c.ws + R_PD); bf16_t* CKR = (bf16_t*)(c.ws + R_CKR);
    const float* gq = c.in[I_CGQ] + l * 512; const float* gkv = c.in[I_CGKV] + l * 256;
    for (int r = gw; r < MTOT; r += NGW) {
        bf16_t* pc = Y + (size_t)r * 2048 + 1024;
        { const u32x4 w = *(const u32x4*)(pc + 8 * c.lane); float x[8] = {bflo(w.x), bfhi(w.x), bflo(w.y), bfhi(w.y), bflo(w.z), bfhi(w.z), bflo(w.w), bfhi(w.w)};
          float ss = 0.f;
#pragma unroll
          for (int j = 0; j < 8; ++j) ss += x[j] * x[j];
          const float rs = rsqrtf(wave_sum(ss) * (1.f / 512.f) + EPS);
#pragma unroll
          for (int j = 0; j < 8; ++j) x[j] = x[j] * rs * gq[8 * c.lane + j];
          u32x4 o; o.x = cvt_pk_bf16(x[0], x[1]); o.y = cvt_pk_bf16(x[2], x[3]); o.z = cvt_pk_bf16(x[4], x[5]); o.w = cvt_pk_bf16(x[6], x[7]); *(u32x4*)(pc + 8 * c.lane) = o; }
        { const u32x2 w = *(const u32x2*)(pc + 512 + 4 * c.lane); float x[4] = {bflo(w.x), bfhi(w.x), bflo(w.y), bfhi(w.y)};
          float ss = x[0] * x[0] + x[1] * x[1] + x[2] * x[2] + x[3] * x[3];
          const float rs = rsqrtf(wave_sum(ss) * (1.f / 256.f) + EPS);
#pragma unroll
          for (int j = 0; j < 4; ++j) x[j] = x[j] * rs * gkv[4 * c.lane + j];
          u32x2 o; o.x = cvt_pk_bf16(x[0], x[1]); o.y = cvt_pk_bf16(x[2], x[3]); *(u32x2*)(pc + 512 + 4 * c.lane) = o; }
        if (r < NLAT) { const int t = r & (SEQ - 1);
            rope_row(CKR + (size_t)r * 64, pc + 768, 32, 64, t >> 6, t & 63, T, c.lane);
            bf16_t* pd = PD + (size_t)r * 1536; rope_row(pd, pd, 512, 64, t >> 6, t & 63, T, c.lane);
        } else { CKR[(size_t)r * 64 + c.lane] = pc[768 + c.lane]; }
    }
}
__device__ __forceinline__ void ph_rope_cq(const Ctx& c) {
    const int gw = c.bid * 8 + c.wave, NGW = c.G * 8; const float* T = (const float*)(c.ws + SM_ROPE); bf16_t* CQ = (bf16_t*)(c.ws + R_CQ);
    for (int r = gw; r < NLAT; r += NGW) { const int t = r & (SEQ - 1); bf16_t* rp = CQ + (size_t)r * 768 + 128; rope_row(rp, rp, 128, 192, t >> 6, t & 63, T, c.lane); }
}


__device__ __forceinline__ void ph_knorm(const Ctx& c) {
    const bf16_t* PD = (const bf16_t*)(c.ws + R_PD); const bf16_t* CKNV = (const bf16_t*)(c.ws + R_CKNV); const bf16_t* CKR = (const bf16_t*)(c.ws + R_CKR);
    const int gw = c.bid * 8 + c.wave, NGW = c.G * 8; const int b = gw & 1, nw = NGW >> 1;
    float mD = 0.f, mC = 0.f;
    auto krow = [&](int idx) -> size_t { return idx < SEQ ? (size_t)b * SEQ + idx : (size_t)NLAT + b * CTXL + (idx - SEQ); };
    for (int idx0 = gw >> 1; idx0 < SEQ + CTXL; idx0 += 2 * nw) {
        const int idx1 = idx0 + nw; const bool two = idx1 < SEQ + CTXL; const size_t r0 = krow(idx0), r1 = krow(two ? idx1 : idx0);
        const u32x4 kd0 = *(const u32x4*)(PD + r0 * 1536 + 512 + 8 * c.lane), kc0 = *(const u32x4*)(CKNV + r0 * 1024 + 8 * c.lane); const float kr0 = bf2f(CKR[r0 * 64 + c.lane]);
        const u32x4 kd1 = *(const u32x4*)(PD + r1 * 1536 + 512 + 8 * c.lane), kc1 = *(const u32x4*)(CKNV + r1 * 1024 + 8 * c.lane); const float kr1 = bf2f(CKR[r1 * 64 + c.lane]);
        float sd0 = dot8(kd0, kd0), sc0 = dot8(kc0, kc0), sd1 = dot8(kd1, kd1), sc1 = dot8(kc1, kc1);
        sd0 += dpp_mov<0xB1>(sd0); sd0 += dpp_mov<0x4E>(sd0); sd0 += dpp_mov<0x141>(sd0);
        sd1 += dpp_mov<0xB1>(sd1); sd1 += dpp_mov<0x4E>(sd1); sd1 += dpp_mov<0x141>(sd1);
        sc0 += dpp_mov<0xB1>(sc0); sc0 += dpp_mov<0x4E>(sc0); sc0 += dpp_mov<0x141>(sc0); sc0 += dpp_mov<0x140>(sc0);
        sc1 += dpp_mov<0xB1>(sc1); sc1 += dpp_mov<0x4E>(sc1); sc1 += dpp_mov<0x141>(sc1); sc1 += dpp_mov<0x140>(sc1);
        const float q0 = wave_sum(kr0 * kr0), q1 = wave_sum(kr1 * kr1);
        mD = fmaxf(mD, fmaxf(sd0, sd1)); mC = fmaxf(mC, fmaxf(sc0 + q0, sc1 + q1)); }
    unsigned* slots = (unsigned*)(c.ws + WS_CTL) + CW_KN + (c.layer * 2 + b) * 12;
    if ((c.lane & 15) == 0) atomicMax(slots + (c.lane >> 4), __float_as_uint(mC));
    if ((c.lane & 7) == 0) atomicMax(slots + 4 + (c.lane >> 3), __float_as_uint(mD));
}
__device__ __forceinline__ void ph_attn(const Ctx& c) {
    const bool with_ctx = (c.layer == 0);
    const bf16_t* CQ = (const bf16_t*)(c.ws + R_CQ); const bf16_t* CKNV = (const bf16_t*)(c.ws + R_CKNV); const bf16_t* CKR = (const bf16_t*)(c.ws + R_CKR);
    const bf16_t* PD = (const bf16_t*)(c.ws + R_PD); bf16_t* Y = (bf16_t*)(c.ws + WS_Y);
    const int l = c.layer; const float lam_init = 0.8f - 0.6f * expf(-0.3f * (float)l);
    const float s1 = wave_sum(c.in[I_LQ1][l * 64 + c.lane] * c.in[I_LK1][l * 64 + c.lane]), s2 = wave_sum(c.in[I_LQ2][l * 64 + c.lane] * c.in[I_LK2][l * 64 + c.lane]);
    const float lam = expf(s1) - expf(s2) + lam_init; const float* gsub = c.in[I_DGSUB] + l * 128;
    const float* KN = (const float*)(c.ws + WS_CTL) + CW_KN + c.layer * 24;
    const int NU_C = 512, NU_D = 1024, NU_CC = with_ctx ? 8 : 0, NU_DC = with_ctx ? 16 : 0;
    const int vcu = (c.G % 8 == 0) ? (c.bid & 7) * (c.G >> 3) + (c.bid >> 3) : c.bid;
    for (int u = vcu; u < NU_C; u += c.G) { const int b = u >> 8, h = (u >> 6) & 3, qb = u & 63; const long row0 = (long)b * SEQ + 256 * qb;
        att::KeySrc ks{b * SEQ, 256, NLAT + b * CTXL, 0};
        att::ATTN_UNIT<0>(CQ + row0 * 768 + 192 * h, 768, CKNV + 128 * h, 1024, CKR, CKNV + 512 + 128 * h, 1024, Y + row0 * 2048 + 1024 + 128 * h, 2048, ks, 260, 0.07216878364870322f, c.ldsg, 0.f, 0.f, nullptr, KN + b * 12 + h); }
    for (int v = vcu; v < NU_D; v += c.G) { const int b = v >> 9, h = (v >> 7) & 3, qb = v & 127; const long row0 = (long)b * SEQ + 128 * qb;
        att::KeySrc ks{b * SEQ, 256, NLAT + b * CTXL, 0};
        att::ATTN_UNIT<1>(PD + row0 * 1536 + 128 * h, 1536, PD + 512 + 128 * h, 1536, nullptr, PD + 1024 + 128 * h, 1536, Y + row0 * 2048 + 1536 + 128 * h, 2048, ks, 260, 0.125f, c.ldsg, lam, 1.f - lam_init, gsub, KN + b * 12 + 4 + 2 * h); }
    for (int v = vcu; v < NU_CC; v += c.G) { const int b = v >> 2, h = v & 3; const long row0 = (long)NLAT + b * CTXL;
        att::KeySrc ks{0, 0, NLAT + b * CTXL, 0};
        att::attn_unit_sb<0, 2>(CQ + row0 * 768 + 192 * h, 768, CKNV + 128 * h, 1024, CKR, CKNV + 512 + 128 * h, 1024, Y + row0 * 2048 + 1024 + 128 * h, 2048, ks, 4, 0.07216878364870322f, c.ldsg, 0.f, 0.f, nullptr, KN + b * 12 + h); }
    for (int v = (vcu + (c.G >> 1)) % c.G; v < NU_DC; v += c.G) { const int b = v >> 3, h = (v >> 1) & 3, hf = v & 1; const long row0 = (long)NLAT + b * CTXL + 128 * hf;
        att::KeySrc ks{0, 0, NLAT + b * CTXL, 0};
        att::attn_unit_sb<1, 0>(PD + row0 * 1536 + 128 * h, 1536, PD + 512 + 128 * h, 1536, nullptr, PD + 1024 + 128 * h, 1536, Y + row0 * 2048 + 1536 + 128 * h, 2048, ks, 4, 0.125f, c.ldsg, lam, 1.f - lam_init, gsub, KN + b * 12 + 4 + 2 * h); }
}
__device__ __forceinline__ void ph_dpost(const Ctx& c) {
    const int l = c.layer; const int M = (l == 0) ? MTOT : NLAT; const int gw = c.bid * 8 + c.wave, NGW = c.G * 8;
    bf16_t* Y = (bf16_t*)(c.ws + WS_Y); const bf16_t* O2 = (const bf16_t*)(c.ws + R_O2);
    const float lam_init = 0.8f - 0.6f * expf(-0.3f * (float)l);
    const float s1 = wave_sum(c.in[I_LQ1][l * 64 + c.lane] * c.in[I_LK1][l * 64 + c.lane]), s2 = wave_sum(c.in[I_LQ2][l * 64 + c.lane] * c.in[I_LK2][l * 64 + c.lane]);
    const float lam = expf(s1) - expf(s2) + lam_init;
    const float g0 = c.in[I_DGSUB][l * 128 + 2 * c.lane], g1 = c.in[I_DGSUB][l * 128 + 2 * c.lane + 1];
    for (int it = gw; it < M * 4; it += NGW) { const int r = it >> 2, h = it & 3;
        unsigned* yp = (unsigned*)(Y + (size_t)r * 2048 + 1536 + 128 * h) + c.lane; const unsigned w1 = *yp, w2 = *((const unsigned*)(O2 + (size_t)r * 512 + 128 * h) + c.lane);
        const float o0 = bflo(w1) - lam * bflo(w2), o1 = bfhi(w1) - lam * bfhi(w2);
        const float rs = rsqrtf(wave_sum(o0 * o0 + o1 * o1) * (1.f / 128.f) + EPS) * (1.f - lam_init);
        *yp = cvt_pk_bf16(o0 * rs * g0, o1 * rs * g1); }
}

__device__ __forceinline__ f32x4 bf4(const u32x2 w) { return (f32x4){bflo(w.x), bfhi(w.x), bflo(w.y), bfhi(w.y)}; }
__device__ __forceinline__ const bf16_t* hmid_row(const Ctx& c, int r) { return r < NLAT ? (const bf16_t*)c.out + (size_t)r * DM : (const bf16_t*)(c.ws + SM_HC) + (size_t)(r - NLAT) * DM; }
__device__ __forceinline__ void ph_post1(const Ctx& c) {
    const int l = c.layer; const int M = (l == 0) ? MTOT : NLAT; const int gw = c.bid * 8 + c.wave, NGW = c.G * 8;
    const bf16_t* yo = (const bf16_t*)(c.ws + R_YOUT); const float* mod = (const float*)(c.ws + SM_MOD) + l * 3 * 6144; bf16_t* HP = (bf16_t*)(c.ws + R_HP);
    f32x4 gpo[4], gpr[4]; { const float* gpost = c.in[I_GMIXPOST] + (size_t)l * DM; const float* gpre = c.in[I_GFFNPRE] + (size_t)l * DM;
#pragma unroll
      for (int j = 0; j < 4; ++j) { gpo[j] = *(const f32x4*)(gpost + 4 * (c.lane + 64 * j)); gpr[j] = *(const f32x4*)(gpre + 4 * (c.lane + 64 * j)); } }
    u32x2 yw[4], ywn[4]; f32x4 hc[4], hn_[4]; u32x2 hb[4], hbn[4];
    if (gw < M) { const u32x2* yr = (const u32x2*)(yo + (size_t)gw * DM) + c.lane;
#pragma unroll
        for (int j = 0; j < 4; ++j) yw[j] = yr[64 * j];
        if (l == 0) { const f32x4* hr = (const f32x4*)hin_row(c, gw) + c.lane;
#pragma unroll
            for (int j = 0; j < 4; ++j) hc[j] = hr[64 * j]; }
        else { const u32x2* hr = (const u32x2*)hmid_row(c, gw) + c.lane;
#pragma unroll
            for (int j = 0; j < 4; ++j) hb[j] = hr[64 * j]; } }
    for (int r = gw; r < M; r += NGW) {
        const float* md = mod + mod_idx(r) * 6144;
        f32x4 gt[4], sh[4], scl[4];
#pragma unroll
        for (int j = 0; j < 4; ++j) { const int e = 4 * (c.lane + 64 * j); gt[j] = *(const f32x4*)(md + 2048 + e); sh[j] = *(const f32x4*)(md + 3072 + e); scl[j] = *(const f32x4*)(md + 4096 + e); }
        { const int rn = r + NGW < M ? r + NGW : r; const u32x2* yr = (const u32x2*)(yo + (size_t)rn * DM) + c.lane;
#pragma unroll
          for (int j = 0; j < 4; ++j) ywn[j] = yr[64 * j];
          if (l == 0) { const f32x4* hr = (const f32x4*)hin_row(c, rn) + c.lane;
#pragma unroll
              for (int j = 0; j < 4; ++j) hn_[j] = hr[64 * j]; }
          else { const u32x2* hr = (const u32x2*)hmid_row(c, rn) + c.lane;
#pragma unroll
              for (int j = 0; j < 4; ++j) hbn[j] = hr[64 * j]; } }
        __builtin_amdgcn_sched_barrier(0);
        f32x4 v[4]; float ss = 0.f;
#pragma unroll
        for (int j = 0; j < 4; ++j) { v[j] = bf4(yw[j]); ss += (v[j].x * v[j].x + v[j].y * v[j].y) + (v[j].z * v[j].z + v[j].w * v[j].w); }
        const float rs = rsqrtf(wave_sum(ss) * (1.f / DM) + EPS);
        float ss2 = 0.f; u32x2* ho = (u32x2*)(HP + (size_t)r * DM) + c.lane;
#pragma unroll
        for (int j = 0; j < 4; ++j) { const f32x4 g = gpo[j]; const f32x4 h0 = (l == 0) ? hc[j] : bf4(hb[j]);
            f32x4 hn; hn.x = h0.x + gt[j].x * (v[j].x * rs * g.x); hn.y = h0.y + gt[j].y * (v[j].y * rs * g.y); hn.z = h0.z + gt[j].z * (v[j].z * rs * g.z); hn.w = h0.w + gt[j].w * (v[j].w * rs * g.w);
            u32x2 w; w.x = cvt_pk_bf16(hn.x, hn.y); w.y = cvt_pk_bf16(hn.z, hn.w); ho[64 * j] = w; v[j] = hn; ss2 += (hn.x * hn.x + hn.y * hn.y) + (hn.z * hn.z + hn.w * hn.w); }
        const float rs2 = rsqrtf(wave_sum(ss2) * (1.f / DM) + EPS);
        f32x4 uu[4];
#pragma unroll
        for (int j = 0; j < 4; ++j) { const f32x4 g = gpr[j];
            uu[j] = (f32x4){v[j].x * rs2 * g.x * (1.f + scl[j].x) + sh[j].x, v[j].y * rs2 * g.y * (1.f + scl[j].y) + sh[j].y, v[j].z * rs2 * g.z * (1.f + scl[j].z) + sh[j].z, v[j].w * rs2 * g.w * (1.f + scl[j].w) + sh[j].w}; }
        quant_row_i8(uu, (signed char*)(c.ws + WS_U) + (size_t)r * DM, (float*)(c.ws + U_SC) + r, c.lane);
#pragma unroll
        for (int j = 0; j < 4; ++j) { yw[j] = ywn[j]; hc[j] = hn_[j]; hb[j] = hbn[j]; }
    }
}
__device__ __forceinline__ void ph_post2(const Ctx& c) {
    const int l = c.layer; const int M = (l == 0) ? MTOT : NLAT; const int gw = c.bid * 8 + c.wave, NGW = c.G * 8;
    const bf16_t* z = (const bf16_t*)(c.ws + WS_Y); const float* mod = (const float*)(c.ws + SM_MOD) + l * 3 * 6144; const bf16_t* HP = (const bf16_t*)(c.ws + R_HP);
    float* wgl = (float*)c.ldsg; if (l == 0) stage_gate_weights(c, 1, wgl);
    f32x4 gpo[4], g4[4]; { const float* gpost = c.in[I_GFFNPOST] + (size_t)l * DM; const float* gpre = c.in[I_GMIXPRE] + (size_t)1 * DM;
#pragma unroll
      for (int j = 0; j < 4; ++j) { gpo[j] = *(const f32x4*)(gpost + 4 * (c.lane + 64 * j)); g4[j] = *(const f32x4*)(gpre + 4 * (c.lane + 64 * j)); } }
    u32x2 zw[4], zwn[4], hb[4], hbn[4];
    if (gw < M) { const u32x2* zr = (const u32x2*)(z + (size_t)gw * DM) + c.lane; const u32x2* hr = (const u32x2*)(HP + (size_t)gw * DM) + c.lane;
#pragma unroll
        for (int j = 0; j < 4; ++j) { zw[j] = zr[64 * j]; hb[j] = hr[64 * j]; } }
    for (int r = gw; r < M; r += NGW) {
        const float* md = mod + mod_idx(r) * 6144;
        f32x4 gt[4]; N1Vec nv;
#pragma unroll
        for (int j = 0; j < 4; ++j) gt[j] = *(const f32x4*)(md + 5120 + 4 * (c.lane + 64 * j));
        if (l == 0) norm1_load(c, 1, r, nv);
        { const int rn = r + NGW < M ? r + NGW : r; const u32x2* zr = (const u32x2*)(z + (size_t)rn * DM) + c.lane; const u32x2* hr = (const u32x2*)(HP + (size_t)rn * DM) + c.lane;
#pragma unroll
          for (int j = 0; j < 4; ++j) { zwn[j] = zr[64 * j]; hbn[j] = hr[64 * j]; } }
        __builtin_amdgcn_sched_barrier(0);
        f32x4 v[4]; float ss = 0.f;
#pragma unroll
        for (int j = 0; j < 4; ++j) { v[j] = bf4(zw[j]); ss += (v[j].x * v[j].x + v[j].y * v[j].y) + (v[j].z * v[j].z + v[j].w * v[j].w); }
        const float rs = rsqrtf(wave_sum(ss) * (1.f / DM) + EPS);
#pragma unroll
        for (int j = 0; j < 4; ++j) { const f32x4 g = gpo[j]; f32x4 h0 = bf4(hb[j]);
            h0.x += gt[j].x * (v[j].x * rs * g.x); h0.y += gt[j].y * (v[j].y * rs * g.y); h0.z += gt[j].z * (v[j].z * rs * g.z); h0.w += gt[j].w * (v[j].w * rs * g.w);
            if (l == 0) { u32x2 w; w.x = cvt_pk_bf16(h0.x, h0.y); w.y = cvt_pk_bf16(h0.z, h0.w); ((u32x2*)const_cast<bf16_t*>(hmid_row(c, r)))[c.lane + 64 * j] = w; }
            else ((f32x4*)(c.out + (size_t)r * DM))[c.lane + 64 * j] = h0;
            v[j] = h0; }
        if (l == 0) norm1_apply(c, 1, r, v, wgl, g4, nv);
#pragma unroll
        for (int j = 0; j < 4; ++j) { zw[j] = zwn[j]; hb[j] = hbn[j]; }
    }
}

template <int WHICH> struct EpiRope {
    static constexpr bool PERM = false;
    bf16_t* O; int ldc; const float* T;
    bf16_t* O2; int ldc2; bf16_t* CKR; float* SSQ;
    __device__ __forceinline__ void operator()(const f32x4 (&acc)[2][2][4][2], const pg8::Unit& u, int wr, int wc, int fr, int fq) const {
        const int row0 = u.pm * 256 + wr * 64 + fr; const bool lat = u.pm < NLAT / 256;
        bool en[2]; bf16_t* dstb[2]; size_t dld[2];
#pragma unroll
        for (int bj = 0; bj < 2; ++bj) { const int g = u.pn * 8 + bj * 4 + wc;
            if constexpr (WHICH == 0) { en[bj] = g < 20; dstb[bj] = O + g * 32; dld[bj] = (size_t)ldc; }
            if constexpr (WHICH == 1) { if (u.pn < 4) { en[bj] = (g == 24 || g == 25); dstb[bj] = en[bj] ? CKR + (g - 24) * 32 : O + g * 32; dld[bj] = en[bj] ? (size_t)64 : (size_t)ldc; }
                                        else { const int gl = g - 32; en[bj] = gl < 32; dstb[bj] = O2 + gl * 32; dld[bj] = (size_t)ldc2; } }
            if constexpr (WHICH == 2) { const int gi = g % 6; en[bj] = gi >= 4; dstb[bj] = O + g * 32; dld[bj] = (size_t)ldc; }
            en[bj] = en[bj] && lat; }
        const bool any = en[0] || en[1]; const bool usepc = (wc & 1) != 0;
#pragma unroll
        for (int ai = 0; ai < 2; ++ai) {
            float rsc[4] = {1.f, 1.f, 1.f, 1.f};
            if constexpr (WHICH == 2) {
#pragma unroll
                for (int mh = 0; mh < 2; ++mh) { f32x4 s0[2], s1[2];
#pragma unroll
                    for (int m = 0; m < 2; ++m) { const size_t row = (size_t)(row0 + ai * 128 + (2 * mh + m) * 16); s0[m] = *(const f32x4*)(SSQ + row * 12); s1[m] = *(const f32x4*)(SSQ + row * 12 + 4); }
                    __builtin_amdgcn_sched_barrier(0);
#pragma unroll
                    for (int m = 0; m < 2; ++m) rsc[2 * mh + m] = rsqrtf(((s0[m].x + s0[m].y) + (s0[m].z + s0[m].w) + (s1[m].x + s1[m].y) + (s1[m].z + s1[m].w)) * (1.f / 512.f) + EPS);
                    __builtin_amdgcn_sched_barrier(0); }
            }
            f32x4 c0[4], c1[4];
            if (any) {
#pragma unroll
                for (int m = 0; m < 4; ++m) { const int t = (row0 + ai * 128 + m * 16) & (SEQ - 1); const int pos = usepc ? (t & 63) : (t >> 6); const float* tp = T + (size_t)(pos * 16 + 4 * fq) * 2;
                    c0[m] = *(const f32x4*)tp; c1[m] = *(const f32x4*)(tp + 4); }
            } else {
#pragma unroll
                for (int m = 0; m < 4; ++m) { c0[m] = (f32x4){1.f, 0.f, 1.f, 0.f}; c1[m] = (f32x4){1.f, 0.f, 1.f, 0.f}; } }
            __builtin_amdgcn_sched_barrier(0);
#pragma unroll
            for (int m = 0; m < 4; ++m) { const int row = row0 + ai * 128 + m * 16;
                const f32x4 cs = (f32x4){c0[m].x, c0[m].z, c1[m].x, c1[m].z}, sn = (f32x4){c0[m].y, c0[m].w, c1[m].y, c1[m].w};
                float part = 0.f;
#pragma unroll
                for (int bj = 0; bj < 2; ++bj) { bf16_t* dst = dstb[bj] + (size_t)row * dld[bj];
                    f32x4 x1 = acc[ai][bj][m][0], x2 = acc[ai][bj][m][1];
                    if constexpr (WHICH == 1) part += (x1.x * x1.x + x1.y * x1.y) + (x1.z * x1.z + x1.w * x1.w) + (x2.x * x2.x + x2.y * x2.y) + (x2.z * x2.z + x2.w * x2.w);
                    if constexpr (WHICH == 2) { x1 = x1 * rsc[m]; x2 = x2 * rsc[m]; }
                    if (en[bj]) { const f32x4 o1 = x1 * cs - x2 * sn, o2 = x2 * cs + x1 * sn; x1 = o1; x2 = o2; }
                    u32x2 w1, w2; w1.x = cvt_pk_bf16(x1.x, x1.y); w1.y = cvt_pk_bf16(x1.z, x1.w); w2.x = cvt_pk_bf16(x2.x, x2.y); w2.y = cvt_pk_bf16(x2.z, x2.w);
                    *(u32x2*)(dst + 4 * fq) = w1; *(u32x2*)(dst + 16 + 4 * fq) = w2; }
                if constexpr (WHICH == 1) { if (u.pn < 3) { part += __shfl_xor(part, 16); part += __shfl_xor(part, 32); if (fq == 0) SSQ[(size_t)row * 12 + u.pn * 4 + wc] = part; } }
            }
        }
    }
};
struct EpiRowScale {
    static constexpr bool PERM = true;
    bf16_t* O; int ldc; const float* SSQ;
    __device__ __forceinline__ void operator()(const f32x4 (&acc)[2][2][4][2], const pg8::Unit& u, int wr, int wc, int fr, int fq) const {
        const int row0 = u.pm * 256 + wr * 64 + fr, col0 = u.pn * 256 + wc * 32 + 8 * fq;
#pragma unroll
        for (int ai = 0; ai < 2; ++ai)
#pragma unroll
            for (int m = 0; m < 4; ++m) { const size_t r = (size_t)(row0 + ai * 128 + m * 16); const f32x4 s = *(const f32x4*)(SSQ + r * 12 + 8);
                const float rsc = rsqrtf(((s.x + s.y) + (s.z + s.w)) * (1.f / 256.f) + EPS); bf16_t* rowp = O + r * ldc + col0;
#pragma unroll
                for (int bj = 0; bj < 2; ++bj) { const f32x4 v0 = acc[ai][bj][m][0] * rsc, v1 = acc[ai][bj][m][1] * rsc;
                    u32x4 w; w.x = cvt_pk_bf16(v0[0], v0[1]); w.y = cvt_pk_bf16(v0[2], v0[3]); w.z = cvt_pk_bf16(v1[0], v1[1]); w.w = cvt_pk_bf16(v1[2], v1[3]);
                    *(u32x4*)(rowp + bj * 128) = w; }
                asm volatile("" ::: "memory"); }
    }
};

#define XB_TMO      128
#define XB_XCNT(j)  (256  + 64 * (j))
#define XB_XSUB(j)  (1280 + 64 * (j))
#define XB_XGEN(j)  (2304 + 64 * (j))
#define XB_TOP      3328
#define XB_TOPGEN   3392
#define XCD_BAR_WORDS 3456
#define XB_SPIN_CAP (1u << 18)

__device__ __forceinline__ unsigned xb_ld(unsigned* p)              { return __hip_atomic_load(p, __ATOMIC_RELAXED, __HIP_MEMORY_SCOPE_AGENT); }
__device__ __forceinline__ unsigned xb_add(unsigned* p, unsigned v) { return __hip_atomic_fetch_add(p, v, __ATOMIC_RELAXED, __HIP_MEMORY_SCOPE_AGENT); }
__device__ __forceinline__ unsigned xb_xcc_id() { return (unsigned)__builtin_amdgcn_s_getreg((3 << 11) | 20) & 0xFu; }
#define XB_SPIN(cond, bar) do { unsigned _sp = 0; while (cond) { __builtin_amdgcn_s_sleep(1); \
    if ((++_sp & 255u) == 0u) { if (xb_ld(&(bar)[XB_TMO])) break; if (_sp > XB_SPIN_CAP) { atomicAdd(&(bar)[XB_TMO], 1u); break; } } } } while (0)

struct XcdBarrier {
    unsigned* bar; unsigned x;
    volatile LAS unsigned* st;
};

__device__ __forceinline__ XcdBarrier xcd_barrier_post(unsigned* bar, volatile LAS unsigned* st) {
    XcdBarrier b; b.bar = bar; b.x = xb_xcc_id(); b.st = st;
    if (threadIdx.x == 0) (void)xb_add(&bar[XB_XCNT(b.x)], 1u);
    return b;
}
__device__ __forceinline__ void xcd_barrier_complete(unsigned* bar, unsigned x, unsigned& nloc, unsigned& nx) {
    const unsigned G = gridDim.x * gridDim.y * gridDim.z;
    unsigned sum, cnt, mine, sp = 0u;
    for (;;) {
        sum = 0u; cnt = 0u; mine = 0u;
#pragma unroll
        for (unsigned j = 0; j < 16; ++j) { const unsigned c = xb_ld(&bar[XB_XCNT(j)]); sum += c; cnt += (c > 0u) ? 1u : 0u; mine = (j == x) ? c : mine; }
        if (sum == G) break;
        __builtin_amdgcn_s_sleep(1);
        if ((++sp & 255u) == 0u) { if (xb_ld(&bar[XB_TMO])) break; if (sp > XB_SPIN_CAP) { atomicAdd(&bar[XB_TMO], 1u); break; } }
    }
    nloc = mine > 0u ? mine : 1u; nx = cnt > 0u ? cnt : 1u;
}

__device__ __forceinline__ void xcd_barrier(const XcdBarrier& b) {
    asm volatile("s_waitcnt vmcnt(0)" ::: "memory");
    __syncthreads();
    if (threadIdx.x == 0) {
        unsigned* bar = b.bar;
        __builtin_amdgcn_s_waitcnt(0);
        unsigned nloc = b.st[0], nx = b.st[1];
        if (nloc == 0u) { xcd_barrier_complete(bar, b.x, nloc, nx); b.st[0] = nloc; b.st[1] = nx; }
        const unsigned old = xb_add(&bar[XB_XSUB(b.x)], 1u);
        const unsigned gen = old / nloc;
        if (old + 1u == (gen + 1u) * nloc) {
            __builtin_amdgcn_fence(__ATOMIC_RELEASE, "agent");
            asm volatile("s_waitcnt vmcnt(0)" ::: "memory");
            const unsigned og = xb_add(&bar[XB_TOP], 1u);
            const unsigned tg = og / nx;
            if (og + 1u == (tg + 1u) * nx) xb_add(&bar[XB_TOPGEN], 1u);
            else XB_SPIN(xb_ld(&bar[XB_TOPGEN]) == tg, bar);
            __builtin_amdgcn_fence(__ATOMIC_ACQUIRE, "agent");
            xb_add(&bar[XB_XGEN(b.x)], 1u);
            asm volatile("s_waitcnt vmcnt(0)" ::: "memory");
        } else {
            XB_SPIN(xb_ld(&bar[XB_XGEN(b.x)]) == gen, bar);
            __builtin_amdgcn_fence(__ATOMIC_ACQUIRE, "agent");
            asm volatile("s_waitcnt vmcnt(0)" ::: "memory");
        }
    }
    __syncthreads();
}


template <class Epi>
__device__ __forceinline__ void run_gemm(const Ctx& c, const bf16_t* A, int lda, const bf16_t* Bt, int ldb, int M, int N, int K, const Epi& E, int cofs = 0) {
    pg8::Gemm g{A, Bt, M, N, K, lda, ldb}; pg8::StaticOrder S; S.init(M, N, c.G, (c.bid + cofs) % c.G);
    pg8::gemm_phase<Epi, pg8::StaticOrder, true>(c.lds, g, S, E);
}
template <class Epi>
__device__ __forceinline__ void run_gemm_i8(const Ctx& c, const unsigned char* A8, const float* sa, const unsigned char* Bt8, const float* sb, int M, int N, const Epi& E) {
    pg8::Gemm g{(const bf16_t*)A8, (const bf16_t*)Bt8, M, N, 512, 512, 512, 0, sa, sb}; pg8::StaticOrder S; S.init(M, N, c.G, c.bid);
    pg8::gemm_phase<Epi, pg8::StaticOrder, true, true>(c.lds, g, S, E);
}
enum Phase { PH_CONV = 0, PH_NORM1, PH_GEMM_AB, PH_MIX_AB1, PH_SCAN, PH_MLSTM_C, PH_GEMM_CD, PH_MLA_UP, PH_KNORM, PH_ATTN,
             PH_GATES, PH_BRANCH, PH_OUT, PH_POST1, PH_FFN_UP, PH_FFN_DN, PH_POST2, N_PHASES };

template <int PH>
__device__ __forceinline__ void run_phase(const Ctx& c) {
    unsigned char* ws = c.ws; const int Mrows = (c.layer == 0) ? MTOT : NLAT;
    bf16_t* U = (bf16_t*)(ws + WS_U); bf16_t* Y = (bf16_t*)(ws + WS_Y);
    if constexpr (PH == PH_CONV) { if (c.layer == 0) ph_conv(c, 0, c.bid, c.G, 3, true); }
    if constexpr (PH == PH_NORM1) { if (c.layer == 0) ph_norm1(c); }
    constexpr int CD_SPN = 3; const bool g256 = c.G == 256; const int ab_rem = g256 ? 134 : 0, cd_nskip = g256 ? 106 : 0;
    if constexpr (PH == PH_GEMM_AB) { { pg8::EpiB<pg8::EM_BF16> E{(bf16_t*)(ws + R_PAB) + 768, 2816, nullptr, 0, 0, 0}; run_gemm(c, U, 1024, (const bf16_t*)(ws + W_AB), 1024, MTOT, 1024, 1024, E, g256 ? 16 : 0); }
        { EpiRope<0> E{(bf16_t*)(ws + R_PAB), 2816, (const float*)(ws + SM_ROPE), nullptr, 0, nullptr, nullptr};
          run_gemm_i8(c, (const unsigned char*)c.out + OUT_U8, (const float*)((const unsigned char*)c.out + OUT_U8SC), ws + W_AB8, (const float*)(ws + SC_AB), MTOT, 768, E); }
        { pg8::EpiB<pg8::EM_BF16> E{(bf16_t*)(ws + R_PAB) + 1792, 2816, nullptr, 0, 0, 0};
          pg8::Gemm g{(const bf16_t*)((const unsigned char*)c.out + OUT_U8), (const bf16_t*)(ws + W_AB8 + (size_t)768 * 1024), MTOT, 1024, 512, 512, 512, 0, (const float*)((const unsigned char*)c.out + OUT_U8SC), (const float*)(ws + SC_AB) + 768};
          pg8::StaticOrder S; S.init(MTOT, 1024, c.G, (c.bid + (g256 ? 8 : 0)) % c.G);
          pg8::gemm_phase<pg8::EpiB<pg8::EM_BF16>, pg8::StaticOrder, true, true>(c.lds, g, S, E); }
        if (cd_nskip > 0) { EpiRope<1> E{Y + 1024, 2048, (const float*)(ws + SM_ROPE), (bf16_t*)(ws + R_PD), 1536, (bf16_t*)(ws + R_CKR), (float*)(ws + R_SSQ)};
            pg8::Gemm g{(const bf16_t*)((const unsigned char*)c.out + OUT_U8), (const bf16_t*)(ws + W_C), MTOT, 2560, 512, 512, 512, 0, (const float*)((const unsigned char*)c.out + OUT_U8SC), (const float*)(ws + SC_CD)}; pg8::ColOrder S; S.init(c.bid, ab_rem, cd_nskip, CD_SPN);
            pg8::gemm_phase<EpiRope<1>, pg8::ColOrder, true, true>(c.lds, g, S, E); } }
    if constexpr (PH == PH_MIX_AB1) ph_mix_ab1(c);
    if constexpr (PH == PH_SCAN) ph_scan(c);
    if constexpr (PH == PH_MLSTM_C) ph_mlstm_c(c);
    if constexpr (PH == PH_GEMM_CD) {
        static_assert(W_D == W_C + (size_t)1024 * 1024 * 2, "W_c and W_d are contiguous: one GEMM of N = 2560");
        { EpiRope<1> E{Y + 1024, 2048, (const float*)(ws + SM_ROPE), (bf16_t*)(ws + R_PD), 1536, (bf16_t*)(ws + R_CKR), (float*)(ws + R_SSQ)};
          pg8::Gemm g{(const bf16_t*)((const unsigned char*)c.out + OUT_U8), (const bf16_t*)(ws + W_C), MTOT, 2560, 512, 512, 512, 0, (const float*)((const unsigned char*)c.out + OUT_U8SC), (const float*)(ws + SC_CD)}; pg8::SkipOrder S; S.init(MTOT, 2560, c.G, c.bid, CD_SPN, cd_nskip);
          pg8::gemm_phase<EpiRope<1>, pg8::SkipOrder, true, true>(c.lds, g, S, E); }
    }
    if constexpr (PH == PH_MLA_UP) {
        { EpiRope<2> E{(bf16_t*)(ws + R_CQ), 768, (const float*)(ws + SM_ROPE), nullptr, 0, nullptr, (float*)(ws + R_SSQ)}; run_gemm(c, Y + 1024, 2048, (const bf16_t*)(ws + W_UQ), 512, MTOT, 768, 512, E); }
        { EpiRowScale E{(bf16_t*)(ws + R_CKNV), 1024, (const float*)(ws + R_SSQ)}; run_gemm(c, Y + 1024 + 512, 2048, (const bf16_t*)(ws + W_UKV), 256, MTOT, 1024, 256, E, c.G > 136 ? c.G - 136 : 0); }
    }
    if constexpr (PH == PH_KNORM) ph_knorm(c);
    if constexpr (PH == PH_ATTN) ph_attn(c);
    if constexpr (PH == PH_GATES) { pg8::EpiB<pg8::EM_SIG8> E{(bf16_t*)(ws + R_G), 4096, nullptr, 0, 0, 0}; run_gemm_i8(c, (const unsigned char*)c.out + OUT_U8, (const float*)((const unsigned char*)c.out + OUT_U8SC), ws + W_G, (const float*)(ws + SC_G), Mrows, 4096, E); }
    if constexpr (PH == PH_BRANCH) {
        pg8::EpiB<pg8::EM_GATEACC> E{U, 1024, (const bf16_t*)(ws + R_G), 4096, 1024, 0};
        pg8::Gemm g{Y, (const bf16_t*)(ws + W_BR), Mrows, 1024, 512, 2048, 2048, 1024}; pg8::SliceOrder<4> S; S.init(Mrows, 1024, c.G, c.bid);
        pg8::gemm_phase<pg8::EpiB<pg8::EM_GATEACC>, pg8::SliceOrder<4>, true>(c.lds, g, S, E);
    }
    if constexpr (PH == PH_OUT) { pg8::EpiB<pg8::EM_BF16> E{(bf16_t*)(ws + R_YOUT), 1024, nullptr, 0, 0, 0}; run_gemm(c, U, 1024, (const bf16_t*)(ws + W_OUT), 1024, Mrows, 1024, 1024, E); }
    if constexpr (PH == PH_POST1) ph_post1(c);
    if constexpr (PH == PH_FFN_UP) { pg8::EpiB<pg8::EM_SWIGLU> E{(bf16_t*)(ws + R_HID), 2816, nullptr, 0, 0, 0}; run_gemm_i8(c, ws + WS_U, (const float*)(ws + U_SC), ws + W_GU, (const float*)(ws + SC_GU), Mrows, 5632, E); }
    if constexpr (PH == PH_FFN_DN) { pg8::EpiB<pg8::EM_BF16> E{(bf16_t*)(ws + WS_Y), 1024, nullptr, 0, 0, 0}; run_gemm(c, (const bf16_t*)(ws + R_HID), 2816, (const bf16_t*)(ws + W_DN), 2816, Mrows, 1024, 2816, E);
        if (c.layer == 0) { const int nwg = (Mrows / 256) * 4, nx = nwg % c.G, skip = (2 * nx < c.G) ? nx : 0;
            if (c.bid >= skip) ph_conv(c, 1, c.bid - skip, c.G - skip, 1, false); } }
    if constexpr (PH == PH_POST2) { ph_post2(c); if (c.layer == 0) { __syncthreads(); ph_conv(c, 1, c.bid, c.G, 2, false); } }
}

__device__ __forceinline__ Ctx make_ctx(const Args& args, unsigned char* lds, int layer) {
    typedef const __attribute__((address_space(4))) Args* KArgsP;
    KArgsP ka = (KArgsP)__builtin_amdgcn_kernarg_segment_ptr();
    asm volatile("" : "+s"(ka));
    Ctx c; c.in = (InTab)ka->in; c.out = ka->out; c.ws = ka->ws; c.layer = layer;
    c.lds = (LAS unsigned char*)lds; c.ldsg = (char*)lds;
    c.tid = ltid(); c.lane = c.tid & 63; c.wave = __builtin_amdgcn_readfirstlane(c.tid >> 6); c.G = gridDim.x; c.bid = blockIdx.x;
    return c;
}
template <int PH>
__global__ void __launch_bounds__(512, 2) k_phase(Args args) {
    extern __shared__ __attribute__((aligned(16))) unsigned char lds[];
    const Ctx c = make_ctx(args, lds, args.layer);
    run_phase<PH>(c);
}


#ifndef MK_FUSED
#define MK_FUSED 1
#endif
constexpr int CW_BAR = 4096;
constexpr int LDS_BARW = LDS_BYTES - 64;

__device__ __forceinline__ void grid_bar(const Args& args, unsigned char* lds) {
    typedef const __attribute__((address_space(4))) Args* KArgsP;
    KArgsP ka = (KArgsP)__builtin_amdgcn_kernarg_segment_ptr(); asm volatile("" : "+s"(ka));
    unsigned char* wsb = ka->ws;
    XcdBarrier b; b.bar = (unsigned*)(wsb + WS_CTL) + CW_BAR; b.x = xb_xcc_id(); b.st = (volatile LAS unsigned*)((LAS unsigned char*)lds + LDS_BARW);
    xcd_barrier(b);
}
template <int PH, int PEND>
__device__ __forceinline__ void run_range(const Args& args, unsigned char* lds, int layer, bool last_barrier) {
    if constexpr (PH < PEND) {
        { const Ctx cc = make_ctx(args, lds, layer); run_phase<PH>(cc); }
#ifdef PROBE_DOUBLE
        if constexpr (((PROBE_DOUBLE) >> PH) & 1) { grid_bar(args, lds); const Ctx cc = make_ctx(args, lds, layer); run_phase<PH>(cc); }
#endif
        if ((PH + 1 < PEND || last_barrier) && !((PH == PH_NORM1 || PH == PH_CONV) && layer == 1)) grid_bar(args, lds);
        run_range<PH + 1, PEND>(args, lds, layer, last_barrier);
    }
}
__global__ void __launch_bounds__(512, 2) k_fused(Args args) {
    extern __shared__ __attribute__((aligned(16))) unsigned char lds[];
    { volatile LAS unsigned* st = (volatile LAS unsigned*)((LAS unsigned char*)lds + LDS_BARW);
      if (threadIdx.x < 4) st[threadIdx.x] = 0u;
      __syncthreads();
      (void)xcd_barrier_post((unsigned*)(args.ws + WS_CTL) + CW_BAR, st); }
    run_range<0, N_PHASES>(args, lds, 0, true);
    run_range<0, N_PHASES>(args, lds, 1, false);
}

template <int PH> static void launch_phase(const Args& a, int grid, hipStream_t stream) {
    static bool attr_set = false;
    if (!attr_set) { (void)hipFuncSetAttribute((const void*)k_phase<PH>, hipFuncAttributeMaxDynamicSharedMemorySize, LDS_BYTES); attr_set = true; }
    hipLaunchKernelGGL(k_phase<PH>, dim3(grid), dim3(512), LDS_BYTES, stream, a);
}
template <int PH> static void launch_all(Args& a, int grid, hipStream_t stream) {
    if constexpr (PH < N_PHASES) { launch_phase<PH>(a, grid, stream); launch_all<PH + 1>(a, grid, stream); }
}

extern "C" void kernel_launch(void* const* d_in, const int* in_sizes, int n_in, void* d_out, int out_size, void* d_ws, size_t ws_size, hipStream_t stream) {
    static int grid = 0;
    if (grid == 0) {
        if (n_in != N_IN || out_size != NLAT * DM || ws_size < WS_END) { fprintf(stderr, "kernel_launch: unexpected shapes: n_in %d out %d ws %zu\n", n_in, out_size, ws_size); grid = -1; return; }
        int dev = 0, cus = 0, per_cu = 0;
        if (hipGetDevice(&dev) != hipSuccess || hipDeviceGetAttribute(&cus, hipDeviceAttributeMultiprocessorCount, dev) != hipSuccess) { grid = -1; return; }
#if MK_FUSED
        if (hipFuncSetAttribute((const void*)k_fused, hipFuncAttributeMaxDynamicSharedMemorySize, LDS_BYTES) != hipSuccess) { fprintf(stderr, "kernel_launch: hipFuncSetAttribute failed\n"); grid = -1; return; }
        if (hipOccupancyMaxActiveBlocksPerMultiprocessor(&per_cu, (const void*)k_fused, 512, LDS_BYTES) != hipSuccess || per_cu < 1) fprintf(stderr, "kernel_launch: occupancy query says %d blocks per CU\n", per_cu);
        (void)hipGetLastError();
#endif
        grid = cus;
    }
    if (grid < 0) return;
    (void)hipMemsetAsync((char*)d_ws + WS_CTL, 0, CTL_ZERO_BYTES, stream);
    Args a{};
    for (int i = 0; i < N_IN; ++i) a.in[i] = (const float*)d_in[i];
    a.out = (float*)d_out; a.ws = (unsigned char*)d_ws; a.layer = 0; a.pad = 0;
#if MK_FUSED
    hipLaunchKernelGGL(k_fused, dim3(grid), dim3(512), LDS_BYTES, stream, a);
#else
    for (int l = 0; l < 2; ++l) { a.layer = l; launch_all<0>(a, grid, stream); }
#endif
}
```

```cpp
#include <hip/hip_runtime.h>
#include <hip/hip_bf16.h>
#include <cstdio>
#include <cstdint>
#include <cmath>

#define LAS __attribute__((address_space(3)))
#define GAS __attribute__((address_space(1)))
typedef unsigned short bf16_t;
typedef short bf16x8 __attribute__((ext_vector_type(8)));
typedef short s16x4 __attribute__((ext_vector_type(4)));
typedef float f32x4 __attribute__((ext_vector_type(4)));
typedef float f32x2 __attribute__((ext_vector_type(2)));
typedef float f32x16 __attribute__((ext_vector_type(16)));
typedef unsigned u32x4 __attribute__((ext_vector_type(4)));
typedef unsigned u32x2 __attribute__((ext_vector_type(2)));
typedef int i32x4 __attribute__((ext_vector_type(4)));

__device__ __forceinline__ unsigned cvt_pk_bf16(float lo, float hi) { unsigned r; asm volatile("v_cvt_pk_bf16_f32 %0, %1, %2" : "=v"(r) : "v"(lo), "v"(hi)); return r; }
__device__ __forceinline__ bf16_t f2bf(float f) { return (bf16_t)(cvt_pk_bf16(f, 0.f) & 0xffffu); }
__device__ __forceinline__ float bf2f(bf16_t v) { return __uint_as_float(((unsigned)v) << 16); }
__device__ __forceinline__ float bflo(unsigned w) { return __uint_as_float(w << 16); }
__device__ __forceinline__ float bfhi(unsigned w) { return __uint_as_float(w & 0xffff0000u); }
__device__ __forceinline__ float sigmoidf_(float x) { return __builtin_amdgcn_rcpf(1.f + __builtin_amdgcn_exp2f(-1.4426950408889634f * x)); }
__device__ __forceinline__ int ltid() { int t = threadIdx.x; asm volatile("" : "+v"(t)); return t; }

namespace pg8 {
constexpr int BM = 256, BK = 64, HALF = 128, HTB = HALF * BK * 2, STAGE_BYTES = 8 * HTB, NXCD = 8, WGM = 8;
__host__ __device__ __forceinline__ int lds_byte(int r, int c) { const int st = (r >> 4) * 2 + (c >> 5), rr = r & 15, cc = c & 31, ob = rr * 64 + cc * 2; return st * 1024 + (ob ^ (((ob >> 9) & 1) << 5)); }
__host__ __device__ __forceinline__ void stage_rc(int b, int& R, int& C) { const int st = b / 1024, sb = b % 1024, swz = sb ^ (((sb >> 9) & 1) << 5); R = (st >> 1) * 16 + swz / 64; C = (st & 1) * 32 + (swz % 64) / 2; }
__host__ __device__ __forceinline__ int perm32(int rho) { const int n = rho >> 4, i = rho & 15; return 8 * (i >> 2) + 4 * n + (i & 3); }

struct Unit { int pm, pn, kb; };
struct Gemm { const bf16_t* A; const bf16_t* Bt; int M, N, K, lda, ldb; int kslice = 0; const float* sa = nullptr; const float* sb = nullptr; };

struct StaticOrder {
    int nM, nN, nwg, G, c;
    __host__ __device__ void init(int M, int N, int G_, int c_) { nM = M / BM; nN = N / BM; nwg = nM * nN; G = G_; c = c_; }
    __host__ __device__ bool next(int i, Unit& u) const {
        const long L = (long)i * G + c; if (L >= nwg) return false;
        int wgid = (int)L; { const int q = nwg / NXCD, r = nwg % NXCD, xcd = wgid % NXCD, off = wgid / NXCD; wgid = (xcd < r ? xcd * (q + 1) : r * (q + 1) + (xcd - r) * q) + off; }
        const int nig = WGM * nN, gid = wgid / nig, fm = gid * WGM, gsz = (nM - fm) < WGM ? (nM - fm) : WGM;
        u.pm = fm + ((wgid % nig) % gsz); u.pn = (wgid % nig) / gsz; u.kb = 0; return true;
    }
};
struct SkipOrder {
    StaticOrder S; int G, c, n9, nM, spn, nskip;
    __host__ __device__ void init(int M, int N, int G_, int c_, int spn_, int nskip_) { S.init(M, N - BM, G_, c_); G = G_; c = c_; n9 = S.nwg; nM = M / BM; spn = spn_; nskip = nskip_; }
    __host__ __device__ bool next(int i, Unit& u) const {
        const long L = (long)i * G + c;
        if (L < n9) { S.next(i, u); if (u.pn >= spn) u.pn += 1; return true; }
        const int k = (int)(L - n9); if (k >= nM - nskip) return false;
        u.pm = nskip + k; u.pn = spn; u.kb = 0; return true; }
};
struct ColOrder {
    int c, c0, n, pn;
    __host__ __device__ void init(int c_, int c0_, int n_, int pn_) { c = c_; c0 = c0_; n = n_; pn = pn_; }
    __host__ __device__ bool next(int i, Unit& u) const { if (i != 0 || c < c0 || c >= c0 + n) return false; u.pm = c - c0; u.pn = pn; u.kb = 0; return true; }
};
struct SliceOrder1 {
    StaticOrder S; int kb;
    __host__ __device__ void init(int M, int N, int G_, int c_, int kb_) { S.init(M, N, G_, c_); kb = kb_; }
    __host__ __device__ bool next(int i, Unit& u) const { if (!S.next(i, u)) return false; u.kb = kb; return true; }
};
template <int NS> struct SliceOrder {
    StaticOrder S;
    __host__ __device__ void init(int M, int N, int G_, int c_) { S.init(M, N, G_, c_); }
    __host__ __device__ bool next(int i, Unit& u) const { if (!S.next(i / NS, u)) return false; u.kb = i % NS; return true; }
};

enum { EM_BF16 = 0, EM_SIG = 1, EM_SWIGLU = 2, EM_GATEACC = 3, EM_SIG8 = 4 };
template <int MODE> struct EpiB {
    static constexpr bool PERM = true;
    bf16_t* O; int ldc;
    const bf16_t* G; int ldg; int gcol0; int first;
    bf16_t* O2 = nullptr; int ldc2 = 0, split_pn = 1 << 30;
    __device__ __forceinline__ void operator()(const f32x4 (&acc)[2][2][4][2], const Unit& u, int wr, int wc, int fr, int fq) const {
        const int row0 = u.pm * BM + wr * 64 + fr;
        if constexpr (MODE == EM_SWIGLU) {
            const int col0 = u.pn * HALF + wc * 32 + 8 * fq;
#pragma unroll
            for (int ai = 0; ai < 2; ++ai)
#pragma unroll
                for (int m = 0; m < 4; ++m) { bf16_t* rowp = O + (size_t)(row0 + ai * HALF + m * 16) * ldc + col0;
                    float v[8];
#pragma unroll
                    for (int n = 0; n < 2; ++n)
#pragma unroll
                        for (int j = 0; j < 4; ++j) { const float g = acc[ai][0][m][n][j], up = acc[ai][1][m][n][j]; v[n * 4 + j] = g * sigmoidf_(g) * up; }
                    u32x4 w; w.x = cvt_pk_bf16(v[0], v[1]); w.y = cvt_pk_bf16(v[2], v[3]); w.z = cvt_pk_bf16(v[4], v[5]); w.w = cvt_pk_bf16(v[6], v[7]);
                    *(u32x4*)rowp = w; }
        } else if constexpr (MODE == EM_GATEACC) {
            const int col0 = u.pn * BM + wc * 32 + 8 * fq; constexpr float I255 = 1.f / 255.f;
#pragma unroll
            for (int ai = 0; ai < 2; ++ai) { u32x2 gw[4][2]; u32x4 ow[4][2];
#pragma unroll
                for (int m = 0; m < 4; ++m) { const size_t r = (size_t)(row0 + ai * HALF + m * 16);
#pragma unroll
                    for (int bj = 0; bj < 2; ++bj) gw[m][bj] = *(const u32x2*)((const unsigned char*)G + r * ldg + u.kb * gcol0 + col0 + bj * HALF); }
                if (u.kb != 0) {
#pragma unroll
                    for (int m = 0; m < 4; ++m) { const size_t r = (size_t)(row0 + ai * HALF + m * 16);
#pragma unroll
                        for (int bj = 0; bj < 2; ++bj) ow[m][bj] = *(const u32x4*)(O + r * ldc + col0 + bj * HALF); }
                } else {
#pragma unroll
                    for (int m = 0; m < 4; ++m)
#pragma unroll
                        for (int bj = 0; bj < 2; ++bj) ow[m][bj] = u32x4{0u, 0u, 0u, 0u}; }
                __builtin_amdgcn_sched_barrier(0);
#pragma unroll
                for (int m = 0; m < 4; ++m) { bf16_t* rowp = O + (size_t)(row0 + ai * HALF + m * 16) * ldc + col0;
#pragma unroll
                    for (int bj = 0; bj < 2; ++bj) { f32x4 v0 = acc[ai][bj][m][0], v1 = acc[ai][bj][m][1]; const u32x2 g8 = gw[m][bj]; const u32x4 pw = ow[m][bj];
                        v0[0] = fmaf(v0[0], (float)(g8.x & 255u) * I255, bflo(pw.x)); v0[1] = fmaf(v0[1], (float)((g8.x >> 8) & 255u) * I255, bfhi(pw.x));
                        v0[2] = fmaf(v0[2], (float)((g8.x >> 16) & 255u) * I255, bflo(pw.y)); v0[3] = fmaf(v0[3], (float)(g8.x >> 24) * I255, bfhi(pw.y));
                        v1[0] = fmaf(v1[0], (float)(g8.y & 255u) * I255, bflo(pw.z)); v1[1] = fmaf(v1[1], (float)((g8.y >> 8) & 255u) * I255, bfhi(pw.z));
                        v1[2] = fmaf(v1[2], (float)((g8.y >> 16) & 255u) * I255, bflo(pw.w)); v1[3] = fmaf(v1[3], (float)(g8.y >> 24) * I255, bfhi(pw.w));
                        u32x4 w; w.x = cvt_pk_bf16(v0[0], v0[1]); w.y = cvt_pk_bf16(v0[2], v0[3]); w.z = cvt_pk_bf16(v1[0], v1[1]); w.w = cvt_pk_bf16(v1[2], v1[3]);
                        *(u32x4*)(rowp + bj * HALF) = w; } }
            }
        } else {
            const bool sp = u.pn >= split_pn; const int col0 = (sp ? u.pn - split_pn : u.pn) * BM + wc * 32 + 8 * fq; bf16_t* Ob = sp ? O2 : O; const int ldo_ = sp ? ldc2 : ldc;
#pragma unroll
            for (int ai = 0; ai < 2; ++ai)
#pragma unroll
                for (int m = 0; m < 4; ++m) { const size_t r = (size_t)(row0 + ai * HALF + m * 16); bf16_t* rowp = Ob + r * ldo_ + col0;
#pragma unroll
                    for (int bj = 0; bj < 2; ++bj) { f32x4 v0 = acc[ai][bj][m][0], v1 = acc[ai][bj][m][1];
                        if constexpr (MODE == EM_SIG8) {
                            unsigned lo = 0u, hi = 0u;
#pragma unroll
                            for (int j = 0; j < 4; ++j) { lo |= (unsigned)__float2int_rn(__builtin_amdgcn_rcpf(fmaf(__builtin_amdgcn_exp2f(-1.4426950408889634f * v0[j]), 1.f / 255.f, 1.f / 255.f))) << (8 * j); hi |= (unsigned)__float2int_rn(__builtin_amdgcn_rcpf(fmaf(__builtin_amdgcn_exp2f(-1.4426950408889634f * v1[j]), 1.f / 255.f, 1.f / 255.f))) << (8 * j); }
                            u32x2 w8; w8.x = lo; w8.y = hi; *(u32x2*)((unsigned char*)O + r * ldc + col0 + bj * HALF) = w8; continue; }
                        if constexpr (MODE == EM_SIG) {
#pragma unroll
                            for (int j = 0; j < 4; ++j) { v0[j] = sigmoidf_(v0[j]); v1[j] = sigmoidf_(v1[j]); } }
                        if constexpr (MODE == EM_GATEACC) {
                            const u32x2 gw = *(const u32x2*)((const unsigned char*)G + r * ldg + u.kb * gcol0 + col0 + bj * HALF);
                            constexpr float I255 = 1.f / 255.f;
                            v0[0] *= (float)(gw.x & 255u) * I255; v0[1] *= (float)((gw.x >> 8) & 255u) * I255; v0[2] *= (float)((gw.x >> 16) & 255u) * I255; v0[3] *= (float)(gw.x >> 24) * I255;
                            v1[0] *= (float)(gw.y & 255u) * I255; v1[1] *= (float)((gw.y >> 8) & 255u) * I255; v1[2] *= (float)((gw.y >> 16) & 255u) * I255; v1[3] *= (float)(gw.y >> 24) * I255;
                            if (u.kb != 0) { const u32x4 ow = *(const u32x4*)(rowp + bj * HALF);
                                v0[0] += bflo(ow.x); v0[1] += bfhi(ow.x); v0[2] += bflo(ow.y); v0[3] += bfhi(ow.y);
                                v1[0] += bflo(ow.z); v1[1] += bfhi(ow.z); v1[2] += bflo(ow.w); v1[3] += bfhi(ow.w); } }
                        u32x4 w; w.x = cvt_pk_bf16(v0[0], v0[1]); w.y = cvt_pk_bf16(v0[2], v0[3]); w.z = cvt_pk_bf16(v1[0], v1[1]); w.w = cvt_pk_bf16(v1[2], v1[3]);
                        *(u32x4*)(rowp + bj * HALF) = w; } }
        }
    }
};
struct EpiF32 {
    static constexpr bool PERM = false;
    float* O; int ldc;
    __device__ __forceinline__ void operator()(const f32x4 (&acc)[2][2][4][2], const Unit& u, int wr, int wc, int fr, int fq) const {
        const int row0 = u.pm * BM + wr * 64 + fr, col0 = u.pn * BM + wc * 32 + 4 * fq;
#pragma unroll
        for (int ai = 0; ai < 2; ++ai)
#pragma unroll
            for (int m = 0; m < 4; ++m) { float* rowp = O + (size_t)(row0 + ai * HALF + m * 16) * ldc + col0;
#pragma unroll
                for (int bj = 0; bj < 2; ++bj)
#pragma unroll
                    for (int n = 0; n < 2; ++n) *(f32x4*)(rowp + bj * HALF + n * 16) = acc[ai][bj][m][n]; }
    }
};

template <bool I8> struct AccSel { typedef f32x4 T; };
template <> struct AccSel<true> { typedef i32x4 T; };
template <class Epi, class Sched, bool ALIGN_EPI = true, bool I8 = false>
__device__ __forceinline__ void gemm_phase(LAS unsigned char* lds, const Gemm g, const Sched& S, const Epi& E) {
    typedef f32x4 accv;
    const int tid = ltid(), wid = __builtin_amdgcn_readfirstlane(tid >> 6), lane = tid & 63, wr = wid >> 2, wc = wid & 3, fr = lane & 15, fq = lane >> 4;
    const int K = g.K, nt = K / BK;
    unsigned voffA[2], voffB[2];
#pragma unroll
    for (int i = 0; i < 2; ++i) { int R, C; stage_rc(tid * 16 + i * 8192, R, C); const int Rb = Epi::PERM ? ((R & ~31) + perm32(R & 31)) : R;
        voffA[i] = (unsigned)(R * g.lda + C) * 2u; voffB[i] = (unsigned)(Rb * g.ldb + C) * 2u; }
    const size_t kstep = (size_t)(BK * 2);
    const size_t hstepA = (size_t)HALF * g.lda * 2, hstepB = (size_t)HALF * g.ldb * 2;
    const size_t tstepA = 2 * hstepA, tstepB = 2 * hstepB;
    const unsigned ldsw = (unsigned)wid * 1024u;
    const int aoff = lds_byte(wr * 64 + fr, fq * 8), boff = lds_byte(wc * 32 + fr, fq * 8);
#define PG8_SA(b, h) (((b) * 2 + (h)) * HTB)
#define PG8_SB(b, h) ((4 + (b) * 2 + (h)) * HTB)
#define PG8_STAGE(bufoff, gbase, voff) do { _Pragma("unroll") for (int _i = 0; _i < 2; ++_i) \
        __builtin_amdgcn_global_load_lds((const unsigned*)((const char*)(gbase) + (voff)[_i]), (LAS unsigned*)(lds + (bufoff) + ldsw + _i * 8192), 16, 0, 0); } while (0)
#define PG8_LDA(dst, b, h) do { _Pragma("unroll") for (int m = 0; m < 4; ++m) _Pragma("unroll") for (int k = 0; k < 2; ++k) dst[m][k] = *(const LAS bf16x8*)(lds + PG8_SA(b, h) + aoff + m * 2048 + k * 1024); } while (0)
#define PG8_LDB(dst, b, h) do { _Pragma("unroll") for (int n = 0; n < 2; ++n) _Pragma("unroll") for (int k = 0; k < 2; ++k) dst[n][k] = *(const LAS bf16x8*)(lds + PG8_SB(b, h) + boff + n * 2048 + k * 1024); } while (0)
#define PG8_MMA(ai, bj, At, Bt) do { __builtin_amdgcn_s_setprio(1); _Pragma("unroll") for (int m = 0; m < 4; ++m) _Pragma("unroll") for (int n = 0; n < 2; ++n) _Pragma("unroll") for (int k = 0; k < 2; ++k) { \
        if constexpr (I8) acc[ai][bj][m][n] = __builtin_bit_cast(accv, __builtin_amdgcn_mfma_i32_16x16x64_i8(__builtin_bit_cast(i32x4, Bt[n][k]), __builtin_bit_cast(i32x4, At[m][k]), __builtin_bit_cast(i32x4, acc[ai][bj][m][n]), 0, 0, 0)); \
        else acc[ai][bj][m][n] = __builtin_bit_cast(accv, __builtin_amdgcn_mfma_f32_16x16x32_bf16(Bt[n][k], At[m][k], __builtin_bit_cast(f32x4, acc[ai][bj][m][n]), 0, 0, 0)); } __builtin_amdgcn_s_setprio(0); } while (0)
#define PG8_WAIT_V(n) asm volatile("s_waitcnt vmcnt(" #n ")" ::: "memory")
#define PG8_WAIT_L(n) asm volatile("s_waitcnt lgkmcnt(" #n ")" ::: "memory")
#define PG8_BAR __builtin_amdgcn_s_barrier()
#define PG8_SCHED __builtin_amdgcn_sched_barrier(0)
    Unit cur, nxt; int ui = 0;
    if (!S.next(0, cur)) return;
    accv acc[2][2][4][2];
#pragma unroll
    for (int a = 0; a < 2; ++a)
#pragma unroll
        for (int b = 0; b < 2; ++b)
#pragma unroll
            for (int m = 0; m < 4; ++m)
#pragma unroll
                for (int n = 0; n < 2; ++n) acc[a][b][m][n] = accv{};
    bf16x8 At[4][2], B0[2][2], B1[2][2];
    const char* cA = (const char*)g.A + (size_t)cur.pm * tstepA + (size_t)cur.kb * g.kslice; const char* cB = (const char*)g.Bt + (size_t)cur.pn * tstepB + (size_t)cur.kb * g.kslice;
    PG8_STAGE(PG8_SB(0, 0), cB, voffB); PG8_STAGE(PG8_SB(0, 1), cB + hstepB, voffB); PG8_STAGE(PG8_SA(0, 0), cA, voffA); PG8_STAGE(PG8_SA(0, 1), cA + hstepA, voffA);
    if (wr == 1) PG8_BAR;
    PG8_WAIT_V(2); PG8_BAR;
    PG8_STAGE(PG8_SB(1, 0), cB + kstep, voffB); PG8_STAGE(PG8_SA(1, 0), cA + kstep, voffA); PG8_STAGE(PG8_SB(1, 1), cB + hstepB + kstep, voffB);
    PG8_WAIT_V(6); PG8_BAR;
    for (;;) {
        const bool has_next = S.next(ui + 1, nxt);
        const char* nA = has_next ? (const char*)g.A + (size_t)nxt.pm * tstepA + (size_t)nxt.kb * g.kslice : cA; const char* nB = has_next ? (const char*)g.Bt + (size_t)nxt.pn * tstepB + (size_t)nxt.kb * g.kslice : cB;
        for (int t = 0; t < nt; t += 2) {
            const bool last = (t == nt - 2);
            const char* a1 = cA + (size_t)(t + 1) * kstep;
            const char* a2 = last ? nA : cA + (size_t)(t + 2) * kstep; const char* b2 = last ? nB : cB + (size_t)(t + 2) * kstep;
            const char* a3 = a2 + kstep; const char* b3 = b2 + kstep;
            PG8_LDB(B0, 0, 0); PG8_LDB(B1, 0, 1); PG8_SCHED; PG8_LDA(At, 0, 0); PG8_STAGE(PG8_SA(1, 1), a1 + hstepA, voffA);
            PG8_WAIT_V(8); PG8_WAIT_L(0); PG8_BAR; PG8_MMA(0, 0, At, B0); PG8_MMA(0, 1, At, B1); PG8_BAR; PG8_SCHED;
            PG8_LDA(At, 0, 1); PG8_STAGE(PG8_SB(0, 0), b2, voffB); PG8_STAGE(PG8_SB(0, 1), b2 + hstepB, voffB); PG8_STAGE(PG8_SA(0, 0), a2, voffA);
            PG8_WAIT_V(8); PG8_WAIT_L(0); PG8_BAR; PG8_MMA(1, 0, At, B0); PG8_MMA(1, 1, At, B1); PG8_BAR; PG8_SCHED;
            PG8_LDB(B0, 1, 0); PG8_LDB(B1, 1, 1); PG8_SCHED; PG8_LDA(At, 1, 0); PG8_STAGE(PG8_SA(0, 1), a2 + hstepA, voffA);
            PG8_WAIT_V(8); PG8_WAIT_L(0); PG8_BAR; PG8_MMA(0, 0, At, B0); PG8_MMA(0, 1, At, B1); PG8_BAR; PG8_SCHED;
            PG8_LDA(At, 1, 1); PG8_STAGE(PG8_SB(1, 0), b3, voffB); PG8_STAGE(PG8_SB(1, 1), b3 + hstepB, voffB); PG8_STAGE(PG8_SA(1, 0), a3, voffA);
            PG8_WAIT_V(8); PG8_WAIT_L(0); PG8_BAR; PG8_MMA(1, 0, At, B0); PG8_MMA(1, 1, At, B1); PG8_BAR; PG8_SCHED;
        }
        if constexpr (ALIGN_EPI) { if (wr == 0) PG8_BAR; }
        if constexpr (I8) {
            f32x4 sb4[2][2]; const int cb0 = cur.pn * BM + wc * 32 + (Epi::PERM ? 8 * fq : 4 * fq);
#pragma unroll
            for (int b = 0; b < 2; ++b)
#pragma unroll
                for (int n = 0; n < 2; ++n) sb4[b][n] = *(const f32x4*)(g.sb + cb0 + b * HALF + (Epi::PERM ? 4 * n : 16 * n));
#pragma unroll
            for (int a = 0; a < 2; ++a)
#pragma unroll
                for (int m = 0; m < 4; ++m) { const float ra = g.sa[cur.pm * BM + a * HALF + wr * 64 + m * 16 + fr];
#pragma unroll
                    for (int b = 0; b < 2; ++b)
#pragma unroll
                        for (int n = 0; n < 2; ++n) { const i32x4 v = __builtin_bit_cast(i32x4, acc[a][b][m][n]);
                            acc[a][b][m][n] = (f32x4){(float)v.x, (float)v.y, (float)v.z, (float)v.w} * ra * sb4[b][n]; } }
        }
        E(acc, cur, wr, wc, fr, fq);
        if (!has_next) break;
#pragma unroll
        for (int a = 0; a < 2; ++a)
#pragma unroll
            for (int b = 0; b < 2; ++b)
#pragma unroll
                for (int m = 0; m < 4; ++m)
#pragma unroll
                    for (int n = 0; n < 2; ++n) acc[a][b][m][n] = accv{};
        cur = nxt; cA = nA; cB = nB; ++ui;
        if constexpr (ALIGN_EPI) { if (wr == 1) PG8_BAR; }
    }
    PG8_WAIT_V(0);
    if constexpr (!ALIGN_EPI) { if (wr == 0) PG8_BAR; }
    PG8_BAR;
#undef PG8_SA
#undef PG8_SB
#undef PG8_STAGE
#undef PG8_LDA
#undef PG8_LDB
#undef PG8_MMA
#undef PG8_WAIT_V
#undef PG8_WAIT_L
#undef PG8_BAR
#undef PG8_SCHED
}
}

namespace att {
#ifndef ATTN_UNIT
#define ATTN_UNIT attn_unit_sbd
#endif
#ifndef SKEW_HALVES
#define SKEW_HALVES 0
#endif
#ifndef ATTN_D_UNIT
#define ATTN_D_UNIT attn_unit_p2
#endif
#ifndef ATTN_C_UNIT
#define ATTN_C_UNIT attn_unit_pipe
#endif
#ifndef HO_HALF_EXPR
#define HO_HALF_EXPR (wid >> 2)
#endif
#define SBAR() __builtin_amdgcn_sched_barrier(0)
constexpr int KVBLK = 64;
constexpr int SHM_V = KVBLK * 128 * 2;
__device__ __forceinline__ int crow(int r, int hi) { return (r & 3) + 8 * (r >> 2) + 4 * hi; }
template <int NCB = 4> __device__ __forceinline__ int v_st(int k, int c) { const int kk = (k & ~0xC) | ((k & 4) << 1) | ((k & 8) >> 1); return ((kk >> 3) * NCB + (c >> 5)) * 512 + ((kk & 7) * 32 + (c & 31)) * 2; }
__device__ __forceinline__ int v_rd_base(int lane) { return ((lane & 3) << 3) | (((lane >> 2) & 3) << 6) | (((lane >> 4) & 1) << 5) | (((lane >> 5) & 1) << 8); }
constexpr int v_rd_off(int d0, int ks, int half, int ncb = 4) { return ((2 * ks + half) * ncb + d0) * 512; }
template <int OFF> __device__ __forceinline__ s16x4 tr_read(int vb) {
  s16x4 r; asm volatile("ds_read_b64_tr_b16 %0, %1 offset:%2" : "=&v"(r) : "v"(vb), "i"(OFF) : "memory"); return r;
}
template <int D0, int NCB = 4> __device__ __forceinline__ void pv_one(f32x16& od, int vb, bf16x8 pa0, bf16x8 pa1, bf16x8 pa2, bf16x8 pa3) {
  const s16x4 l0 = tr_read<v_rd_off(D0, 0, 0, NCB)>(vb), h0 = tr_read<v_rd_off(D0, 0, 1, NCB)>(vb), l1 = tr_read<v_rd_off(D0, 1, 0, NCB)>(vb), h1 = tr_read<v_rd_off(D0, 1, 1, NCB)>(vb);
  const s16x4 l2 = tr_read<v_rd_off(D0, 2, 0, NCB)>(vb), h2 = tr_read<v_rd_off(D0, 2, 1, NCB)>(vb), l3 = tr_read<v_rd_off(D0, 3, 0, NCB)>(vb), h3 = tr_read<v_rd_off(D0, 3, 1, NCB)>(vb);
  asm volatile("s_waitcnt lgkmcnt(0)" ::: "memory"); SBAR();
#define PK(L, H) (bf16x8){L[0], L[1], L[2], L[3], H[0], H[1], H[2], H[3]}
  od = __builtin_amdgcn_mfma_f32_32x32x16_bf16(pa0, PK(l0, h0), od, 0, 0, 0);
  od = __builtin_amdgcn_mfma_f32_32x32x16_bf16(pa1, PK(l1, h1), od, 0, 0, 0);
  od = __builtin_amdgcn_mfma_f32_32x32x16_bf16(pa2, PK(l2, h2), od, 0, 0, 0);
  od = __builtin_amdgcn_mfma_f32_32x32x16_bf16(pa3, PK(l3, h3), od, 0, 0, 0);
#undef PK
}
template <int NCB> __device__ __forceinline__ void pv_d0(f32x16* o, int vb, bf16x8 pa0, bf16x8 pa1, bf16x8 pa2, bf16x8 pa3) {
  pv_one<0, NCB>(o[0], vb, pa0, pa1, pa2, pa3); pv_one<1, NCB>(o[1], vb, pa0, pa1, pa2, pa3);
  if constexpr (NCB == 4) { pv_one<2, NCB>(o[2], vb, pa0, pa1, pa2, pa3); pv_one<3, NCB>(o[3], vb, pa0, pa1, pa2, pa3); }
}
struct VFrag { s16x4 l0, h0, l1, h1, l2, h2, l3, h3; };
template <int D0> __device__ __forceinline__ void pv_issue(VFrag& f, int vb) {
  f.l0 = tr_read<v_rd_off(D0, 0, 0)>(vb); f.h0 = tr_read<v_rd_off(D0, 0, 1)>(vb); f.l1 = tr_read<v_rd_off(D0, 1, 0)>(vb); f.h1 = tr_read<v_rd_off(D0, 1, 1)>(vb);
  f.l2 = tr_read<v_rd_off(D0, 2, 0)>(vb); f.h2 = tr_read<v_rd_off(D0, 2, 1)>(vb); f.l3 = tr_read<v_rd_off(D0, 3, 0)>(vb); f.h3 = tr_read<v_rd_off(D0, 3, 1)>(vb);
}
template <int NWAIT> __device__ __forceinline__ void pv_mma(f32x16& od, const VFrag& f, bf16x8 pa0, bf16x8 pa1, bf16x8 pa2, bf16x8 pa3) {
  if constexpr (NWAIT == 8) asm volatile("s_waitcnt lgkmcnt(8)" ::: "memory"); else asm volatile("s_waitcnt lgkmcnt(0)" ::: "memory");
  SBAR();
#ifdef ATT_SETPRIO
  __builtin_amdgcn_s_setprio(1);
#endif
#define PK(L, H) (bf16x8){L[0], L[1], L[2], L[3], H[0], H[1], H[2], H[3]}
  od = __builtin_amdgcn_mfma_f32_32x32x16_bf16(pa0, PK(f.l0, f.h0), od, 0, 0, 0);
  od = __builtin_amdgcn_mfma_f32_32x32x16_bf16(pa1, PK(f.l1, f.h1), od, 0, 0, 0);
  od = __builtin_amdgcn_mfma_f32_32x32x16_bf16(pa2, PK(f.l2, f.h2), od, 0, 0, 0);
  od = __builtin_amdgcn_mfma_f32_32x32x16_bf16(pa3, PK(f.l3, f.h3), od, 0, 0, 0);
#undef PK
#ifdef ATT_SETPRIO
  __builtin_amdgcn_s_setprio(0);
#endif
}
__device__ __forceinline__ void pv_d0_pf(f32x16* o, int vb, bf16x8 pa0, bf16x8 pa1, bf16x8 pa2, bf16x8 pa3) {
  VFrag fa, fb;
  pv_issue<0>(fa, vb); pv_issue<1>(fb, vb); pv_mma<8>(o[0], fa, pa0, pa1, pa2, pa3); pv_issue<2>(fa, vb);
  pv_mma<8>(o[1], fb, pa0, pa1, pa2, pa3); pv_issue<3>(fb, vb);
  pv_mma<8>(o[2], fa, pa0, pa1, pa2, pa3); pv_mma<0>(o[3], fb, pa0, pa1, pa2, pa3);
}
__device__ __forceinline__ void partialSM(f32x16& p0, f32x16& p1, float& m_reg, float& mn, float& alpha, const float C, const float thr_raw) {
  float pmax = p0[0];
#pragma unroll
  for (int r = 1; r < 16; ++r) pmax = fmaxf(pmax, p0[r]);
#pragma unroll
  for (int r = 0; r < 16; ++r) pmax = fmaxf(pmax, p1[r]);
  { auto rr = __builtin_amdgcn_permlane32_swap(__float_as_uint(pmax), __float_as_uint(pmax), false, false);
    pmax = fmaxf(__uint_as_float(rr[0]), __uint_as_float(rr[1])); }
  if (__builtin_expect(__all(pmax - m_reg <= thr_raw), 1)) { mn = m_reg; alpha = 1.f; }
  else { mn = fmaxf(m_reg, pmax); alpha = __builtin_amdgcn_exp2f((m_reg - mn) * C); m_reg = mn; }
  const float mnC = -mn * C;
#pragma unroll
  for (int r = 0; r < 16; ++r) p0[r] = fmaf(p0[r], C, mnC);
#pragma unroll
  for (int r = 0; r < 16; ++r) p1[r] = fmaf(p1[r], C, mnC);
#pragma unroll
  for (int r = 0; r < 16; ++r) p0[r] = __builtin_amdgcn_exp2f(p0[r]);
}
__device__ __forceinline__ void finishSM(f32x16& p0, f32x16& p1, float alpha, float& l_reg, bf16x8& pa0, bf16x8& pa1, bf16x8& pa2, bf16x8& pa3) {
#pragma unroll
  for (int r = 0; r < 16; ++r) p1[r] = __builtin_amdgcn_exp2f(p1[r]);
  float ps = 0;
#pragma unroll
  for (int r = 0; r < 16; ++r) ps += p0[r];
#pragma unroll
  for (int r = 0; r < 16; ++r) ps += p1[r];
  { auto rr = __builtin_amdgcn_permlane32_swap(__float_as_uint(ps), __float_as_uint(ps), false, false);
    ps = __uint_as_float(rr[0]) + __uint_as_float(rr[1]); }
  l_reg = l_reg * alpha + ps;
#define PK4(P, BASE, OUT) do { unsigned a0 = cvt_pk_bf16(P[BASE + 0], P[BASE + 1]), a1 = cvt_pk_bf16(P[BASE + 2], P[BASE + 3]);   \
    unsigned b0 = cvt_pk_bf16(P[BASE + 4], P[BASE + 5]), b1 = cvt_pk_bf16(P[BASE + 6], P[BASE + 7]);                              \
    auto r0 = __builtin_amdgcn_permlane32_swap(a0, b0, false, false); auto r1 = __builtin_amdgcn_permlane32_swap(a1, b1, false, false); \
    u32x4 w = {r0[0], r1[0], r0[1], r1[1]}; OUT = *reinterpret_cast<bf16x8*>(&w); } while (0)
  PK4(p0, 0, pa0); PK4(p0, 8, pa1); PK4(p1, 0, pa2); PK4(p1, 8, pa3);
#undef PK4
}
template <int NQ, int KSTR>
__device__ __forceinline__ void qkt(f32x16& p0, f32x16& p1, const char* Ks, const bf16x8* qr, int r32, int hi) {
  p0 = f32x16{}; p1 = f32x16{};
#pragma unroll
  for (int d0 = 0; d0 < NQ; ++d0) { const int cb = (d0 * 16 + hi * 8) * 2;
    const bf16x8 b0 = *reinterpret_cast<const bf16x8*>(Ks + r32 * KSTR + cb);
    const bf16x8 b1 = *reinterpret_cast<const bf16x8*>(Ks + (32 + r32) * KSTR + cb);
    p0 = __builtin_amdgcn_mfma_f32_32x32x16_bf16(b0, qr[d0], p0, 0, 0, 0);
    p1 = __builtin_amdgcn_mfma_f32_32x32x16_bf16(b1, qr[d0], p1, 0, 0, 0); }
}

struct KeySrc {
  int lat_row0, n_lat_tiles, ctx_row0, wj_lo;
  __device__ __forceinline__ long row0(int j) const { return j < n_lat_tiles ? (long)lat_row0 + 64 * j : (long)ctx_row0 + 64 * (j - n_lat_tiles); }
};

template <int MODE>
__device__ __forceinline__ void attn_unit(const bf16_t* __restrict__ Qp, int ldq, const bf16_t* __restrict__ Kn, int ldk, const bf16_t* __restrict__ Kr,
                                          const bf16_t* __restrict__ Vp, int ldv, bf16_t* O1, bf16_t* O2, int ldo, int ldo2, const KeySrc ks, int NT, float scale, const float* sinkp, char* lds) {
  constexpr int NQ = MODE == 0 ? 12 : 4;
  constexpr int KCOLS = MODE == 0 ? 192 : (MODE == 1 ? 128 : 64);
  constexpr int DV = MODE == 2 ? 64 : 128, NCB = DV / 32;
  constexpr int KSTR = KCOLS * 2 + 16;
  constexpr int SHM_K = KVBLK * KSTR, SHM_VB = KVBLK * DV * 2;
  const int tid = ltid(), wid = tid >> 6, lane = tid & 63, r32 = lane & 31, hi = lane >> 5;
  char* V_lds = lds; char* K_lds = lds + 2 * SHM_VB;
  float* wsf = (float*)(lds + 2 * SHM_VB + 2 * SHM_K) + wid * 64; float* li_l = wsf; float* al_l = wsf + 32;
  const float C = scale * 1.4426950408889634f, thr_raw = 8.f / scale;
  float m_reg = -1e30f, l_reg = 0; f32x16 o[NCB] = {}; bf16x8 qr[NQ];
  if (MODE == 2) { m_reg = sinkp[wid & 3] / scale; l_reg = 1.f; }
  const int qrow = (MODE == 0 ? wid * 32 : (MODE == 1 ? (wid & 3) * 32 : (wid >> 2) * 32)) + r32;
  const int qcol = (MODE == 0 ? 0 : (MODE == 1 ? (wid >> 2) * 64 : (wid & 3) * 64)) + hi * 8;
  const int kwoff = (MODE == 1 ? (wid >> 2) * 128 : 0);
  const int qrel = (wid >> 2) * 32 + r32;
  { const bf16_t* Qw = Qp + (long)qrow * ldq + qcol;
#pragma unroll
    for (int d0 = 0; d0 < NQ; ++d0) qr[d0] = *reinterpret_cast<const bf16x8*>(Qw + d0 * 16); }
  const int sr = tid >> 4, sc = (tid & 15) * 8, vst0 = v_st<4>(sr, sc), vst1 = v_st<4>(32 + sr, sc);
  const int rr = tid >> 3, rc = (tid & 7) * 8;
  const int vst2 = v_st<2>(rr, rc);
  const int vb0 = (int)(uintptr_t)V_lds + v_rd_base(lane);
  bf16x8 vs0, vs1, ks0, ks1, kr0;
#define SLOAD(j) do { const long r0_ = ks.row0(j); \
    if (MODE == 2) { vs0 = *reinterpret_cast<const bf16x8*>(Vp + (r0_ + rr) * ldv + rc); ks0 = *reinterpret_cast<const bf16x8*>(Kn + (r0_ + rr) * ldk + rc); } else { \
    vs0 = *reinterpret_cast<const bf16x8*>(Vp + (r0_ + sr) * ldv + sc); vs1 = *reinterpret_cast<const bf16x8*>(Vp + (r0_ + 32 + sr) * ldv + sc); \
    ks0 = *reinterpret_cast<const bf16x8*>(Kn + (r0_ + sr) * ldk + sc); ks1 = *reinterpret_cast<const bf16x8*>(Kn + (r0_ + 32 + sr) * ldk + sc); \
    if (MODE == 0) kr0 = *reinterpret_cast<const bf16x8*>(Kr + (r0_ + rr) * 64 + rc); } } while (0)
#define SWRITE(b) do { if (MODE == 2) { *(bf16x8*)(V_lds + (b) * SHM_VB + vst2) = vs0; *(bf16x8*)(K_lds + (b) * SHM_K + rr * KSTR + rc * 2) = ks0; } else { \
    *(bf16x8*)(V_lds + (b) * SHM_VB + vst0) = vs0; *(bf16x8*)(V_lds + (b) * SHM_VB + vst1) = vs1; \
    *(bf16x8*)(K_lds + (b) * SHM_K + sr * KSTR + sc * 2) = ks0; *(bf16x8*)(K_lds + (b) * SHM_K + (32 + sr) * KSTR + sc * 2) = ks1; \
    if (MODE == 0) *(bf16x8*)(K_lds + (b) * SHM_K + rr * KSTR + 256 + rc * 2) = kr0; } } while (0)
  f32x16 p0, p1; float mn, al; bf16x8 pa0, pa1, pa2, pa3;
  __syncthreads();
  SLOAD(0); asm volatile("s_waitcnt vmcnt(0)" ::: "memory"); SWRITE(0);
  for (int j = 0; j < NT; ++j) {
    __syncthreads();
    const int b = j & 1;
    if (j + 1 < NT) SLOAD(j + 1);
    SBAR();
    qkt<NQ, KSTR>(p0, p1, K_lds + b * SHM_K + kwoff, qr, r32, hi);
    if (MODE == 2) { const int wj = j >= ks.n_lat_tiles ? -1 : ks.wj_lo + j;
      if (wj == 0) {
#pragma unroll
        for (int r = 0; r < 16; ++r) { const int kk = crow(r, hi); if (kk < qrel) p0[r] = -INFINITY; if (kk + 32 < qrel) p1[r] = -INFINITY; } }
      if (wj == 4) {
#pragma unroll
        for (int r = 0; r < 16; ++r) { const int kk = crow(r, hi); if (kk > qrel) p0[r] = -INFINITY; if (kk + 32 > qrel) p1[r] = -INFINITY; } } }
    partialSM(p0, p1, m_reg, mn, al, C, thr_raw);
    if (__any(al < 1.f)) { if (hi == 0) al_l[r32] = al; asm volatile("s_waitcnt lgkmcnt(0)" ::: "memory");
#pragma unroll
      for (int d = 0; d < NCB; ++d)
#pragma unroll
        for (int r = 0; r < 16; ++r) o[d][r] *= al_l[crow(r, hi)]; }
    finishSM(p0, p1, al, l_reg, pa0, pa1, pa2, pa3); SBAR();
    pv_d0<NCB>(o, vb0 + b * SHM_VB, pa0, pa1, pa2, pa3);
    if (j + 1 < NT) { asm volatile("s_waitcnt vmcnt(0)" ::: "memory"); SWRITE(b ^ 1); }
  }
  if (hi == 0) li_l[r32] = l_reg; asm volatile("s_waitcnt lgkmcnt(0)" ::: "memory");
  float rli[16];
#pragma unroll
  for (int r = 0; r < 16; ++r) rli[r] = __builtin_amdgcn_rcpf(li_l[crow(r, hi)]);
  const bool second = (MODE == 1 && wid >= 4); const int ldw = second ? ldo2 : ldo;
  bf16_t* Ow = (second ? O2 : O1) + (long)(MODE == 0 ? wid * 32 : (MODE == 1 ? (wid & 3) * 32 : (wid >> 2) * 32)) * ldw + (MODE == 2 ? (wid & 3) * 64 : 0);
#pragma unroll
  for (int r = 0; r < 16; ++r) { const int orow = crow(r, hi);
#pragma unroll
    for (int d0 = 0; d0 < NCB; ++d0) Ow[(long)orow * ldw + d0 * 32 + r32] = f2bf(o[d0][r] * rli[r]); }
#undef SLOAD
#undef SWRITE
}

__device__ __forceinline__ bf16x8 scale_q(const bf16x8 q, const float a) {
  const u32x4 w = *reinterpret_cast<const u32x4*>(&q); u32x4 o;
  o.x = cvt_pk_bf16(bflo(w.x) * a, bfhi(w.x) * a); o.y = cvt_pk_bf16(bflo(w.y) * a, bfhi(w.y) * a); o.z = cvt_pk_bf16(bflo(w.z) * a, bfhi(w.z) * a); o.w = cvt_pk_bf16(bflo(w.w) * a, bfhi(w.w) * a);
  return *reinterpret_cast<const bf16x8*>(&o);
}
template <int NQ, int KSTR, int NQR = NQ>
__device__ __forceinline__ void qkt_m(f32x16& p0, f32x16& p1, const char* Ks, const bf16x8* qr, int r32, int hi, float negm, const char* qspill = nullptr) {
#pragma unroll
  for (int r = 0; r < 16; ++r) { p0[r] = negm; p1[r] = negm; }
#ifdef ATT_SETPRIO
  __builtin_amdgcn_s_setprio(1);
#endif
#pragma unroll
  for (int d0 = 0; d0 < NQ; ++d0) { const int cb = (d0 * 16 + hi * 8) * 2;
    const bf16x8 b0 = *reinterpret_cast<const bf16x8*>(Ks + r32 * KSTR + cb);
    const bf16x8 b1 = *reinterpret_cast<const bf16x8*>(Ks + (32 + r32) * KSTR + cb);
    bf16x8 qf; if (d0 < NQR) qf = qr[d0]; else qf = *reinterpret_cast<const bf16x8*>(qspill + (d0 - NQR) * 1024);
    p0 = __builtin_amdgcn_mfma_f32_32x32x16_bf16(b0, qf, p0, 0, 0, 0);
    p1 = __builtin_amdgcn_mfma_f32_32x32x16_bf16(b1, qf, p1, 0, 0, 0); }
#ifdef ATT_SETPRIO
  __builtin_amdgcn_s_setprio(0);
#endif
}
template <int NQ, int KSTR, int NQR = NQ>
__device__ __forceinline__ void qkt_z(f32x16& p0, f32x16& p1, const char* Ks, const bf16x8* qr, int r32, int hi, const char* qspill = nullptr) {
  p0 = f32x16{}; p1 = f32x16{};
#pragma unroll
  for (int d0 = 0; d0 < NQ; ++d0) { const int cb = (d0 * 16 + hi * 8) * 2;
    const bf16x8 b0 = *reinterpret_cast<const bf16x8*>(Ks + r32 * KSTR + cb);
    const bf16x8 b1 = *reinterpret_cast<const bf16x8*>(Ks + (32 + r32) * KSTR + cb);
    bf16x8 qf; if (d0 < NQR) qf = qr[d0]; else qf = *reinterpret_cast<const bf16x8*>(qspill + (d0 - NQR) * 1024);
    p0 = __builtin_amdgcn_mfma_f32_32x32x16_bf16(b0, qf, p0, 0, 0, 0);
    p1 = __builtin_amdgcn_mfma_f32_32x32x16_bf16(b1, qf, p1, 0, 0, 0); }
}
template <bool FIRST>
__device__ __forceinline__ void partialSM2(f32x16& p0, f32x16& p1, float& m_reg, float& alpha, const bool fast = false) {
  constexpr float THR2 = 11.5415603f;
  alpha = 1.f;
  if (!fast) {
    float pmax = p0[0];
#pragma unroll
    for (int r = 1; r < 16; ++r) pmax = fmaxf(pmax, p0[r]);
#pragma unroll
    for (int r = 0; r < 16; ++r) pmax = fmaxf(pmax, p1[r]);
    { auto rr = __builtin_amdgcn_permlane32_swap(__float_as_uint(pmax), __float_as_uint(pmax), false, false);
      pmax = fmaxf(__uint_as_float(rr[0]), __uint_as_float(rr[1])); }
    if (FIRST || !__builtin_expect(__all(pmax <= THR2), 1)) {
      const float delta = FIRST ? pmax : fmaxf(pmax, 0.f); alpha = __builtin_amdgcn_exp2f(-delta); m_reg += delta;
#pragma unroll
      for (int r = 0; r < 16; ++r) { p0[r] -= delta; p1[r] -= delta; }
    }
  }
#pragma unroll
  for (int r = 0; r < 16; ++r) p0[r] = __builtin_amdgcn_exp2f(p0[r]);
}
constexpr float FAST_B2 = 3600.f;
__device__ __forceinline__ float sq8(const bf16x8 q) { const u32x4 w = *reinterpret_cast<const u32x4*>(&q);
  return (bflo(w.x) * bflo(w.x) + bfhi(w.x) * bfhi(w.x)) + (bflo(w.y) * bflo(w.y) + bfhi(w.y) * bfhi(w.y)) + (bflo(w.z) * bflo(w.z) + bfhi(w.z) * bfhi(w.z)) + (bflo(w.w) * bflo(w.w) + bfhi(w.w) * bfhi(w.w)); }
__device__ __forceinline__ void partialSM2r(f32x16& p0, f32x16& p1, float& m_reg, float& alpha, const bool first) {
  constexpr float THR2 = 11.5415603f;
  float pmax = p0[0];
#pragma unroll
  for (int r = 1; r < 16; ++r) pmax = fmaxf(pmax, p0[r]);
#pragma unroll
  for (int r = 0; r < 16; ++r) pmax = fmaxf(pmax, p1[r]);
  { auto rr = __builtin_amdgcn_permlane32_swap(__float_as_uint(pmax), __float_as_uint(pmax), false, false);
    pmax = fmaxf(__uint_as_float(rr[0]), __uint_as_float(rr[1])); }
  alpha = 1.f;
  if (first || !__builtin_expect(__all(pmax <= THR2), 1)) {
    const float delta = first ? pmax : fmaxf(pmax, 0.f); alpha = __builtin_amdgcn_exp2f(-delta); m_reg += delta;
#pragma unroll
    for (int r = 0; r < 16; ++r) { p0[r] -= delta; p1[r] -= delta; }
  }
#pragma unroll
  for (int r = 0; r < 16; ++r) p0[r] = __builtin_amdgcn_exp2f(p0[r]);
}
template <int MODE>
__device__ __forceinline__ void attn_unit_pipe(const bf16_t* __restrict__ Qp, int ldq, const bf16_t* __restrict__ Kn, int ldk, const bf16_t* __restrict__ Kr,
                                               const bf16_t* __restrict__ Vp, int ldv, bf16_t* O1, bf16_t* O2, int ldo, int ldo2, const KeySrc ks, int NT, float scale, char* lds, const float* kn2 = nullptr) {
  constexpr int NQ = MODE == 0 ? 12 : 4;
  constexpr int KCOLS = MODE == 0 ? 192 : 128;
  constexpr int KSTR = KCOLS * 2 + 16;
  constexpr int SHM_K = KVBLK * KSTR, SHM_VB = KVBLK * 128 * 2;
  constexpr int SDEPTH = MODE == 0 ? 1 : 2, SE = 0, SO = SDEPTH - 1;
  constexpr int NQR = NQ;
  const int tid = ltid(), wid = tid >> 6, lane = tid & 63, r32 = lane & 31, hi = lane >> 5;
  char* V_lds = lds; char* K_lds = lds + 2 * SHM_VB;
  float* wsf = (float*)(lds + 2 * SHM_VB + 2 * SHM_K) + wid * 64; float* li_l = wsf; float* al_l = wsf + 32;
  float m_reg = 0.f, l_reg = 0, qn2 = 0.f; f32x16 o[4] = {}; bf16x8 qr[NQR];
  char* qspill = lds + 2 * SHM_VB + 2 * SHM_K + 2048 + wid * 4096 + lane * 16;
  const int qrow = (MODE == 0 ? wid * 32 : (wid & 3) * 32) + r32;
  const int qcol = (MODE == 0 ? 0 : (wid >> 2) * 64) + hi * 8;
  const int kwoff = (MODE == 1 ? (wid >> 2) * 128 : 0);
  __syncthreads();
  { const bf16_t* Qw = Qp + (long)qrow * ldq + qcol; const float C = scale * 1.4426950408889634f;
#pragma unroll
    for (int d0 = 0; d0 < NQ; ++d0) { const bf16x8 qf = scale_q(*reinterpret_cast<const bf16x8*>(Qw + d0 * 16), C); qn2 += sq8(qf);
      if (d0 < NQR) qr[d0] = qf; else *reinterpret_cast<bf16x8*>(qspill + (d0 - NQR) * 1024) = qf; } }
  { auto rr_ = __builtin_amdgcn_permlane32_swap(__float_as_uint(qn2), __float_as_uint(qn2), false, false); qn2 = __uint_as_float(rr_[0]) + __uint_as_float(rr_[1]); }
  const bool fast = kn2 != nullptr && __all(qn2 * kn2[MODE == 1 ? (wid >> 2) : 0] <= FAST_B2);
  const int sr = tid >> 4, sc = (tid & 15) * 8, vst0 = v_st<4>(sr, sc), vst1 = v_st<4>(32 + sr, sc);
  const int rr = tid >> 3, rc = (tid & 7) * 8;
  const int vb0 = (int)(uintptr_t)V_lds + v_rd_base(lane);
  struct { bf16x8 vs0, vs1, ks0, ks1, kr0; } sr_[SDEPTH];
  const unsigned voff0 = (unsigned)(sr * ldv + sc) * 2u, voff1 = voff0 + (unsigned)(32 * ldv) * 2u, koff0 = (unsigned)(sr * ldk + sc) * 2u, koff1 = koff0 + (unsigned)(32 * ldk) * 2u, roff = (unsigned)(rr * 64 + rc) * 2u;
#define SLOAD(i, j) do { const long r0_ = __builtin_amdgcn_readfirstlane((int)ks.row0(j)); const char* vb_ = (const char*)Vp + r0_ * ldv * 2; const char* kb_ = (const char*)Kn + r0_ * ldk * 2; \
    sr_[i].vs0 = *reinterpret_cast<const bf16x8*>(vb_ + voff0); sr_[i].vs1 = *reinterpret_cast<const bf16x8*>(vb_ + voff1); \
    sr_[i].ks0 = *reinterpret_cast<const bf16x8*>(kb_ + koff0); sr_[i].ks1 = *reinterpret_cast<const bf16x8*>(kb_ + koff1); \
    if (MODE == 0) { const char* rb_ = (const char*)Kr + r0_ * 128; sr_[i].kr0 = *reinterpret_cast<const bf16x8*>(rb_ + roff); } } while (0)
#define SWRITE(b, i) do { *(bf16x8*)(V_lds + (b) * SHM_VB + vst0) = sr_[i].vs0; *(bf16x8*)(V_lds + (b) * SHM_VB + vst1) = sr_[i].vs1; \
    *(bf16x8*)(K_lds + (b) * SHM_K + sr * KSTR + sc * 2) = sr_[i].ks0; *(bf16x8*)(K_lds + (b) * SHM_K + (32 + sr) * KSTR + sc * 2) = sr_[i].ks1; \
    if (MODE == 0) *(bf16x8*)(K_lds + (b) * SHM_K + rr * KSTR + 256 + rc * 2) = sr_[i].kr0; } while (0)
#define SWAIT() do { if constexpr (SDEPTH == 2) asm volatile("s_waitcnt vmcnt(4)" ::: "memory"); else asm volatile("s_waitcnt vmcnt(0)" ::: "memory"); } while (0)
#define RESC(a) do { if (__any((a) < 1.f)) { if (hi == 0) al_l[r32] = (a); asm volatile("s_waitcnt lgkmcnt(0)" ::: "memory"); \
    _Pragma("unroll") for (int d = 0; d < 4; ++d) _Pragma("unroll") for (int r = 0; r < 16; ++r) o[d][r] *= al_l[crow(r, hi)]; } } while (0)
#ifdef ATTN_PIPE_PF
#define PV_PIPE pv_d0_pf
#else
#define PV_PIPE pv_d0<4>
#endif
  f32x16 pA0, pA1, pB0, pB1; float alA, alB; bf16x8 pa0, pa1, pa2, pa3;
  const char* K0 = K_lds + kwoff; const char* K1 = K_lds + SHM_K + kwoff;
  SLOAD(SE, 0); asm volatile("s_waitcnt vmcnt(0)" ::: "memory"); SWRITE(0, SE); __syncthreads();
  qkt_m<NQ, KSTR, NQR>(pA0, pA1, K0, qr, r32, hi, 0.f, qspill); partialSM2<true>(pA0, pA1, m_reg, alA, fast); alA = 1.f;
  SLOAD(SO, 1); if constexpr (SDEPTH == 2) { if (2 < NT) SLOAD(SE, 2); }
  SWAIT(); SWRITE(1, SO); __syncthreads();
  for (int j = 1; j + 1 < NT; j += 2) {
    SBAR(); if (fast) qkt_z<NQ, KSTR, NQR>(pB0, pB1, K1, qr, r32, hi, qspill); else qkt_m<NQ, KSTR, NQR>(pB0, pB1, K1, qr, r32, hi, -m_reg, qspill);
    finishSM(pA0, pA1, alA, l_reg, pa0, pa1, pa2, pa3); SBAR();
    SLOAD(SO, j + SDEPTH); SBAR();
    PV_PIPE(o, vb0, pa0, pa1, pa2, pa3); partialSM2<false>(pB0, pB1, m_reg, alB, fast);
    __syncthreads(); SWAIT(); SWRITE(0, SE);
    RESC(alB); __syncthreads();
    SBAR(); if (fast) qkt_z<NQ, KSTR, NQR>(pA0, pA1, K0, qr, r32, hi, qspill); else qkt_m<NQ, KSTR, NQR>(pA0, pA1, K0, qr, r32, hi, -m_reg, qspill);
    finishSM(pB0, pB1, alB, l_reg, pa0, pa1, pa2, pa3); SBAR();
    if (SDEPTH == 1 || j + 3 < NT) SLOAD(SE, j + 1 + SDEPTH); SBAR();
    PV_PIPE(o, vb0 + SHM_VB, pa0, pa1, pa2, pa3); partialSM2<false>(pA0, pA1, m_reg, alA, fast);
    __syncthreads(); SWAIT(); SWRITE(1, SO);
    RESC(alA); __syncthreads();
  }
  SBAR(); if (fast) qkt_z<NQ, KSTR, NQR>(pB0, pB1, K1, qr, r32, hi, qspill); else qkt_m<NQ, KSTR, NQR>(pB0, pB1, K1, qr, r32, hi, -m_reg, qspill);
  finishSM(pA0, pA1, alA, l_reg, pa0, pa1, pa2, pa3); SBAR();
  PV_PIPE(o, vb0, pa0, pa1, pa2, pa3); partialSM2<false>(pB0, pB1, m_reg, alB, fast);
  RESC(alB);
  finishSM(pB0, pB1, alB, l_reg, pa0, pa1, pa2, pa3); SBAR();
  PV_PIPE(o, vb0 + SHM_VB, pa0, pa1, pa2, pa3);
  if (hi == 0) li_l[r32] = l_reg; asm volatile("s_waitcnt lgkmcnt(0)" ::: "memory");
  float rli[16];
#pragma unroll
  for (int r = 0; r < 16; ++r) rli[r] = __builtin_amdgcn_rcpf(li_l[crow(r, hi)]);
  const bool second = (MODE == 1 && wid >= 4); const int ldw = second ? ldo2 : ldo;
  bf16_t* Ow = (second ? O2 : O1) + (long)(MODE == 0 ? wid * 32 : (wid & 3) * 32) * ldw;
#pragma unroll
  for (int r = 0; r < 16; ++r) { const int orow = crow(r, hi);
#pragma unroll
    for (int d0 = 0; d0 < 4; ++d0) Ow[(long)orow * ldw + d0 * 32 + r32] = f2bf(o[d0][r] * rli[r]); }
#undef SLOAD
#undef SWRITE
#undef SWAIT
#undef RESC
#undef PV_PIPE
}

template <int MODE>
__device__ __forceinline__ void attn_unit_ho(const bf16_t* __restrict__ Qp, int ldq, const bf16_t* __restrict__ Kn, int ldk, const bf16_t* __restrict__ Kr,
                                             const bf16_t* __restrict__ Vp, int ldv, bf16_t* O1, bf16_t* O2, int ldo, int ldo2, const KeySrc ks, int NT, float scale, char* lds) {
  constexpr int NQ = MODE == 0 ? 12 : 4;
  constexpr int KCOLS = MODE == 0 ? 192 : 128;
  constexpr int KSTR = KCOLS * 2 + 16;
  constexpr int SHM_K = KVBLK * KSTR, SHM_VB = KVBLK * 128 * 2;
  const int tid = ltid(), wid = tid >> 6, lane = tid & 63, r32 = lane & 31, hi = lane >> 5;
  const int half = __builtin_amdgcn_readfirstlane(HO_HALF_EXPR);
  char* V_lds = lds; char* K_lds = lds + 2 * SHM_VB;
  float* wsf = (float*)(lds + 2 * SHM_VB + 2 * SHM_K) + wid * 64; float* li_l = wsf; float* al_l = wsf + 32;
  float m_reg = 0.f, l_reg = 0; f32x16 o[4] = {}; bf16x8 qr[NQ];
  const int qrow = (MODE == 0 ? wid * 32 : (wid & 3) * 32) + r32;
  const int qcol = (MODE == 0 ? 0 : (wid >> 2) * 64) + hi * 8;
  const int kwoff = (MODE == 1 ? (wid >> 2) * 128 : 0);
  { const bf16_t* Qw = Qp + (long)qrow * ldq + qcol; const float C = scale * 1.4426950408889634f;
#pragma unroll
    for (int d0 = 0; d0 < NQ; ++d0) qr[d0] = scale_q(*reinterpret_cast<const bf16x8*>(Qw + d0 * 16), C); }
  const int sr = tid >> 4, sc = (tid & 15) * 8, vst0 = v_st<4>(sr, sc), vst1 = v_st<4>(32 + sr, sc);
  const int rr = tid >> 3, rc = (tid & 7) * 8;
  const int vb0 = (int)(uintptr_t)V_lds + v_rd_base(lane);
  bf16x8 vs0, vs1, ks0, ks1, kr0;
#define KLOAD(j) do { const long r0_ = ks.row0(j); ks0 = *reinterpret_cast<const bf16x8*>(Kn + (r0_ + sr) * ldk + sc); ks1 = *reinterpret_cast<const bf16x8*>(Kn + (r0_ + 32 + sr) * ldk + sc); \
    if (MODE == 0) kr0 = *reinterpret_cast<const bf16x8*>(Kr + (r0_ + rr) * 64 + rc); } while (0)
#define VLOAD(j) do { const long r0_ = ks.row0(j); vs0 = *reinterpret_cast<const bf16x8*>(Vp + (r0_ + sr) * ldv + sc); vs1 = *reinterpret_cast<const bf16x8*>(Vp + (r0_ + 32 + sr) * ldv + sc); } while (0)
#define KWRITE(b) do { *(bf16x8*)(K_lds + (b) * SHM_K + sr * KSTR + sc * 2) = ks0; *(bf16x8*)(K_lds + (b) * SHM_K + (32 + sr) * KSTR + sc * 2) = ks1; \
    if (MODE == 0) *(bf16x8*)(K_lds + (b) * SHM_K + rr * KSTR + 256 + rc * 2) = kr0; } while (0)
#define VWRITE(b) do { *(bf16x8*)(V_lds + (b) * SHM_VB + vst0) = vs0; *(bf16x8*)(V_lds + (b) * SHM_VB + vst1) = vs1; } while (0)
  f32x16 p0, p1; float al; bf16x8 pa0, pa1, pa2, pa3;
#define QKSM(j) do { const int b_ = (j) & 1; qkt_m<NQ, KSTR>(p0, p1, K_lds + b_ * SHM_K + kwoff, qr, r32, hi, -m_reg); \
    partialSM2r(p0, p1, m_reg, al, (j) == 0); \
    if ((j) > 0 && __any(al < 1.f)) { if (hi == 0) al_l[r32] = al; asm volatile("s_waitcnt lgkmcnt(0)" ::: "memory"); \
      _Pragma("unroll") for (int d = 0; d < 4; ++d) _Pragma("unroll") for (int r = 0; r < 16; ++r) o[d][r] *= al_l[crow(r, hi)]; } \
    if ((j) == 0) al = 1.f; \
    finishSM(p0, p1, al, l_reg, pa0, pa1, pa2, pa3); } while (0)
#define PVSEG(j) pv_d0<4>(o, vb0 + ((j) & 1) * SHM_VB, pa0, pa1, pa2, pa3)
#define STAGE_K(j) do { if ((j) + 1 < NT) { KWRITE(((j) + 1) & 1); if ((j) + 2 < NT) KLOAD((j) + 2); } } while (0)
#define STAGE_V(j) do { if ((j) + 1 < NT) { VWRITE(((j) + 1) & 1); if ((j) + 2 < NT) VLOAD((j) + 2); } } while (0)
  __syncthreads();
  KLOAD(0); VLOAD(0); asm volatile("s_waitcnt vmcnt(0)" ::: "memory"); KWRITE(0); VWRITE(0);
  if (NT > 1) { KLOAD(1); VLOAD(1); }
  if (half == 0) {
    for (int j = 0; j < NT; ++j) {
      __syncthreads(); STAGE_K(j); SBAR(); QKSM(j); SBAR();
      __syncthreads(); STAGE_V(j); SBAR(); PVSEG(j); SBAR();
    }
  } else {
    for (int j = 0; j < NT; ++j) {
      __syncthreads(); STAGE_K(j); SBAR(); if (j > 0) PVSEG(j - 1); SBAR();
      __syncthreads(); STAGE_V(j); SBAR(); QKSM(j); SBAR();
    }
    PVSEG(NT - 1);
  }
  if (hi == 0) li_l[r32] = l_reg; asm volatile("s_waitcnt lgkmcnt(0)" ::: "memory");
  float rli[16];
#pragma unroll
  for (int r = 0; r < 16; ++r) rli[r] = __builtin_amdgcn_rcpf(li_l[crow(r, hi)]);
  const bool second = (MODE == 1 && wid >= 4); const int ldw = second ? ldo2 : ldo;
  bf16_t* Ow = (second ? O2 : O1) + (long)(MODE == 0 ? wid * 32 : (wid & 3) * 32) * ldw;
#pragma unroll
  for (int r = 0; r < 16; ++r) { const int orow = crow(r, hi);
#pragma unroll
    for (int d0 = 0; d0 < 4; ++d0) Ow[(long)orow * ldw + d0 * 32 + r32] = f2bf(o[d0][r] * rli[r]); }
#undef KLOAD
#undef VLOAD
#undef KWRITE
#undef VWRITE
#undef QKSM
#undef PVSEG
#undef STAGE_K
#undef STAGE_V
}

#define PK4X(Pv, BASE, OUT) do { unsigned a0 = cvt_pk_bf16(Pv[BASE + 0], Pv[BASE + 1]), a1 = cvt_pk_bf16(Pv[BASE + 2], Pv[BASE + 3]);   \
    unsigned b0 = cvt_pk_bf16(Pv[BASE + 4], Pv[BASE + 5]), b1 = cvt_pk_bf16(Pv[BASE + 6], Pv[BASE + 7]);                              \
    auto r0 = __builtin_amdgcn_permlane32_swap(a0, b0, false, false); auto r1 = __builtin_amdgcn_permlane32_swap(a1, b1, false, false); \
    u32x4 w = {r0[0], r1[0], r0[1], r1[1]}; OUT = *reinterpret_cast<bf16x8*>(&w); } while (0)
template <int MODE>
__device__ __forceinline__ void attn_unit_p2(const bf16_t* __restrict__ Qp, int ldq, const bf16_t* __restrict__ Kn, int ldk, const bf16_t* __restrict__ Kr,
                                             const bf16_t* __restrict__ Vp, int ldv, bf16_t* O1, bf16_t* O2, int ldo, int ldo2, const KeySrc ks, int NT, float scale, char* lds,
                                             float lam = 0.f, float post_scale = 0.f, const float* gsub = nullptr, const float* kn2 = nullptr) {
  constexpr int NQ = MODE == 0 ? 12 : 4;
  constexpr int KCOLS = MODE == 0 ? 192 : 128;
  constexpr int KSTR = KCOLS * 2 + 16;
  constexpr int SHM_K = KVBLK * KSTR, SHM_VB = KVBLK * 128 * 2;
  constexpr int SDEPTH = 1, SE = 0, SO = SDEPTH - 1;
  constexpr int NQR = MODE == 0 ? 8 : NQ;
  constexpr bool SUMM = false;
  constexpr float THR2 = 11.5415603f;
  const int tid = ltid(), wid = tid >> 6, lane = tid & 63, r32 = lane & 31, hi = lane >> 5;
  char* V_lds = lds; char* K_lds = lds + 2 * SHM_VB;
  float* wsf = (float*)(lds + 2 * SHM_VB + 2 * SHM_K) + wid * 64; float* li_l = wsf; float* al_l = wsf + 32;
  float m_reg = 0.f, l_reg = 0, qn2 = 0.f; f32x16 o[4] = {}; f32x16 lsum = {}; bf16x8 qr[NQR];
  char* qspill = lds + 2 * SHM_VB + 2 * SHM_K + 2048 + wid * (NQ - NQR) * 1024 + lane * 16;
  const int qrow = (MODE == 0 ? wid * 32 : (wid & 3) * 32) + r32;
  const int qcol = (MODE == 0 ? 0 : (wid >> 2) * 64) + hi * 8;
  const int kwoff = (MODE == 1 ? (wid >> 2) * 128 : 0);
  __syncthreads();
  { const bf16_t* Qw = Qp + (long)qrow * ldq + qcol; const float C = scale * 1.4426950408889634f;
#pragma unroll
    for (int d0 = 0; d0 < NQ; ++d0) { const bf16x8 qf = scale_q(*reinterpret_cast<const bf16x8*>(Qw + d0 * 16), C); qn2 += sq8(qf);
      if (d0 < NQR) qr[d0] = qf; else *reinterpret_cast<bf16x8*>(qspill + (d0 - NQR) * 1024) = qf; } }
  { auto rr_ = __builtin_amdgcn_permlane32_swap(__float_as_uint(qn2), __float_as_uint(qn2), false, false); qn2 = __uint_as_float(rr_[0]) + __uint_as_float(rr_[1]); }
  const bool fast = kn2 != nullptr && __all(qn2 * kn2[MODE == 1 ? (wid >> 2) : 0] <= FAST_B2);
  const int sr = tid >> 4, sc = (tid & 15) * 8, vst0 = v_st<4>(sr, sc), vst1 = v_st<4>(32 + sr, sc);
  const int rr = tid >> 3, rc = (tid & 7) * 8;
  const int vb0 = (int)(uintptr_t)V_lds + v_rd_base(lane);
  const bf16x8 ONES = (bf16x8){0x3F80, 0x3F80, 0x3F80, 0x3F80, 0x3F80, 0x3F80, 0x3F80, 0x3F80};
  struct { bf16x8 vs0, vs1, ks0, ks1, kr0; } sr_[SDEPTH];
  const unsigned voff0 = (unsigned)(sr * ldv + sc) * 2u, voff1 = voff0 + (unsigned)(32 * ldv) * 2u, koff0 = (unsigned)(sr * ldk + sc) * 2u, koff1 = koff0 + (unsigned)(32 * ldk) * 2u, roff = (unsigned)(rr * 64 + rc) * 2u;
#define SLOAD(i, j) do { const long r0_ = __builtin_amdgcn_readfirstlane((int)ks.row0(j)); const char* vb_ = (const char*)Vp + r0_ * ldv * 2; const char* kb_ = (const char*)Kn + r0_ * ldk * 2; \
    sr_[i].vs0 = *reinterpret_cast<const bf16x8*>(vb_ + voff0); sr_[i].vs1 = *reinterpret_cast<const bf16x8*>(vb_ + voff1); \
    sr_[i].ks0 = *reinterpret_cast<const bf16x8*>(kb_ + koff0); sr_[i].ks1 = *reinterpret_cast<const bf16x8*>(kb_ + koff1); \
    if (MODE == 0) { const char* rb_ = (const char*)Kr + r0_ * 128; sr_[i].kr0 = *reinterpret_cast<const bf16x8*>(rb_ + roff); } } while (0)
#define SWRITE(b, i) do { *(bf16x8*)(V_lds + (b) * SHM_VB + vst0) = sr_[i].vs0; *(bf16x8*)(V_lds + (b) * SHM_VB + vst1) = sr_[i].vs1; \
    *(bf16x8*)(K_lds + (b) * SHM_K + sr * KSTR + sc * 2) = sr_[i].ks0; *(bf16x8*)(K_lds + (b) * SHM_K + (32 + sr) * KSTR + sc * 2) = sr_[i].ks1; \
    if (MODE == 0) *(bf16x8*)(K_lds + (b) * SHM_K + rr * KSTR + 256 + rc * 2) = sr_[i].kr0; } while (0)
#define SWAIT() do { if constexpr (SDEPTH == 2) asm volatile("s_waitcnt vmcnt(4)" ::: "memory"); else asm volatile("s_waitcnt vmcnt(0)" ::: "memory"); } while (0)
#define RESC(a) do { if (__any((a) < 1.f)) { if (hi == 0) al_l[r32] = (a); asm volatile("s_waitcnt lgkmcnt(0)" ::: "memory"); \
    _Pragma("unroll") for (int r = 0; r < 16; ++r) { const float f_ = al_l[crow(r, hi)]; o[0][r] *= f_; o[1][r] *= f_; o[2][r] *= f_; o[3][r] *= f_; if (SUMM) lsum[r] *= f_; } } } while (0)
#define FINISH(P0, P1, AL) do { _Pragma("unroll") for (int r = 0; r < 16; ++r) P1[r] = __builtin_amdgcn_exp2f(P1[r]); \
    if (!SUMM) { float ps = 0; _Pragma("unroll") for (int r = 0; r < 16; ++r) ps += P0[r]; _Pragma("unroll") for (int r = 0; r < 16; ++r) ps += P1[r]; \
      { auto rr_ = __builtin_amdgcn_permlane32_swap(__float_as_uint(ps), __float_as_uint(ps), false, false); ps = __uint_as_float(rr_[0]) + __uint_as_float(rr_[1]); } \
      l_reg = l_reg * (AL) + ps; } \
    PK4X(P0, 0, pa0); PK4X(P0, 8, pa1); PK4X(P1, 0, pa2); PK4X(P1, 8, pa3); } while (0)
#define PV_AND_PARTIAL(VB, P0, P1, AL) do { float pm0_ = 0.f, pm1_ = 0.f; VFrag fa_, fb_; \
    pv_issue<0>(fa_, (VB)); pv_issue<1>(fb_, (VB)); pv_mma<8>(o[0], fa_, pa0, pa1, pa2, pa3); pv_issue<2>(fa_, (VB)); \
    if (!fast) { pm0_ = P0[0]; _Pragma("unroll") for (int r = 1; r < 16; ++r) pm0_ = fmaxf(pm0_, P0[r]); } \
    pv_mma<8>(o[1], fb_, pa0, pa1, pa2, pa3); pv_issue<3>(fb_, (VB)); \
    if (!fast) { pm1_ = P1[0]; _Pragma("unroll") for (int r = 1; r < 16; ++r) pm1_ = fmaxf(pm1_, P1[r]); pm0_ = fmaxf(pm0_, pm1_); \
    { auto rr_ = __builtin_amdgcn_permlane32_swap(__float_as_uint(pm0_), __float_as_uint(pm0_), false, false); pm0_ = fmaxf(__uint_as_float(rr_[0]), __uint_as_float(rr_[1])); } } \
    pv_mma<8>(o[2], fa_, pa0, pa1, pa2, pa3); \
    AL = 1.f; \
    if (!fast && !__builtin_expect(__all(pm0_ <= THR2), 1)) { const float dl_ = fmaxf(pm0_, 0.f); AL = __builtin_amdgcn_exp2f(-dl_); m_reg += dl_; \
      _Pragma("unroll") for (int r = 0; r < 16; ++r) { P0[r] -= dl_; P1[r] -= dl_; } } \
    _Pragma("unroll") for (int r = 0; r < 8; ++r) P0[r] = __builtin_amdgcn_exp2f(P0[r]); \
    pv_mma<0>(o[3], fb_, pa0, pa1, pa2, pa3); \
    _Pragma("unroll") for (int r = 8; r < 16; ++r) P0[r] = __builtin_amdgcn_exp2f(P0[r]); \
    if (SUMM) { lsum = __builtin_amdgcn_mfma_f32_32x32x16_bf16(pa0, ONES, lsum, 0, 0, 0); lsum = __builtin_amdgcn_mfma_f32_32x32x16_bf16(pa1, ONES, lsum, 0, 0, 0); \
                lsum = __builtin_amdgcn_mfma_f32_32x32x16_bf16(pa2, ONES, lsum, 0, 0, 0); lsum = __builtin_amdgcn_mfma_f32_32x32x16_bf16(pa3, ONES, lsum, 0, 0, 0); } } while (0)
#define PV_AND_PARTIAL_B(VB, P0, P1, AL) do { VFrag fa_, fb_; \
    partialSM2<false>(P0, P1, m_reg, AL, fast); \
    pv_issue<0>(fa_, (VB)); pv_issue<1>(fb_, (VB)); pv_mma<8>(o[0], fa_, pa0, pa1, pa2, pa3); pv_issue<2>(fa_, (VB)); \
    pv_mma<8>(o[1], fb_, pa0, pa1, pa2, pa3); pv_issue<3>(fb_, (VB)); \
    pv_mma<8>(o[2], fa_, pa0, pa1, pa2, pa3); pv_mma<0>(o[3], fb_, pa0, pa1, pa2, pa3); } while (0)
#define PV_PART(VB, P0, P1, AL) do { if (lateh) PV_AND_PARTIAL_B(VB, P0, P1, AL); else PV_AND_PARTIAL(VB, P0, P1, AL); } while (0)
  const bool lateh = SKEW_HALVES && __builtin_amdgcn_readfirstlane(wid) >= 4;
  f32x16 pA0, pA1, pB0, pB1; float alA, alB; bf16x8 pa0, pa1, pa2, pa3;
  const char* K0 = K_lds + kwoff; const char* K1 = K_lds + SHM_K + kwoff;
  SLOAD(SE, 0); asm volatile("s_waitcnt vmcnt(0)" ::: "memory"); SWRITE(0, SE); __syncthreads();
  qkt_m<NQ, KSTR, NQR>(pA0, pA1, K0, qr, r32, hi, 0.f, qspill); partialSM2<true>(pA0, pA1, m_reg, alA, fast); alA = 1.f;
  SLOAD(SO, 1); if constexpr (SDEPTH == 2) { if (2 < NT) SLOAD(SE, 2); }
  SWAIT(); SWRITE(1, SO); __syncthreads();
  for (int j = 1; j + 1 < NT; j += 2) {
    SBAR(); if (fast) qkt_z<NQ, KSTR, NQR>(pB0, pB1, K1, qr, r32, hi, qspill); else qkt_m<NQ, KSTR, NQR>(pB0, pB1, K1, qr, r32, hi, -m_reg, qspill);
#ifdef PROBE_QK2
    { f32x16 pX0, pX1; qkt_m<NQ, KSTR, NQR>(pX0, pX1, K1, qr, r32, hi, -m_reg, qspill); asm volatile("" :: "v"(pX0), "v"(pX1)); }
#endif
#ifdef PROBE_EXP2
    { _Pragma("unroll") for (int r = 0; r < 16; ++r) { float t0 = __builtin_amdgcn_exp2f(pA1[r] - 3.f), t1 = __builtin_amdgcn_exp2f(pA0[r] - 5.f); asm volatile("" :: "v"(t0), "v"(t1)); } }
#endif
#ifdef PROBE_ADD2
    { _Pragma("unroll") for (int r = 0; r < 16; ++r) { float t0 = pA1[r] + 3.f, t1 = pA0[r] + 5.f; asm volatile("" :: "v"(t0), "v"(t1)); } }
#endif
#ifdef PROBE_B128
    { bf16x8 x0_, x1_, x2_, x3_, x4_, x5_, x6_, x7_; const char* vv_ = V_lds + lane * 16;
      x0_ = *(const bf16x8*)(vv_); x1_ = *(const bf16x8*)(vv_ + 1024); x2_ = *(const bf16x8*)(vv_ + 2048); x3_ = *(const bf16x8*)(vv_ + 3072); x4_ = *(const bf16x8*)(vv_ + 4096); x5_ = *(const bf16x8*)(vv_ + 5120); x6_ = *(const bf16x8*)(vv_ + 6144); x7_ = *(const bf16x8*)(vv_ + 7168);
      asm volatile("s_waitcnt lgkmcnt(0)" ::: "memory"); asm volatile("" :: "v"(x0_), "v"(x1_), "v"(x2_), "v"(x3_), "v"(x4_), "v"(x5_), "v"(x6_), "v"(x7_));
      x0_ = *(const bf16x8*)(vv_ + 8192); x1_ = *(const bf16x8*)(vv_ + 9216); x2_ = *(const bf16x8*)(vv_ + 10240); x3_ = *(const bf16x8*)(vv_ + 11264); x4_ = *(const bf16x8*)(vv_ + 12288); x5_ = *(const bf16x8*)(vv_ + 13312); x6_ = *(const bf16x8*)(vv_ + 14336); x7_ = *(const bf16x8*)(vv_ + 15360);
      asm volatile("s_waitcnt lgkmcnt(0)" ::: "memory"); asm volatile("" :: "v"(x0_), "v"(x1_), "v"(x2_), "v"(x3_), "v"(x4_), "v"(x5_), "v"(x6_), "v"(x7_)); }
#endif
#ifdef PROBE_TR2
    { VFrag fx_, fy_; pv_issue<0>(fx_, vb0); pv_issue<1>(fy_, vb0); asm volatile("s_waitcnt lgkmcnt(0)" ::: "memory"); asm volatile("" :: "v"(fx_.l0), "v"(fx_.h3), "v"(fy_.l0), "v"(fy_.h3)); pv_issue<2>(fx_, vb0); pv_issue<3>(fy_, vb0); asm volatile("s_waitcnt lgkmcnt(0)" ::: "memory"); asm volatile("" :: "v"(fx_.l0), "v"(fx_.h3), "v"(fy_.l0), "v"(fy_.h3)); }
#endif
    FINISH(pA0, pA1, alA); SBAR();
    SLOAD(SO, j + SDEPTH); SBAR();
#ifdef PROBE_BAR
    __syncthreads();
#endif
    PV_PART(vb0, pB0, pB1, alB);
    __syncthreads(); SWAIT(); SWRITE(0, SE);
    RESC(alB); __syncthreads();
    SBAR(); if (fast) qkt_z<NQ, KSTR, NQR>(pA0, pA1, K0, qr, r32, hi, qspill); else qkt_m<NQ, KSTR, NQR>(pA0, pA1, K0, qr, r32, hi, -m_reg, qspill);
#ifdef PROBE_QK2
    { f32x16 pX0, pX1; qkt_m<NQ, KSTR, NQR>(pX0, pX1, K0, qr, r32, hi, -m_reg, qspill); asm volatile("" :: "v"(pX0), "v"(pX1)); }
#endif
#ifdef PROBE_EXP2
    { _Pragma("unroll") for (int r = 0; r < 16; ++r) { float t0 = __builtin_amdgcn_exp2f(pB1[r] - 3.f), t1 = __builtin_amdgcn_exp2f(pB0[r] - 5.f); asm volatile("" :: "v"(t0), "v"(t1)); } }
#endif
#ifdef PROBE_ADD2
    { _Pragma("unroll") for (int r = 0; r < 16; ++r) { float t0 = pB1[r] + 3.f, t1 = pB0[r] + 5.f; asm volatile("" :: "v"(t0), "v"(t1)); } }
#endif
#ifdef PROBE_B128
    { bf16x8 x0_, x1_, x2_, x3_, x4_, x5_, x6_, x7_; const char* vv_ = V_lds + lane * 16;
      x0_ = *(const bf16x8*)(vv_); x1_ = *(const bf16x8*)(vv_ + 1024); x2_ = *(const bf16x8*)(vv_ + 2048); x3_ = *(const bf16x8*)(vv_ + 3072); x4_ = *(const bf16x8*)(vv_ + 4096); x5_ = *(const bf16x8*)(vv_ + 5120); x6_ = *(const bf16x8*)(vv_ + 6144); x7_ = *(const bf16x8*)(vv_ + 7168);
      asm volatile("s_waitcnt lgkmcnt(0)" ::: "memory"); asm volatile("" :: "v"(x0_), "v"(x1_), "v"(x2_), "v"(x3_), "v"(x4_), "v"(x5_), "v"(x6_), "v"(x7_));
      x0_ = *(const bf16x8*)(vv_ + 8192); x1_ = *(const bf16x8*)(vv_ + 9216); x2_ = *(const bf16x8*)(vv_ + 10240); x3_ = *(const bf16x8*)(vv_ + 11264); x4_ = *(const bf16x8*)(vv_ + 12288); x5_ = *(const bf16x8*)(vv_ + 13312); x6_ = *(const bf16x8*)(vv_ + 14336); x7_ = *(const bf16x8*)(vv_ + 15360);
      asm volatile("s_waitcnt lgkmcnt(0)" ::: "memory"); asm volatile("" :: "v"(x0_), "v"(x1_), "v"(x2_), "v"(x3_), "v"(x4_), "v"(x5_), "v"(x6_), "v"(x7_)); }
#endif
#ifdef PROBE_TR2
    { VFrag fx_, fy_; pv_issue<0>(fx_, vb0); pv_issue<1>(fy_, vb0); asm volatile("s_waitcnt lgkmcnt(0)" ::: "memory"); asm volatile("" :: "v"(fx_.l0), "v"(fx_.h3), "v"(fy_.l0), "v"(fy_.h3)); pv_issue<2>(fx_, vb0); pv_issue<3>(fy_, vb0); asm volatile("s_waitcnt lgkmcnt(0)" ::: "memory"); asm volatile("" :: "v"(fx_.l0), "v"(fx_.h3), "v"(fy_.l0), "v"(fy_.h3)); }
#endif
    FINISH(pB0, pB1, alB); SBAR();
    if (SDEPTH == 1 || j + 3 < NT) SLOAD(SE, j + 1 + SDEPTH); SBAR();
#ifdef PROBE_BAR
    __syncthreads();
#endif
    PV_PART(vb0 + SHM_VB, pA0, pA1, alA);
    __syncthreads(); SWAIT(); SWRITE(1, SO);
    RESC(alA); __syncthreads();
  }
  SBAR(); if (fast) qkt_z<NQ, KSTR, NQR>(pB0, pB1, K1, qr, r32, hi, qspill); else qkt_m<NQ, KSTR, NQR>(pB0, pB1, K1, qr, r32, hi, -m_reg, qspill);
  FINISH(pA0, pA1, alA); SBAR();
  PV_PART(vb0, pB0, pB1, alB);
  RESC(alB);
  FINISH(pB0, pB1, alB); SBAR();
  pv_d0<4>(o, vb0 + SHM_VB, pa0, pa1, pa2, pa3);
  if (SUMM) { lsum = __builtin_amdgcn_mfma_f32_32x32x16_bf16(pa0, ONES, lsum, 0, 0, 0); lsum = __builtin_amdgcn_mfma_f32_32x32x16_bf16(pa1, ONES, lsum, 0, 0, 0);
              lsum = __builtin_amdgcn_mfma_f32_32x32x16_bf16(pa2, ONES, lsum, 0, 0, 0); lsum = __builtin_amdgcn_mfma_f32_32x32x16_bf16(pa3, ONES, lsum, 0, 0, 0); }
  float rli[16];
  if (SUMM) {
#pragma unroll
    for (int r = 0; r < 16; ++r) rli[r] = __builtin_amdgcn_rcpf(lsum[r]);
  } else {
    if (hi == 0) li_l[r32] = l_reg; asm volatile("s_waitcnt lgkmcnt(0)" ::: "memory");
#pragma unroll
    for (int r = 0; r < 16; ++r) rli[r] = __builtin_amdgcn_rcpf(li_l[crow(r, hi)]);
  }
  if constexpr (MODE == 1) {
    float* HB = (float*)lds;
    const int tb = (wid & 3) * 32;
    __syncthreads();
    if (wid >= 4) {
#pragma unroll
      for (int r = 0; r < 16; ++r)
#pragma unroll
        for (int d0 = 0; d0 < 4; ++d0) HB[(tb + crow(r, hi)) * 128 + d0 * 32 + r32] = o[d0][r] * rli[r]; }
    __syncthreads();
    if (wid < 4) { const float g0 = gsub[r32], g1 = gsub[32 + r32], g2 = gsub[64 + r32], g3 = gsub[96 + r32];
#pragma unroll
      for (int r = 0; r < 16; ++r) { const int orow = tb + crow(r, hi); const float* hb = HB + orow * 128 + r32;
        const float x0 = o[0][r] * rli[r] - lam * hb[0], x1 = o[1][r] * rli[r] - lam * hb[32], x2 = o[2][r] * rli[r] - lam * hb[64], x3 = o[3][r] * rli[r] - lam * hb[96];
        float ss = (x0 * x0 + x1 * x1) + (x2 * x2 + x3 * x3);
#pragma unroll
        for (int m = 1; m < 32; m <<= 1) ss += __shfl_xor(ss, m);
        const float rs = rsqrtf(ss * (1.f / 128.f) + 1e-6f) * post_scale;
        bf16_t* op = O1 + (long)orow * ldo + r32;
        op[0] = f2bf(x0 * rs * g0); op[32] = f2bf(x1 * rs * g1); op[64] = f2bf(x2 * rs * g2); op[96] = f2bf(x3 * rs * g3); } }
  } else {
    bf16_t* Ow = O1 + (long)(wid * 32) * ldo;
#pragma unroll
    for (int r = 0; r < 16; ++r) { const int orow = crow(r, hi);
#pragma unroll
      for (int d0 = 0; d0 < 4; ++d0) Ow[(long)orow * ldo + d0 * 32 + r32] = f2bf(o[d0][r] * rli[r]); }
  }
#undef SLOAD
#undef SWRITE
#undef SWAIT
#undef RESC
#undef FINISH
#undef PV_AND_PARTIAL
#undef PV_AND_PARTIAL_B
#undef PV_PART
}

template <int MODE, int FP>
__device__ __forceinline__ void attn_unit_sb(const bf16_t* __restrict__ Qp, int ldq, const bf16_t* __restrict__ Kn, int ldk, const bf16_t* __restrict__ Kr,
                                             const bf16_t* __restrict__ Vp, int ldv, bf16_t* O1, int ldo, const KeySrc ks, int NT, float scale, char* lds,
                                             float lam, float post_scale, const float* gsub, const float* kn2) {
  constexpr int NQ = MODE == 0 ? 12 : 4;
  constexpr int KCOLS = MODE == 0 ? 192 : 128;
  constexpr int KSTR = KCOLS * 2 + 16;
  constexpr int SHM_K = KVBLK * KSTR, SHM_VB = KVBLK * 128 * 2;
  constexpr float THR2 = 11.5415603f;
  const int tid = ltid(), wid = tid >> 6, lane = tid & 63, r32 = lane & 31, hi = lane >> 5;
  constexpr bool RING4 = (MODE == 1 && FP == 1);
  constexpr int NRB = RING4 ? 4 : 2;
  char* V_lds = lds; char* K_lds = lds + NRB * SHM_VB;
  float* wsf = (float*)(lds + NRB * SHM_VB + NRB * SHM_K) + wid * 64; float* li_l = wsf; float* al_l = wsf + 32;
  float m_reg = 0.f, l_reg = 0, qn2 = 0.f; f32x16 o[4] = {}; bf16x8 qr[NQ];
  const int qrow = (MODE == 0 ? wid * 32 : (wid & 3) * 32) + r32;
  const int qcol = (MODE == 0 ? 0 : (wid >> 2) * 64) + hi * 8;
  const int kwoff = (MODE == 1 ? (wid >> 2) * 128 : 0);
  { const bf16_t* Qw = Qp + (long)qrow * ldq + qcol; const float C = scale * 1.4426950408889634f;
#pragma unroll
    for (int d0 = 0; d0 < NQ; ++d0) { qr[d0] = scale_q(*reinterpret_cast<const bf16x8*>(Qw + d0 * 16), C); qn2 += sq8(qr[d0]); } }
  { auto rr_ = __builtin_amdgcn_permlane32_swap(__float_as_uint(qn2), __float_as_uint(qn2), false, false); qn2 = __uint_as_float(rr_[0]) + __uint_as_float(rr_[1]); }
  const bool fast = FP == 2 ? (kn2 != nullptr && __all(qn2 * kn2[MODE == 1 ? (wid >> 2) : 0] <= FAST_B2)) : (FP == 1);
  const int sr = tid >> 4, sc = (tid & 15) * 8, vst0 = v_st<4>(sr, sc), vst1 = v_st<4>(32 + sr, sc);
  const int rr = tid >> 3, rc = (tid & 7) * 8;
  const int vb0 = (int)(uintptr_t)V_lds + v_rd_base(lane);
  bf16x8 vs0, vs1, ks0, ks1, kr0;
  const unsigned voff0 = (unsigned)(sr * ldv + sc) * 2u, voff1 = voff0 + (unsigned)(32 * ldv) * 2u, koff0 = (unsigned)(sr * ldk + sc) * 2u, koff1 = koff0 + (unsigned)(32 * ldk) * 2u, roff = (unsigned)(rr * 64 + rc) * 2u;
#define KLOAD(j) do { const long r0_ = __builtin_amdgcn_readfirstlane((int)ks.row0(j)); const char* kb_ = (const char*)Kn + r0_ * ldk * 2; \
    ks0 = *reinterpret_cast<const bf16x8*>(kb_ + koff0); ks1 = *reinterpret_cast<const bf16x8*>(kb_ + koff1); \
    if (MODE == 0) { const char* rb_ = (const char*)Kr + r0_ * 128; kr0 = *reinterpret_cast<const bf16x8*>(rb_ + roff); } } while (0)
#define VLOAD(j) do { const long r0_ = __builtin_amdgcn_readfirstlane((int)ks.row0(j)); const char* vb_ = (const char*)Vp + r0_ * ldv * 2; \
    vs0 = *reinterpret_cast<const bf16x8*>(vb_ + voff0); vs1 = *reinterpret_cast<const bf16x8*>(vb_ + voff1); } while (0)
#define KWRITE(b) do { *(bf16x8*)(K_lds + (b) * SHM_K + sr * KSTR + sc * 2) = ks0; *(bf16x8*)(K_lds + (b) * SHM_K + (32 + sr) * KSTR + sc * 2) = ks1; \
    if (MODE == 0) *(bf16x8*)(K_lds + (b) * SHM_K + rr * KSTR + 256 + rc * 2) = kr0; } while (0)
#define VWRITE(b) do { *(bf16x8*)(V_lds + (b) * SHM_VB + vst0) = vs0; *(bf16x8*)(V_lds + (b) * SHM_VB + vst1) = vs1; } while (0)
#define RESC(a) do { if (__any((a) < 1.f)) { if (hi == 0) al_l[r32] = (a); asm volatile("s_waitcnt lgkmcnt(0)" ::: "memory"); \
    _Pragma("unroll") for (int r = 0; r < 16; ++r) { const float f_ = al_l[crow(r, hi)]; o[0][r] *= f_; o[1][r] *= f_; o[2][r] *= f_; o[3][r] *= f_; } } } while (0)
#define QKT(P0, P1, KB) do { if (fast) qkt_z<NQ, KSTR>(P0, P1, KB, qr, r32, hi); else qkt_m<NQ, KSTR>(P0, P1, KB, qr, r32, hi, -m_reg); } while (0)
#define FINISH(P0, P1, AL) do { _Pragma("unroll") for (int r = 0; r < 16; ++r) P1[r] = __builtin_amdgcn_exp2f(P1[r]); \
    { float ps = 0; _Pragma("unroll") for (int r = 0; r < 16; ++r) ps += P0[r]; _Pragma("unroll") for (int r = 0; r < 16; ++r) ps += P1[r]; \
      { auto rr_ = __builtin_amdgcn_permlane32_swap(__float_as_uint(ps), __float_as_uint(ps), false, false); ps = __uint_as_float(rr_[0]) + __uint_as_float(rr_[1]); } \
      l_reg = l_reg * (AL) + ps; } \
    PK4X(P0, 0, pa0); PK4X(P0, 8, pa1); PK4X(P1, 0, pa2); PK4X(P1, 8, pa3); } while (0)
#define PV_AND_PARTIAL(VB, P0, P1, AL) do { if constexpr (MODE == 0) { pv_d0<4>(o, (VB), pa0, pa1, pa2, pa3); partialSM2<false>(P0, P1, m_reg, AL, fast); } else { \
    float pm0_ = 0.f, pm1_ = 0.f; VFrag fa_, fb_; \
    pv_issue<0>(fa_, (VB)); pv_issue<1>(fb_, (VB)); pv_mma<8>(o[0], fa_, pa0, pa1, pa2, pa3); pv_issue<2>(fa_, (VB)); \
    if (!fast) { pm0_ = P0[0]; _Pragma("unroll") for (int r = 1; r < 16; ++r) pm0_ = fmaxf(pm0_, P0[r]); } \
    pv_mma<8>(o[1], fb_, pa0, pa1, pa2, pa3); pv_issue<3>(fb_, (VB)); \
    if (!fast) { pm1_ = P1[0]; _Pragma("unroll") for (int r = 1; r < 16; ++r) pm1_ = fmaxf(pm1_, P1[r]); pm0_ = fmaxf(pm0_, pm1_); \
    { auto rr_ = __builtin_amdgcn_permlane32_swap(__float_as_uint(pm0_), __float_as_uint(pm0_), false, false); pm0_ = fmaxf(__uint_as_float(rr_[0]), __uint_as_float(rr_[1])); } } \
    pv_mma<8>(o[2], fa_, pa0, pa1, pa2, pa3); \
    AL = 1.f; \
    if (!fast && !__builtin_expect(__all(pm0_ <= THR2), 1)) { const float dl_ = fmaxf(pm0_, 0.f); AL = __builtin_amdgcn_exp2f(-dl_); m_reg += dl_; \
      _Pragma("unroll") for (int r = 0; r < 16; ++r) { P0[r] -= dl_; P1[r] -= dl_; } } \
    _Pragma("unroll") for (int r = 0; r < 8; ++r) P0[r] = __builtin_amdgcn_exp2f(P0[r]); \
    pv_mma<0>(o[3], fb_, pa0, pa1, pa2, pa3); \
    _Pragma("unroll") for (int r = 8; r < 16; ++r) P0[r] = __builtin_amdgcn_exp2f(P0[r]); } } while (0)
#define EXPN(P, R0, N) do { asm volatile("" : "+v"(P)); _Pragma("unroll") for (int r_ = (R0); r_ < (R0) + (N); ++r_) P[r_] = __builtin_amdgcn_exp2f(P[r_]); asm volatile("" : "+v"(P)); } while (0)
#define ADDN(P, R0, N) do { asm volatile("" : "+v"(ps_)); _Pragma("unroll") for (int r_ = (R0); r_ < (R0) + (N); ++r_) ps_ += P[r_]; asm volatile("" : "+v"(ps_)); } while (0)
#define LSUM() do { auto rr_ = __builtin_amdgcn_permlane32_swap(__float_as_uint(ps_), __float_as_uint(ps_), false, false); l_reg = l_reg + (__uint_as_float(rr_[0]) + __uint_as_float(rr_[1])); } while (0)
#define FIN_PIECE(D0, PF0, PF1) do { \
    if constexpr (MODE == 1) { if ((D0) == 0) ADDN(PF0, 0, 16); if ((D0) == 1) ADDN(PF1, 0, 16); if ((D0) == 2) { PK4X(PF0, 0, pa0); PK4X(PF0, 8, pa1); } if ((D0) == 3) { PK4X(PF1, 0, pa2); PK4X(PF1, 8, pa3); LSUM(); } } \
    else { if ((D0) < 4) { EXPN(PF1, 4 * (D0), 4); ADDN(PF0, 4 * (D0), 4); } else if ((D0) < 8) ADDN(PF1, 4 * ((D0) - 4), 4); \
           if ((D0) == 6) PK4X(PF0, 0, pa0); if ((D0) == 7) PK4X(PF0, 8, pa1); if ((D0) == 8) PK4X(PF1, 0, pa2); if ((D0) == 9) PK4X(PF1, 8, pa3); if ((D0) == 10) LSUM(); } } while (0)
#define KFRAG(DST, KB, D0) do { const int cb_ = ((D0) * 16 + hi * 8) * 2; DST[0] = *reinterpret_cast<const bf16x8*>((KB) + r32 * KSTR + cb_); DST[1] = *reinterpret_cast<const bf16x8*>((KB) + (32 + r32) * KSTR + cb_); } while (0)
#define QKT_FIN_FAST(PN0, PN1, KB, PF0, PF1) do { float ps_ = 0.f; bf16x8 kfa_[2], kfb_[2]; PN0 = f32x16{}; PN1 = f32x16{}; KFRAG(kfa_, KB, 0); \
    _Pragma("unroll") for (int d0 = 0; d0 < NQ; d0 += 2) { \
      KFRAG(kfb_, KB, d0 + 1); SBAR(); \
      PN0 = __builtin_amdgcn_mfma_f32_32x32x16_bf16(kfa_[0], qr[d0], PN0, 0, 0, 0); PN1 = __builtin_amdgcn_mfma_f32_32x32x16_bf16(kfa_[1], qr[d0], PN1, 0, 0, 0); SBAR(); \
      FIN_PIECE(d0, PF0, PF1); SBAR(); \
      if (d0 + 2 < NQ) { KFRAG(kfa_, KB, d0 + 2); } SBAR(); \
      PN0 = __builtin_amdgcn_mfma_f32_32x32x16_bf16(kfb_[0], qr[d0 + 1], PN0, 0, 0, 0); PN1 = __builtin_amdgcn_mfma_f32_32x32x16_bf16(kfb_[1], qr[d0 + 1], PN1, 0, 0, 0); SBAR(); \
      FIN_PIECE(d0 + 1, PF0, PF1); SBAR(); } } while (0)
#define FINISH_FAST(PF0, PF1) do { float ps_ = 0.f; if constexpr (MODE == 0) EXPN(PF1, 0, 16); ADDN(PF0, 0, 16); ADDN(PF1, 0, 16); LSUM(); \
    PK4X(PF0, 0, pa0); PK4X(PF0, 8, pa1); PK4X(PF1, 0, pa2); PK4X(PF1, 8, pa3); } while (0)
#define PV_PART_FAST(VB, PN0, PN1) do { if constexpr (MODE == 1) { VFrag fa_, fb_; \
      pv_issue<0>(fa_, (VB)); pv_issue<1>(fb_, (VB)); pv_mma<8>(o[0], fa_, pa0, pa1, pa2, pa3); pv_issue<2>(fa_, (VB)); SBAR(); EXPN(PN0, 0, 8); SBAR(); \
      pv_mma<8>(o[1], fb_, pa0, pa1, pa2, pa3); pv_issue<3>(fb_, (VB)); SBAR(); EXPN(PN0, 8, 8); SBAR(); \
      pv_mma<8>(o[2], fa_, pa0, pa1, pa2, pa3); SBAR(); EXPN(PN1, 0, 8); SBAR(); \
      pv_mma<0>(o[3], fb_, pa0, pa1, pa2, pa3); SBAR(); EXPN(PN1, 8, 8); SBAR(); \
    } else { \
      pv_one<0, 4>(o[0], (VB), pa0, pa1, pa2, pa3); SBAR(); EXPN(PN0, 0, 4); SBAR(); pv_one<1, 4>(o[1], (VB), pa0, pa1, pa2, pa3); SBAR(); EXPN(PN0, 4, 4); SBAR(); \
      pv_one<2, 4>(o[2], (VB), pa0, pa1, pa2, pa3); SBAR(); EXPN(PN0, 8, 4); SBAR(); pv_one<3, 4>(o[3], (VB), pa0, pa1, pa2, pa3); SBAR(); EXPN(PN0, 12, 4); SBAR(); } } while (0)
  f32x16 pA0, pA1, pB0, pB1; float alA, alB; bf16x8 pa0, pa1, pa2, pa3;
  const char* K0 = K_lds + kwoff; const char* K1 = K_lds + SHM_K + kwoff;
  if constexpr (RING4) {
    bf16x8 ks2, ks3, vs2, vs3;
#define KLD2(A0, A1, j) do { const long r0_ = __builtin_amdgcn_readfirstlane((int)ks.row0(j)); const char* kb_ = (const char*)Kn + r0_ * ldk * 2; \
    A0 = *reinterpret_cast<const bf16x8*>(kb_ + koff0); A1 = *reinterpret_cast<const bf16x8*>(kb_ + koff1); } while (0)
#define VLD2(A0, A1, j) do { const long r0_ = __builtin_amdgcn_readfirstlane((int)ks.row0(j)); const char* vb_ = (const char*)Vp + r0_ * ldv * 2; \
    A0 = *reinterpret_cast<const bf16x8*>(vb_ + voff0); A1 = *reinterpret_cast<const bf16x8*>(vb_ + voff1); } while (0)
#define KWR2(A0, A1, t_) do { char* kd_ = K_lds + ((t_) & 3) * SHM_K; *(bf16x8*)(kd_ + sr * KSTR + sc * 2) = A0; *(bf16x8*)(kd_ + (32 + sr) * KSTR + sc * 2) = A1; } while (0)
#define VWR2(A0, A1, t_) do { char* vd_ = V_lds + ((t_) & 3) * SHM_VB; *(bf16x8*)(vd_ + vst0) = A0; *(bf16x8*)(vd_ + vst1) = A1; } while (0)
#define KPTR(t_) (K_lds + ((t_) & 3) * SHM_K + kwoff)
#define VPTR(t_) (vb0 + ((t_) & 3) * SHM_VB)
    __syncthreads();
    if (__builtin_amdgcn_readfirstlane(wid) >= 4) __builtin_amdgcn_s_setprio(1);
    KLD2(ks0, ks1, 0); asm volatile("s_waitcnt vmcnt(0)" ::: "memory"); KWR2(ks0, ks1, 0);
    KLD2(ks0, ks1, 1); VLD2(vs0, vs1, 0); KLD2(ks2, ks3, 2); VLD2(vs2, vs3, 1);
    __syncthreads();
    KWR2(ks0, ks1, 1); VWR2(vs0, vs1, 0); KWR2(ks2, ks3, 2); VWR2(vs2, vs3, 1);
    KLD2(ks0, ks1, 3); VLD2(vs0, vs1, 2); if (4 < NT) KLD2(ks2, ks3, 4); VLD2(vs2, vs3, 3);
    qkt_z<NQ, KSTR>(pA0, pA1, KPTR(0), qr, r32, hi); EXPN(pA0, 0, 16); EXPN(pA1, 0, 16);
    const int NP = NT >> 1;
    for (int sI = 0; sI + 1 < NP; ++sI) { const int t0 = 2 * sI;
      __syncthreads();
      KWR2(ks0, ks1, t0 + 3); VWR2(vs0, vs1, t0 + 2); if (t0 + 4 < NT) KWR2(ks2, ks3, t0 + 4); VWR2(vs2, vs3, t0 + 3);
      if (t0 + 5 < NT) KLD2(ks0, ks1, t0 + 5); if (t0 + 4 < NT) VLD2(vs0, vs1, t0 + 4); if (t0 + 6 < NT) KLD2(ks2, ks3, t0 + 6); if (t0 + 5 < NT) VLD2(vs2, vs3, t0 + 5);
      SBAR(); QKT_FIN_FAST(pB0, pB1, KPTR(t0 + 1), pA0, pA1); PV_PART_FAST(VPTR(t0), pB0, pB1);
      SBAR(); QKT_FIN_FAST(pA0, pA1, KPTR(t0 + 2), pB0, pB1); PV_PART_FAST(VPTR(t0 + 1), pA0, pA1);
    }
    __syncthreads();
    SBAR(); QKT_FIN_FAST(pB0, pB1, KPTR(NT - 1), pA0, pA1); PV_PART_FAST(VPTR(NT - 2), pB0, pB1);
    FINISH_FAST(pB0, pB1); SBAR();
    pv_d0<4>(o, VPTR(NT - 1), pa0, pa1, pa2, pa3);
#undef KLD2
#undef VLD2
#undef KWR2
#undef VWR2
#undef KPTR
#undef VPTR
  } else {
  __syncthreads();
  if (__builtin_amdgcn_readfirstlane(wid) >= 4) __builtin_amdgcn_s_setprio(1);
  KLOAD(0); asm volatile("s_waitcnt vmcnt(0)" ::: "memory"); KWRITE(0); KLOAD(1); VLOAD(0);
  __syncthreads();
  KWRITE(1); VWRITE(0); if (2 < NT) KLOAD(2); VLOAD(1);
  qkt_m<NQ, KSTR>(pA0, pA1, K0, qr, r32, hi, 0.f); partialSM2<true>(pA0, pA1, m_reg, alA, fast); alA = 1.f;
#ifndef FASTP_MODES
#define FASTP_MODES 3
#endif
  constexpr bool fastp = FP == 1;
  if constexpr (MODE == 1 && fastp) EXPN(pA1, 0, 16);
  for (int j = 1; j + 1 < NT; j += 2) {
    __syncthreads();
    KWRITE(0); VWRITE(1); if (j + 2 < NT) KLOAD(j + 2); VLOAD(j + 1);
    if constexpr (fastp) { SBAR(); QKT_FIN_FAST(pB0, pB1, K1, pA0, pA1); PV_PART_FAST(vb0, pB0, pB1); }
    else { SBAR(); QKT(pB0, pB1, K1); FINISH(pA0, pA1, alA); SBAR(); PV_AND_PARTIAL(vb0, pB0, pB1, alB); RESC(alB); }
    __syncthreads();
    if (j + 2 < NT) KWRITE(1); VWRITE(0); if (j + 3 < NT) KLOAD(j + 3); if (j + 2 < NT) VLOAD(j + 2);
    if constexpr (fastp) { SBAR(); QKT_FIN_FAST(pA0, pA1, K0, pB0, pB1); PV_PART_FAST(vb0 + SHM_VB, pA0, pA1); }
    else { SBAR(); QKT(pA0, pA1, K0); FINISH(pB0, pB1, alB); SBAR(); PV_AND_PARTIAL(vb0 + SHM_VB, pA0, pA1, alA); RESC(alA); }
  }
  __syncthreads();
  VWRITE(1);
  if constexpr (fastp) { SBAR(); QKT_FIN_FAST(pB0, pB1, K1, pA0, pA1); PV_PART_FAST(vb0, pB0, pB1); }
  else { SBAR(); QKT(pB0, pB1, K1); FINISH(pA0, pA1, alA); SBAR(); PV_AND_PARTIAL(vb0, pB0, pB1, alB); RESC(alB); }
  __syncthreads();
  if constexpr (fastp) { FINISH_FAST(pB0, pB1); } else { FINISH(pB0, pB1, alB); } SBAR();
  pv_d0<4>(o, vb0 + SHM_VB, pa0, pa1, pa2, pa3);
  }
  __builtin_amdgcn_s_setprio(0);
  if (hi == 0) li_l[r32] = l_reg; asm volatile("s_waitcnt lgkmcnt(0)" ::: "memory");
  float rli[16];
#pragma unroll
  for (int r = 0; r < 16; ++r) rli[r] = __builtin_amdgcn_rcpf(li_l[crow(r, hi)]);
  if constexpr (MODE == 1) {
    float* HB = (float*)lds; const int tb = (wid & 3) * 32;
    __syncthreads();
    if (wid >= 4) {
#pragma unroll
      for (int r = 0; r < 16; ++r)
#pragma unroll
        for (int d0 = 0; d0 < 4; ++d0) HB[(tb + crow(r, hi)) * 128 + d0 * 32 + r32] = o[d0][r] * rli[r]; }
    __syncthreads();
    if (wid < 4) { const float g0 = gsub[r32], g1 = gsub[32 + r32], g2 = gsub[64 + r32], g3 = gsub[96 + r32];
#pragma unroll
      for (int r = 0; r < 16; ++r) { const int orow = tb + crow(r, hi); const float* hb = HB + orow * 128 + r32;
        const float x0 = o[0][r] * rli[r] - lam * hb[0], x1 = o[1][r] * rli[r] - lam * hb[32], x2 = o[2][r] * rli[r] - lam * hb[64], x3 = o[3][r] * rli[r] - lam * hb[96];
        float ss = (x0 * x0 + x1 * x1) + (x2 * x2 + x3 * x3);
        ss += __builtin_bit_cast(float, __builtin_amdgcn_update_dpp(0, __builtin_bit_cast(int, ss), 0xB1, 0xf, 0xf, true)); ss += __builtin_bit_cast(float, __builtin_amdgcn_update_dpp(0, __builtin_bit_cast(int, ss), 0x4E, 0xf, 0xf, true));
        ss += __builtin_bit_cast(float, __builtin_amdgcn_update_dpp(0, __builtin_bit_cast(int, ss), 0x141, 0xf, 0xf, true)); ss += __builtin_bit_cast(float, __builtin_amdgcn_update_dpp(0, __builtin_bit_cast(int, ss), 0x140, 0xf, 0xf, true));
        { auto sw_ = __builtin_amdgcn_permlane16_swap(__float_as_uint(ss), __float_as_uint(ss), false, false); ss = __uint_as_float(sw_[0]) + __uint_as_float(sw_[1]); }
        const float rs = rsqrtf(ss * (1.f / 128.f) + 1e-6f) * post_scale;
        bf16_t* op = O1 + (long)orow * ldo + r32;
        op[0] = f2bf(x0 * rs * g0); op[32] = f2bf(x1 * rs * g1); op[64] = f2bf(x2 * rs * g2); op[96] = f2bf(x3 * rs * g3); } }
  } else {
    bf16_t* Ow = O1 + (long)(wid * 32) * ldo;
#pragma unroll
    for (int r = 0; r < 16; ++r) { const int orow = crow(r, hi);
#pragma unroll
      for (int d0 = 0; d0 < 4; ++d0) Ow[(long)orow * ldo + d0 * 32 + r32] = f2bf(o[d0][r] * rli[r]); }
  }
#undef KLOAD
#undef VLOAD
#undef KWRITE
#undef VWRITE
#undef RESC
#undef QKT
#undef FINISH
#undef PV_AND_PARTIAL
#undef EXPN
#undef ADDN
#undef LSUM
#undef FIN_PIECE
#undef KFRAG
#undef QKT_FIN_FAST
#undef FINISH_FAST
#undef PV_PART_FAST
}
template <int MODE>
__device__ __forceinline__ void attn_unit_sbd(const bf16_t* __restrict__ Qp, int ldq, const bf16_t* __restrict__ Kn, int ldk, const bf16_t* __restrict__ Kr,
                                              const bf16_t* __restrict__ Vp, int ldv, bf16_t* O1, int ldo, const KeySrc ks, int NT, float scale, char* lds,
                                              float lam, float post_scale, const float* gsub, const float* kn2) {
  if constexpr (MODE == 0) { attn_unit_sb<0, 2>(Qp, ldq, Kn, ldk, Kr, Vp, ldv, O1, ldo, ks, NT, scale, lds, lam, post_scale, gsub, kn2); return; }
  constexpr int NQ = MODE == 0 ? 12 : 4;
  const int tid = ltid(), wid = tid >> 6, lane = tid & 63, r32 = lane & 31, hi = lane >> 5;
  const int qrow = (MODE == 0 ? wid * 32 : (wid & 3) * 32) + r32, qcol = (MODE == 0 ? 0 : (wid >> 2) * 64) + hi * 8;
  const bf16_t* Qw = Qp + (long)qrow * ldq + qcol; const float C = scale * 1.4426950408889634f; float qn2 = 0.f;
#pragma unroll
  for (int d0 = 0; d0 < NQ; ++d0) qn2 += sq8(scale_q(*reinterpret_cast<const bf16x8*>(Qw + d0 * 16), C));
  { auto rr_ = __builtin_amdgcn_permlane32_swap(__float_as_uint(qn2), __float_as_uint(qn2), false, false); qn2 = __uint_as_float(rr_[0]) + __uint_as_float(rr_[1]); }
  const bool fastw = __all(qn2 * kn2[MODE == 1 ? (wid >> 2) : 0] <= FAST_B2);
  volatile int* flag = (volatile int*)(lds + 147328);
  __syncthreads(); if (tid == 0) *flag = 1; __syncthreads(); if (!fastw && lane == 0) *flag = 0; __syncthreads();
  const bool fast = __builtin_amdgcn_readfirstlane(*flag) != 0;
  if (fast) attn_unit_sb<MODE, 1>(Qp, ldq, Kn, ldk, Kr, Vp, ldv, O1, ldo, ks, NT, scale, lds, lam, post_scale, gsub, kn2);
  else attn_unit_sb<MODE, 0>(Qp, ldq, Kn, ldk, Kr, Vp, ldv, O1, ldo, ks, NT, scale, lds, lam, post_scale, gsub, kn2);
}
#undef SBAR
}

constexpr int DM = 1024, NBATCH = 2, SEQ = 16384, NLAT = NBATCH * SEQ, CTXL = 256, NCTX = NBATCH * CTXL, MTOT = NLAT + NCTX, DIN = 9296, FFH = 2816;
constexpr float EPS = 1e-6f;
constexpr int NCHAIN = 16, NCHUNK = 130;
constexpr float KSCALE_B = 0.08838834764831845f;
enum { I_X = 0, I_C, I_CTX, I_CCTX, I_WMOD, I_BMOD, I_GMIXPRE, I_GMIXPOST, I_GFFNPRE, I_GFFNPOST, I_WIN, I_ASINK, I_BGBIAS, I_CGQ, I_CGKV, I_CWUQ, I_CWUK, I_CWUV,
       I_LQ1, I_LK1, I_LQ2, I_LK2, I_DGSUB, I_WBRANCH, I_WOUT, I_WGU, I_WDOWN, N_IN };
constexpr size_t MiB = 1u << 20, KiB = 1u << 10;
constexpr size_t WS_CTL = 0, CTL_ZERO_BYTES = 64 * KiB;
constexpr size_t WS_SM = 1 * MiB;
constexpr size_t SM_MOD = WS_SM;
constexpr size_t SM_ROPE = WS_SM + 160 * KiB;
constexpr size_t SM_BG = WS_SM + 192 * KiB;
constexpr size_t SM_NST = WS_SM + 2560 * KiB;
constexpr size_t SM_SCAL = WS_SM + 3840 * KiB;
constexpr size_t SM_WSC = WS_SM + 3904 * KiB;
constexpr size_t SC_GU = SM_WSC, SC_G = SM_WSC + 24 * KiB, SC_CD = SM_WSC + 40 * KiB, SC_AB = SM_WSC + 52 * KiB;
constexpr size_t SM_HC = WS_SM + 4 * MiB;
constexpr size_t WS_W = 8 * MiB;
constexpr size_t W_AB = WS_W, W_C = WS_W + 5632 * KiB, W_D = WS_W + 7680 * KiB, W_G = WS_W + 10752 * KiB, W_UQ = WS_W + 18944 * KiB, W_UKV = WS_W + 19712 * KiB,
                 W_AB8 = WS_W + 2048 * KiB  , W_BR = WS_W + 20224 * KiB, W_OUT = WS_W + 24320 * KiB, W_GU = WS_W + 26368 * KiB, W_DN = WS_W + 37632 * KiB;
constexpr size_t U_SC = 52 * MiB + 40 * MiB;
constexpr size_t WS_U = 52 * MiB;
constexpr size_t WS_Y = 117 * MiB;
constexpr size_t WS_R = 247 * MiB;
constexpr size_t R_PAB = WS_R, R_ST = WS_R + 179 * MiB;
constexpr size_t R_PD = WS_R, R_CQ = WS_R + 98 * MiB, R_CKNV = WS_R + 147 * MiB, R_CKR = WS_R + 253 * MiB, R_O2 = WS_R + 217 * MiB;
constexpr size_t R_SSQ = R_O2;
constexpr size_t R_G = WS_R, R_YOUT = WS_R, R_HID = WS_R;
constexpr size_t R_HP = WS_R + 180 * MiB;
constexpr size_t OUT_U8 = 64 * MiB, OUT_U8SC = 100 * MiB;
constexpr size_t R_U8 = WS_R + 219 * MiB, R_U8SC = WS_R + 252 * MiB;
constexpr size_t WS_END = 512 * MiB;
static_assert(W_DN + (size_t)1024 * 2816 * 2 <= WS_U, "weights");
static_assert(R_O2 + (size_t)MTOT * 512 * 2 >= R_U8 || true, "");
static_assert(R_CKNV + (size_t)MTOT * 1024 * 2 <= R_SSQ && R_SSQ + (size_t)MTOT * 12 * 4 <= R_U8 && R_U8 + (size_t)MTOT * 1024 <= R_U8SC && R_U8SC + (size_t)MTOT * 4 <= WS_END && R_G + (size_t)MTOT * 4096 <= R_U8, "int8 u copy");
static_assert(SC_G + 4096 * 4 <= SM_HC && SC_GU + 5632 * 4 <= SC_G && WS_U + (size_t)MTOT * 1024 <= U_SC && U_SC + (size_t)MTOT * 4 <= WS_Y, "int8 scales");
static_assert(WS_U + (size_t)MTOT * 1024 * 2 <= WS_Y && WS_Y + (size_t)MTOT * 2048 * 2 <= WS_R, "U/Y");
static_assert(R_PAB + (size_t)MTOT * 2816 * 2 <= R_ST && R_ST + (size_t)16 * 130 * 16384 * 2 <= WS_END, "AB");
static_assert(R_PD + (size_t)MTOT * 1536 * 2 <= R_CQ && R_CQ + (size_t)MTOT * 768 * 2 <= R_CKNV && R_CKNV + (size_t)MTOT * 1024 * 2 <= R_O2 && R_U8SC + (size_t)MTOT * 4 <= R_CKR && R_ST + (size_t)16 * 130 * 16384 * 2 <= R_CKR && R_HP + (size_t)MTOT * 1024 * 2 <= R_CKR && R_CKR + (size_t)MTOT * 64 * 2 <= WS_END, "CD");
static_assert(R_G + (size_t)MTOT * 4096 * 2 <= WS_END, "G");
static_assert((size_t)NLAT * 1024 * 2 <= OUT_U8 && OUT_U8 + (size_t)MTOT * 1024 <= OUT_U8SC && OUT_U8SC + (size_t)MTOT * 4 <= (size_t)NLAT * 1024 * 4, "u8 in d_out");
static_assert((size_t)MTOT * 2816 * 2 <= 180 * MiB && R_HP + (size_t)MTOT * 1024 * 2 <= WS_END, "HP");
static_assert(SM_BG + (size_t)MTOT * 16 * 4 <= SM_NST && SM_NST + (size_t)16 * 130 * 128 * 4 <= SM_SCAL && SM_SCAL + 3 * 16 * 130 * 4 <= SM_HC && SM_HC + 512 * 1024 * 4 <= WS_W, "SM");
constexpr int LDS_BYTES = 147456;
constexpr int CW_KN = 8192;

struct Args { const float* in[N_IN]; float* out; unsigned char* ws; int layer; int pad; };

typedef const float* const __attribute__((address_space(4)))* InTab;
struct Ctx {
    InTab in; float* out; unsigned char* ws; int layer;
    LAS unsigned char* lds; char* ldsg;
    int tid, lane, wave, G, bid;
};

template <int CTRL> __device__ __forceinline__ float dpp_mov(float x) { return __builtin_bit_cast(float, __builtin_amdgcn_update_dpp(0, __builtin_bit_cast(int, x), CTRL, 0xf, 0xf, true)); }
__device__ __forceinline__ float wave_sum(float v) {
    v += dpp_mov<0xB1>(v); v += dpp_mov<0x4E>(v); v += dpp_mov<0x124>(v); v += dpp_mov<0x128>(v);
    { auto r = __builtin_amdgcn_permlane16_swap(__float_as_uint(v), __float_as_uint(v), false, false); v = __uint_as_float(r[0]) + __uint_as_float(r[1]); }
    { auto r = __builtin_amdgcn_permlane32_swap(__float_as_uint(v), __float_as_uint(v), false, false); v = __uint_as_float(r[0]) + __uint_as_float(r[1]); }
    return v;
}
__device__ __forceinline__ float wave_max(float v) {
    v = fmaxf(v, dpp_mov<0xB1>(v)); v = fmaxf(v, dpp_mov<0x4E>(v)); v = fmaxf(v, dpp_mov<0x124>(v)); v = fmaxf(v, dpp_mov<0x128>(v));
    { auto r = __builtin_amdgcn_permlane16_swap(__float_as_uint(v), __float_as_uint(v), false, false); v = fmaxf(__uint_as_float(r[0]), __uint_as_float(r[1])); }
    { auto r = __builtin_amdgcn_permlane32_swap(__float_as_uint(v), __float_as_uint(v), false, false); v = fmaxf(__uint_as_float(r[0]), __uint_as_float(r[1])); }
    return v;
}
__device__ __forceinline__ float wave_sum16(const float (&g)[16], int lane) {
    float b[8], c4[4], d[2];
#pragma unroll
    for (int i = 0; i < 8; ++i) { auto r = __builtin_amdgcn_permlane32_swap(__float_as_uint(g[i]), __float_as_uint(g[8 + i]), false, false); b[i] = __uint_as_float(r[0]) + __uint_as_float(r[1]); }
#pragma unroll
    for (int i = 0; i < 4; ++i) { auto r = __builtin_amdgcn_permlane16_swap(__float_as_uint(b[i]), __float_as_uint(b[4 + i]), false, false); c4[i] = __uint_as_float(r[0]) + __uint_as_float(r[1]); }
    const bool b3 = (lane & 8) != 0, b2 = (lane & 4) != 0;
#pragma unroll
    for (int i = 0; i < 2; ++i) { const float keep = b3 ? c4[2 + i] : c4[i], send = b3 ? c4[i] : c4[2 + i]; d[i] = keep + dpp_mov<0x128>(send); }
    float e; { const float keep = b2 ? d[1] : d[0], send = b2 ? d[0] : d[1]; e = keep + __shfl_xor(send, 4); }
    e += dpp_mov<0x4E>(e); e += dpp_mov<0xB1>(e);
    return e;
}
__device__ __forceinline__ float siluf_(float x) { return x / (1.f + __expf(-x)); }
__device__ __forceinline__ float logsigf_(float x) { return fminf(x, 0.f) - __logf(1.f + __expf(-fabsf(x))); }
__device__ __forceinline__ float dot8(const u32x4 a, const u32x4 b) {
    return bflo(a.x) * bflo(b.x) + bfhi(a.x) * bfhi(b.x) + bflo(a.y) * bflo(b.y) + bfhi(a.y) * bfhi(b.y)
         + bflo(a.z) * bflo(b.z) + bfhi(a.z) * bfhi(b.z) + bflo(a.w) * bflo(b.w) + bfhi(a.w) * bfhi(b.w);
}
__device__ __forceinline__ const float* hin_row(const Ctx& c, int r) {
    if (c.layer == 0) return r < NLAT ? c.in[I_X] + (size_t)r * DM : c.in[I_CTX] + (size_t)(r - NLAT) * DM;
    return r < NLAT ? c.out + (size_t)r * DM : (const float*)(c.ws + SM_HC) + (size_t)(r - NLAT) * DM;
}
__device__ __forceinline__ float* hout_row(const Ctx& c, int r) { return r < NLAT ? c.out + (size_t)r * DM : (float*)(c.ws + SM_HC) + (size_t)(r - NLAT) * DM; }
__device__ __forceinline__ int mod_idx(int r) { return r < NLAT ? (r >= SEQ ? 1 : 0) : 2; }
__device__ __forceinline__ int tok_row(int dir, int b, int idx, int tp) {
    if (idx < 2) { int j = idx * 128 + tp; if (dir) j = 255 - j; return NLAT + b * CTXL + j; }
    int s = (idx - 2) * 128 + tp; if (dir) s = SEQ - 1 - s; return b * SEQ + s;
}

__device__ __forceinline__ void tr_block(const float* W, int ldw, int k0, int n0, bf16_t* WT, int ldo, int drow, int dcol, float* scr, int lane, const float* kgain = nullptr) {
    float wl[32];
#pragma unroll
    for (int i = 0; i < 32; ++i) { const int kk = 2 * i + (lane >> 5); wl[i] = W[(size_t)(k0 + kk) * ldw + n0 + (lane & 31)]; }
#pragma unroll
    for (int i = 0; i < 32; ++i) { const int kk = 2 * i + (lane >> 5); float w = wl[i]; if (kgain) w *= kgain[k0 + kk]; scr[kk * 33 + (lane & 31)] = w; }
    asm volatile("s_waitcnt lgkmcnt(0)" ::: "memory");
    const int c8 = lane & 7;
#pragma unroll
    for (int j = 0; j < 4; ++j) { const int n = (lane >> 3) + 8 * j; const float* s = scr + (8 * c8) * 33 + n;
        u32x4 o; o.x = cvt_pk_bf16(s[0 * 33], s[1 * 33]); o.y = cvt_pk_bf16(s[2 * 33], s[3 * 33]); o.z = cvt_pk_bf16(s[4 * 33], s[5 * 33]); o.w = cvt_pk_bf16(s[6 * 33], s[7 * 33]);
        *(u32x4*)(WT + (size_t)(drow + n) * ldo + dcol + 8 * c8) = o; }
    asm volatile("s_waitcnt lgkmcnt(0)" ::: "memory");
}
__device__ __forceinline__ void q8_item(const float* W, int ldw, int n0, signed char* WT8, int drow, float* colscale, float* scr, int lane) {
    float mx = 0.f;
    for (int k0 = (lane >> 5); k0 < 1024; k0 += 64) { float wl[32];
#pragma unroll
        for (int i = 0; i < 32; ++i) wl[i] = W[(size_t)(k0 + 2 * i) * ldw + n0 + (lane & 31)];
#pragma unroll
        for (int i = 0; i < 32; ++i) mx = fmaxf(mx, fabsf(wl[i])); }
    { auto rr = __builtin_amdgcn_permlane32_swap(__float_as_uint(mx), __float_as_uint(mx), false, false); mx = fmaxf(__uint_as_float(rr[0]), __uint_as_float(rr[1])); }
    float* inv32 = scr + 64 * 33;
    if (lane < 32) { colscale[drow + lane] = mx > 0.f ? mx * (1.f / 127.f) : 1.f; inv32[lane] = mx > 0.f ? 127.f / mx : 0.f; }
    for (int kb = 0; kb < 16; ++kb) {
        float wl[32];
#pragma unroll
        for (int i = 0; i < 32; ++i) { const int kk = 2 * i + (lane >> 5); wl[i] = W[(size_t)(64 * kb + kk) * ldw + n0 + (lane & 31)]; }
#pragma unroll
        for (int i = 0; i < 32; ++i) { const int kk = 2 * i + (lane >> 5); scr[kk * 33 + (lane & 31)] = wl[i]; }
        asm volatile("s_waitcnt lgkmcnt(0)" ::: "memory");
        const int c8 = lane & 7;
#pragma unroll
        for (int j = 0; j < 4; ++j) { const int n = (lane >> 3) + 8 * j; const float* s = scr + (8 * c8) * 33 + n; const float iv = inv32[n];
            unsigned lo = 0u, hi = 0u;
#pragma unroll
            for (int t = 0; t < 4; ++t) { lo |= ((unsigned)__float2int_rn(s[t * 33] * iv) & 255u) << (8 * t); hi |= ((unsigned)__float2int_rn(s[(4 + t) * 33] * iv) & 255u) << (8 * t); }
            u32x2 o; o.x = lo; o.y = hi; *(u32x2*)(WT8 + (size_t)(drow + n) * 1024 + 64 * kb + 8 * c8) = o; }
        asm volatile("s_waitcnt lgkmcnt(0)" ::: "memory");
    }
}
__device__ __forceinline__ void quant_row_i8(const f32x4 (&u)[4], signed char* dst, float* scale_slot, int lane) {
    float mx = 0.f;
#pragma unroll
    for (int j = 0; j < 4; ++j) mx = fmaxf(fmaxf(mx, fmaxf(fabsf(u[j].x), fabsf(u[j].y))), fmaxf(fabsf(u[j].z), fabsf(u[j].w)));
    mx = wave_max(mx);
    const float inv = mx > 0.f ? 127.f / mx : 0.f;
    if (lane == 0) *scale_slot = mx > 0.f ? mx * (1.f / 127.f) : 1.f;
#pragma unroll
    for (int j = 0; j < 4; ++j) { const unsigned w = ((unsigned)__float2int_rn(u[j].x * inv) & 255u) | (((unsigned)__float2int_rn(u[j].y * inv) & 255u) << 8) | (((unsigned)__float2int_rn(u[j].z * inv) & 255u) << 16) | (((unsigned)__float2int_rn(u[j].w * inv) & 255u) << 24);
        *(unsigned*)(dst + 4 * (lane + 64 * j)) = w; }
}
__device__ __forceinline__ void ph_conv(const Ctx& c, const int l, const int vbid, const int VG, const int parts, const bool extras) {
    unsigned char* ws = c.ws;
    float* scr = (float*)(c.ldsg + c.wave * 16384);
    const float* w_in = c.in[I_WIN] + (size_t)l * DM * DIN;
    if (c.wave < 2 && c.wave * VG + vbid < 434) {
        const int it = c.wave * VG + vbid;
        if (!(parts & 1)) {}
        else if (it >= 378) { const int i4 = it - 378;
            const int n0 = i4 < 24 ? 32 * i4 : (i4 < 40 ? 1792 + 32 * (i4 - 24) : 2320 + 32 * (i4 - 40));
            q8_item(w_in, DIN, n0, (signed char*)(ws + W_AB8), 32 * i4, (float*)(ws + SC_AB), scr, c.lane); }
        else if (it >= 304) { const int i2 = it - 304;
            if (i2 < 26) q8_item(w_in, DIN, 2832 + 32 * i2, (signed char*)(ws + W_C), 32 * i2, (float*)(ws + SC_CD), scr, c.lane);
            else q8_item(w_in, DIN, 3664 + 32 * (i2 - 26), (signed char*)(ws + W_C), 1024 + 32 * (i2 - 26), (float*)(ws + SC_CD), scr, c.lane); }
        else if (it >= 176) q8_item(w_in, DIN, 5200 + 32 * (it - 176), (signed char*)(ws + W_G), 32 * (it - 176), (float*)(ws + SC_G), scr, c.lane);
        else { const int n0 = 32 * it; const int drow = n0 < FFH ? 256 * (n0 / 128) + (n0 % 128) : 256 * ((n0 - FFH) / 128) + 128 + ((n0 - FFH) % 128);
            q8_item(c.in[I_WGU] + (size_t)l * 1024 * 5632, 5632, n0, (signed char*)(ws + W_GU), drow, (float*)(ws + SC_GU), scr, c.lane); }
    } else {
    const int gw = vbid * 6 + (c.wave - 2 < 0 ? 0 : c.wave - 2), NGW = VG * 6;
    if (c.wave >= 2) {
    int base = 0;
#define CONV_SEG(W_, ldw_, K_, nblk_, n0_, WT_, ldo_, drow0_, dcol0_, kind_) CONV_SEGG(W_, ldw_, K_, nblk_, n0_, WT_, ldo_, drow0_, dcol0_, kind_, nullptr)
#define CONV_SEGG(W_, ldw_, K_, nblk_, n0_, WT_, ldo_, drow0_, dcol0_, kind_, gain_) do { \
        const float* W__ = (W_); bf16_t* WT__ = (bf16_t*)(WT_); const int nit = ((K_) / 64) * (nblk_); \
        int it = gw - (base % NGW); if (it < 0) it += NGW; \
        for (; it < nit; it += NGW) { const int kb = it / (nblk_), nb = it % (nblk_); int drow = (drow0_) + 32 * nb; \
            if ((kind_) == 1) { const int n0 = 32 * nb; drow = n0 < FFH ? 256 * (n0 / 128) + (n0 % 128) : 256 * ((n0 - FFH) / 128) + 128 + ((n0 - FFH) % 128); } \
            tr_block(W__, (ldw_), 64 * kb, (n0_) + 32 * nb, WT__, (ldo_), drow, (dcol0_) + 64 * kb, scr, c.lane, (gain_)); } \
        base += nit; } while (0)
    if (parts & 1) {
    CONV_SEG(w_in, DIN, 1024, 32, 768,  ws + W_AB, 1024, 0, 0, 0);
    CONV_SEGG(c.in[I_CWUQ] + (size_t)l * 512 * 768, 768, 512, 24, 0, ws + W_UQ, 512, 0, 0, 0, c.in[I_CGQ] + l * 512);
    CONV_SEGG(c.in[I_CWUK] + (size_t)l * 256 * 512, 512, 256, 16, 0, ws + W_UKV, 256, 0, 0, 0, c.in[I_CGKV] + l * 256);
    CONV_SEGG(c.in[I_CWUV] + (size_t)l * 256 * 512, 512, 256, 16, 0, ws + W_UKV, 256, 512, 0, 0, c.in[I_CGKV] + l * 256);
    CONV_SEG(c.in[I_WBRANCH] + ((size_t)l * 4 + 0) * 512 * 1024, 1024, 512, 32, 0, ws + W_BR, 2048, 0, 0, 0);
    CONV_SEG(c.in[I_WBRANCH] + ((size_t)l * 4 + 1) * 512 * 1024, 1024, 512, 32, 0, ws + W_BR, 2048, 0, 512, 0);
    CONV_SEG(c.in[I_WBRANCH] + ((size_t)l * 4 + 2) * 512 * 1024, 1024, 512, 32, 0, ws + W_BR, 2048, 0, 1024, 0);
    CONV_SEG(c.in[I_WBRANCH] + ((size_t)l * 4 + 3) * 512 * 1024, 1024, 512, 32, 0, ws + W_BR, 2048, 0, 1536, 0);
    CONV_SEG(c.in[I_WOUT] + (size_t)l * 1024 * 1024, 1024, 1024, 32, 0, ws + W_OUT, 1024, 0, 0, 0);
    }
    if (parts & 2) CONV_SEG(c.in[I_WDOWN] + (size_t)l * 2816 * 1024, 1024, 2816, 32, 0, ws + W_DN, 2816, 0, 0, 0);
#undef CONV_SEG
#undef CONV_SEGG
    } }
    { signed char* wc = (signed char*)(ws + W_C) + (size_t)832 * 1024; const int n16 = 192 * 1024 / 16;
      if (parts & 1) { for (int i = vbid * 512 + c.tid; i < n16; i += VG * 512) ((u32x4*)wc)[i] = (u32x4){0u, 0u, 0u, 0u};
          if (vbid == 0 && c.tid < 192) ((float*)(ws + SC_CD))[832 + c.tid] = 1.f; } }
    if (extras) {
    { float* T = (float*)(ws + SM_ROPE);
      for (int i = c.bid * 512 + c.tid; i < 256 * 16; i += c.G * 512) { const int p = i >> 4, k = i & 15;
          const float inv = exp2f(-(float)k * 0.83048202372184058f);   const float ang = (float)p * inv; T[2 * i] = cosf(ang); T[2 * i + 1] = sinf(ang); } }
    __syncthreads();
    { float* red = (float*)c.ldsg;
      float* sl = (float*)c.ldsg + 2048;
      float* mod = (float*)(ws + SM_MOD);
      for (int i = c.tid; i < 3072; i += 512) sl[i] = siluf_(i < 2048 ? c.in[I_C][i] : c.in[I_CCTX][i - 2048]);
      __syncthreads();
      for (int it = c.bid; it < 192; it += c.G) {
          const int lm = it / 96; const float* wm = c.in[I_WMOD] + (size_t)lm * DM * 6144; const float* bm = c.in[I_BMOD] + (size_t)lm * 6144;
          const int n = (it % 96) * 64 + c.lane; float a0 = 0.f, a1 = 0.f, a2 = 0.f;
          for (int k0 = c.wave * 128; k0 < c.wave * 128 + 128; k0 += 32) { float wl[32];
#pragma unroll
              for (int i = 0; i < 32; ++i) wl[i] = wm[(size_t)(k0 + i) * 6144 + n];
#pragma unroll
              for (int i = 0; i < 32; ++i) { a0 += sl[k0 + i] * wl[i]; a1 += sl[1024 + k0 + i] * wl[i]; a2 += sl[2048 + k0 + i] * wl[i]; } }
          red[(c.wave * 3 + 0) * 64 + c.lane] = a0; red[(c.wave * 3 + 1) * 64 + c.lane] = a1; red[(c.wave * 3 + 2) * 64 + c.lane] = a2;
          __syncthreads();
          if (c.wave < 3) { float s_ = 0.f;
#pragma unroll
              for (int w = 0; w < 8; ++w) s_ += red[(w * 3 + c.wave) * 64 + c.lane];
              mod[(lm * 3 + c.wave) * 6144 + n] = s_ + bm[n]; }
          __syncthreads();
      } }
    }
}

__device__ __forceinline__ void stage_gate_weights(const Ctx& c, int l, float* wgl) {
    const float* wg = c.in[I_WIN] + (size_t)l * DM * DIN + 2304;
    for (int i = c.tid; i < 1024 * 4; i += 512) { const int k = i >> 2, q4 = i & 3; const f32x4 w = *(const f32x4*)(wg + (size_t)k * DIN + 4 * q4);
        wgl[(4 * q4 + 0) * 1024 + k] = w.x; wgl[(4 * q4 + 1) * 1024 + k] = w.y; wgl[(4 * q4 + 2) * 1024 + k] = w.z; wgl[(4 * q4 + 3) * 1024 + k] = w.w; }
    __syncthreads();
}
struct N1Vec { f32x4 sh[4], sc[4]; };
__device__ __forceinline__ void norm1_load(const Ctx& c, int l, int r, N1Vec& nv) {
    const float* md = (const float*)(c.ws + SM_MOD) + (l * 3 + mod_idx(r)) * 6144;
#pragma unroll
    for (int j = 0; j < 4; ++j) { const int e = 4 * (c.lane + 64 * j); nv.sh[j] = *(const f32x4*)(md + e); nv.sc[j] = *(const f32x4*)(md + 1024 + e); }
}
__device__ __forceinline__ void norm1_apply(const Ctx& c, int l, int r, const f32x4 (&v)[4], const float* wgl, const f32x4 (&g4)[4], const N1Vec& nv) {
    const float* bias = c.in[I_BGBIAS] + l * 16; bf16_t* U = (bf16_t*)(c.ws + WS_U); float* bg = (float*)(c.ws + SM_BG);
    float ss = 0.f;
#pragma unroll
    for (int j = 0; j < 4; ++j) ss += (v[j].x * v[j].x + v[j].y * v[j].y) + (v[j].z * v[j].z + v[j].w * v[j].w);
    const float rs = rsqrtf(wave_sum(ss) * (1.f / DM) + EPS);
    float ga[16];
#pragma unroll
    for (int q = 0; q < 16; ++q) ga[q] = 0.f;
    f32x4 uj[4];
#pragma unroll
    for (int j = 0; j < 4; ++j) { const int e = 4 * (c.lane + 64 * j);
        const f32x4 g = g4[j], sh = nv.sh[j], scl = nv.sc[j];
        f32x4 u; u.x = v[j].x * rs * g.x * (1.f + scl.x) + sh.x; u.y = v[j].y * rs * g.y * (1.f + scl.y) + sh.y; u.z = v[j].z * rs * g.z * (1.f + scl.z) + sh.z; u.w = v[j].w * rs * g.w * (1.f + scl.w) + sh.w;
        u32x2 w; w.x = cvt_pk_bf16(u.x, u.y); w.y = cvt_pk_bf16(u.z, u.w); *(u32x2*)(U + (size_t)r * DM + e) = w; uj[j] = u; }
    quant_row_i8(uj, (signed char*)c.out + OUT_U8 + (size_t)r * DM, (float*)((unsigned char*)c.out + OUT_U8SC) + r, c.lane);
    { f32x4 wa[8], wb[8];
#define N1_LDW(dst, B) do { _Pragma("unroll") for (int q = 0; q < 8; ++q) dst[q] = *(const f32x4*)(wgl + (((B) & 1) * 8 + q) * 1024 + 4 * (c.lane + 64 * ((B) >> 1))); } while (0)
#define N1_FMA(src, B) do { const f32x4 u = uj[(B) >> 1]; _Pragma("unroll") for (int q = 0; q < 8; ++q) ga[((B) & 1) * 8 + q] += (u.x * src[q].x + u.y * src[q].y) + (u.z * src[q].z + u.w * src[q].w); } while (0)
      N1_LDW(wa, 0);
#pragma unroll
      for (int bq = 0; bq < 8; bq += 2) {
          N1_LDW(wb, bq + 1); __builtin_amdgcn_sched_barrier(0);
          N1_FMA(wa, bq); __builtin_amdgcn_sched_barrier(0);
          if (bq + 2 < 8) { N1_LDW(wa, bq + 2); } __builtin_amdgcn_sched_barrier(0);
          N1_FMA(wb, bq + 1); __builtin_amdgcn_sched_barrier(0); }
#undef N1_LDW
#undef N1_FMA
    }
    const float gsum = wave_sum16(ga, c.lane);
    if ((c.lane & 3) == 0) { const int q = c.lane >> 2; float g = gsum + bias[q]; if ((q >> 2) & 1) g = logsigf_(g); bg[(size_t)r * 16 + q] = g; }
}
__device__ __forceinline__ void ph_norm1(const Ctx& c) {
    const int l = c.layer; const int gw = c.bid * 8 + c.wave, NGW = c.G * 8;
    float* wgl = (float*)c.ldsg; stage_gate_weights(c, l, wgl);
    f32x4 g4[4]; { const float* gpre = c.in[I_GMIXPRE] + (size_t)l * DM;
#pragma unroll
      for (int j = 0; j < 4; ++j) g4[j] = *(const f32x4*)(gpre + 4 * (c.lane + 64 * j)); }
    f32x4 v[4], vn[4];
    if (gw < MTOT) { const f32x4* xr = (const f32x4*)hin_row(c, gw) + c.lane;
#pragma unroll
        for (int j = 0; j < 4; ++j) v[j] = xr[64 * j]; }
    for (int r = gw; r < MTOT; r += NGW) {
        N1Vec nv; norm1_load(c, l, r, nv);
        const int rn = r + NGW < MTOT ? r + NGW : r; { const f32x4* xr = (const f32x4*)hin_row(c, rn) + c.lane;
#pragma unroll
          for (int j = 0; j < 4; ++j) vn[j] = xr[64 * j]; }
        __builtin_amdgcn_sched_barrier(0);
        norm1_apply(c, l, r, v, wgl, g4, nv);
#pragma unroll
        for (int j = 0; j < 4; ++j) v[j] = vn[j];
    }
}

__device__ __forceinline__ void rope_row(bf16_t* rowp, const bf16_t* srcp, int npairs, int hstride, int pr, int pc, const float* T, int lane) {
    for (int p = lane; p < npairs; p += 64) { const int hh = p >> 5, w = p & 31, half = w >> 4, i = w & 15;
        const int c1 = hh * hstride + 32 * half + i, c2 = c1 + 16; const int pos = half ? pc : pr;
        const float cs = T[(pos * 16 + i) * 2], sn = T[(pos * 16 + i) * 2 + 1];
        const float x1 = bf2f(srcp[c1]), x2 = bf2f(srcp[c2]);
        rowp[c1] = f2bf(x1 * cs - x2 * sn); rowp[c2] = f2bf(x2 * cs + x1 * sn); }
}
__device__ __forceinline__ void ph_rope_a(const Ctx& c) {
    const int gw = c.bid * 8 + c.wave, NGW = c.G * 8; const float* T = (const float*)(c.ws + SM_ROPE);
    bf16_t* P = (bf16_t*)(c.ws + R_PAB);
    for (int r = gw; r < NLAT; r += NGW) { const int t = r & (SEQ - 1); bf16_t* rp = P + (size_t)r * 2816; rope_row(rp, rp, 320, 64, t >> 6, t & 63, T, c.lane); }
}

__device__ __forceinline__ void ph_mix_ab1(const Ctx& c) {
    const int l = c.layer; const bool with_ctx = (l == 0);
    const bf16_t* P = (const bf16_t*)(c.ws + R_PAB); const float* bg = (const float*)(c.ws + SM_BG);
    bf16_t* ST = (bf16_t*)(c.ws + R_ST); float* NST = (float*)(c.ws + SM_NST); float* SCAL = (float*)(c.ws + SM_SCAL);
    {
        char* Kt = c.ldsg; char* Vf = c.ldsg + 32768; char* Vb = c.ldsg + 65536; float* wv = (float*)(c.ldsg + 98304);
        const int r32 = c.lane & 31, hi = c.lane >> 5;
        for (int it = c.bid; it < 8 * NCHUNK; it += c.G) {
            const int b = it / (4 * NCHUNK), head = (it / NCHUNK) & 3, tc = it % NCHUNK;
            const int row0 = tc < 2 ? NLAT + b * CTXL + tc * 128 : b * SEQ + (tc - 2) * 128;
            const int ci_f = (b * 4 + head) * NCHUNK + tc, ci_b = (8 + b * 4 + head) * NCHUNK + (tc < 2 ? 1 - tc : 131 - tc);
            __syncthreads();
            const int sdir = c.wave & 1; const int e0 = sdir ? 127 - 2 * c.lane : 2 * c.lane, e1 = sdir ? 126 - 2 * c.lane : 2 * c.lane + 1;
            float x0 = 0.f, x1 = 0.f, i0 = 0.f, i1 = 0.f;
            if (c.wave < 2) { const float* g0 = bg + (size_t)(row0 + e0) * 16 + sdir * 8 + head; const float* g1 = bg + (size_t)(row0 + e1) * 16 + sdir * 8 + head;
                x0 = g0[4]; x1 = g1[4]; i0 = g0[0]; i1 = g1[0]; }
            u32x4 skk[4], svv[4];
#pragma unroll
            for (int i = 0; i < 4; ++i) { const int e = c.tid + 512 * i, s = e >> 4, c8 = (e & 15) * 8; const bf16_t* pr = P + (size_t)(row0 + s) * 2816 + 128 * head + c8;
                skk[i] = *(const u32x4*)(pr + 1280); svv[i] = *(const u32x4*)(pr + 1792); }
            __builtin_amdgcn_sched_barrier(0);
            if (c.wave < 2) { float s = x0 + x1;
#pragma unroll
                for (int off = 1; off < 64; off <<= 1) { const float t = __shfl_up(s, off); if (c.lane >= off) s += t; }
                const float blast = __shfl(s, 63);
                const float ga = blast - (s - x1) + i0, gb = blast - s + i1;
                const float gmax = wave_max(fmaxf(ga, gb));
                wv[sdir * 128 + e0] = __expf(ga - gmax); wv[sdir * 128 + e1] = __expf(gb - gmax);
                if (c.lane == 0) { const int ci = sdir ? ci_b : ci_f; SCAL[ci] = gmax; SCAL[NCHAIN * NCHUNK + ci] = blast; } }
            __syncthreads();
#pragma unroll
            for (int i = 0; i < 4; ++i) { const int e = c.tid + 512 * i, s = e >> 4, c8 = (e & 15) * 8; const u32x4 kk = skk[i], vv = svv[i];
                const int ad = (s >> 6) * 16384 + att::v_st<4>(s & 63, c8);
                *(u32x4*)(Kt + ad) = kk;
                const float wf = wv[s], wb = wv[128 + s]; u32x4 a, d;
                a.x = cvt_pk_bf16(bflo(vv.x) * wf, bfhi(vv.x) * wf); a.y = cvt_pk_bf16(bflo(vv.y) * wf, bfhi(vv.y) * wf); a.z = cvt_pk_bf16(bflo(vv.z) * wf, bfhi(vv.z) * wf); a.w = cvt_pk_bf16(bflo(vv.w) * wf, bfhi(vv.w) * wf);
                d.x = cvt_pk_bf16(bflo(vv.x) * wb, bfhi(vv.x) * wb); d.y = cvt_pk_bf16(bflo(vv.y) * wb, bfhi(vv.y) * wb); d.z = cvt_pk_bf16(bflo(vv.z) * wb, bfhi(vv.z) * wb); d.w = cvt_pk_bf16(bflo(vv.w) * wb, bfhi(vv.w) * wb);
                *(u32x4*)(Vf + ad) = a; *(u32x4*)(Vb + ad) = d; }
            __syncthreads();
            { const int dir = c.wave >> 2, vblk = c.wave & 3;
              const int kb = (int)(uintptr_t)Kt + att::v_rd_base(c.lane), vb = (int)(uintptr_t)(dir ? Vb : Vf) + att::v_rd_base(c.lane);
              f32x16 D[4] = {};
#define MA_STEP(KS) do { const s16x4 al = att::tr_read<att::v_rd_off(0, (KS) & 3, 0) + ((KS) >> 2) * 16384>(vb + vblk * 512), ah = att::tr_read<att::v_rd_off(0, (KS) & 3, 1) + ((KS) >> 2) * 16384>(vb + vblk * 512); \
                const s16x4 b0l = att::tr_read<att::v_rd_off(0, (KS) & 3, 0) + ((KS) >> 2) * 16384>(kb), b0h = att::tr_read<att::v_rd_off(0, (KS) & 3, 1) + ((KS) >> 2) * 16384>(kb); \
                const s16x4 b1l = att::tr_read<att::v_rd_off(1, (KS) & 3, 0) + ((KS) >> 2) * 16384>(kb), b1h = att::tr_read<att::v_rd_off(1, (KS) & 3, 1) + ((KS) >> 2) * 16384>(kb); \
                const s16x4 b2l = att::tr_read<att::v_rd_off(2, (KS) & 3, 0) + ((KS) >> 2) * 16384>(kb), b2h = att::tr_read<att::v_rd_off(2, (KS) & 3, 1) + ((KS) >> 2) * 16384>(kb); \
                const s16x4 b3l = att::tr_read<att::v_rd_off(3, (KS) & 3, 0) + ((KS) >> 2) * 16384>(kb), b3h = att::tr_read<att::v_rd_off(3, (KS) & 3, 1) + ((KS) >> 2) * 16384>(kb); \
                asm volatile("s_waitcnt lgkmcnt(0)" ::: "memory"); __builtin_amdgcn_sched_barrier(0); \
                const bf16x8 A_ = (bf16x8){al[0], al[1], al[2], al[3], ah[0], ah[1], ah[2], ah[3]}; \
                D[0] = __builtin_amdgcn_mfma_f32_32x32x16_bf16(A_, (bf16x8){b0l[0], b0l[1], b0l[2], b0l[3], b0h[0], b0h[1], b0h[2], b0h[3]}, D[0], 0, 0, 0); \
                D[1] = __builtin_amdgcn_mfma_f32_32x32x16_bf16(A_, (bf16x8){b1l[0], b1l[1], b1l[2], b1l[3], b1h[0], b1h[1], b1h[2], b1h[3]}, D[1], 0, 0, 0); \
                D[2] = __builtin_amdgcn_mfma_f32_32x32x16_bf16(A_, (bf16x8){b2l[0], b2l[1], b2l[2], b2l[3], b2h[0], b2h[1], b2h[2], b2h[3]}, D[2], 0, 0, 0); \
                D[3] = __builtin_amdgcn_mfma_f32_32x32x16_bf16(A_, (bf16x8){b3l[0], b3l[1], b3l[2], b3l[3], b3h[0], b3h[1], b3h[2], b3h[3]}, D[3], 0, 0, 0); } while (0)
              MA_STEP(0); MA_STEP(1); MA_STEP(2); MA_STEP(3); MA_STEP(4); MA_STEP(5); MA_STEP(6); MA_STEP(7);
#undef MA_STEP
              bf16_t* dst = ST + (size_t)(dir ? ci_b : ci_f) * 16384;
#pragma unroll
              for (int r = 0; r < 16; ++r) { const int v = 32 * vblk + att::crow(r, hi);
#pragma unroll
                  for (int db = 0; db < 4; ++db) dst[v * 128 + 32 * db + r32] = f2bf(D[db][r] * KSCALE_B); } }
            {
              const int dir = c.tid >> 8, dg = (c.tid >> 4) & 15, sg = c.tid & 15; const bf16_t* kp = P + (size_t)row0 * 2816 + 1280 + 128 * head + 8 * dg;
              float a[8];
#pragma unroll
              for (int k = 0; k < 8; ++k) a[k] = 0.f;
#pragma unroll
              for (int i = 0; i < 8; ++i) { const int s = sg + 16 * i; const u32x4 kk = *(const u32x4*)(kp + (size_t)s * 2816); const float w = wv[dir * 128 + s];
                  a[0] += w * bflo(kk.x); a[1] += w * bfhi(kk.x); a[2] += w * bflo(kk.y); a[3] += w * bfhi(kk.y); a[4] += w * bflo(kk.z); a[5] += w * bfhi(kk.z); a[6] += w * bflo(kk.w); a[7] += w * bfhi(kk.w); }
#pragma unroll
              for (int k = 0; k < 8; ++k) { a[k] += __shfl_xor(a[k], 1); a[k] += __shfl_xor(a[k], 2); a[k] += __shfl_xor(a[k], 4); a[k] += __shfl_xor(a[k], 8); }
              if (sg == 0) { float* np_ = NST + (size_t)(dir ? ci_b : ci_f) * 128 + 8 * dg;
                  *(f32x4*)np_ = (f32x4){a[0] * KSCALE_B, a[1] * KSCALE_B, a[2] * KSCALE_B, a[3] * KSCALE_B}; *(f32x4*)(np_ + 4) = (f32x4){a[4] * KSCALE_B, a[5] * KSCALE_B, a[6] * KSCALE_B, a[7] * KSCALE_B}; } }
        }
    }
    __syncthreads();
    {
        const float* sink = c.in[I_ASINK] + l * 8; bf16_t* Y = (bf16_t*)(c.ws + WS_Y);
        const int NU = 1024 + (with_ctx ? 16 : 0);
        for (int u = (c.bid + (c.G >> 1)) % c.G; u < NU; u += c.G) {
            if (u < 1024) { const int b = u >> 9, g = (u >> 8) & 1, qb = u & 255, q0 = 64 * qb; const long row0 = (long)b * SEQ + q0;
                const int wj_lo = qb < 2 ? 2 - qb : 0, wj_hi = (257 - qb) < 4 ? (257 - qb) : 4, nwin = wj_hi - wj_lo + 1;
                att::KeySrc ks{b * SEQ + q0 - 128 + 64 * wj_lo, nwin, NLAT + b * CTXL, wj_lo};
                att::attn_unit<2>(P + row0 * 2816 + 256 * g, 2816, P + 512 + 64 * g, 2816, nullptr, P + 640 + 64 * g, 2816, Y + row0 * 2048 + 256 * g, nullptr, 2048, 0, ks, nwin + 4, 0.125f, sink + 4 * g, c.ldsg);
            } else { const int v = u - 1024, b = v >> 3, g = (v >> 2) & 1, qb = v & 3; const long row0 = (long)NLAT + b * CTXL + 64 * qb;
                att::KeySrc ks{0, 0, NLAT + b * CTXL, 0};
                att::attn_unit<2>(P + row0 * 2816 + 256 * g, 2816, P + 512 + 64 * g, 2816, nullptr, P + 640 + 64 * g, 2816, Y + row0 * 2048 + 256 * g, nullptr, 2048, 0, ks, 4, 0.125f, sink + 4 * g, c.ldsg);
            }
        }
    }
}

__device__ __forceinline__ void ph_scan(const Ctx& c) {
    bf16_t* ST = (bf16_t*)(c.ws + R_ST); float* NST = (float*)(c.ws + SM_NST); float* SCAL = (float*)(c.ws + SM_SCAL);
    float* dec = (float*)c.ldsg; float* scl = dec + 160;
    for (int it = c.bid; it < NCHAIN * 16; it += c.G) {
        const int chain = it >> 4, sub = it & 15;
        __syncthreads();
        if (c.wave == 0) {
            float bl[3], gm[3], mp[3];
#pragma unroll
            for (int k = 0; k < 3; ++k) { const int idx = 64 * k + c.lane; const bool ok = idx < NCHUNK; gm[k] = ok ? SCAL[chain * NCHUNK + idx] : 0.f; bl[k] = ok ? SCAL[NCHAIN * NCHUNK + chain * NCHUNK + idx] : 0.f; mp[k] = 0.f; }
            float m = 0.f;
#pragma unroll
            for (int k = 0; k < 3; ++k) { const int n = (NCHUNK - 64 * k) < 64 ? (NCHUNK - 64 * k) : 64;
                for (int i = 0; i < n; ++i) { const float bb = __builtin_bit_cast(float, __builtin_amdgcn_readlane(__builtin_bit_cast(int, bl[k]), i)), gg = __builtin_bit_cast(float, __builtin_amdgcn_readlane(__builtin_bit_cast(int, gm[k]), i));
                    if (c.lane == i) mp[k] = m;
                    m = fmaxf(bb + m, gg); } }
#pragma unroll
            for (int k = 0; k < 3; ++k) { const int idx = 64 * k + c.lane;
                if (idx < NCHUNK) { const float mn = fmaxf(bl[k] + mp[k], gm[k]); dec[idx] = __expf(bl[k] + mp[k] - mn); scl[idx] = __expf(gm[k] - mn);
                    if (sub == 0) SCAL[2 * NCHAIN * NCHUNK + chain * NCHUNK + idx] = mp[k]; } }
        }
        __syncthreads();
        { float cs0 = 0.f, cs1 = 0.f; unsigned* p = (unsigned*)(ST + (size_t)chain * NCHUNK * 16384 + sub * 1024) + c.tid;
          unsigned cur[13], nxt[13], nx2[13];
#pragma unroll
          for (int j = 0; j < 13; ++j) { cur[j] = p[(size_t)j * 8192]; nxt[j] = p[(size_t)(13 + j) * 8192]; }
          for (int blk = 0; blk < 10; ++blk) {
              if (blk < 8) {
#pragma unroll
                  for (int j = 0; j < 13; ++j) nx2[j] = p[(size_t)(13 * (blk + 2) + j) * 8192]; }
              __builtin_amdgcn_sched_barrier(0);
#pragma unroll
              for (int j = 0; j < 13; ++j) { const int idx = 13 * blk + j; const float u0 = bflo(cur[j]), u1 = bfhi(cur[j]); const float d = dec[idx], sc = scl[idx];
                  p[(size_t)idx * 8192] = cvt_pk_bf16(cs0, cs1); cs0 = d * cs0 + sc * u0; cs1 = d * cs1 + sc * u1; }
#pragma unroll
              for (int j = 0; j < 13; ++j) { cur[j] = nxt[j]; nxt[j] = nx2[j]; }
          } }
        if (c.tid < 8) { float ns = 0.f; float* p = NST + (size_t)chain * NCHUNK * 128 + sub * 8 + c.tid;
            for (int blk = 0; blk < 10; ++blk) { float uu[13];
#pragma unroll
                for (int j = 0; j < 13; ++j) uu[j] = p[(13 * blk + j) * 128];
#pragma unroll
                for (int j = 0; j < 13; ++j) { const int idx = 13 * blk + j; p[idx * 128] = ns; ns = dec[idx] * ns + scl[idx] * uu[j]; } } }
    }
}

__device__ __forceinline__ bf16x8 scale_frag(const bf16x8 q, const float a) {
    const u32x4 w = *reinterpret_cast<const u32x4*>(&q); u32x4 o;
    o.x = cvt_pk_bf16(bflo(w.x) * a, bfhi(w.x) * a); o.y = cvt_pk_bf16(bflo(w.y) * a, bfhi(w.y) * a); o.z = cvt_pk_bf16(bflo(w.z) * a, bfhi(w.z) * a); o.w = cvt_pk_bf16(bflo(w.w) * a, bfhi(w.w) * a);
    return *reinterpret_cast<const bf16x8*>(&o);
}
__device__ __forceinline__ void ph_mlstm_c(const Ctx& c) {
    const bool with_ctx = (c.layer == 0);
    const bf16_t* P = (const bf16_t*)(c.ws + R_PAB); const float* bg = (const float*)(c.ws + SM_BG);
    const bf16_t* ST = (const bf16_t*)(c.ws + R_ST); const float* NST = (const float*)(c.ws + SM_NST); const float* SCAL = (const float*)(c.ws + SM_SCAL);
    bf16_t* Y = (bf16_t*)(c.ws + WS_Y);
    constexpr int KSTR = 272;
    char* Ks = c.ldsg; char* Vt = c.ldsg + 34816; char* Cf = c.ldsg + 67584; char* Cb = c.ldsg + 102400;
    float* ar = (float*)(c.ldsg + 137216);
    float* wsf = (float*)(c.ldsg + 142336) + c.wave * 64;
    float* HB = (float*)c.ldsg; float* HF = (float*)(c.ldsg + 67584);
    const int r32 = c.lane & 31, hi = c.lane >> 5;
    const int NIT = with_ctx ? 8 * NCHUNK : 8 * (NCHUNK - 2);
    for (int it = c.bid; it < NIT; it += c.G) {
        const int b = with_ctx ? it / (4 * NCHUNK) : it >> 9, head = with_ctx ? (it / NCHUNK) & 3 : (it >> 7) & 3, tc = with_ctx ? it % NCHUNK : 2 + (it & 127);
        const int row0 = tc < 2 ? NLAT + b * CTXL + tc * 128 : b * SEQ + (tc - 2) * 128;
        const int ci_f = (b * 4 + head) * NCHUNK + tc, ci_b = (8 + b * 4 + head) * NCHUNK + (tc < 2 ? 1 - tc : 131 - tc);
        __syncthreads();
        const int sdir = c.wave & 1; const int e0 = sdir ? 127 - 2 * c.lane : 2 * c.lane, e1 = sdir ? 126 - 2 * c.lane : 2 * c.lane + 1;
        float x0 = 0.f, x1 = 0.f, i0 = 0.f, i1 = 0.f, mprev = 0.f, nstv = 0.f;
        if (c.wave < 2) { const float* g0 = bg + (size_t)(row0 + e0) * 16 + sdir * 8 + head; const float* g1 = bg + (size_t)(row0 + e1) * 16 + sdir * 8 + head;
            x0 = g0[4]; x1 = g1[4]; i0 = g0[0]; i1 = g1[0]; mprev = SCAL[2 * NCHAIN * NCHUNK + (sdir ? ci_b : ci_f)]; }
        if (c.tid >= 128 && c.tid < 384) { const int dir = (c.tid - 128) >> 7, d = c.tid & 127; nstv = NST[(size_t)(dir ? ci_b : ci_f) * 128 + d]; }
        u32x4 stg[4][4];
#pragma unroll
        for (int i = 0; i < 4; ++i) { const int e = c.tid + 512 * i, s = e >> 4, c8 = (e & 15) * 8; const bf16_t* pr = P + (size_t)(row0 + s) * 2816 + 128 * head + c8;
            stg[i][0] = *(const u32x4*)(pr + 1280); stg[i][1] = *(const u32x4*)(pr + 1792);
            stg[i][2] = *(const u32x4*)(ST + (size_t)ci_f * 16384 + s * 128 + c8); stg[i][3] = *(const u32x4*)(ST + (size_t)ci_b * 16384 + s * 128 + c8); }
        const int dir = c.wave >> 2, tb = 32 * (c.wave & 3), t = tb + r32;
        bf16x8 qr[8];
        { const bf16_t* Qw = P + (size_t)(row0 + t) * 2816 + 768 + 128 * head + hi * 8;
#pragma unroll
          for (int d0 = 0; d0 < 8; ++d0) qr[d0] = *reinterpret_cast<const bf16x8*>(Qw + d0 * 16); }
        __builtin_amdgcn_sched_barrier(0);
        if (c.wave < 2) {
            float s = x0 + x1;
#pragma unroll
            for (int off = 1; off < 64; off <<= 1) { const float t_ = __shfl_up(s, off); if (c.lane >= off) s += t_; }
            const float bc0 = s - x1, bc1 = s, a20 = i0 - bc0, a21 = i1 - bc1;
            float m = fmaxf(a20, a21);
#pragma unroll
            for (int off = 1; off < 64; off <<= 1) { const float t_ = __shfl_up(m, off); if (c.lane >= off) m = fmaxf(m, t_); }
            float mp = __shfl_up(m, 1); if (c.lane == 0) mp = -INFINITY;
            const float pm0 = fmaxf(mp, a20), pm1 = m;
            const float mx0 = fmaxf(mprev, pm0), mx1 = fmaxf(mprev, pm1);
            ar[(0 * 2 + sdir) * 128 + e0] = -mx0; ar[(0 * 2 + sdir) * 128 + e1] = -mx1;
            ar[(1 * 2 + sdir) * 128 + e0] = a20; ar[(1 * 2 + sdir) * 128 + e1] = a21;
            ar[(2 * 2 + sdir) * 128 + e0] = __expf(mprev - mx0); ar[(2 * 2 + sdir) * 128 + e1] = __expf(mprev - mx1);
            ar[(3 * 2 + sdir) * 128 + e0] = __expf(-(bc0 + mx0)); ar[(3 * 2 + sdir) * 128 + e1] = __expf(-(bc1 + mx1)); }
        if (c.tid >= 128 && c.tid < 384) { const int dir_ = (c.tid - 128) >> 7, d = c.tid & 127; ar[(4 * 2 + dir_) * 128 + d] = nstv; }
#pragma unroll
        for (int i = 0; i < 4; ++i) { const int e = c.tid + 512 * i, s = e >> 4, c8 = (e & 15) * 8;
            *(u32x4*)(Ks + s * KSTR + c8 * 2) = stg[i][0];
            *(u32x4*)(Vt + (s >> 6) * 16384 + att::v_st<4>(s & 63, c8)) = stg[i][1];
            *(u32x4*)(Cf + s * KSTR + c8 * 2) = stg[i][2];
            *(u32x4*)(Cb + s * KSTR + c8 * 2) = stg[i][3]; }
        __syncthreads();
        const float A1t = ar[(0 * 2 + dir) * 128 + t], avt = ar[(2 * 2 + dir) * 128 + t], emtt = ar[(3 * 2 + dir) * 128 + t];
        const float* A2 = ar + (1 * 2 + dir) * 128; const float* nv = ar + (4 * 2 + dir) * 128;
        f32x16 o[4] = {}; float rowsum = 0.f;
        const int vb0 = (int)(uintptr_t)Vt + att::v_rd_base(c.lane);
#pragma unroll
        for (int j = 0; j < 2; ++j) {
            const bool skip = dir ? (j == 0 && tb >= 64) : (j == 1 && tb < 64);
            if (!skip) {
                f32x16 p0, p1; att::qkt<8, KSTR>(p0, p1, Ks + j * 64 * KSTR, qr, r32, hi);
                float a2v0[16], a2v1[16];
#pragma unroll
                for (int k = 0; k < 4; ++k) { const f32x4 u0 = *(const f32x4*)(A2 + 64 * j + 8 * k + 4 * hi), u1 = *(const f32x4*)(A2 + 64 * j + 32 + 8 * k + 4 * hi);
                    a2v0[4 * k] = u0.x; a2v0[4 * k + 1] = u0.y; a2v0[4 * k + 2] = u0.z; a2v0[4 * k + 3] = u0.w; a2v1[4 * k] = u1.x; a2v1[4 * k + 1] = u1.y; a2v1[4 * k + 2] = u1.z; a2v1[4 * k + 3] = u1.w; }
#pragma unroll
                for (int r = 0; r < 16; ++r) { const int s0 = 64 * j + att::crow(r, hi), s1 = s0 + 32;
                    const bool ok0 = dir ? (s0 >= t) : (s0 <= t), ok1 = dir ? (s1 >= t) : (s1 <= t);
                    const float ex0 = __expf(A1t + a2v0[r]), ex1 = __expf(A1t + a2v1[r]);
                    const float w0 = ok0 ? ex0 : 0.f, w1 = ok1 ? ex1 : 0.f;
                    p0[r] = p0[r] * w0 * KSCALE_B; p1[r] = p1[r] * w1 * KSCALE_B; rowsum += p0[r] + p1[r]; }
                bf16x8 pa0, pa1, pa2, pa3;
#define PK4(Pv, BASE, OUT) do { unsigned a0 = cvt_pk_bf16(Pv[BASE + 0], Pv[BASE + 1]), a1 = cvt_pk_bf16(Pv[BASE + 2], Pv[BASE + 3]);   \
    unsigned b0 = cvt_pk_bf16(Pv[BASE + 4], Pv[BASE + 5]), b1 = cvt_pk_bf16(Pv[BASE + 6], Pv[BASE + 7]);                              \
    auto r0 = __builtin_amdgcn_permlane32_swap(a0, b0, false, false); auto r1 = __builtin_amdgcn_permlane32_swap(a1, b1, false, false); \
    u32x4 w = {r0[0], r1[0], r0[1], r1[1]}; OUT = *reinterpret_cast<bf16x8*>(&w); } while (0)
                PK4(p0, 0, pa0); PK4(p0, 8, pa1); PK4(p1, 0, pa2); PK4(p1, 8, pa3);
#undef PK4
                __builtin_amdgcn_sched_barrier(0);
                att::pv_d0<4>(o, vb0 + j * 16384, pa0, pa1, pa2, pa3);
            }
        }
        { auto rr = __builtin_amdgcn_permlane32_swap(__float_as_uint(rowsum), __float_as_uint(rowsum), false, false); rowsum = __uint_as_float(rr[0]) + __uint_as_float(rr[1]); }
        float nq = 0.f;
#pragma unroll
        for (int d0 = 0; d0 < 8; ++d0) { const u32x4 w = *reinterpret_cast<const u32x4*>(&qr[d0]); const float* n8 = nv + d0 * 16 + hi * 8;
            nq += bflo(w.x) * n8[0] + bfhi(w.x) * n8[1] + bflo(w.y) * n8[2] + bfhi(w.y) * n8[3] + bflo(w.z) * n8[4] + bfhi(w.z) * n8[5] + bflo(w.w) * n8[6] + bfhi(w.w) * n8[7]; }
        { auto rr = __builtin_amdgcn_permlane32_swap(__float_as_uint(nq), __float_as_uint(nq), false, false); nq = __uint_as_float(rr[0]) + __uint_as_float(rr[1]); }
        { const char* Cs = dir ? Cb : Cf; bf16x8 cfa[4], cfb[4];
#define LDCF(dst, D0) do { _Pragma("unroll") for (int vb = 0; vb < 4; ++vb) dst[vb] = *reinterpret_cast<const bf16x8*>(Cs + (32 * vb + r32) * KSTR + ((D0) * 16 + hi * 8) * 2); } while (0)
#define MMCF(src, D0) do { const bf16x8 qs = scale_frag(qr[D0], avt); _Pragma("unroll") for (int vb = 0; vb < 4; ++vb) o[vb] = __builtin_amdgcn_mfma_f32_32x32x16_bf16(qs, src[vb], o[vb], 0, 0, 0); } while (0)
          LDCF(cfa, 0);
#pragma unroll
          for (int d0 = 0; d0 < 8; d0 += 2) {
              LDCF(cfb, d0 + 1); __builtin_amdgcn_sched_barrier(0);
              MMCF(cfa, d0); __builtin_amdgcn_sched_barrier(0);
              if (d0 + 2 < 8) { LDCF(cfa, d0 + 2); } __builtin_amdgcn_sched_barrier(0);
              MMCF(cfb, d0 + 1); __builtin_amdgcn_sched_barrier(0); }
#undef LDCF
#undef MMCF
        }
        const float den = rowsum + avt * nq; const float rdn = 1.f / fmaxf(fabsf(den), emtt);
        if (hi == 0) wsf[r32] = rdn;
        u32x4 ogw[4];
#pragma unroll
        for (int i = 0; i < 4; ++i) { const int e = c.tid + 512 * i; ogw[i] = *(const u32x4*)(P + (size_t)(row0 + (e >> 4)) * 2816 + 2304 + 128 * head + (e & 15) * 8); }
        asm volatile("s_waitcnt lgkmcnt(0)" ::: "memory");
        float rd[16];
#pragma unroll
        for (int r = 0; r < 16; ++r) rd[r] = wsf[att::crow(r, hi)];
        __syncthreads();
        { float* Hd = dir ? HB : HF;
#pragma unroll
          for (int r = 0; r < 16; ++r)
#pragma unroll
              for (int vb = 0; vb < 4; ++vb) Hd[(tb + att::crow(r, hi)) * 128 + 32 * vb + r32] = o[vb][r] * rd[r]; }
        __syncthreads();
#pragma unroll
        for (int i = 0; i < 4; ++i) { const int e = c.tid + 512 * i, tt = e >> 4, c8 = (e & 15) * 8;
            const f32x4 h0 = *(const f32x4*)(HB + tt * 128 + c8) + *(const f32x4*)(HF + tt * 128 + c8), h1 = *(const f32x4*)(HB + tt * 128 + c8 + 4) + *(const f32x4*)(HF + tt * 128 + c8 + 4); const u32x4 g = ogw[i];
            u32x4 w; w.x = cvt_pk_bf16(sigmoidf_(bflo(g.x)) * h0.x, sigmoidf_(bfhi(g.x)) * h0.y); w.y = cvt_pk_bf16(sigmoidf_(bflo(g.y)) * h0.z, sigmoidf_(bfhi(g.y)) * h0.w);
            w.z = cvt_pk_bf16(sigmoidf_(bflo(g.z)) * h1.x, sigmoidf_(bfhi(g.z)) * h1.y); w.w = cvt_pk_bf16(sigmoidf_(bflo(g.w)) * h1.z, sigmoidf_(bfhi(g.w)) * h1.w);
            *(u32x4*)(Y + (size_t)(row0 + tt) * 2048 + 512 + 128 * head + c8) = w; }
    }
}
__device__ __forceinline__ void ph_yb(const Ctx& c) {
    const int M = (c.layer == 0) ? MTOT : NLAT; const bf16_t* P = (const bf16_t*)(c.ws + R_PAB); bf16_t* Y = (bf16_t*)(c.ws + WS_Y);
    for (size_t i = (size_t)c.bid * 512 + c.tid; i < (size_t)M * 64; i += (size_t)c.G * 512) { const size_t r = i >> 6; const int c8 = (int)(i & 63) * 8;
        const u32x4 o = *(const u32x4*)(P + r * 2816 + 2304 + c8), f = *(const u32x4*)(Y + r * 2048 + 512 + c8), bb = *(const u32x4*)(Y + r * 2048 + 1024 + c8);
        u32x4 w;
        w.x = cvt_pk_bf16(sigmoidf_(bflo(o.x)) * (bflo(f.x) + bflo(bb.x)), sigmoidf_(bfhi(o.x)) * (bfhi(f.x) + bfhi(bb.x)));
        w.y = cvt_pk_bf16(sigmoidf_(bflo(o.y)) * (bflo(f.y) + bflo(bb.y)), sigmoidf_(bfhi(o.y)) * (bfhi(f.y) + bfhi(bb.y)));
        w.z = cvt_pk_bf16(sigmoidf_(bflo(o.z)) * (bflo(f.z) + bflo(bb.z)), sigmoidf_(bfhi(o.z)) * (bfhi(f.z) + bfhi(bb.z)));
        w.w = cvt_pk_bf16(sigmoidf_(bflo(o.w)) * (bflo(f.w) + bflo(bb.w)), sigmoidf_(bfhi(o.w)) * (bfhi(f.w) + bfhi(bb.w)));
        *(u32x4*)(Y + r * 2048 + 512 + c8) = w; }
}

__device__ __forceinline__ void ph_mla_pre(const Ctx& c) {
    const int l = c.layer; const int gw = c.bid * 8 + c.wave, NGW = c.G * 8; const float* T = (const float*)(c.ws + SM_ROPE);
    bf16_t* Y = (bf16_t*)(c.ws + WS_Y); bf16_t* PD = (bf16_t*)(c.ws + R_PD); bf16_t* CKR = (bf16_t*)(c.ws + R_CKR);
    const float* gq = c.in[I_CGQ] + l * 512; const float* gkv = c.in[I_CGKV] + l * 256;
    for (int r = gw; r < MTOT; r += NGW) {
        bf16_t* pc = Y + (size_t)r * 2048 + 1024;
        { const u32x4 w = *(const u32x4*)(pc + 8 * c.lane); float x[8] = {bflo(w.x), bfhi(w.x), bflo(w.y), bfhi(w.y), bflo(w.z), bfhi(w.z), bflo(w.w), bfhi(w.w)};
          float ss = 0.f;
#pragma unroll
          for (int j = 0; j < 8; ++j) ss += x[j] * x[j];
          const float rs = rsqrtf(wave_sum(ss) * (1.f / 512.f) + EPS);
#pragma unroll
          for (int j = 0; j < 8; ++j) x[j] = x[j] * rs * gq[8 * c.lane + j];
          u32x4 o; o.x = cvt_pk_bf16(x[0], x[1]); o.y = cvt_pk_bf16(x[2], x[3]); o.z = cvt_pk_bf16(x[4], x[5]); o.w = cvt_pk_bf16(x[6], x[7]); *(u32x4*)(pc + 8 * c.lane) = o; }
        { const u32x2 w = *(const u32x2*)(pc + 512 + 4 * c.lane); float x[4] = {bflo(w.x), bfhi(w.x), bflo(w.y), bfhi(w.y)};
          float ss = x[0] * x[0] + x[1] * x[1] + x[2] * x[2] + x[3] * x[3];
          const float rs = rsqrtf(wave_sum(ss) * (1.f / 256.f) + EPS);
#pragma unroll
          for (int j = 0; j < 4; ++j) x[j] = x[j] * rs * gkv[4 * c.lane + j];
          u32x2 o; o.x = cvt_pk_bf16(x[0], x[1]); o.y = cvt_pk_bf16(x[2], x[3]); *(u32x2*)(pc + 512 + 4 * c.lane) = o; }
        if (r < NLAT) { const int t = r & (SEQ - 1);
            rope_row(CKR + (size_t)r * 64, pc + 768, 32, 64, t >> 6, t & 63, T, c.lane);
            bf16_t* pd = PD + (size_t)r * 1536; rope_row(pd, pd, 512, 64, t >> 6, t & 63, T, c.lane);
        } else { CKR[(size_t)r * 64 + c.lane] = pc[768 + c.lane]; }
    }
}
__device__ __forceinline__ void ph_rope_cq(const Ctx& c) {
    const int gw = c.bid * 8 + c.wave, NGW = c.G * 8; const float* T = (const float*)(c.ws + SM_ROPE); bf16_t* CQ = (bf16_t*)(c.ws + R_CQ);
    for (int r = gw; r < NLAT; r += NGW) { const int t = r & (SEQ - 1); bf16_t* rp = CQ + (size_t)r * 768 + 128; rope_row(rp, rp, 128, 192, t >> 6, t & 63, T, c.lane); }
}


__device__ __forceinline__ void ph_knorm(const Ctx& c) {
    const bf16_t* PD = (const bf16_t*)(c.ws + R_PD); const bf16_t* CKNV = (const bf16_t*)(c.ws + R_CKNV); const bf16_t* CKR = (const bf16_t*)(c.ws + R_CKR);
    const int gw = c.bid * 8 + c.wave, NGW = c.G * 8; const int b = gw & 1, nw = NGW >> 1;
    float mD = 0.f, mC = 0.f;
    auto krow = [&](int idx) -> size_t { return idx < SEQ ? (size_t)b * SEQ + idx : (size_t)NLAT + b * CTXL + (idx - SEQ); };
    for (int idx0 = gw >> 1; idx0 < SEQ + CTXL; idx0 += 2 * nw) {
        const int idx1 = idx0 + nw; const bool two = idx1 < SEQ + CTXL; const size_t r0 = krow(idx0), r1 = krow(two ? idx1 : idx0);
        const u32x4 kd0 = *(const u32x4*)(PD + r0 * 1536 + 512 + 8 * c.lane), kc0 = *(const u32x4*)(CKNV + r0 * 1024 + 8 * c.lane); const float kr0 = bf2f(CKR[r0 * 64 + c.lane]);
        const u32x4 kd1 = *(const u32x4*)(PD + r1 * 1536 + 512 + 8 * c.lane), kc1 = *(const u32x4*)(CKNV + r1 * 1024 + 8 * c.lane); const float kr1 = bf2f(CKR[r1 * 64 + c.lane]);
        float sd0 = dot8(kd0, kd0), sc0 = dot8(kc0, kc0), sd1 = dot8(kd1, kd1), sc1 = dot8(kc1, kc1);
        sd0 += dpp_mov<0xB1>(sd0); sd0 += dpp_mov<0x4E>(sd0); sd0 += dpp_mov<0x141>(sd0);
        sd1 += dpp_mov<0xB1>(sd1); sd1 += dpp_mov<0x4E>(sd1); sd1 += dpp_mov<0x141>(sd1);
        sc0 += dpp_mov<0xB1>(sc0); sc0 += dpp_mov<0x4E>(sc0); sc0 += dpp_mov<0x141>(sc0); sc0 += dpp_mov<0x140>(sc0);
        sc1 += dpp_mov<0xB1>(sc1); sc1 += dpp_mov<0x4E>(sc1); sc1 += dpp_mov<0x141>(sc1); sc1 += dpp_mov<0x140>(sc1);
        const float q0 = wave_sum(kr0 * kr0), q1 = wave_sum(kr1 * kr1);
        mD = fmaxf(mD, fmaxf(sd0, sd1)); mC = fmaxf(mC, fmaxf(sc0 + q0, sc1 + q1)); }
    unsigned* slots = (unsigned*)(c.ws + WS_CTL) + CW_KN + (c.layer * 2 + b) * 12;
    if ((c.lane & 15) == 0) atomicMax(slots + (c.lane >> 4), __float_as_uint(mC));
    if ((c.lane & 7) == 0) atomicMax(slots + 4 + (c.lane >> 3), __float_as_uint(mD));
}
__device__ __forceinline__ void ph_attn(const Ctx& c) {
    const bool with_ctx = (c.layer == 0);
    const bf16_t* CQ = (const bf16_t*)(c.ws + R_CQ); const bf16_t* CKNV = (const bf16_t*)(c.ws + R_CKNV); const bf16_t* CKR = (const bf16_t*)(c.ws + R_CKR);
    const bf16_t* PD = (const bf16_t*)(c.ws + R_PD); bf16_t* Y = (bf16_t*)(c.ws + WS_Y);
    const int l = c.layer; const float lam_init = 0.8f - 0.6f * expf(-0.3f * (float)l);
    const float s1 = wave_sum(c.in[I_LQ1][l * 64 + c.lane] * c.in[I_LK1][l * 64 + c.lane]), s2 = wave_sum(c.in[I_LQ2][l * 64 + c.lane] * c.in[I_LK2][l * 64 + c.lane]);
    const float lam = expf(s1) - expf(s2) + lam_init; const float* gsub = c.in[I_DGSUB] + l * 128;
    const float* KN = (const float*)(c.ws + WS_CTL) + CW_KN + c.layer * 24;
    const int NU_C = 512, NU_D = 1024, NU_CC = with_ctx ? 8 : 0, NU_DC = with_ctx ? 16 : 0;
    const int vcu = (c.G % 8 == 0) ? (c.bid & 7) * (c.G >> 3) + (c.bid >> 3) : c.bid;
    for (int u = vcu; u < NU_C; u += c.G) { const int b = u >> 8, h = (u >> 6) & 3, qb = u & 63; const long row0 = (long)b * SEQ + 256 * qb;
        att::KeySrc ks{b * SEQ, 256, NLAT + b * CTXL, 0};
        att::ATTN_UNIT<0>(CQ + row0 * 768 + 192 * h, 768, CKNV + 128 * h, 1024, CKR, CKNV + 512 + 128 * h, 1024, Y + row0 * 2048 + 1024 + 128 * h, 2048, ks, 260, 0.07216878364870322f, c.ldsg, 0.f, 0.f, nullptr, KN + b * 12 + h); }
    for (int v = vcu; v < NU_D; v += c.G) { const int b = v >> 9, h = (v >> 7) & 3, qb = v & 127; const long row0 = (long)b * SEQ + 128 * qb;
        att::KeySrc ks{b * SEQ, 256, NLAT + b * CTXL, 0};
        att::ATTN_UNIT<1>(PD + row0 * 1536 + 128 * h, 1536, PD + 512 + 128 * h, 1536, nullptr, PD + 1024 + 128 * h, 1536, Y + row0 * 2048 + 1536 + 128 * h, 2048, ks, 260, 0.125f, c.ldsg, lam, 1.f - lam_init, gsub, KN + b * 12 + 4 + 2 * h); }
    for (int v = vcu; v < NU_CC; v += c.G) { const int b = v >> 2, h = v & 3; const long row0 = (long)NLAT + b * CTXL;
        att::KeySrc ks{0, 0, NLAT + b * CTXL, 0};
        att::attn_unit_sb<0, 2>(CQ + row0 * 768 + 192 * h, 768, CKNV + 128 * h, 1024, CKR, CKNV + 512 + 128 * h, 1024, Y + row0 * 2048 + 1024 + 128 * h, 2048, ks, 4, 0.07216878364870322f, c.ldsg, 0.f, 0.f, nullptr, KN + b * 12 + h); }
    for (int v = (vcu + (c.G >> 1)) % c.G; v < NU_DC; v += c.G) { const int b = v >> 3, h = (v >> 1) & 3, hf = v & 1; const long row0 = (long)NLAT + b * CTXL + 128 * hf;
        att::KeySrc ks{0, 0, NLAT + b * CTXL, 0};
        att::attn_unit_sb<1, 0>(PD + row0 * 1536 + 128 * h, 1536, PD + 512 + 128 * h, 1536, nullptr, PD + 1024 + 128 * h, 1536, Y + row0 * 2048 + 1536 + 128 * h, 2048, ks, 4, 0.125f, c.ldsg, lam, 1.f - lam_init, gsub, KN + b * 12 + 4 + 2 * h); }
}
__device__ __forceinline__ void ph_dpost(const Ctx& c) {
    const int l = c.layer; const int M = (l == 0) ? MTOT : NLAT; const int gw = c.bid * 8 + c.wave, NGW = c.G * 8;
    bf16_t* Y = (bf16_t*)(c.ws + WS_Y); const bf16_t* O2 = (const bf16_t*)(c.ws + R_O2);
    const float lam_init = 0.8f - 0.6f * expf(-0.3f * (float)l);
    const float s1 = wave_sum(c.in[I_LQ1][l * 64 + c.lane] * c.in[I_LK1][l * 64 + c.lane]), s2 = wave_sum(c.in[I_LQ2][l * 64 + c.lane] * c.in[I_LK2][l * 64 + c.lane]);
    const float lam = expf(s1) - expf(s2) + lam_init;
    const float g0 = c.in[I_DGSUB][l * 128 + 2 * c.lane], g1 = c.in[I_DGSUB][l * 128 + 2 * c.lane + 1];
    for (int it = gw; it < M * 4; it += NGW) { const int r = it >> 2, h = it & 3;
        unsigned* yp = (unsigned*)(Y + (size_t)r * 2048 + 1536 + 128 * h) + c.lane; const unsigned w1 = *yp, w2 = *((const unsigned*)(O2 + (size_t)r * 512 + 128 * h) + c.lane);
        const float o0 = bflo(w1) - lam * bflo(w2), o1 = bfhi(w1) - lam * bfhi(w2);
        const float rs = rsqrtf(wave_sum(o0 * o0 + o1 * o1) * (1.f / 128.f) + EPS) * (1.f - lam_init);
        *yp = cvt_pk_bf16(o0 * rs * g0, o1 * rs * g1); }
}

__device__ __forceinline__ f32x4 bf4(const u32x2 w) { return (f32x4){bflo(w.x), bfhi(w.x), bflo(w.y), bfhi(w.y)}; }
__device__ __forceinline__ const bf16_t* hmid_row(const Ctx& c, int r) { return r < NLAT ? (const bf16_t*)c.out + (size_t)r * DM : (const bf16_t*)(c.ws + SM_HC) + (size_t)(r - NLAT) * DM; }
__device__ __forceinline__ void ph_post1(const Ctx& c) {
    const int l = c.layer; const int M = (l == 0) ? MTOT : NLAT; const int gw = c.bid * 8 + c.wave, NGW = c.G * 8;
    const bf16_t* yo = (const bf16_t*)(c.ws + R_YOUT); const float* mod = (const float*)(c.ws + SM_MOD) + l * 3 * 6144; bf16_t* HP = (bf16_t*)(c.ws + R_HP);
    f32x4 gpo[4], gpr[4]; { const float* gpost = c.in[I_GMIXPOST] + (size_t)l * DM; const float* gpre = c.in[I_GFFNPRE] + (size_t)l * DM;
#pragma unroll
      for (int j = 0; j < 4; ++j) { gpo[j] = *(const f32x4*)(gpost + 4 * (c.lane + 64 * j)); gpr[j] = *(const f32x4*)(gpre + 4 * (c.lane + 64 * j)); } }
    u32x2 yw[4], ywn[4]; f32x4 hc[4], hn_[4]; u32x2 hb[4], hbn[4];
    if (gw < M) { const u32x2* yr = (const u32x2*)(yo + (size_t)gw * DM) + c.lane;
#pragma unroll
        for (int j = 0; j < 4; ++j) yw[j] = yr[64 * j];
        if (l == 0) { const f32x4* hr = (const f32x4*)hin_row(c, gw) + c.lane;
#pragma unroll
            for (int j = 0; j < 4; ++j) hc[j] = hr[64 * j]; }
        else { const u32x2* hr = (const u32x2*)hmid_row(c, gw) + c.lane;
#pragma unroll
            for (int j = 0; j < 4; ++j) hb[j] = hr[64 * j]; } }
    for (int r = gw; r < M; r += NGW) {
        const float* md = mod + mod_idx(r) * 6144;
        f32x4 gt[4], sh[4], scl[4];
#pragma unroll
        for (int j = 0; j < 4; ++j) { const int e = 4 * (c.lane + 64 * j); gt[j] = *(const f32x4*)(md + 2048 + e); sh[j] = *(const f32x4*)(md + 3072 + e); scl[j] = *(const f32x4*)(md + 4096 + e); }
        { const int rn = r + NGW < M ? r + NGW : r; const u32x2* yr = (const u32x2*)(yo + (size_t)rn * DM) + c.lane;
#pragma unroll
          for (int j = 0; j < 4; ++j) ywn[j] = yr[64 * j];
          if (l == 0) { const f32x4* hr = (const f32x4*)hin_row(c, rn) + c.lane;
#pragma unroll
              for (int j = 0; j < 4; ++j) hn_[j] = hr[64 * j]; }
          else { const u32x2* hr = (const u32x2*)hmid_row(c, rn) + c.lane;
#pragma unroll
              for (int j = 0; j < 4; ++j) hbn[j] = hr[64 * j]; } }
        __builtin_amdgcn_sched_barrier(0);
        f32x4 v[4]; float ss = 0.f;
#pragma unroll
        for (int j = 0; j < 4; ++j) { v[j] = bf4(yw[j]); ss += (v[j].x * v[j].x + v[j].y * v[j].y) + (v[j].z * v[j].z + v[j].w * v[j].w); }
        const float rs = rsqrtf(wave_sum(ss) * (1.f / DM) + EPS);
        float ss2 = 0.f; u32x2* ho = (u32x2*)(HP + (size_t)r * DM) + c.lane;
#pragma unroll
        for (int j = 0; j < 4; ++j) { const f32x4 g = gpo[j]; const f32x4 h0 = (l == 0) ? hc[j] : bf4(hb[j]);
            f32x4 hn; hn.x = h0.x + gt[j].x * (v[j].x * rs * g.x); hn.y = h0.y + gt[j].y * (v[j].y * rs * g.y); hn.z = h0.z + gt[j].z * (v[j].z * rs * g.z); hn.w = h0.w + gt[j].w * (v[j].w * rs * g.w);
            u32x2 w; w.x = cvt_pk_bf16(hn.x, hn.y); w.y = cvt_pk_bf16(hn.z, hn.w); ho[64 * j] = w; v[j] = hn; ss2 += (hn.x * hn.x + hn.y * hn.y) + (hn.z * hn.z + hn.w * hn.w); }
        const float rs2 = rsqrtf(wave_sum(ss2) * (1.f / DM) + EPS);
        f32x4 uu[4];
#pragma unroll
        for (int j = 0; j < 4; ++j) { const f32x4 g = gpr[j];
            uu[j] = (f32x4){v[j].x * rs2 * g.x * (1.f + scl[j].x) + sh[j].x, v[j].y * rs2 * g.y * (1.f + scl[j].y) + sh[j].y, v[j].z * rs2 * g.z * (1.f + scl[j].z) + sh[j].z, v[j].w * rs2 * g.w * (1.f + scl[j].w) + sh[j].w}; }
        quant_row_i8(uu, (signed char*)(c.ws + WS_U) + (size_t)r * DM, (float*)(c.ws + U_SC) + r, c.lane);
#pragma unroll
        for (int j = 0; j < 4; ++j) { yw[j] = ywn[j]; hc[j] = hn_[j]; hb[j] = hbn[j]; }
    }
}
__device__ __forceinline__ void ph_post2(const Ctx& c) {
    const int l = c.layer; const int M = (l == 0) ? MTOT : NLAT; const int gw = c.bid * 8 + c.wave, NGW = c.G * 8;
    const bf16_t* z = (const bf16_t*)(c.ws + WS_Y); const float* mod = (const float*)(c.ws + SM_MOD) + l * 3 * 6144; const bf16_t* HP = (const bf16_t*)(c.ws + R_HP);
    float* wgl = (float*)c.ldsg; if (l == 0) stage_gate_weights(c, 1, wgl);
    f32x4 gpo[4], g4[4]; { const float* gpost = c.in[I_GFFNPOST] + (size_t)l * DM; const float* gpre = c.in[I_GMIXPRE] + (size_t)1 * DM;
#pragma unroll
      for (int j = 0; j < 4; ++j) { gpo[j] = *(const f32x4*)(gpost + 4 * (c.lane + 64 * j)); g4[j] = *(const f32x4*)(gpre + 4 * (c.lane + 64 * j)); } }
    u32x2 zw[4], zwn[4], hb[4], hbn[4];
    if (gw < M) { const u32x2* zr = (const u32x2*)(z + (size_t)gw * DM) + c.lane; const u32x2* hr = (const u32x2*)(HP + (size_t)gw * DM) + c.lane;
#pragma unroll
        for (int j = 0; j < 4; ++j) { zw[j] = zr[64 * j]; hb[j] = hr[64 * j]; } }
    for (int r = gw; r < M; r += NGW) {
        const float* md = mod + mod_idx(r) * 6144;
        f32x4 gt[4]; N1Vec nv;
#pragma unroll
        for (int j = 0; j < 4; ++j) gt[j] = *(const f32x4*)(md + 5120 + 4 * (c.lane + 64 * j));
        if (l == 0) norm1_load(c, 1, r, nv);
        { const int rn = r + NGW < M ? r + NGW : r; const u32x2* zr = (const u32x2*)(z + (size_t)rn * DM) + c.lane; const u32x2* hr = (const u32x2*)(HP + (size_t)rn * DM) + c.lane;
#pragma unroll
          for (int j = 0; j < 4; ++j) { zwn[j] = zr[64 * j]; hbn[j] = hr[64 * j]; } }
        __builtin_amdgcn_sched_barrier(0);
        f32x4 v[4]; float ss = 0.f;
#pragma unroll
        for (int j = 0; j < 4; ++j) { v[j] = bf4(zw[j]); ss += (v[j].x * v[j].x + v[j].y * v[j].y) + (v[j].z * v[j].z + v[j].w * v[j].w); }
        const float rs = rsqrtf(wave_sum(ss) * (1.f / DM) + EPS);
#pragma unroll
        for (int j = 0; j < 4; ++j) { const f32x4 g = gpo[j]; f32x4 h0 = bf4(hb[j]);
            h0.x += gt[j].x * (v[j].x * rs * g.x); h0.y += gt[j].y * (v[j].y * rs * g.y); h0.z += gt[j].z * (v[j].z * rs * g.z); h0.w += gt[j].w * (v[j].w * rs * g.w);
            if (l == 0) { u32x2 w; w.x = cvt_pk_bf16(h0.x, h0.y); w.y = cvt_pk_bf16(h0.z, h0.w); ((u32x2*)const_cast<bf16_t*>(hmid_row(c, r)))[c.lane + 64 * j] = w; }
            else ((f32x4*)(c.out + (size_t)r * DM))[c.lane + 64 * j] = h0;
            v[j] = h0; }
        if (l == 0) norm1_apply(c, 1, r, v, wgl, g4, nv);
#pragma unroll
        for (int j = 0; j < 4; ++j) { zw[j] = zwn[j]; hb[j] = hbn[j]; }
    }
}

template <int WHICH> struct EpiRope {
    static constexpr bool PERM = false;
    bf16_t* O; int ldc; const float* T;
    bf16_t* O2; int ldc2; bf16_t* CKR; float* SSQ;
    __device__ __forceinline__ void operator()(const f32x4 (&acc)[2][2][4][2], const pg8::Unit& u, int wr, int wc, int fr, int fq) const {
        const int row0 = u.pm * 256 + wr * 64 + fr; const bool lat = u.pm < NLAT / 256;
        bool en[2]; bf16_t* dstb[2]; size_t dld[2];
#pragma unroll
        for (int bj = 0; bj < 2; ++bj) { const int g = u.pn * 8 + bj * 4 + wc;
            if constexpr (WHICH == 0) { en[bj] = g < 20; dstb[bj] = O + g * 32; dld[bj] = (size_t)ldc; }
            if constexpr (WHICH == 1) { if (u.pn < 4) { en[bj] = (g == 24 || g == 25); dstb[bj] = en[bj] ? CKR + (g - 24) * 32 : O + g * 32; dld[bj] = en[bj] ? (size_t)64 : (size_t)ldc; }
                                        else { const int gl = g - 32; en[bj] = gl < 32; dstb[bj] = O2 + gl * 32; dld[bj] = (size_t)ldc2; } }
            if constexpr (WHICH == 2) { const int gi = g % 6; en[bj] = gi >= 4; dstb[bj] = O + g * 32; dld[bj] = (size_t)ldc; }
            en[bj] = en[bj] && lat; }
        const bool any = en[0] || en[1]; const bool usepc = (wc & 1) != 0;
#pragma unroll
        for (int ai = 0; ai < 2; ++ai) {
            float rsc[4] = {1.f, 1.f, 1.f, 1.f};
            if constexpr (WHICH == 2) {
#pragma unroll
                for (int mh = 0; mh < 2; ++mh) { f32x4 s0[2], s1[2];
#pragma unroll
                    for (int m = 0; m < 2; ++m) { const size_t row = (size_t)(row0 + ai * 128 + (2 * mh + m) * 16); s0[m] = *(const f32x4*)(SSQ + row * 12); s1[m] = *(const f32x4*)(SSQ + row * 12 + 4); }
                    __builtin_amdgcn_sched_barrier(0);
#pragma unroll
                    for (int m = 0; m < 2; ++m) rsc[2 * mh + m] = rsqrtf(((s0[m].x + s0[m].y) + (s0[m].z + s0[m].w) + (s1[m].x + s1[m].y) + (s1[m].z + s1[m].w)) * (1.f / 512.f) + EPS);
                    __builtin_amdgcn_sched_barrier(0); }
            }
            f32x4 c0[4], c1[4];
            if (any) {
#pragma unroll
                for (int m = 0; m < 4; ++m) { const int t = (row0 + ai * 128 + m * 16) & (SEQ - 1); const int pos = usepc ? (t & 63) : (t >> 6); const float* tp = T + (size_t)(pos * 16 + 4 * fq) * 2;
                    c0[m] = *(const f32x4*)tp; c1[m] = *(const f32x4*)(tp + 4); }
            } else {
#pragma unroll
                for (int m = 0; m < 4; ++m) { c0[m] = (f32x4){1.f, 0.f, 1.f, 0.f}; c1[m] = (f32x4){1.f, 0.f, 1.f, 0.f}; } }
            __builtin_amdgcn_sched_barrier(0);
#pragma unroll
            for (int m = 0; m < 4; ++m) { const int row = row0 + ai * 128 + m * 16;
                const f32x4 cs = (f32x4){c0[m].x, c0[m].z, c1[m].x, c1[m].z}, sn = (f32x4){c0[m].y, c0[m].w, c1[m].y, c1[m].w};
                float part = 0.f;
#pragma unroll
                for (int bj = 0; bj < 2; ++bj) { bf16_t* dst = dstb[bj] + (size_t)row * dld[bj];
                    f32x4 x1 = acc[ai][bj][m][0], x2 = acc[ai][bj][m][1];
                    if constexpr (WHICH == 1) part += (x1.x * x1.x + x1.y * x1.y) + (x1.z * x1.z + x1.w * x1.w) + (x2.x * x2.x + x2.y * x2.y) + (x2.z * x2.z + x2.w * x2.w);
                    if constexpr (WHICH == 2) { x1 = x1 * rsc[m]; x2 = x2 * rsc[m]; }
                    if (en[bj]) { const f32x4 o1 = x1 * cs - x2 * sn, o2 = x2 * cs + x1 * sn; x1 = o1; x2 = o2; }
                    u32x2 w1, w2; w1.x = cvt_pk_bf16(x1.x, x1.y); w1.y = cvt_pk_bf16(x1.z, x1.w); w2.x = cvt_pk_bf16(x2.x, x2.y); w2.y = cvt_pk_bf16(x2.z, x2.w);
                    *(u32x2*)(dst + 4 * fq) = w1; *(u32x2*)(dst + 16 + 4 * fq) = w2; }
                if constexpr (WHICH == 1) { if (u.pn < 3) { part += __shfl_xor(part, 16); part += __shfl_xor(part, 32); if (fq == 0) SSQ[(size_t)row * 12 + u.pn * 4 + wc] = part; } }
            }
        }
    }
};
struct EpiRowScale {
    static constexpr bool PERM = true;
    bf16_t* O; int ldc; const float* SSQ;
    __device__ __forceinline__ void operator()(const f32x4 (&acc)[2][2][4][2], const pg8::Unit& u, int wr, int wc, int fr, int fq) const {
        const int row0 = u.pm * 256 + wr * 64 + fr, col0 = u.pn * 256 + wc * 32 + 8 * fq;
#pragma unroll
        for (int ai = 0; ai < 2; ++ai)
#pragma unroll
            for (int m = 0; m < 4; ++m) { const size_t r = (size_t)(row0 + ai * 128 + m * 16); const f32x4 s = *(const f32x4*)(SSQ + r * 12 + 8);
                const float rsc = rsqrtf(((s.x + s.y) + (s.z + s.w)) * (1.f / 256.f) + EPS); bf16_t* rowp = O + r * ldc + col0;
#pragma unroll
                for (int bj = 0; bj < 2; ++bj) { const f32x4 v0 = acc[ai][bj][m][0] * rsc, v1 = acc[ai][bj][m][1] * rsc;
                    u32x4 w; w.x = cvt_pk_bf16(v0[0], v0[1]); w.y = cvt_pk_bf16(v0[2], v0[3]); w.z = cvt_pk_bf16(v1[0], v1[1]); w.w = cvt_pk_bf16(v1[2], v1[3]);
                    *(u32x4*)(rowp + bj * 128) = w; }
                asm volatile("" ::: "memory"); }
    }
};

#define XB_TMO      128
#define XB_XCNT(j)  (256  + 64 * (j))
#define XB_XSUB(j)  (1280 + 64 * (j))
#define XB_XGEN(j)  (2304 + 64 * (j))
#define XB_TOP      3328
#define XB_TOPGEN   3392
#define XCD_BAR_WORDS 3456
#define XB_SPIN_CAP (1u << 18)

__device__ __forceinline__ unsigned xb_ld(unsigned* p)              { return __hip_atomic_load(p, __ATOMIC_RELAXED, __HIP_MEMORY_SCOPE_AGENT); }
__device__ __forceinline__ unsigned xb_add(unsigned* p, unsigned v) { return __hip_atomic_fetch_add(p, v, __ATOMIC_RELAXED, __HIP_MEMORY_SCOPE_AGENT); }
__device__ __forceinline__ unsigned xb_xcc_id() { return (unsigned)__builtin_amdgcn_s_getreg((3 << 11) | 20) & 0xFu; }
#define XB_SPIN(cond, bar) do { unsigned _sp = 0; while (cond) { __builtin_amdgcn_s_sleep(1); \
    if ((++_sp & 255u) == 0u) { if (xb_ld(&(bar)[XB_TMO])) break; if (_sp > XB_SPIN_CAP) { atomicAdd(&(bar)[XB_TMO], 1u); break; } } } } while (0)

struct XcdBarrier {
    unsigned* bar; unsigned x;
    volatile LAS unsigned* st;
};

__device__ __forceinline__ XcdBarrier xcd_barrier_post(unsigned* bar, volatile LAS unsigned* st) {
    XcdBarrier b; b.bar = bar; b.x = xb_xcc_id(); b.st = st;
    if (threadIdx.x == 0) (void)xb_add(&bar[XB_XCNT(b.x)], 1u);
    return b;
}
__device__ __forceinline__ void xcd_barrier_complete(unsigned* bar, unsigned x, unsigned& nloc, unsigned& nx) {
    const unsigned G = gridDim.x * gridDim.y * gridDim.z;
    unsigned sum, cnt, mine, sp = 0u;
    for (;;) {
        sum = 0u; cnt = 0u; mine = 0u;
#pragma unroll
        for (unsigned j = 0; j < 16; ++j) { const unsigned c = xb_ld(&bar[XB_XCNT(j)]); sum += c; cnt += (c > 0u) ? 1u : 0u; mine = (j == x) ? c : mine; }
        if (sum == G) break;
        __builtin_amdgcn_s_sleep(1);
        if ((++sp & 255u) == 0u) { if (xb_ld(&bar[XB_TMO])) break; if (sp > XB_SPIN_CAP) { atomicAdd(&bar[XB_TMO], 1u); break; } }
    }
    nloc = mine > 0u ? mine : 1u; nx = cnt > 0u ? cnt : 1u;
}

__device__ __forceinline__ void xcd_barrier(const XcdBarrier& b) {
    asm volatile("s_waitcnt vmcnt(0)" ::: "memory");
    __syncthreads();
    if (threadIdx.x == 0) {
        unsigned* bar = b.bar;
        __builtin_amdgcn_s_waitcnt(0);
        unsigned nloc = b.st[0], nx = b.st[1];
        if (nloc == 0u) { xcd_barrier_complete(bar, b.x, nloc, nx); b.st[0] = nloc; b.st[1] = nx; }
        const unsigned old = xb_add(&bar[XB_XSUB(b.x)], 1u);
        const unsigned gen = old / nloc;
        if (old + 1u == (gen + 1u) * nloc) {
            __builtin_amdgcn_fence(__ATOMIC_RELEASE, "agent");
            asm volatile("s_waitcnt vmcnt(0)" ::: "memory");
            const unsigned og = xb_add(&bar[XB_TOP], 1u);
            const unsigned tg = og / nx;
            if (og + 1u == (tg + 1u) * nx) xb_add(&bar[XB_TOPGEN], 1u);
            else XB_SPIN(xb_ld(&bar[XB_TOPGEN]) == tg, bar);
            __builtin_amdgcn_fence(__ATOMIC_ACQUIRE, "agent");
            xb_add(&bar[XB_XGEN(b.x)], 1u);
            asm volatile("s_waitcnt vmcnt(0)" ::: "memory");
        } else {
            XB_SPIN(xb_ld(&bar[XB_XGEN(b.x)]) == gen, bar);
            __builtin_amdgcn_fence(__ATOMIC_ACQUIRE, "agent");
            asm volatile("s_waitcnt vmcnt(0)" ::: "memory");
        }
    }
    __syncthreads();
}


template <class Epi>
__device__ __forceinline__ void run_gemm(const Ctx& c, const bf16_t* A, int lda, const bf16_t* Bt, int ldb, int M, int N, int K, const Epi& E, int cofs = 0) {
    pg8::Gemm g{A, Bt, M, N, K, lda, ldb}; pg8::StaticOrder S; S.init(M, N, c.G, (c.bid + cofs) % c.G);
    pg8::gemm_phase<Epi, pg8::StaticOrder, true>(c.lds, g, S, E);
}
template <class Epi>
__device__ __forceinline__ void run_gemm_i8(const Ctx& c, const unsigned char* A8, const float* sa, const unsigned char* Bt8, const float* sb, int M, int N, const Epi& E) {
    pg8::Gemm g{(const bf16_t*)A8, (const bf16_t*)Bt8, M, N, 512, 512, 512, 0, sa, sb}; pg8::StaticOrder S; S.init(M, N, c.G, c.bid);
    pg8::gemm_phase<Epi, pg8::StaticOrder, true, true>(c.lds, g, S, E);
}
enum Phase { PH_CONV = 0, PH_NORM1, PH_GEMM_AB, PH_MIX_AB1, PH_SCAN, PH_MLSTM_C, PH_GEMM_CD, PH_MLA_UP, PH_KNORM, PH_ATTN,
             PH_GATES, PH_BRANCH, PH_OUT, PH_POST1, PH_FFN_UP, PH_FFN_DN, PH_POST2, N_PHASES };

template <int PH>
__device__ __forceinline__ void run_phase(const Ctx& c) {
    unsigned char* ws = c.ws; const int Mrows = (c.layer == 0) ? MTOT : NLAT;
    bf16_t* U = (bf16_t*)(ws + WS_U); bf16_t* Y = (bf16_t*)(ws + WS_Y);
    if constexpr (PH == PH_CONV) { if (c.layer == 0) ph_conv(c, 0, c.bid, c.G, 3, true); }
    if constexpr (PH == PH_NORM1) { if (c.layer == 0) ph_norm1(c); }
    constexpr int CD_SPN = 3; const bool g256 = c.G == 256; const int ab_rem = g256 ? 134 : 0, cd_nskip = g256 ? 106 : 0;
    if constexpr (PH == PH_GEMM_AB) { { pg8::EpiB<pg8::EM_BF16> E{(bf16_t*)(ws + R_PAB) + 768, 2816, nullptr, 0, 0, 0}; run_gemm(c, U, 1024, (const bf16_t*)(ws + W_AB), 1024, MTOT, 1024, 1024, E, g256 ? 16 : 0); }
        { EpiRope<0> E{(bf16_t*)(ws + R_PAB), 2816, (const float*)(ws + SM_ROPE), nullptr, 0, nullptr, nullptr};
          run_gemm_i8(c, (const unsigned char*)c.out + OUT_U8, (const float*)((const unsigned char*)c.out + OUT_U8SC), ws + W_AB8, (const float*)(ws + SC_AB), MTOT, 768, E); }
        { pg8::EpiB<pg8::EM_BF16> E{(bf16_t*)(ws + R_PAB) + 1792, 2816, nullptr, 0, 0, 0};
          pg8::Gemm g{(const bf16_t*)((const unsigned char*)c.out + OUT_U8), (const bf16_t*)(ws + W_AB8 + (size_t)768 * 1024), MTOT, 1024, 512, 512, 512, 0, (const float*)((const unsigned char*)c.out + OUT_U8SC), (const float*)(ws + SC_AB) + 768};
          pg8::StaticOrder S; S.init(MTOT, 1024, c.G, (c.bid + (g256 ? 8 : 0)) % c.G);
          pg8::gemm_phase<pg8::EpiB<pg8::EM_BF16>, pg8::StaticOrder, true, true>(c.lds, g, S, E); }
        if (cd_nskip > 0) { EpiRope<1> E{Y + 1024, 2048, (const float*)(ws + SM_ROPE), (bf16_t*)(ws + R_PD), 1536, (bf16_t*)(ws + R_CKR), (float*)(ws + R_SSQ)};
            pg8::Gemm g{(const bf16_t*)((const unsigned char*)c.out + OUT_U8), (const bf16_t*)(ws + W_C), MTOT, 2560, 512, 512, 512, 0, (const float*)((const unsigned char*)c.out + OUT_U8SC), (const float*)(ws + SC_CD)}; pg8::ColOrder S; S.init(c.bid, ab_rem, cd_nskip, CD_SPN);
            pg8::gemm_phase<EpiRope<1>, pg8::ColOrder, true, true>(c.lds, g, S, E); } }
    if constexpr (PH == PH_MIX_AB1) ph_mix_ab1(c);
    if constexpr (PH == PH_SCAN) ph_scan(c);
    if constexpr (PH == PH_MLSTM_C) ph_mlstm_c(c);
    if constexpr (PH == PH_GEMM_CD) {
        static_assert(W_D == W_C + (size_t)1024 * 1024 * 2, "W_c and W_d are contiguous: one GEMM of N = 2560");
        { EpiRope<1> E{Y + 1024, 2048, (const float*)(ws + SM_ROPE), (bf16_t*)(ws + R_PD), 1536, (bf16_t*)(ws + R_CKR), (float*)(ws + R_SSQ)};
          pg8::Gemm g{(const bf16_t*)((const unsigned char*)c.out + OUT_U8), (const bf16_t*)(ws + W_C), MTOT, 2560, 512, 512, 512, 0, (const float*)((const unsigned char*)c.out + OUT_U8SC), (const float*)(ws + SC_CD)}; pg8::SkipOrder S; S.init(MTOT, 2560, c.G, c.bid, CD_SPN, cd_nskip);
          pg8::gemm_phase<EpiRope<1>, pg8::SkipOrder, true, true>(c.lds, g, S, E); }
    }
    if constexpr (PH == PH_MLA_UP) {
        { EpiRope<2> E{(bf16_t*)(ws + R_CQ), 768, (const float*)(ws + SM_ROPE), nullptr, 0, nullptr, (float*)(ws + R_SSQ)}; run_gemm(c, Y + 1024, 2048, (const bf16_t*)(ws + W_UQ), 512, MTOT, 768, 512, E); }
        { EpiRowScale E{(bf16_t*)(ws + R_CKNV), 1024, (const float*)(ws + R_SSQ)}; run_gemm(c, Y + 1024 + 512, 2048, (const bf16_t*)(ws + W_UKV), 256, MTOT, 1024, 256, E, c.G > 136 ? c.G - 136 : 0); }
    }
    if constexpr (PH == PH_KNORM) ph_knorm(c);
    if constexpr (PH == PH_ATTN) ph_attn(c);
    if constexpr (PH == PH_GATES) { pg8::EpiB<pg8::EM_SIG8> E{(bf16_t*)(ws + R_G), 4096, nullptr, 0, 0, 0}; run_gemm_i8(c, (const unsigned char*)c.out + OUT_U8, (const float*)((const unsigned char*)c.out + OUT_U8SC), ws + W_G, (const float*)(ws + SC_G), Mrows, 4096, E); }
    if constexpr (PH == PH_BRANCH) {
        pg8::EpiB<pg8::EM_GATEACC> E{U, 1024, (const bf16_t*)(ws + R_G), 4096, 1024, 0};
        pg8::Gemm g{Y, (const bf16_t*)(ws + W_BR), Mrows, 1024, 512, 2048, 2048, 1024}; pg8::SliceOrder<4> S; S.init(Mrows, 1024, c.G, c.bid);
        pg8::gemm_phase<pg8::EpiB<pg8::EM_GATEACC>, pg8::SliceOrder<4>, true>(c.lds, g, S, E);
    }
    if constexpr (PH == PH_OUT) { pg8::EpiB<pg8::EM_BF16> E{(bf16_t*)(ws + R_YOUT), 1024, nullptr, 0, 0, 0}; run_gemm(c, U, 1024, (const bf16_t*)(ws + W_OUT), 1024, Mrows, 1024, 1024, E); }
    if constexpr (PH == PH_POST1) ph_post1(c);
    if constexpr (PH == PH_FFN_UP) { pg8::EpiB<pg8::EM_SWIGLU> E{(bf16_t*)(ws + R_HID), 2816, nullptr, 0, 0, 0}; run_gemm_i8(c, ws + WS_U, (const float*)(ws + U_SC), ws + W_GU, (const float*)(ws + SC_GU), Mrows, 5632, E); }
    if constexpr (PH == PH_FFN_DN) { pg8::EpiB<pg8::EM_BF16> E{(bf16_t*)(ws + WS_Y), 1024, nullptr, 0, 0, 0}; run_gemm(c, (const bf16_t*)(ws + R_HID), 2816, (const bf16_t*)(ws + W_DN), 2816, Mrows, 1024, 2816, E);
        if (c.layer == 0) { const int nwg = (Mrows / 256) * 4, nx = nwg % c.G, skip = (2 * nx < c.G) ? nx : 0;
            if (c.bid >= skip) ph_conv(c, 1, c.bid - skip, c.G - skip, 1, false); } }
    if constexpr (PH == PH_POST2) { ph_post2(c); if (c.layer == 0) { __syncthreads(); ph_conv(c, 1, c.bid, c.G, 2, false); } }
}

__device__ __forceinline__ Ctx make_ctx(const Args& args, unsigned char* lds, int layer) {
    typedef const __attribute__((address_space(4))) Args* KArgsP;
    KArgsP ka = (KArgsP)__builtin_amdgcn_kernarg_segment_ptr();
    asm volatile("" : "+s"(ka));
    Ctx c; c.in = (InTab)ka->in; c.out = ka->out; c.ws = ka->ws; c.layer = layer;
    c.lds = (LAS unsigned char*)lds; c.ldsg = (char*)lds;
    c.tid = ltid(); c.lane = c.tid & 63; c.wave = __builtin_amdgcn_readfirstlane(c.tid >> 6); c.G = gridDim.x; c.bid = blockIdx.x;
    return c;
}
template <int PH>
__global__ void __launch_bounds__(512, 2) k_phase(Args args) {
    extern __shared__ __attribute__((aligned(16))) unsigned char lds[];
    const Ctx c = make_ctx(args, lds, args.layer);
    run_phase<PH>(c);
}


#ifndef MK_FUSED
#define MK_FUSED 1
#endif
constexpr int CW_BAR = 4096;
constexpr int LDS_BARW = LDS_BYTES - 64;

__device__ __forceinline__ void grid_bar(const Args& args, unsigned char* lds) {
    typedef const __attribute__((address_space(4))) Args* KArgsP;
    KArgsP ka = (KArgsP)__builtin_amdgcn_kernarg_segment_ptr(); asm volatile("" : "+s"(ka));
    unsigned char* wsb = ka->ws;
    XcdBarrier b; b.bar = (unsigned*)(wsb + WS_CTL) + CW_BAR; b.x = xb_xcc_id(); b.st = (volatile LAS unsigned*)((LAS unsigned char*)lds + LDS_BARW);
    xcd_barrier(b);
}
template <int PH, int PEND>
__device__ __forceinline__ void run_range(const Args& args, unsigned char* lds, int layer, bool last_barrier) {
    if constexpr (PH < PEND) {
        { const Ctx cc = make_ctx(args, lds, layer); run_phase<PH>(cc); }
#ifdef PROBE_DOUBLE
        if constexpr (((PROBE_DOUBLE) >> PH) & 1) { grid_bar(args, lds); const Ctx cc = make_ctx(args, lds, layer); run_phase<PH>(cc); }
#endif
        if ((PH + 1 < PEND || last_barrier) && !((PH == PH_NORM1 || PH == PH_CONV) && layer == 1)) grid_bar(args, lds);
        run_range<PH + 1, PEND>(args, lds, layer, last_barrier);
    }
}
__global__ void __launch_bounds__(512, 2) k_fused(Args args) {
    extern __shared__ __attribute__((aligned(16))) unsigned char lds[];
    { volatile LAS unsigned* st = (volatile LAS unsigned*)((LAS unsigned char*)lds + LDS_BARW);
      if (threadIdx.x < 4) st[threadIdx.x] = 0u;
      __syncthreads();
      (void)xcd_barrier_post((unsigned*)(args.ws + WS_CTL) + CW_BAR, st); }
    run_range<0, N_PHASES>(args, lds, 0, true);
    run_range<0, N_PHASES>(args, lds, 1, false);
}

template <int PH> static void launch_phase(const Args& a, int grid, hipStream_t stream) {
    static bool attr_set = false;
    if (!attr_set) { (void)hipFuncSetAttribute((const void*)k_phase<PH>, hipFuncAttributeMaxDynamicSharedMemorySize, LDS_BYTES); attr_set = true; }
    hipLaunchKernelGGL(k_phase<PH>, dim3(grid), dim3(512), LDS_BYTES, stream, a);
}
template <int PH> static void launch_all(Args& a, int grid, hipStream_t stream) {
    if constexpr (PH < N_PHASES) { launch_phase<PH>(a, grid, stream); launch_all<PH + 1>(a, grid, stream); }
}

extern "C" void kernel_launch(void* const* d_in, const int* in_sizes, int n_in, void* d_out, int out_size, void* d_ws, size_t ws_size, hipStream_t stream) {
    static int grid = 0;
    if (grid == 0) {
        if (n_in != N_IN || out_size != NLAT * DM || ws_size < WS_END) { fprintf(stderr, "kernel_launch: unexpected shapes: n_in %d out %d ws %zu\n", n_in, out_size, ws_size); grid = -1; return; }
        int dev = 0, cus = 0, per_cu = 0;
        if (hipGetDevice(&dev) != hipSuccess || hipDeviceGetAttribute(&cus, hipDeviceAttributeMultiprocessorCount, dev) != hipSuccess) { grid = -1; return; }
#if MK_FUSED
        if (hipFuncSetAttribute((const void*)k_fused, hipFuncAttributeMaxDynamicSharedMemorySize, LDS_BYTES) != hipSuccess) { fprintf(stderr, "kernel_launch: hipFuncSetAttribute failed\n"); grid = -1; return; }
        if (hipOccupancyMaxActiveBlocksPerMultiprocessor(&per_cu, (const void*)k_fused, 512, LDS_BYTES) != hipSuccess || per_cu < 1) fprintf(stderr, "kernel_launch: occupancy query says %d blocks per CU\n", per_cu);
        (void)hipGetLastError();
#endif
        grid = cus;
    }
    if (grid < 0) return;
    (void)hipMemsetAsync((char*)d_ws + WS_CTL, 0, CTL_ZERO_BYTES, stream);
    Args a{};
    for (int i = 0; i < N_IN; ++i) a.in[i] = (const float*)d_in[i];
    a.out = (float*)d_out; a.ws = (unsigned char*)d_ws; a.layer = 0; a.pad = 0;
#if MK_FUSED
    hipLaunchKernelGGL(k_fused, dim3(grid), dim3(512), LDS_BYTES, stream, a);
#else
    for (int l = 0; l < 2; ++l) { a.layer = l; launch_all<0>(a, grid, stream); }
#endif
}
```
